# Optimizing an MI355X kernel written in HIP

```python
import math
import jax, jax.numpy as jnp
from jax import lax
import numpy as np

D_MODEL = 1024
BATCH = 4
SEQ = 4096
DEPTH = 1

GRID_W = 64
CTX_LEN = 256
SSD_HEADS = 8
SSD_HEAD_DIM = 64
SSD_INNER = SSD_HEADS * SSD_HEAD_DIM
SSD_STATE = 64
SSD_GROUPS = 2
SSD_CONV = 5
SSD_XBC = SSD_INNER + 2 * SSD_GROUPS * SSD_STATE
SSD_COLS = SSD_INNER + SSD_XBC + 2 * SSD_HEADS
HG_HEADS = 4
HG_DK = 128
HG_DV = 128
HG_INNER = HG_HEADS * HG_DV
HG_COLS = 5 * HG_INNER
D_MIX = SSD_INNER + HG_INNER
IN_COLS = SSD_COLS + HG_COLS
CHUNK = 64
N_EXPERTS = 32
TOP_K = 4
D_FF = D_MODEL
SWIGLU_ALPHA = 1.702
SWIGLU_LIMIT = 7.0
MOE_BLOCK = 128
EPS = 1e-6

kernel_name = 'hybrid_ssd_hgrn2_moe_diffusion_block'


def rmsnorm(x, w):
    xf = x.astype(jnp.float32)
    y = xf * lax.rsqrt(jnp.mean(xf * xf, axis=-1, keepdims=True) + EPS)
    return (y * w.astype(jnp.float32)).astype(x.dtype)


def modulate(h, shift, scale):
    return h * (1 + scale) + shift


def centred_dwconv(x, w, b):
    pad = SSD_CONV // 2
    y = lax.conv_general_dilated(x, w[:, None, :].astype(x.dtype), window_strides=(1,),
                                 padding=[(pad, pad)], dimension_numbers=('NWC', 'WIO', 'NWC'),
                                 feature_group_count=x.shape[-1])
    return y + b


def chunked_scan(q, k, v, log_a, s0):
    bsz, t_len, n_h, _ = q.shape
    n_chunks = t_len // CHUNK
    scalar_decay = log_a.shape[-1] == 1
    causal = jnp.tril(jnp.ones((CHUNK, CHUNK), dtype=bool))[None, None, :, :, None]

    def to_chunks(a):
        a = a.astype(jnp.float32).reshape(bsz, n_chunks, CHUNK, n_h, a.shape[-1])
        return jnp.moveaxis(a, 1, 0)

    def step(s, blk):
        qc, kc, vc, lac = blk
        g = jnp.cumsum(lac, axis=1)
        gh = jnp.swapaxes(g, 1, 2)
        decay = jnp.exp(jnp.where(causal, gh[:, :, :, None, :] - gh[:, :, None, :, :], -jnp.inf))
        if scalar_decay:
            scores = jnp.einsum('bihk,bjhk->bhij', qc, kc) * decay[..., 0]
        else:
            scores = jnp.einsum('bihk,bjhk,bhijk->bhij', qc, kc, decay)
        o = jnp.einsum('bhij,bjhv->bihv', scores, vc) + jnp.einsum('bihk,bhkv->bihv', qc * jnp.exp(g), s)
        g_last = g[:, -1]
        s = jnp.exp(g_last)[..., None] * s + jnp.einsum('bjhk,bjhv->bhkv', kc * jnp.exp(g_last[:, None] - g), vc)
        return s, o

    s_fin, o = lax.scan(step, s0.astype(jnp.float32),
                        (to_chunks(q), to_chunks(k), to_chunks(v), to_chunks(log_a)))
    o = jnp.moveaxis(o, 0, 1).reshape(bsz, t_len, n_h, v.shape[-1])
    return o.astype(v.dtype), s_fin


def bidir_scan(q, k_f, k_b, v, la_f, la_b, s0_f, s0_b):
    rev = lambda a: jnp.flip(a, axis=1)
    o_f, s_f = chunked_scan(q, k_f, v, la_f, s0_f)
    o_b, s_b = chunked_scan(rev(q), rev(k_b), rev(v), rev(la_b), s0_b)
    return o_f + rev(o_b), s_f, s_b


def ssd_branch(u, conv_w, conv_b, dt_bias, a_log, d_skip, norm_w, s0_f, s0_b, need_out):
    bsz, t_len, _ = u.shape
    z = u[..., :SSD_INNER]
    xbc = jax.nn.silu(centred_dwconv(u[..., SSD_INNER:SSD_INNER + SSD_XBC], conv_w, conv_b))
    dt_raw = u[..., SSD_INNER + SSD_XBC:]
    xs = xbc[..., :SSD_INNER].reshape(bsz, t_len, SSD_HEADS, SSD_HEAD_DIM)
    rep = SSD_HEADS // SSD_GROUPS
    gn = SSD_GROUPS * SSD_STATE
    b_mat = jnp.repeat(xbc[..., SSD_INNER:SSD_INNER + gn].reshape(bsz, t_len, SSD_GROUPS, SSD_STATE), rep, axis=2)
    c_mat = jnp.repeat(xbc[..., SSD_INNER + gn:].reshape(bsz, t_len, SSD_GROUPS, SSD_STATE), rep, axis=2)
    dt = jax.nn.softplus(dt_raw.astype(jnp.float32).reshape(bsz, t_len, 2, SSD_HEADS) + dt_bias)
    log_a = dt * (-jnp.exp(a_log.astype(jnp.float32)))
    y, s_f, s_b = bidir_scan(c_mat, b_mat * dt[:, :, 0, :, None], b_mat * dt[:, :, 1, :, None], xs,
                             log_a[:, :, 0, :, None], log_a[:, :, 1, :, None], s0_f, s0_b)
    if not need_out:
        return None, s_f, s_b
    y = (y + d_skip[:, None] * xs).reshape(bsz, t_len, SSD_INNER)
    return rmsnorm(y * jax.nn.silu(z), norm_w), s_f, s_b


def hgrn_branch(u, lb_f, lb_b, norm_w, s0_f, s0_b, need_out):
    bsz, t_len, _ = u.shape
    q, f_raw_f, f_raw_b, i, g = jnp.split(u, 5, axis=-1)
    shape4 = (bsz, t_len, HG_HEADS, HG_DK)
    q = (jax.nn.silu(q) * HG_DK ** -0.5).reshape(shape4)

    def forget(f_raw, lb):
        return (lb + (1 - lb) * jax.nn.sigmoid(f_raw.astype(jnp.float32))).reshape(shape4)

    f_f = forget(f_raw_f, lb_f)
    f_b = forget(f_raw_b, lb_b)
    o, s_f, s_b = bidir_scan(q, 1 - f_f, 1 - f_b, i.reshape(bsz, t_len, HG_HEADS, HG_DV),
                             jnp.log(f_f), jnp.log(f_b), s0_f, s0_b)
    if not need_out:
        return None, s_f, s_b
    o = rmsnorm(o, norm_w.reshape(HG_HEADS, HG_DV)).reshape(bsz, t_len, HG_INNER)
    return o * jax.nn.silu(g), s_f, s_b


def to_col_major(a):
    bsz, t_len, ch = a.shape
    rows = t_len // GRID_W
    return a.reshape(bsz, rows, GRID_W, ch).transpose(0, 2, 1, 3).reshape(bsz, t_len, ch)


def from_col_major(a):
    bsz, t_len, ch = a.shape
    rows = t_len // GRID_W
    return a.reshape(bsz, GRID_W, rows, ch).transpose(0, 2, 1, 3).reshape(bsz, t_len, ch)


def moe_ffn(h, router_w, router_b, w1, b1, w2, b2):
    n_tok, d = h.shape
    n_pairs = n_tok * TOP_K
    logits = h.astype(jnp.float32) @ router_w.astype(jnp.float32) + router_b.astype(jnp.float32)
    top_v, top_i = lax.top_k(logits, TOP_K)
    gates = jax.nn.softmax(top_v, axis=-1)
    flat_e = top_i.reshape(-1)
    flat_tok = jnp.arange(n_pairs) // TOP_K
    order = jnp.argsort(flat_e)
    e_sorted, tok_sorted, w_sorted = flat_e[order], flat_tok[order], gates.reshape(-1)[order]
    counts = jnp.bincount(flat_e, length=N_EXPERTS)
    start = jnp.cumsum(counts) - counts
    padded = (counts + MOE_BLOCK - 1) // MOE_BLOCK * MOE_BLOCK
    pend = jnp.cumsum(padded)
    pstart = pend - padded
    dest = pstart[e_sorted] + jnp.arange(n_pairs) - start[e_sorted]
    n_blocks = (n_pairs + N_EXPERTS * (MOE_BLOCK - 1) + MOE_BLOCK - 1) // MOE_BLOCK
    xbuf = jnp.zeros((n_blocks * MOE_BLOCK, d), h.dtype).at[dest].set(h[tok_sorted])
    block_e = jnp.clip(jnp.searchsorted(pend, jnp.arange(n_blocks) * MOE_BLOCK, side='right'), 0, N_EXPERTS - 1)

    def expert_block(args):
        xb, e = args
        u = xb @ w1[e] + b1[e]
        glu = jnp.minimum(u[:, ::2], SWIGLU_LIMIT)
        lin = jnp.clip(u[:, 1::2], -SWIGLU_LIMIT, SWIGLU_LIMIT)
        return (glu * jax.nn.sigmoid(SWIGLU_ALPHA * glu) * (lin + 1)) @ w2[e] + b2[e]

    ybuf = lax.map(expert_block, (xbuf.reshape(n_blocks, MOE_BLOCK, d), block_e)).reshape(-1, d)
    y_pairs = ybuf[dest] * w_sorted[:, None].astype(h.dtype)
    return jax.ops.segment_sum(y_pairs, tok_sorted, num_segments=n_tok)


def setup_inputs(seed: int = 0) -> dict:
    key = jax.random.key(seed)
    ks = jax.random.split(key, 26)
    f32 = jnp.float32
    nrm = lambda k, shape, s: jax.random.normal(k, shape, f32) * s
    dt0 = jnp.exp(jax.random.uniform(ks[10], (DEPTH, 2, SSD_HEADS), f32, math.log(1e-3), math.log(1e-1)))
    return {
        'x': nrm(ks[0], (BATCH, SEQ, D_MODEL), 1.0),
        'c': nrm(ks[1], (BATCH, D_MODEL), 1.0),
        'ctx': nrm(ks[2], (BATCH, CTX_LEN, D_MODEL), 1.0),
        'c_ctx': nrm(ks[3], (D_MODEL,), 1.0),
        'ada_w': nrm(ks[4], (DEPTH, D_MODEL, 6 * D_MODEL), 0.5 * D_MODEL ** -0.5),
        'ada_b': nrm(ks[5], (DEPTH, 6 * D_MODEL), 0.02),
        'mix_pre_norm': 1.0 + nrm(ks[6], (DEPTH, D_MODEL), 0.02),
        'mix_post_norm': 1.0 + nrm(ks[7], (DEPTH, D_MODEL), 0.02),
        'w_in': nrm(ks[8], (DEPTH, D_MODEL, IN_COLS), D_MODEL ** -0.5),
        'w_out': nrm(ks[9], (DEPTH, D_MIX, D_MODEL), D_MIX ** -0.5),
        'ssd_conv_w': nrm(ks[11], (DEPTH, SSD_CONV, SSD_XBC), SSD_CONV ** -0.5),
        'ssd_conv_b': nrm(ks[12], (DEPTH, SSD_XBC), 0.02),
        'ssd_dt_bias': dt0 + jnp.log(-jnp.expm1(-dt0)),
        'ssd_a_log': jnp.log(jax.random.uniform(ks[13], (DEPTH, 2, SSD_HEADS), f32, 1.0, 16.0)),
        'ssd_d': 1.0 + nrm(ks[14], (DEPTH, SSD_HEADS), 0.1),
        'ssd_norm': 1.0 + nrm(ks[15], (DEPTH, SSD_INNER), 0.02),
        'hg_lb': 1.0 + nrm(ks[16], (DEPTH + 1, 2, HG_INNER), 0.1),
        'hg_norm': 1.0 + nrm(ks[17], (DEPTH, HG_INNER), 0.02),
        'ffn_pre_norm': 1.0 + nrm(ks[18], (DEPTH, D_MODEL), 0.02),
        'ffn_post_norm': 1.0 + nrm(ks[19], (DEPTH, D_MODEL), 0.02),
        'router_w': nrm(ks[20], (DEPTH, D_MODEL, N_EXPERTS), D_MODEL ** -0.5),
        'router_b': nrm(ks[21], (DEPTH, N_EXPERTS), 0.01),
        'moe_w1': nrm(ks[22], (DEPTH, N_EXPERTS, D_MODEL, 2 * D_FF), D_MODEL ** -0.5),
        'moe_b1': nrm(ks[23], (DEPTH, N_EXPERTS, 2 * D_FF), 0.02),
        'moe_w2': nrm(ks[24], (DEPTH, N_EXPERTS, D_FF, D_MODEL), D_FF ** -0.5),
        'moe_b2': nrm(ks[25], (DEPTH, N_EXPERTS, D_MODEL), 0.02),
    }


def reference(x, c, ctx, c_ctx, ada_w, ada_b, mix_pre_norm, mix_post_norm, w_in, w_out,
              ssd_conv_w, ssd_conv_b, ssd_dt_bias, ssd_a_log, ssd_d, ssd_norm, hg_lb, hg_norm,
              ffn_pre_norm, ffn_post_norm, router_w, router_b, moe_w1, moe_b1, moe_w2, moe_b2):
    bsz = x.shape[0]
    lb = jnp.cumsum(jax.nn.softmax(hg_lb.astype(jnp.float32), axis=0), axis=0)
    zero_ssd = jnp.zeros((bsz, SSD_HEADS, SSD_STATE, SSD_HEAD_DIM), jnp.float32)
    zero_hg = jnp.zeros((bsz, HG_HEADS, HG_DK, HG_DV), jnp.float32)
    for l in range(DEPTH):
        update_ctx = l < DEPTH - 1
        sh_m, sc_m, g_m, sh_f, sc_f, g_f = [m[:, None, :] for m in
                                            jnp.split(jax.nn.silu(c) @ ada_w[l] + ada_b[l], 6, axis=-1)]
        csh_m, csc_m, cg_m, csh_f, csc_f, cg_f = jnp.split(jax.nn.silu(c_ctx) @ ada_w[l] + ada_b[l], 6, axis=-1)
        ux = modulate(rmsnorm(x, mix_pre_norm[l]), sh_m, sc_m) @ w_in[l]
        uc = modulate(rmsnorm(ctx, mix_pre_norm[l]), csh_m, csc_m) @ w_in[l]
        ssd_p = (ssd_conv_w[l], ssd_conv_b[l], ssd_dt_bias[l], ssd_a_log[l], ssd_d[l], ssd_norm[l])
        yc_ssd, sf, sb = ssd_branch(uc[..., :SSD_COLS], *ssd_p, zero_ssd, zero_ssd, update_ctx)
        yx_ssd, _, _ = ssd_branch(ux[..., :SSD_COLS], *ssd_p, sf, sb, True)
        yc_hg, hf, hb = hgrn_branch(uc[..., SSD_COLS:], lb[l, 0], lb[l, 1], hg_norm[l], zero_hg, zero_hg, update_ctx)
        yx_hg, _, _ = hgrn_branch(to_col_major(ux[..., SSD_COLS:]), lb[l, 0], lb[l, 1], hg_norm[l], hf, hb, True)
        mix_x = jnp.concatenate([yx_ssd, from_col_major(yx_hg)], axis=-1) @ w_out[l]
        x = x + g_m * rmsnorm(mix_x, mix_post_norm[l])
        hx = modulate(rmsnorm(x, ffn_pre_norm[l]), sh_f, sc_f)
        moe_p = (router_w[l], router_b[l], moe_w1[l], moe_b1[l], moe_w2[l], moe_b2[l])
        if update_ctx:
            mix_c = jnp.concatenate([yc_ssd, yc_hg], axis=-1) @ w_out[l]
            ctx = ctx + cg_m * rmsnorm(mix_c, mix_post_norm[l])
            hc = modulate(rmsnorm(ctx, ffn_pre_norm[l]), csh_f, csc_f)
            n_lat = hx.shape[0] * hx.shape[1]
            f_all = moe_ffn(jnp.concatenate([hx.reshape(-1, D_MODEL), hc.reshape(-1, D_MODEL)], axis=0), *moe_p)
            fx = f_all[:n_lat].reshape(hx.shape)
            ctx = ctx + cg_f * rmsnorm(f_all[n_lat:].reshape(hc.shape), ffn_post_norm[l])
        else:
            fx = moe_ffn(hx.reshape(-1, D_MODEL), *moe_p).reshape(hx.shape)
        x = x + g_f * rmsnorm(fx, ffn_post_norm[l])
    return x
```

```cpp
#include <hip/hip_runtime.h>
#include <cstdio>
#include <cstdint>

#ifndef MK_PER_PHASE
#define MK_PER_PHASE 0
#endif

#ifndef PROBE_REP_MASK
#define PROBE_REP_MASK 0u
#endif
#define NREP(k) ((((PROBE_REP_MASK) >> (k)) & 1u) ? 2 : 1)
#define LAS __attribute__((address_space(3)))
typedef unsigned short bf16;
typedef short bf16x8 __attribute__((ext_vector_type(8)));
typedef float f32x4 __attribute__((ext_vector_type(4)));
typedef float f32x2 __attribute__((ext_vector_type(2)));
typedef unsigned u32x4 __attribute__((ext_vector_type(4)));
typedef unsigned u32x2 __attribute__((ext_vector_type(2)));
typedef int i32x4 __attribute__((ext_vector_type(4)));
typedef int i32x8 __attribute__((ext_vector_type(8)));

constexpr int D = 1024, NB = 4, SEQ = 4096, CTXL = 256;
constexpr int NLAT = NB * SEQ, NCTX = NB * CTXL, MROWS = NLAT + NCTX;
constexpr int NU = 3840;
constexpr int W_IN_COLS = 3856;
constexpr int SP = CTXL + SEQ;
constexpr int NCH = SP / 64;
constexpr int NPR = NCH / 2;
constexpr int NE = 32;
constexpr float EPS = 1e-6f;
constexpr int NPHASE = 14;

constexpr size_t MiB = 1u << 20;
constexpr size_t WS_CTL = 0, CTL_ZERO_BYTES = 1 * MiB;
constexpr size_t WS_MODP = 1 * MiB, WS_MOD = 5 * MiB, WS_DTRAW = 6 * MiB, WS_WINT = 8 * MiB, WS_WOUTT = 16 * MiB;
constexpr size_t WS_W1T = 18 * MiB, WS_W2T = 146 * MiB, WS_XN = 210 * MiB, WS_U = 244 * MiB;
constexpr size_t WS_BC = 372 * MiB, WS_XST = 381 * MiB, WS_XSW = 398 * MiB, WS_BT = 432 * MiB, WS_GA = 437 * MiB, WS_DTA = 439 * MiB, WS_GEND = 441 * MiB;
constexpr size_t WS_QS = 442 * MiB, WS_KS = 476 * MiB, WS_KHT = 510 * MiB, WS_VT = 544 * MiB, WS_EG = 561 * MiB;
constexpr size_t WS_DSP = WS_KHT, WS_EGP = WS_EG + 1179648;
constexpr size_t WS_DSS = 563 * MiB, WS_DSH = 631 * MiB, WS_SPS = 767 * MiB, WS_SPH = 801 * MiB, WS_Y = 869 * MiB, WS_MIX = 901 * MiB, WS_ROUTE = 965 * MiB;
constexpr size_t WS_XS = 372 * MiB, WS_ACT = 516 * MiB, WS_Y2 = 660 * MiB;
constexpr size_t WS_ROWTOK = 966 * MiB;
constexpr size_t WS_END = 968 * MiB;
constexpr int CW_BAR = 4096, CW_CNT = 16384;

constexpr int LDS_BYTES = 147456;
constexpr int LDSCTL_OFF = 144896;
constexpr int MISC_OFF = LDSCTL_OFF;
constexpr int TS_OFF = LDSCTL_OFF + 128;
constexpr int LCNT_OFF = LDSCTL_OFF + 2048;

typedef __bf16 bf16x2_t __attribute__((ext_vector_type(2)));
__device__ __forceinline__ unsigned cvt_pk_bf16(float lo, float hi) { const f32x2 v = {lo, hi}; const bf16x2_t b = __builtin_convertvector(v, bf16x2_t); return __builtin_bit_cast(unsigned, b); }
__device__ __forceinline__ unsigned pk4_fp8(float a, float b, float c, float d) { int w = __builtin_amdgcn_cvt_pk_fp8_f32(a, b, 0, false); w = __builtin_amdgcn_cvt_pk_fp8_f32(c, d, w, true); return (unsigned)w; }
constexpr float W_SCALE = 64.0f, ACT_SCALE = 4.0f, Y_SCALE = 16.0f;
__device__ __forceinline__ float bf2f(unsigned short b) { return __uint_as_float(((unsigned)b) << 16); }
__device__ __forceinline__ float bflo(unsigned w) { return __uint_as_float(w << 16); }
__device__ __forceinline__ float bfhi(unsigned w) { return __uint_as_float(w & 0xffff0000u); }
__device__ __forceinline__ float siluf(float x) { return x * __builtin_amdgcn_rcpf(1.0f + __expf(-x)); }
__device__ __forceinline__ float wave_sum(float v) {
#pragma unroll
    for (int o = 1; o < 64; o <<= 1) v += __shfl_xor(v, o);
    return v;
}
#define LDS_WAIT() asm volatile("s_waitcnt lgkmcnt(0)" ::: "memory")
#define VM_WAIT() asm volatile("s_waitcnt vmcnt(0)" ::: "memory")
#define LDS_BARRIER() do { asm volatile("s_waitcnt lgkmcnt(0)" ::: "memory"); __builtin_amdgcn_s_barrier(); asm volatile("" ::: "memory"); } while (0)
#define RLX_AGENT __ATOMIC_RELAXED, __HIP_MEMORY_SCOPE_AGENT
#define NTLOAD(p) __builtin_nontemporal_load(p)
#define MFMA16(a, b, c) __builtin_amdgcn_mfma_f32_16x16x32_bf16((a), (b), (c), 0, 0, 0)

namespace pg8 {
constexpr int BM = 256, BK = 64, HALF = 128, HTB = HALF * BK * 2, STAGE_BYTES = 8 * HTB, NXCD = 8, WGM = 8;
__host__ __device__ __forceinline__ int lds_byte(int r, int c) { const int st = (r >> 4) * 2 + (c >> 5), rr = r & 15, cc = c & 31, ob = rr * 64 + cc * 2; return st * 1024 + (ob ^ (((ob >> 9) & 1) << 5)); }
__host__ __device__ __forceinline__ void stage_rc(int b, int& R, int& C) { const int st = b / 1024, sb = b % 1024, swz = sb ^ (((sb >> 9) & 1) << 5); R = (st >> 1) * 16 + swz / 64; C = (st & 1) * 32 + (swz % 64) / 2; }
__host__ __device__ __forceinline__ int perm32(int rho) { const int n = rho >> 4, i = rho & 15; return 8 * (i >> 2) + 4 * n + (i & 3); }

struct Unit { int pm, pn, pb, e, ord; };
struct Gemm { const bf16* A; const bf16* Bt; int K; };
struct DenseRows {
    __device__ __forceinline__ size_t ubase(const Unit& u, int h, int K) const { return (size_t)(u.pm * BM + h * HALF) * K * 2; }
    __device__ __forceinline__ unsigned lane_off(const Unit&, int, int R, int K) const { return (unsigned)(R * K) * 2u; } };
struct GatherRows { const LAS unsigned* rowl;
    __device__ __forceinline__ size_t ubase(const Unit&, int, int) const { return 0; }
    __device__ __forceinline__ unsigned lane_off(const Unit& u, int h, int R, int) const { return rowl[u.ord * BM + h * HALF + R]; } };

struct StaticOrder {
    int nM, nN, nwg, G, c, i0, n;
    __device__ void init(int M, int N, int G_, int c_) { nM = M / BM; nN = N / BM; nwg = nM * nN; G = G_; c = c_; i0 = 0; n = 1 << 30; }
    __device__ bool next(int i_, Unit& u) const {
        if (i_ >= n) return false; const int i = i_ + i0;
        const long L = (long)i * G + c; if (L >= nwg) return false;
        int wgid = (int)L; { const int q = nwg / NXCD, r = nwg % NXCD, xcd = wgid % NXCD, off = wgid / NXCD; wgid = (xcd < r ? xcd * (q + 1) : r * (q + 1) + (xcd - r) * q) + off; }
        const int nig = WGM * nN, gid = wgid / nig, fm = gid * WGM, gsz = (nM - fm) < WGM ? (nM - fm) : WGM;
        u.pm = fm + ((wgid % nig) % gsz); u.pn = (wgid % nig) / gsz; u.pb = u.pn; u.e = 0; u.ord = i; return true;
    }
};
struct MoeOrder {
    const LAS int* ts; int ntn, mg, x, j, i0, n;
    __device__ void init(const LAS int* ts_, int ntn_, int mg_, int c) { ts = ts_; ntn = ntn_; mg = mg_; x = c & 7; j = c >> 3; i0 = 0; n = 1 << 30; }
    __device__ bool next(int i_, Unit& u) const {
        if (i_ >= n) return false; const int i = i_ + i0;
        const int st = i * 8 + x, mt = mg * st + (j % mg), nt = j / mg;
        if (mt >= ts[NE]) return false;
        const int e = ts[80 + mt];
        u.pm = mt; u.pn = nt; u.e = e; u.pb = e * ntn + nt; u.ord = i; return true;
    }
};

struct EpiF32 {
    static constexpr bool PERM = false;
    float* C; int ldc;
    __device__ __forceinline__ const float* bias_src(const Unit&) const { return nullptr; }
    __device__ __forceinline__ void operator()(const f32x4 (&acc)[2][2][4][2], const Unit& u, int wr, int wc, int fr, int fq, const LAS float*) const {
        const int row0 = u.pm * BM + wr * 64 + fr, col0 = u.pn * BM + wc * 32 + 4 * fq;
#pragma unroll
        for (int ai = 0; ai < 2; ++ai)
#pragma unroll
            for (int m = 0; m < 4; ++m) { float* rowp = C + (size_t)(row0 + ai * HALF + m * 16) * ldc + col0;
#pragma unroll
                for (int bj = 0; bj < 2; ++bj)
#pragma unroll
                    for (int n = 0; n < 2; ++n) *(f32x4*)(rowp + bj * HALF + n * 16) = acc[ai][bj][m][n]; }
    }
};
struct EpiBf16 {
    static constexpr bool PERM = true;
    bf16* O; int ldc; const float* bias; int bias_stride; float scale;
    __device__ __forceinline__ const float* bias_src(const Unit& u) const { return bias ? bias + (size_t)u.e * bias_stride + u.pn * BM : nullptr; }
    __device__ __forceinline__ void operator()(const f32x4 (&acc)[2][2][4][2], const Unit& u, int wr, int wc, int fr, int fq, const LAS float* bl) const {
        const int row0 = u.pm * BM + wr * 64 + fr, col0 = u.pn * BM + wc * 32 + 8 * fq;
        f32x4 bv[2][2];
#pragma unroll
        for (int bj = 0; bj < 2; ++bj)
#pragma unroll
            for (int n = 0; n < 2; ++n) bv[bj][n] = bias ? *(const LAS f32x4*)(bl + wc * 32 + 8 * fq + bj * HALF + 4 * n) : (f32x4){0.f, 0.f, 0.f, 0.f};
#pragma unroll
        for (int ai = 0; ai < 2; ++ai)
#pragma unroll
            for (int m = 0; m < 4; ++m) { bf16* rowp = O + (size_t)(row0 + ai * HALF + m * 16) * ldc + col0;
#pragma unroll
                for (int bj = 0; bj < 2; ++bj) { const f32x4 v0 = acc[ai][bj][m][0] * scale + bv[bj][0], v1 = acc[ai][bj][m][1] * scale + bv[bj][1];
                    u32x4 w; w.x = cvt_pk_bf16(v0[0], v0[1]); w.y = cvt_pk_bf16(v0[2], v0[3]); w.z = cvt_pk_bf16(v1[0], v1[1]); w.w = cvt_pk_bf16(v1[2], v1[3]);
                    *(u32x4*)(rowp + bj * HALF) = w; } }
    }
};
struct EpiFp8 {
    static constexpr bool PERM = true;
    unsigned char* O; int ldc; const float* bias; int bias_stride; float scale;
    __device__ __forceinline__ const float* bias_src(const Unit& u) const { return bias + (size_t)u.e * bias_stride + u.pn * BM; }
    __device__ __forceinline__ void operator()(const f32x4 (&acc)[2][2][4][2], const Unit& u, int wr, int wc, int fr, int fq, const LAS float* bl) const {
        const int row0 = u.pm * BM + wr * 64 + fr, col0 = u.pn * BM + wc * 32 + 8 * fq;
        f32x4 bv[2][2];
#pragma unroll
        for (int bj = 0; bj < 2; ++bj)
#pragma unroll
            for (int n = 0; n < 2; ++n) bv[bj][n] = *(const LAS f32x4*)(bl + wc * 32 + 8 * fq + bj * HALF + 4 * n) * Y_SCALE;
        const float sc = scale * Y_SCALE;
#pragma unroll
        for (int ai = 0; ai < 2; ++ai)
#pragma unroll
            for (int m = 0; m < 4; ++m) { unsigned char* rowp = O + (size_t)(row0 + ai * HALF + m * 16) * ldc + col0;
#pragma unroll
                for (int bj = 0; bj < 2; ++bj) { const f32x4 v0 = acc[ai][bj][m][0] * sc + bv[bj][0], v1 = acc[ai][bj][m][1] * sc + bv[bj][1];
                    *(u32x2*)(rowp + bj * HALF) = (u32x2){pk4_fp8(v0[0], v0[1], v0[2], v0[3]), pk4_fp8(v1[0], v1[1], v1[2], v1[3])}; } }
    }
};
__device__ __forceinline__ float swiglu1(float glu, float lin) {
    const float g = fminf(glu, 7.0f), l = fminf(fmaxf(lin, -7.0f), 7.0f);
    return g * __builtin_amdgcn_rcpf(1.0f + __expf(-1.702f * g)) * (l + 1.0f);
}
struct EpiSwiglu {
    static constexpr bool PERM = true;
    unsigned char* O; int ldc; const float* bias; int bias_stride;
    __device__ __forceinline__ const float* bias_src(const Unit& u) const { return bias + (size_t)u.e * bias_stride + u.pn * BM; }
    __device__ __forceinline__ void operator()(const f32x4 (&acc)[2][2][4][2], const Unit& u, int wr, int wc, int fr, int fq, const LAS float* bl) const {
        const int row0 = u.pm * BM + wr * 64 + fr, col0 = u.pn * BM + wc * 32 + 8 * fq, ocol0 = col0 >> 1;
        f32x4 bv[2][2];
#pragma unroll
        for (int bj = 0; bj < 2; ++bj)
#pragma unroll
            for (int n = 0; n < 2; ++n) bv[bj][n] = *(const LAS f32x4*)(bl + wc * 32 + 8 * fq + bj * HALF + 4 * n);
#pragma unroll
        for (int ai = 0; ai < 2; ++ai)
#pragma unroll
            for (int m = 0; m < 4; ++m) { unsigned char* rowp = O + (size_t)(row0 + ai * HALF + m * 16) * ldc + ocol0;
#pragma unroll
                for (int bj = 0; bj < 2; ++bj) { const f32x4 v0 = acc[ai][bj][m][0] * (1.0f / W_SCALE) + bv[bj][0], v1 = acc[ai][bj][m][1] * (1.0f / W_SCALE) + bv[bj][1];
                    *(unsigned*)(rowp + bj * (HALF / 2)) = pk4_fp8(ACT_SCALE * swiglu1(v0[0], v0[1]), ACT_SCALE * swiglu1(v0[2], v0[3]), ACT_SCALE * swiglu1(v1[0], v1[1]), ACT_SCALE * swiglu1(v1[2], v1[3])); } }
    }
};

template <bool F8, class Epi, class Sched, class AMap>
__device__ __forceinline__ void gemm_phase(LAS unsigned char* lds, const Gemm g, const Sched& S, const Epi& E, const AMap& AM) {
    const int tid = threadIdx.x, wid = __builtin_amdgcn_readfirstlane(tid >> 6), lane = tid & 63, wr = wid >> 2, wc = wid & 3, fr = lane & 15, fq = lane >> 4;
    const int K = g.K, nt = K / BK;
    unsigned voffB[2];
#pragma unroll
    for (int i = 0; i < 2; ++i) { int R, C; stage_rc(tid * 16 + i * 8192, R, C); const int Rb = Epi::PERM ? ((R & ~31) + perm32(R & 31)) : R;
        voffB[i] = (unsigned)(Rb * K + C) * 2u; }
    unsigned vA0[2], vA1[2], nA0[2], nA1[2];
#define PG8_AOFF(u, o0, o1) do { int _t = tid; asm volatile("" : "+v"(_t));   _Pragma("unroll") for (int _i = 0; _i < 2; ++_i) { int _R, _C; stage_rc(_t * 16 + _i * 8192, _R, _C); \
        o0[_i] = AM.lane_off(u, 0, _R, K) + (unsigned)_C * 2u; o1[_i] = AM.lane_off(u, 1, _R, K) + (unsigned)_C * 2u; } } while (0)
    const size_t kstep = (size_t)(BK * 2);
    const size_t hstep = (size_t)HALF * K * 2;
    const size_t tstep = 2 * hstep;
    const unsigned ldsw = (unsigned)wid * 1024u;
    const int aoff = lds_byte(wr * 64 + fr, fq * 8), boff = lds_byte(wc * 32 + fr, fq * 8);
#define PG8_SA(b, h) (((b) * 2 + (h)) * HTB)
#define PG8_SB(b, h) ((4 + (b) * 2 + (h)) * HTB)
#define PG8_STAGE(bufoff, gbase, voff) do { _Pragma("unroll") for (int _i = 0; _i < 2; ++_i) \
        __builtin_amdgcn_global_load_lds((const unsigned*)((const char*)(gbase) + (voff)[_i]), (LAS unsigned*)(lds + (bufoff) + ldsw + _i * 8192), 16, 0, 0); } while (0)
#define PG8_LDA(dst, b, h) do { _Pragma("unroll") for (int m = 0; m < 4; ++m) { const i32x4 _lo = *(const LAS i32x4*)(lds + PG8_SA(b, h) + aoff + m * 2048), _hi = *(const LAS i32x4*)(lds + PG8_SA(b, h) + aoff + m * 2048 + 1024); \
        dst[m] = __builtin_shufflevector(_lo, _hi, 0, 1, 2, 3, 4, 5, 6, 7); } } while (0)
#define PG8_LDB(dst, b, h) do { _Pragma("unroll") for (int n = 0; n < 2; ++n) { const i32x4 _lo = *(const LAS i32x4*)(lds + PG8_SB(b, h) + boff + n * 2048), _hi = *(const LAS i32x4*)(lds + PG8_SB(b, h) + boff + n * 2048 + 1024); \
        dst[n] = __builtin_shufflevector(_lo, _hi, 0, 1, 2, 3, 4, 5, 6, 7); } } while (0)
#define PG8_LO(x) __builtin_bit_cast(bf16x8, __builtin_shufflevector(x, x, 0, 1, 2, 3))
#define PG8_HI(x) __builtin_bit_cast(bf16x8, __builtin_shufflevector(x, x, 4, 5, 6, 7))
#define PG8_MMA(ai, bj, At, Bt) do { __builtin_amdgcn_s_setprio(1); _Pragma("unroll") for (int m = 0; m < 4; ++m) _Pragma("unroll") for (int n = 0; n < 2; ++n) { \
        if constexpr (F8) asm volatile("v_mfma_scale_f32_16x16x128_f8f6f4 %0, %1, %2, %0, %3, %3 op_sel_hi:[0,0,0]" : "+v"(acc[ai][bj][m][n]) : "v"(Bt[n]), "v"(At[m]), "v"(f8scale)); \
        else { acc[ai][bj][m][n] = __builtin_amdgcn_mfma_f32_16x16x32_bf16(PG8_LO(Bt[n]), PG8_LO(At[m]), acc[ai][bj][m][n], 0, 0, 0); \
               acc[ai][bj][m][n] = __builtin_amdgcn_mfma_f32_16x16x32_bf16(PG8_HI(Bt[n]), PG8_HI(At[m]), acc[ai][bj][m][n], 0, 0, 0); } } \
        __builtin_amdgcn_s_setprio(0); } while (0)
#define PG8_WAIT_V(n) asm volatile("s_waitcnt vmcnt(" #n ")" ::: "memory")
#define PG8_WAIT_L(n) asm volatile("s_waitcnt lgkmcnt(" #n ")" ::: "memory")
#define PG8_BAR __builtin_amdgcn_s_barrier()
#define PG8_SCHED __builtin_amdgcn_sched_barrier(0)
    Unit cur, nxt; int ui = 0;
    if (!S.next(0, cur)) return;
    f32x4 acc[2][2][4][2];
#pragma unroll
    for (int a = 0; a < 2; ++a)
#pragma unroll
        for (int b = 0; b < 2; ++b)
#pragma unroll
            for (int m = 0; m < 4; ++m)
#pragma unroll
                for (int n = 0; n < 2; ++n) acc[a][b][m][n] = (f32x4){0.f, 0.f, 0.f, 0.f};
    i32x8 At[4], B0[2], B1[2];
    int f8scale = 0x7F7F7F7F; asm volatile("" : "+v"(f8scale));
    LAS float* const biasl = (LAS float*)(lds + STAGE_BYTES);
#define PG8_BIAS(u, slot) do { const float* _bs = E.bias_src(u); if (_bs != nullptr && wid == 0) { int _ln = lane; asm volatile("" : "+v"(_ln));     \
        __builtin_amdgcn_global_load_lds((const unsigned*)(_bs + _ln * 4), (LAS unsigned*)(biasl + (slot) * 256), 16, 0, 0); } } while (0)
    PG8_BIAS(cur, 0);
    const char* cA0 = (const char*)g.A + AM.ubase(cur, 0, K); const char* cA1 = (const char*)g.A + AM.ubase(cur, 1, K); const char* cB = (const char*)g.Bt + (size_t)cur.pb * tstep;
    PG8_AOFF(cur, vA0, vA1);
    PG8_STAGE(PG8_SB(0, 0), cB, voffB); PG8_STAGE(PG8_SB(0, 1), cB + hstep, voffB); PG8_STAGE(PG8_SA(0, 0), cA0, vA0); PG8_STAGE(PG8_SA(0, 1), cA1, vA1);
    if (wr == 1) PG8_BAR;
    PG8_WAIT_V(2); PG8_BAR;
    PG8_STAGE(PG8_SB(1, 0), cB + kstep, voffB); PG8_STAGE(PG8_SA(1, 0), cA0 + kstep, vA0); PG8_STAGE(PG8_SB(1, 1), cB + hstep + kstep, voffB);
    PG8_WAIT_V(6); PG8_BAR;
    for (;;) {
        const bool has_next = S.next(ui + 1, nxt);
        const char* nB = has_next ? (const char*)g.Bt + (size_t)nxt.pb * tstep : cB;
        const char* nxA0 = has_next ? (const char*)g.A + AM.ubase(nxt, 0, K) : cA0; const char* nxA1 = has_next ? (const char*)g.A + AM.ubase(nxt, 1, K) : cA1;
        if (has_next) { PG8_AOFF(nxt, nA0, nA1); PG8_BIAS(nxt, (ui + 1) & 1); } else { nA0[0] = vA0[0]; nA0[1] = vA0[1]; nA1[0] = vA1[0]; nA1[1] = vA1[1]; }
#pragma unroll 1
        for (int t = 0; t < nt; t += 2) {
            const bool last = (t == nt - 2);
            const char* a1 = cA1 + (size_t)(t + 1) * kstep;
            const char* a2 = last ? nxA0 : cA0 + (size_t)(t + 2) * kstep; const char* a2h = last ? nxA1 : cA1 + (size_t)(t + 2) * kstep; const char* b2 = last ? nB : cB + (size_t)(t + 2) * kstep;
            const char* a3 = a2 + kstep; const char* b3 = b2 + kstep;
            unsigned w0[2], w1[2];
            w0[0] = last ? nA0[0] : vA0[0]; w0[1] = last ? nA0[1] : vA0[1]; w1[0] = last ? nA1[0] : vA1[0]; w1[1] = last ? nA1[1] : vA1[1];
            PG8_LDB(B0, 0, 0); PG8_LDB(B1, 0, 1); PG8_SCHED; PG8_LDA(At, 0, 0); PG8_STAGE(PG8_SA(1, 1), a1, vA1);
            PG8_WAIT_V(8); PG8_WAIT_L(0); PG8_BAR; PG8_MMA(0, 0, At, B0); PG8_MMA(0, 1, At, B1); PG8_BAR; PG8_SCHED;
            PG8_LDA(At, 0, 1); PG8_STAGE(PG8_SB(0, 0), b2, voffB); PG8_STAGE(PG8_SB(0, 1), b2 + hstep, voffB); PG8_STAGE(PG8_SA(0, 0), a2, w0);
            PG8_WAIT_V(8); PG8_WAIT_L(0); PG8_BAR; PG8_MMA(1, 0, At, B0); PG8_MMA(1, 1, At, B1); PG8_BAR; PG8_SCHED;
            PG8_LDB(B0, 1, 0); PG8_LDB(B1, 1, 1); PG8_SCHED; PG8_LDA(At, 1, 0); PG8_STAGE(PG8_SA(0, 1), a2h, w1);
            PG8_WAIT_V(8); PG8_WAIT_L(0); PG8_BAR; PG8_MMA(0, 0, At, B0); PG8_MMA(0, 1, At, B1); PG8_BAR; PG8_SCHED;
            PG8_LDA(At, 1, 1); PG8_STAGE(PG8_SB(1, 0), b3, voffB); PG8_STAGE(PG8_SB(1, 1), b3 + hstep, voffB); PG8_STAGE(PG8_SA(1, 0), a3, w0);
            PG8_WAIT_V(8); PG8_WAIT_L(0); PG8_BAR; PG8_MMA(1, 0, At, B0); PG8_MMA(1, 1, At, B1); PG8_BAR; PG8_SCHED;
        }
        if (wr == 0) PG8_BAR;
        if constexpr (F8) asm volatile("s_nop 15\n\ts_nop 15" ::: "memory");
        E(acc, cur, wr, wc, fr, fq, biasl + (ui & 1) * 256);
        if (!has_next) break;
#pragma unroll
        for (int a = 0; a < 2; ++a)
#pragma unroll
            for (int b = 0; b < 2; ++b)
#pragma unroll
                for (int m = 0; m < 4; ++m)
#pragma unroll
                    for (int n = 0; n < 2; ++n) acc[a][b][m][n] = (f32x4){0.f, 0.f, 0.f, 0.f};
        cur = nxt; cB = nB; cA0 = nxA0; cA1 = nxA1; ++ui; vA0[0] = nA0[0]; vA0[1] = nA0[1]; vA1[0] = nA1[0]; vA1[1] = nA1[1];
        if (wr == 1) PG8_BAR;
    }
    PG8_WAIT_V(0);
    PG8_BAR;
#undef PG8_AOFF
#undef PG8_BIAS
#undef PG8_SA
#undef PG8_SB
#undef PG8_STAGE
#undef PG8_LDA
#undef PG8_LDB
#undef PG8_MMA
#undef PG8_LO
#undef PG8_HI
#undef PG8_WAIT_V
#undef PG8_WAIT_L
#undef PG8_BAR
#undef PG8_SCHED
}
}

#define XB_TMO      128
#define XB_XCNT(j)  (256  + 64 * (j))
#define XB_XSUB(j)  (1280 + 64 * (j))
#define XB_XGEN(j)  (2304 + 64 * (j))
#define XB_TOP      3328
#define XB_TOPGEN   3392
#define XCD_BAR_WORDS 3456
#define XB_SPIN_CAP (1u << 22)
__device__ __forceinline__ unsigned xb_ld(unsigned* p)              { return __hip_atomic_load(p, __ATOMIC_RELAXED, __HIP_MEMORY_SCOPE_AGENT); }
__device__ __forceinline__ unsigned xb_add(unsigned* p, unsigned v) { return __hip_atomic_fetch_add(p, v, __ATOMIC_RELAXED, __HIP_MEMORY_SCOPE_AGENT); }
__device__ __forceinline__ unsigned xb_xcc_id() { return (unsigned)__builtin_amdgcn_s_getreg((3 << 11) | 20) & 0xFu; }
#define XB_SPIN(cond, bar) do { unsigned _sp = 0; while (cond) { __builtin_amdgcn_s_sleep(1); \
    if ((++_sp & 255u) == 0u) { if (xb_ld(&(bar)[XB_TMO])) break; if (_sp > XB_SPIN_CAP) { atomicAdd(&(bar)[XB_TMO], 1u); break; } } } } while (0)
struct XcdBarrier { unsigned* bar; unsigned x; volatile LAS unsigned* st; };
__device__ __forceinline__ XcdBarrier xcd_barrier_post(unsigned* bar, volatile LAS unsigned* st) {
    XcdBarrier b; b.bar = bar; b.x = xb_xcc_id(); b.st = st;
    if (threadIdx.x == 0) (void)xb_add(&bar[XB_XCNT(b.x)], 1u);
    return b;
}
__device__ __forceinline__ void xcd_barrier_complete(unsigned* bar, unsigned x, unsigned& nloc, unsigned& nx) {
    const unsigned G = gridDim.x * gridDim.y * gridDim.z;
    unsigned sum, cnt, mine, sp = 0u;
    for (;;) {
        sum = 0u; cnt = 0u; mine = 0u;
#pragma unroll
        for (unsigned j = 0; j < 16; ++j) { const unsigned c = xb_ld(&bar[XB_XCNT(j)]); sum += c; cnt += (c > 0u) ? 1u : 0u; mine = (j == x) ? c : mine; }
        if (sum == G) break;
        __builtin_amdgcn_s_sleep(1);
        if ((++sp & 255u) == 0u) { if (xb_ld(&bar[XB_TMO])) break; if (sp > XB_SPIN_CAP) { atomicAdd(&bar[XB_TMO], 1u); break; } }
    }
    nloc = mine > 0u ? mine : 1u; nx = cnt > 0u ? cnt : 1u;
}
__device__ __forceinline__ void xcd_barrier(const XcdBarrier& b) {
    asm volatile("s_waitcnt vmcnt(0)" ::: "memory");
    __syncthreads();
    if (threadIdx.x == 0) {
        unsigned* bar = b.bar;
        __builtin_amdgcn_s_waitcnt(0);
        unsigned nloc = b.st[0], nx = b.st[1];
        if (nloc == 0u) { xcd_barrier_complete(bar, b.x, nloc, nx); b.st[0] = nloc; b.st[1] = nx; }
        const unsigned old = xb_add(&bar[XB_XSUB(b.x)], 1u);
        const unsigned gen = old / nloc;
        if (old + 1u == (gen + 1u) * nloc) {
            __builtin_amdgcn_fence(__ATOMIC_RELEASE, "agent");
            asm volatile("s_waitcnt vmcnt(0)" ::: "memory");
            const unsigned og = xb_add(&bar[XB_TOP], 1u);
            const unsigned tg = og / nx;
            if (og + 1u == (tg + 1u) * nx) xb_add(&bar[XB_TOPGEN], 1u);
            else XB_SPIN(xb_ld(&bar[XB_TOPGEN]) == tg, bar);
            __builtin_amdgcn_fence(__ATOMIC_ACQUIRE, "agent");
            xb_add(&bar[XB_XGEN(b.x)], 1u);
            asm volatile("s_waitcnt vmcnt(0)" ::: "memory");
        } else {
            XB_SPIN(xb_ld(&bar[XB_XGEN(b.x)]) == gen, bar);
            __builtin_amdgcn_fence(__ATOMIC_ACQUIRE, "agent");
            asm volatile("s_waitcnt vmcnt(0)" ::: "memory");
        }
    }
    __syncthreads();
}

struct Args {
    const float *x, *c, *ctx, *c_ctx, *ada_w, *ada_b, *mix_pre, *mix_post, *w_in, *w_out, *conv_w, *conv_b, *dt_bias, *a_log, *ssd_d, *ssd_norm,
                *hg_lb, *hg_norm, *ffn_pre, *ffn_post, *router_w, *router_b, *w1, *b1, *w2, *b2;
    float* out; unsigned char* ws; int ph_lo, ph_hi;
};

typedef const Args __attribute__((address_space(4))) CArgs;
struct Ctx { LAS unsigned char* lds; int tid, lane, wave, vcu, G, gw, NGW; };

__device__ __forceinline__ void transpose_item(const float* W, int ldw, int K, bf16* WT, int dst_row0, int nblk, LAS float* scr, int item, int lane) {
    const int kb = item / nblk, nb = item % nblk, k0 = 64 * kb, n0 = 32 * nb;
    float ld[32];
#pragma unroll
    for (int i = 0; i < 32; ++i) ld[i] = W[(size_t)(k0 + 2 * i + (lane >> 5)) * ldw + n0 + (lane & 31)];
#pragma unroll
    for (int i = 0; i < 32; ++i) scr[(2 * i + (lane >> 5)) * 33 + (lane & 31)] = ld[i];
    LDS_WAIT(); asm volatile("" ::: "memory");
    const int c = lane & 7;
#pragma unroll
    for (int j = 0; j < 4; ++j) { const int n = (lane >> 3) + 8 * j; const LAS float* s = scr + (8 * c) * 33 + n;
        u32x4 o; o.x = cvt_pk_bf16(s[0 * 33], s[1 * 33]); o.y = cvt_pk_bf16(s[2 * 33], s[3 * 33]); o.z = cvt_pk_bf16(s[4 * 33], s[5 * 33]); o.w = cvt_pk_bf16(s[6 * 33], s[7 * 33]);
        *(u32x4*)(WT + (size_t)(dst_row0 + n0 + n) * K + k0 + 8 * c) = o; }
    LDS_WAIT(); asm volatile("" ::: "memory");
}
__device__ __forceinline__ void transpose_item_f8(const float* W, int ldw, int K, unsigned char* WT, int nblk, LAS float* scr, int item, int lane, float scale) {
    const int kb = item / nblk, nb = item % nblk, k0 = 64 * kb, n0 = 32 * nb;
    float ld[32];
#pragma unroll
    for (int i = 0; i < 32; ++i) ld[i] = __builtin_nontemporal_load(&W[(size_t)(k0 + 2 * i + (lane >> 5)) * ldw + n0 + (lane & 31)]);
#pragma unroll
    for (int i = 0; i < 32; ++i) scr[(2 * i + (lane >> 5)) * 33 + (lane & 31)] = ld[i] * scale;
    LDS_WAIT(); asm volatile("" ::: "memory");
    const int c = lane & 7;
#pragma unroll
    for (int j = 0; j < 4; ++j) { const int n = (lane >> 3) + 8 * j; const LAS float* sp = scr + (8 * c) * 33 + n;
        u32x2 o; o.x = pk4_fp8(sp[0 * 33], sp[1 * 33], sp[2 * 33], sp[3 * 33]); o.y = pk4_fp8(sp[4 * 33], sp[5 * 33], sp[6 * 33], sp[7 * 33]);
        *(u32x2*)(WT + (size_t)(n0 + n) * K + k0 + 8 * c) = o; }
    LDS_WAIT(); asm volatile("" ::: "memory");
}
__device__ __forceinline__ void phase0(CArgs& a, const Ctx& C) {
    LAS float* scr = (LAS float*)(C.lds + C.wave * 16384);
    bf16* WINT = (bf16*)(a.ws + WS_WINT); bf16* WOUTT = (bf16*)(a.ws + WS_WOUTT);
    float* MODP = (float*)(a.ws + WS_MODP);
    constexpr int I_GEMV = 96 * 32, I_INA = 16 * 40, I_INB = 16 * 80, I_OUT = 16 * 32;
    constexpr int NITEMS = I_GEMV + I_INA + I_INB + I_OUT;
    for (int it = C.gw; it < NITEMS; it += C.NGW) {
        int r = it;
        if (r < I_GEMV) {
            const int cg = r % 96, ks = r / 96, col = 64 * cg + C.lane, k0 = 32 * ks;
            float sv[5];
            { const int kk = C.lane & 31;
#pragma unroll
              for (int b = 0; b < 4; ++b) sv[b] = siluf(a.c[b * D + k0 + kk]);
              sv[4] = siluf(a.c_ctx[k0 + kk]); }
            float acc[5] = {0.f, 0.f, 0.f, 0.f, 0.f};
#pragma unroll 8
            for (int kk = 0; kk < 32; ++kk) { const float w = a.ada_w[(size_t)(k0 + kk) * 6144 + col];
#pragma unroll
                for (int b = 0; b < 5; ++b) acc[b] += __shfl(sv[b], kk) * w; }
#pragma unroll
            for (int b = 0; b < 5; ++b) MODP[(size_t)(ks * 5 + b) * 6144 + col] = acc[b];
            continue;
        }
        r -= I_GEMV;
        if (r < I_INA) { transpose_item(a.w_in, W_IN_COLS, D, WINT, 0, 40, scr, r, C.lane); continue; } r -= I_INA;
        if (r < I_INB) { transpose_item(a.w_in + 1296, W_IN_COLS, D, WINT, 1280, 80, scr, r, C.lane); continue; } r -= I_INB;
        transpose_item(a.w_out, D, D, WOUTT, 0, 32, scr, r, C.lane);
    }
}
__device__ __forceinline__ void conv_w1_slice(CArgs& a, const Ctx& C, int sl, int nsl) {
    LAS float* scr = (LAS float*)(C.lds + C.wave * 16384); unsigned char* W1T = a.ws + WS_W1T;
    const int per = 16 / nsl;
    for (int jx = sl * per; jx < (sl + 1) * per; ++jx) { const int r = C.gw + C.NGW * jx; if (r >= 32 * 16 * 64) break;
        const int e = r / (16 * 64), ri = r % (16 * 64); transpose_item_f8(a.w1 + (size_t)e * D * 2048, 2048, D, W1T + (size_t)e * 2048 * D, 64, scr, ri, C.lane, W_SCALE); }
}
__device__ __forceinline__ void conv_w2_slice(CArgs& a, const Ctx& C, int sl, int nsl) {
    LAS float* scr = (LAS float*)(C.lds + C.wave * 16384); unsigned char* W2T = a.ws + WS_W2T;
    const int per = 8 / nsl;
    for (int jx = sl * per; jx < (sl + 1) * per; ++jx) { const int r = C.gw + C.NGW * jx; if (r >= 32 * 16 * 32) break;
        const int e = r / (16 * 32), ri = r % (16 * 32); transpose_item_f8(a.w2 + (size_t)e * D * D, D, D, W2T + (size_t)e * D * D, 32, scr, ri, C.lane, W_SCALE); }
}
__device__ __forceinline__ void phase1(CArgs& a, const Ctx& C) {
    const float* MODP = (const float*)(a.ws + WS_MODP); float* MOD = (float*)(a.ws + WS_MOD);
    for (int i = C.vcu * 512 + C.tid; i < 5 * 6144; i += C.G * 512) {
        const int col = i % 6144, b = i / 6144; float s = a.ada_b[col];
#pragma unroll 8
        for (int ks = 0; ks < 32; ++ks) s += MODP[(size_t)(ks * 5 + b) * 6144 + col];
        MOD[i] = s;
    }
}
template <int N, int O> struct RS { template <int M> static __device__ __forceinline__ void run(float (&v)[M], int lane) {
    const bool up = (lane & O) != 0;
#pragma unroll
    for (int i = 0; i < N / 2; ++i) { const float keep = up ? v[i + N / 2] : v[i], send = up ? v[i] : v[i + N / 2]; v[i] = keep + __shfl_xor(send, O); }
    RS<N / 2, O / 2>::run(v, lane); } };
template <int O> struct RS<1, O> { template <int M> static __device__ __forceinline__ void run(float (&v)[M], int) { v[0] += __shfl_xor(v[0], O); RS<1, O / 2>::run(v, 0); } };
template <> struct RS<1, 0> { template <int M> static __device__ __forceinline__ void run(float (&)[M], int) {} };
template <int N> __device__ __forceinline__ void reduce_scatter(float (&v)[N], int lane) { RS<N, 32>::run(v, lane); }
__device__ __forceinline__ void phase2(CArgs& a, const Ctx& C) {
    const float* MOD = (const float*)(a.ws + WS_MOD); bf16* XN = (bf16*)(a.ws + WS_XN); float* DTRAW = (float*)(a.ws + WS_DTRAW);
    LAS f32x4* WD = (LAS f32x4*)C.lds;
    for (int idx = C.tid; idx < 16 * 4 * 64; idx += 512) { const int ln = idx & 63, cg = (idx >> 6) & 3, je = idx >> 8, j = je >> 3, e = je & 7, k = 8 * ln + 512 * j + e;
        WD[idx] = *(const f32x4*)(a.w_in + (size_t)k * W_IN_COLS + 1280 + 4 * cg); }
    __syncthreads();
    f32x4 nx[2][2];
    { const int m = C.gw; const float* xrow = m < NLAT ? a.x + (size_t)m * D : a.ctx + (size_t)(m - NLAT) * D;
#pragma unroll
      for (int j = 0; j < 2; ++j) { nx[j][0] = NTLOAD((const f32x4*)(xrow + 8 * C.lane + 512 * j)); nx[j][1] = NTLOAD((const f32x4*)(xrow + 8 * C.lane + 512 * j + 4)); } }
    for (int m = C.gw; m < MROWS; m += C.NGW) {
        const int b = m < NLAT ? (m >> 12) : 4;
        const float* sh = MOD + b * 6144, *sc = sh + 1024;
        float h[2][8]; float ss = 0.f;
#pragma unroll
        for (int j = 0; j < 2; ++j) { const f32x4 v0 = nx[j][0], v1 = nx[j][1];
#pragma unroll
            for (int e = 0; e < 4; ++e) { h[j][e] = v0[e]; h[j][4 + e] = v1[e]; ss += v0[e] * v0[e] + v1[e] * v1[e]; } }
        { const int m2 = m + C.NGW < MROWS ? m + C.NGW : m; const float* xrow = m2 < NLAT ? a.x + (size_t)m2 * D : a.ctx + (size_t)(m2 - NLAT) * D;
#pragma unroll
          for (int j = 0; j < 2; ++j) { nx[j][0] = NTLOAD((const f32x4*)(xrow + 8 * C.lane + 512 * j)); nx[j][1] = NTLOAD((const f32x4*)(xrow + 8 * C.lane + 512 * j + 4)); } }
        const float rstd = rsqrtf(wave_sum(ss) * (1.0f / D) + EPS);
#pragma unroll
        for (int j = 0; j < 2; ++j) { const int k0 = 8 * C.lane + 512 * j;
#pragma unroll
            for (int e4 = 0; e4 < 2; ++e4) { const f32x4 w = *(const f32x4*)(a.mix_pre + k0 + 4 * e4), s1 = *(const f32x4*)(sc + k0 + 4 * e4), s0 = *(const f32x4*)(sh + k0 + 4 * e4);
#pragma unroll
                for (int e = 0; e < 4; ++e) h[j][4 * e4 + e] = h[j][4 * e4 + e] * rstd * w[e] * (1.0f + s1[e]) + s0[e]; }
            u32x4 o; o.x = cvt_pk_bf16(h[j][0], h[j][1]); o.y = cvt_pk_bf16(h[j][2], h[j][3]); o.z = cvt_pk_bf16(h[j][4], h[j][5]); o.w = cvt_pk_bf16(h[j][6], h[j][7]);
            *(u32x4*)(XN + (size_t)m * D + k0) = o; }
        float acc[16];
#pragma unroll
        for (int i = 0; i < 16; ++i) acc[i] = 0.f;
#pragma unroll
        for (int j = 0; j < 2; ++j)
#pragma unroll
            for (int e = 0; e < 8; ++e)
#pragma unroll
                for (int cg = 0; cg < 4; ++cg) { const f32x4 w = WD[((j * 8 + e) * 4 + cg) * 64 + C.lane];
#pragma unroll
                    for (int i = 0; i < 4; ++i) acc[4 * cg + i] += h[j][e] * w[i];
                    if (cg == 3 && (e & 1)) asm volatile("" ::: "memory"); }
        reduce_scatter<16>(acc, C.lane);
        if ((C.lane & 3) == 0) DTRAW[(size_t)m * 16 + (C.lane >> 2)] = acc[0];
    }
}
__device__ __forceinline__ void prep_ssd_unit(CArgs& a, const Ctx& C, int unit) {
    const bf16* U = (const bf16*)(a.ws + WS_U); const float* DTRAW = (const float*)(a.ws + WS_DTRAW);
    bf16* BC = (bf16*)(a.ws + WS_BC); bf16* XST = (bf16*)(a.ws + WS_XST);
    float* GA = (float*)(a.ws + WS_GA); float* DTA = (float*)(a.ws + WS_DTA); float* GEND = (float*)(a.ws + WS_GEND); u32x2* DSS = (u32x2*)(a.ws + WS_DSS);
    const int b = unit / NCH, tc = unit % NCH, s0 = 64 * tc; const bool isctx = tc < 4;
    const int rowbase = isctx ? NLAT + b * CTXL + s0 : b * SEQ + (s0 - CTXL);
    const int ilo = isctx ? -s0 : CTXL - s0, ihi = isctx ? CTXL - s0 : SP - s0;
    LAS float* dtl = (LAS float*)C.lds; LAS float* al = dtl + 1024; LAS float* wl = al + 1024;
    LAS bf16* XTl = (LAS bf16*)(C.lds + 12288);
    int ltid = C.tid; asm volatile("" : "+v"(ltid));
    const int ch0 = 2 * ltid;
    unsigned uw[68];
    if (C.tid < 384) { const bf16* up = U + (size_t)rowbase * NU + 512 + ch0;
#pragma unroll
        for (int t = 0; t < 68; ++t) { const int i = t - 2; uw[t] = (i >= ilo && i < ihi) ? *(const unsigned*)(up + (ptrdiff_t)i * NU) : 0u; } }
#pragma unroll
    for (int pi = 0; pi < 2; ++pi) { const int dh = 2 * C.wave + pi, dir = dh >> 3, h = dh & 7, i = C.lane;
        const float xv = DTRAW[(size_t)(rowbase + i) * 16 + dh] + a.dt_bias[dh];
        const float dt = fmaxf(xv, 0.f) + log1pf(__expf(-fabsf(xv)));
        const float av = -dt * __expf(a.a_log[dh]);
        float pre = av;
#pragma unroll
        for (int o = 1; o < 64; o <<= 1) { const float t = __shfl_up(pre, o); pre += (i >= o) ? t : 0.f; }
        const float tot = __shfl(pre, 63);
        const float g = dir == 0 ? pre : tot - pre + av;
        const float gend = tot;
        al[dh * 64 + i] = g; dtl[dh * 64 + i] = dt; wl[dh * 64 + i] = dt * __expf(gend - g);
        const size_t o = (size_t)((b * 2 + dir) * 8 + h) * SP + s0 + i; GA[o] = g; DTA[o] = dt;
        if (i == 0) GEND[((b * 2 + dir) * 8 + h) * NCH + tc] = gend; }
    LDS_BARRIER();
    if (C.tid < 384) {
        f32x2 wk[5];
#pragma unroll
        for (int k = 0; k < 5; ++k) wk[k] = *(const f32x2*)(a.conv_w + k * 768 + ch0);
        const f32x2 cb = *(const f32x2*)(a.conv_b + ch0);
        const int cls = ch0 < 512 ? 0 : (ch0 < 640 ? 1 : 2);
#pragma unroll
        for (int i8 = 0; i8 < 8; ++i8) {
            unsigned t0[4], t1[4]; float pv0 = 0.f, pv1 = 0.f;
#pragma unroll
            for (int ii = 0; ii < 8; ++ii) {
                const int i = 8 * i8 + ii;
                float y0 = cb.x, y1 = cb.y;
#pragma unroll
                for (int k = 0; k < 5; ++k) { y0 += wk[k].x * bflo(uw[i + k]); y1 += wk[k].y * bfhi(uw[i + k]); }
                y0 = siluf(y0); y1 = siluf(y1);
                if (cls != 0) *(unsigned*)(BC + (size_t)(rowbase + i) * 256 + (ch0 - 512)) = cvt_pk_bf16(y0, y1);
                if (ii & 1) { t0[ii >> 1] = cvt_pk_bf16(pv0, y0); t1[ii >> 1] = cvt_pk_bf16(pv1, y1); } else { pv0 = y0; pv1 = y1; }
            }
            if (cls != 2) {
                const u32x4 v0 = (u32x4){t0[0], t0[1], t0[2], t0[3]}, v1 = (u32x4){t1[0], t1[1], t1[2], t1[3]};
                *(LAS u32x4*)(XTl + ch0 * 72 + 8 * i8) = v0; *(LAS u32x4*)(XTl + (ch0 + 1) * 72 + 8 * i8) = v1;
                if (cls == 0) { const size_t r0 = (size_t)(b * 512 + ch0) * SP + s0 + 8 * i8; *(u32x4*)(XST + r0) = v0; *(u32x4*)(XST + r0 + SP) = v1; }
            }
        }
    }
    LDS_BARRIER();
    {
        const int fr = C.lane & 15, q = C.lane >> 4;
#pragma unroll 1
        for (int pi = 0; pi < 2; ++pi) { const int pid = 2 * C.wave + pi, dir = pid >> 3, h = pid & 7, g = h >> 2;
            bf16x8 Bf[4][2]; f32x4 wv[2][2];
#pragma unroll
            for (int ks = 0; ks < 2; ++ks) { wv[ks][0] = *(const LAS f32x4*)(wl + pid * 64 + 32 * ks + 8 * q); wv[ks][1] = *(const LAS f32x4*)(wl + pid * 64 + 32 * ks + 8 * q + 4); }
#pragma unroll
            for (int t = 0; t < 4; ++t)
#pragma unroll
                for (int ks = 0; ks < 2; ++ks) Bf[t][ks] = *(const LAS bf16x8*)(XTl + (h * 64 + 16 * t + fr) * 72 + 32 * ks + 8 * q);
            const size_t ob = ((size_t)((b * 2 + dir) * 8 + h) * NCH + tc) * 1024;
#pragma unroll
            for (int at = 0; at < 4; ++at) { bf16x8 Af[2];
#pragma unroll
                for (int ks = 0; ks < 2; ++ks) { const u32x4 raw = *(const LAS u32x4*)(XTl + (512 + g * 64 + 16 * at + fr) * 72 + 32 * ks + 8 * q); const unsigned rw[4] = {raw.x, raw.y, raw.z, raw.w}; u32x4 o;
                    o.x = cvt_pk_bf16(bflo(rw[0]) * wv[ks][0][0], bfhi(rw[0]) * wv[ks][0][1]); o.y = cvt_pk_bf16(bflo(rw[1]) * wv[ks][0][2], bfhi(rw[1]) * wv[ks][0][3]);
                    o.z = cvt_pk_bf16(bflo(rw[2]) * wv[ks][1][0], bfhi(rw[2]) * wv[ks][1][1]); o.w = cvt_pk_bf16(bflo(rw[3]) * wv[ks][1][2], bfhi(rw[3]) * wv[ks][1][3]);
                    Af[ks] = __builtin_bit_cast(bf16x8, o); }
#pragma unroll
                for (int pt = 0; pt < 4; ++pt) { f32x4 acc = (f32x4){0.f, 0.f, 0.f, 0.f};
                    acc = MFMA16(Af[0], Bf[pt][0], acc); acc = MFMA16(Af[1], Bf[pt][1], acc);
                    DSS[ob + (at * 4 + pt) * 64 + C.lane] = (u32x2){cvt_pk_bf16(acc[0], acc[1]), cvt_pk_bf16(acc[2], acc[3])}; } } }
    }
    LDS_BARRIER();
}
__device__ __forceinline__ void prep_hg_pair(CArgs& a, const Ctx& C, int unit) {
    const bf16* U = (const bf16*)(a.ws + WS_U);
    bf16* QS = (bf16*)(a.ws + WS_QS); bf16* KS = (bf16*)(a.ws + WS_KS); bf16* VT = (bf16*)(a.ws + WS_VT); float* EG = (float*)(a.ws + WS_EG); u32x2* DSP = (u32x2*)(a.ws + WS_DSP); float* EGP = (float*)(a.ws + WS_EGP);
    const int b = unit / (NPR * 4), pr = (unit >> 2) % NPR, h = unit & 3;
    LAS float* ETl = (LAS float*)(C.lds + 63488);
    LAS u32x2* DL = (LAS u32x2*)(C.lds + 65536);
#pragma unroll 1
    for (int sub = 0; sub < 2; ++sub) {
    const int c = 2 * pr + sub, s0 = 64 * c; const bool isctx = c < 4;
    int ltid = C.tid; asm volatile("" : "+v"(ltid));
    const int cp = ltid & 63, tg = ltid >> 6, ch0 = 2 * cp, hc = h * 128 + ch0;
    const int rbase = isctx ? NLAT + b * CTXL + s0 : b * SEQ + (c - 4), rstride = isctx ? 1 : 64;
    const bf16* up = U + (size_t)rbase * NU + 1280 + hc;
    unsigned rq[8], rf[8], rb[8], ri[8];
#pragma unroll
    for (int t = 0; t < 8; ++t) { const bf16* r = up + (size_t)(8 * tg + t) * rstride * NU;
        rq[t] = *(const unsigned*)r; rf[t] = *(const unsigned*)(r + 512); rb[t] = *(const unsigned*)(r + 1024); ri[t] = *(const unsigned*)(r + 1536); }
    LAS float* part = (LAS float*)C.lds;
    LAS bf16* KHl = (LAS bf16*)(C.lds + 8192);
    LAS bf16* VTl = KHl + 2 * 128 * 72;
    f32x2 lbv[2];
#pragma unroll
    for (int d = 0; d < 2; ++d) { lbv[d].x = __builtin_amdgcn_rcpf(1.0f + __expf(a.hg_lb[1024 + d * 512 + hc] - a.hg_lb[d * 512 + hc])); lbv[d].y = __builtin_amdgcn_rcpf(1.0f + __expf(a.hg_lb[1024 + d * 512 + hc + 1] - a.hg_lb[d * 512 + hc + 1])); }
    float la[2][2][8], om[2][2][8];
    float sum[2][2] = {{0.f, 0.f}, {0.f, 0.f}};
#pragma unroll
    for (int t = 0; t < 8; ++t)
#pragma unroll
        for (int d = 0; d < 2; ++d)
#pragma unroll
            for (int e = 0; e < 2; ++e) { const unsigned w = d == 0 ? rf[t] : rb[t]; const float fr_ = e == 0 ? bflo(w) : bfhi(w); const float lb = e == 0 ? lbv[d].x : lbv[d].y;
                const float ex = __builtin_amdgcn_exp2f(fr_ * -1.4426950408889634f); const float t1 = (1.0f - lb) * __builtin_amdgcn_rcpf(1.0f + ex);
                om[d][e][t] = t1 * ex;
                la[d][e][t] = __builtin_amdgcn_logf(lb + t1); sum[d][e] += la[d][e][t]; }
#pragma unroll
    for (int d = 0; d < 2; ++d)
#pragma unroll
        for (int e = 0; e < 2; ++e) part[(tg * 4 + d * 2 + e) * 64 + cp] = sum[d][e];
    LDS_BARRIER();
    float T[2][2], pre[2][2];
#pragma unroll
    for (int d = 0; d < 2; ++d)
#pragma unroll
        for (int e = 0; e < 2; ++e) { float tt = 0.f, pp = 0.f;
#pragma unroll
            for (int g2 = 0; g2 < 8; ++g2) { const float v = part[(g2 * 4 + d * 2 + e) * 64 + cp]; pp += (g2 < tg) ? v : 0.f; tt += v; }
            T[d][e] = tt; pre[d][e] = pp; }
    const size_t DST = (size_t)NB * 4 * SP * 128;
    unsigned khp[2][2][4], vp[2][4];
    float eT[2][2];
#pragma unroll
    for (int d = 0; d < 2; ++d)
#pragma unroll
        for (int e = 0; e < 2; ++e) eT[d][e] = __builtin_amdgcn_exp2f(T[d][e]);
    {
        float runf[2] = {pre[0][0], pre[0][1]}, runb[2] = {pre[1][0], pre[1][1]}, pkf[2] = {0.f, 0.f}, pkb[2] = {0.f, 0.f}, pkv[2] = {0.f, 0.f};
#pragma unroll
        for (int t = 0; t < 8; ++t) { const size_t rm = ((size_t)(b * 4 + h) * SP + s0 + 8 * tg + t) * 128 + ch0;
            const float qv[2] = {siluf(bflo(rq[t])) * 0.08838834764831845f, siluf(bfhi(rq[t])) * 0.08838834764831845f};
            float ktf[2], ktb[2], qtf[2], qtb[2];
#pragma unroll
            for (int e = 0; e < 2; ++e) {
                runf[e] += la[0][e][t]; const float Ef = __builtin_amdgcn_exp2f(-runf[e]);
                const float gb = T[1][e] - runb[e]; runb[e] += la[1][e][t]; const float Eb = __builtin_amdgcn_exp2f(-gb);
                ktf[e] = om[0][e][t] * Ef; ktb[e] = om[1][e][t] * Eb; qtf[e] = qv[e] * __builtin_amdgcn_rcpf(Ef); qtb[e] = qv[e] * __builtin_amdgcn_rcpf(Eb);
                const float khf = ktf[e] * eT[0][e], khb = ktb[e] * eT[1][e], iv = e == 0 ? bflo(ri[t]) : bfhi(ri[t]);
                if (t & 1) { khp[0][e][t >> 1] = cvt_pk_bf16(pkf[e], khf); khp[1][e][t >> 1] = cvt_pk_bf16(pkb[e], khb); vp[e][t >> 1] = cvt_pk_bf16(pkv[e], iv); } else { pkf[e] = khf; pkb[e] = khb; pkv[e] = iv; } }
            *(unsigned*)(QS + rm) = cvt_pk_bf16(qtf[0], qtf[1]); *(unsigned*)(QS + DST + rm) = cvt_pk_bf16(qtb[0], qtb[1]);
            *(unsigned*)(KS + rm) = cvt_pk_bf16(ktf[0], ktf[1]); *(unsigned*)(KS + DST + rm) = cvt_pk_bf16(ktb[0], ktb[1]); }
    }
#pragma unroll
    for (int e = 0; e < 2; ++e) {
        *(LAS u32x4*)(KHl + (0 * 128 + ch0 + e) * 72 + 8 * tg) = (u32x4){khp[0][e][0], khp[0][e][1], khp[0][e][2], khp[0][e][3]};
        *(LAS u32x4*)(KHl + (1 * 128 + ch0 + e) * 72 + 8 * tg) = (u32x4){khp[1][e][0], khp[1][e][1], khp[1][e][2], khp[1][e][3]};
        *(LAS u32x4*)(VTl + (ch0 + e) * 72 + 8 * tg) = (u32x4){vp[e][0], vp[e][1], vp[e][2], vp[e][3]};
        *(u32x4*)(VT + (size_t)((b * 4 + h) * 128 + ch0 + e) * SP + s0 + 8 * tg) = (u32x4){vp[e][0], vp[e][1], vp[e][2], vp[e][3]}; }
    if (tg == 0) {
#pragma unroll
        for (int d = 0; d < 2; ++d) { const f32x2 et = (f32x2){eT[d][0], eT[d][1]};
            *(f32x2*)(EG + ((size_t)((d * 4 + b) * 4 + h) * NCH + c) * 128 + ch0) = et; *(LAS f32x2*)(ETl + (sub * 2 + d) * 128 + ch0) = et;
            if (sub) { const f32x2 e0 = *(const LAS f32x2*)(ETl + d * 128 + ch0); *(f32x2*)(EGP + ((size_t)((d * 4 + b) * 4 + h) * NPR + pr) * 128 + ch0) = (f32x2){e0.x * et.x, e0.y * et.y}; } } }
    LDS_BARRIER();
    {
        const int fr = C.lane & 15, q = C.lane >> 4;
        LAS u32x2* dlb = DL + C.tid; asm volatile("" : "+v"(dlb));
        bf16x8 Bf[2];
#pragma unroll
        for (int ks = 0; ks < 2; ++ks) Bf[ks] = *(const LAS bf16x8*)(VTl + (16 * C.wave + fr) * 72 + 32 * ks + 8 * q);
#pragma unroll
        for (int d = 0; d < 2; ++d) { const int seq = (d * NB + b) * 4 + h;
#pragma unroll
            for (int at = 0; at < 8; ++at) { f32x4 t4 = (f32x4){0.f, 0.f, 0.f, 0.f};
#pragma unroll
                for (int ks = 0; ks < 2; ++ks) { const bf16x8 Af = *(const LAS bf16x8*)(KHl + (d * 128 + 16 * at + fr) * 72 + 32 * ks + 8 * q); t4 = MFMA16(Af, Bf[ks], t4); }
                LAS u32x2* dl = dlb + (d * 8 + at) * 512;
                if (sub == 0) *dl = (u32x2){cvt_pk_bf16(t4[0], t4[1]), cvt_pk_bf16(t4[2], t4[3])};
                else { const u32x2 pw = *dl; const f32x4 pv = (f32x4){bflo(pw.x), bfhi(pw.x), bflo(pw.y), bfhi(pw.y)};
                    const f32x4 r4 = d == 0 ? pv * *(const LAS f32x4*)(ETl + (1 * 2 + 0) * 128 + 16 * at + 4 * q) + t4
                                            : pv + t4 * *(const LAS f32x4*)(ETl + (0 * 2 + 1) * 128 + 16 * at + 4 * q);
                    DSP[((size_t)seq * NPR + pr) * 4096 + (at * 8 + C.wave) * 64 + C.lane] = (u32x2){cvt_pk_bf16(r4[0], r4[1]), cvt_pk_bf16(r4[2], r4[3])}; }
                if (at & 1) asm volatile("" ::: "memory"); } }
    }
    LDS_BARRIER();
    }
}
__device__ __forceinline__ void phase4(CArgs& a, const Ctx& C) {
    constexpr int NHU = NB * NPR * 4;
#pragma unroll 1
    for (int k = 0; k < 4; ++k) { int u; const int v = C.vcu;
        if (k == 0) u = v;
        else if (k == 1) u = v < 208 ? 256 + v : NHU + (v - 208);
        else if (k == 2) u = v < 80 ? 464 + v : (v < 208 ? NHU + 48 + (v - 80) : NHU + 176 + (v - 208));
        else { if (v < 208) break; u = NHU + 224 + (v - 208); }
        if (u < NHU) prep_hg_pair(a, C, u); else prep_ssd_unit(a, C, u - NHU); }
}
__device__ __forceinline__ void phase5(CArgs& a, const Ctx& C) { (void)a; (void)C; }
__device__ __forceinline__ int scan_chunk(int dir, int k) { return dir == 0 ? k : (k < 4 ? 3 - k : 71 - k); }
__device__ __forceinline__ void phase6(CArgs& a, const Ctx& C) {
    const u32x2* DSS = (const u32x2*)(a.ws + WS_DSS); const u32x2* DSP = (const u32x2*)(a.ws + WS_DSP);
    u32x2* SPS = (u32x2*)(a.ws + WS_SPS); u32x2* SPH = (u32x2*)(a.ws + WS_SPH);
    const float* GEND = (const float*)(a.ws + WS_GEND); const float* EGP = (const float*)(a.ws + WS_EGP);
    if (C.vcu < 128) {
        const int task = C.vcu * 512 + C.tid, seq = task >> 10, grp = task & 1023, dir = (seq >> 3) & 1;
        f32x4 S = (f32x4){0.f, 0.f, 0.f, 0.f};
#pragma unroll 1
        for (int kb = 0; kb < NCH; kb += 17) { u32x2 dw[17]; float gd[17];
#pragma unroll
            for (int j = 0; j < 17; ++j) { const int tc = scan_chunk(dir, kb + j); dw[j] = NTLOAD(&DSS[((size_t)seq * NCH + tc) * 1024 + grp]); gd[j] = GEND[seq * NCH + tc]; }
            asm volatile("" ::: "memory");
#pragma unroll
            for (int j = 0; j < 17; ++j) { const int tc = scan_chunk(dir, kb + j);
                if (tc >= 4) SPS[((size_t)seq * NCH + tc) * 1024 + grp] = (u32x2){cvt_pk_bf16(S[0], S[1]), cvt_pk_bf16(S[2], S[3])};
                S = S * __expf(gd[j]) + (f32x4){bflo(dw[j].x), bfhi(dw[j].x), bflo(dw[j].y), bfhi(dw[j].y)}; }
            asm volatile("" ::: "memory"); }
    } else {
#pragma unroll 1
        for (int rep = 0; rep < 2; ++rep) {
            const int t = (C.vcu - 128) * 1024 + rep * 512 + C.tid, seq = t >> 12, grp = t & 4095, d = seq >> 4, tile = grp >> 6, ln = grp & 63, cb = 16 * (tile >> 3) + 4 * (ln >> 4);
            f32x4 S = (f32x4){0.f, 0.f, 0.f, 0.f};
#pragma unroll 1
            for (int kb = 0; kb < NPR; kb += 17) { u32x2 dw[17]; f32x4 dec[17];
#pragma unroll
                for (int j = 0; j < 17; ++j) { const int k = kb + j, tp = d == 0 ? k : (k < 2 ? 1 - k : 35 - k); dw[j] = NTLOAD(&DSP[((size_t)seq * NPR + tp) * 4096 + grp]); dec[j] = *(const f32x4*)(EGP + ((size_t)seq * NPR + tp) * 128 + cb); }
                asm volatile("" ::: "memory");
#pragma unroll
                for (int j = 0; j < 17; ++j) { const int k = kb + j, tp = d == 0 ? k : (k < 2 ? 1 - k : 35 - k);
                    if (tp >= 2) SPH[((size_t)seq * NPR + tp) * 4096 + grp] = (u32x2){cvt_pk_bf16(S[0], S[1]), cvt_pk_bf16(S[2], S[3])};
                    S = S * dec[j] + (f32x4){bflo(dw[j].x), bfhi(dw[j].x), bflo(dw[j].y), bfhi(dw[j].y)}; }
                asm volatile("" ::: "memory"); } }
    }
}
typedef short s16x4 __attribute__((ext_vector_type(4)));
typedef short s16x8 __attribute__((ext_vector_type(8)));
__device__ __forceinline__ s16x4 lds_tr(const LAS bf16* p) { return __builtin_amdgcn_ds_read_tr16_b64_v4i16((LAS s16x4*)p); }
__device__ __forceinline__ bf16x8 ld_split8(const bf16* p0, const bf16* p1) {
    const u32x2 lo = *(const u32x2*)p0, hi = *(const u32x2*)p1; u32x4 w = (u32x4){lo.x, lo.y, hi.x, hi.y}; return __builtin_bit_cast(bf16x8, w);
}
__device__ __forceinline__ void passc_ssd_unit(CArgs& a, const Ctx& C, int unit) {
    const bf16* BC = (const bf16*)(a.ws + WS_BC); const bf16* XST = (const bf16*)(a.ws + WS_XST); const bf16* U = (const bf16*)(a.ws + WS_U);
    const float* GA = (const float*)(a.ws + WS_GA); const float* DTA = (const float*)(a.ws + WS_DTA); const bf16* SPS = (const bf16*)(a.ws + WS_SPS);
    bf16* Y = (bf16*)(a.ws + WS_Y);
    const int b = unit >> 6, tcl = unit & 63, tc = tcl + 4, s0 = 64 * tc, row0 = b * SEQ + 64 * tcl;
    const int h = C.wave, g = h >> 2, fr = C.lane & 15, q = C.lane >> 4;
    LAS unsigned char* wl = C.lds + C.wave * 17408;
    LAS bf16* Ml = (LAS bf16*)wl; LAS float* Yl = (LAS float*)wl; LAS float* red = (LAS float*)(C.lds + 8 * 17408);
    {
        bf16x8 Ca[4][2], Bb[4][2];
#pragma unroll
        for (int t = 0; t < 4; ++t)
#pragma unroll
            for (int ks = 0; ks < 2; ++ks) { const bf16* rp = BC + (size_t)(row0 + 16 * t + fr) * 256 + g * 64 + 32 * ks + 8 * q;
                Bb[t][ks] = *(const bf16x8*)rp; Ca[t][ks] = *(const bf16x8*)(rp + 128); }
        const size_t sf = (size_t)((b * 2 + 0) * 8 + h) * SP + s0, sb = (size_t)((b * 2 + 1) * 8 + h) * SP + s0;
        float gjf[4], gjb[4], dtf[4], dtb[4];
#pragma unroll
        for (int jt = 0; jt < 4; ++jt) { gjf[jt] = GA[sf + 16 * jt + fr]; gjb[jt] = GA[sb + 16 * jt + fr]; dtf[jt] = DTA[sf + 16 * jt + fr]; dtb[jt] = DTA[sb + 16 * jt + fr]; }
        const float Dh = a.ssd_d[h];
#pragma unroll
        for (int it = 0; it < 4; ++it) {
            const f32x4 gif = *(const f32x4*)(GA + sf + 16 * it + 4 * q), gib = *(const f32x4*)(GA + sb + 16 * it + 4 * q);
#pragma unroll
            for (int jt = 0; jt < 4; ++jt) { f32x4 G = (f32x4){0.f, 0.f, 0.f, 0.f};
                G = MFMA16(Ca[it][0], Bb[jt][0], G); G = MFMA16(Ca[it][1], Bb[jt][1], G);
                const int j = 16 * jt + fr;
#pragma unroll
                for (int r = 0; r < 4; ++r) { const int i = 16 * it + 4 * q + r;
                    const float lf = (j <= i) ? dtf[jt] * __expf(fminf(gif[r] - gjf[jt], 0.f)) : 0.f;
                    const float lb = (j >= i) ? dtb[jt] * __expf(fminf(gib[r] - gjb[jt], 0.f)) : 0.f;
                    const float m = G[r] * (lf + lb) + ((i == j) ? Dh : 0.f);
                    Ml[i * 72 + j] = (bf16)(cvt_pk_bf16(m, 0.f) & 0xffff); } } }
    }
    LDS_WAIT(); asm volatile("" ::: "memory");
    bf16x8 Ma[4][2], Cp[4][2];
#pragma unroll
    for (int it = 0; it < 4; ++it)
#pragma unroll
        for (int ks = 0; ks < 2; ++ks) { Ma[it][ks] = *(const LAS bf16x8*)(Ml + (16 * it + fr) * 72 + 32 * ks + 8 * q);
            const bf16* cp = BC + (size_t)(row0 + 16 * it + fr) * 256 + 128 + g * 64 + 32 * ks + 4 * q; Cp[it][ks] = ld_split8(cp, cp + 16); }
    LDS_WAIT(); asm volatile("" ::: "memory");
    f32x4 eg[2][4];
#pragma unroll
    for (int d = 0; d < 2; ++d)
#pragma unroll
        for (int it = 0; it < 4; ++it) { const f32x4 gi = *(const f32x4*)(GA + (size_t)((b * 2 + d) * 8 + h) * SP + s0 + 16 * it + 4 * q);
            eg[d][it] = (f32x4){__expf(gi[0]), __expf(gi[1]), __expf(gi[2]), __expf(gi[3])}; }
#pragma unroll 1
    for (int pt = 0; pt < 4; ++pt) {
        bf16x8 Bx[2];
#pragma unroll
        for (int ks = 0; ks < 2; ++ks) Bx[ks] = *(const bf16x8*)(XST + (size_t)((b * 8 + h) * 64 + 16 * pt + fr) * SP + s0 + 32 * ks + 8 * q);
        f32x4 Yv[4];
#pragma unroll
        for (int it = 0; it < 4; ++it) { Yv[it] = (f32x4){0.f, 0.f, 0.f, 0.f}; Yv[it] = MFMA16(Ma[it][0], Bx[0], Yv[it]); Yv[it] = MFMA16(Ma[it][1], Bx[1], Yv[it]); }
#pragma unroll
        for (int d = 0; d < 2; ++d) { const size_t sbase = ((size_t)((b * 2 + d) * 8 + h) * NCH + tc) * 1024;
            bf16x8 Sb[2];
#pragma unroll
            for (int ks = 0; ks < 2; ++ks) Sb[ks] = ld_split8(SPS + (sbase + ((2 * ks) * 4 + pt) * 64 + C.lane) * 4, SPS + (sbase + ((2 * ks + 1) * 4 + pt) * 64 + C.lane) * 4);
#pragma unroll
            for (int it = 0; it < 4; ++it) { f32x4 T = (f32x4){0.f, 0.f, 0.f, 0.f}; T = MFMA16(Cp[it][0], Sb[0], T); T = MFMA16(Cp[it][1], Sb[1], T); Yv[it] += eg[d][it] * T; } }
#pragma unroll
        for (int it = 0; it < 4; ++it)
#pragma unroll
            for (int r = 0; r < 4; ++r) Yl[(16 * it + 4 * q + r) * 68 + 16 * pt + fr] = Yv[it][r];
    }
    LDS_WAIT(); asm volatile("" ::: "memory");
    const int i = C.lane; float v[64]; float ss = 0.f;
    const bf16* zp = U + (size_t)(row0 + i) * NU + h * 64;
#pragma unroll
    for (int c8 = 0; c8 < 8; ++c8) { const u32x4 zw = *(const u32x4*)(zp + 8 * c8); const f32x4 y0 = *(const LAS f32x4*)(Yl + i * 68 + 8 * c8), y1 = *(const LAS f32x4*)(Yl + i * 68 + 8 * c8 + 4);
        const unsigned zz[4] = {zw.x, zw.y, zw.z, zw.w};
#pragma unroll
        for (int e = 0; e < 4; ++e) { const float ya = e < 2 ? y0[2 * e] : y1[2 * e - 4], yb = e < 2 ? y0[2 * e + 1] : y1[2 * e - 3];
            const float va = ya * siluf(bflo(zz[e])), vb = yb * siluf(bfhi(zz[e])); v[8 * c8 + 2 * e] = va; v[8 * c8 + 2 * e + 1] = vb; ss += va * va + vb * vb; } }
    red[C.wave * 64 + i] = ss;
    LDS_BARRIER();
    float tot = 0.f;
#pragma unroll
    for (int w = 0; w < 8; ++w) tot += red[w * 64 + i];
    const float rstd = rsqrtf(tot * (1.0f / 512.0f) + EPS);
    bf16* yo = Y + (size_t)(row0 + i) * D + h * 64;
#pragma unroll
    for (int c8 = 0; c8 < 8; ++c8) { const f32x4 n0 = *(const f32x4*)(a.ssd_norm + h * 64 + 8 * c8), n1 = *(const f32x4*)(a.ssd_norm + h * 64 + 8 * c8 + 4);
        u32x4 o; o.x = cvt_pk_bf16(v[8 * c8] * rstd * n0[0], v[8 * c8 + 1] * rstd * n0[1]); o.y = cvt_pk_bf16(v[8 * c8 + 2] * rstd * n0[2], v[8 * c8 + 3] * rstd * n0[3]);
        o.z = cvt_pk_bf16(v[8 * c8 + 4] * rstd * n1[0], v[8 * c8 + 5] * rstd * n1[1]); o.w = cvt_pk_bf16(v[8 * c8 + 6] * rstd * n1[2], v[8 * c8 + 7] * rstd * n1[3]);
        *(u32x4*)(yo + 8 * c8) = o; }
    LDS_BARRIER();
}
__device__ __forceinline__ void passc_hg_pair(CArgs& a, const Ctx& C, int unit) {
    const bf16* QS = (const bf16*)(a.ws + WS_QS); const bf16* KS = (const bf16*)(a.ws + WS_KS); const bf16* VT = (const bf16*)(a.ws + WS_VT); const bf16* SPH = (const bf16*)(a.ws + WS_SPH);
    const bf16* U = (const bf16*)(a.ws + WS_U); bf16* Y = (bf16*)(a.ws + WS_Y); const float* EG = (const float*)(a.ws + WS_EG);
    const int b = unit >> 7, pr = 2 + ((unit >> 2) & 31), h = unit & 3;
    const int wv = C.wave, fr = C.lane & 15, q = C.lane >> 4;
    LAS bf16* Pl = (LAS bf16*)C.lds; LAS float* Ol = (LAS float*)(C.lds + 9216); LAS float* red = (LAS float*)(C.lds + 9216 + 64 * 132 * 4);
    LAS bf16* KL = (LAS bf16*)(C.lds + 79872);
    LAS bf16* QL = (LAS bf16*)(C.lds + 45056);
    const size_t DST = (size_t)NB * 4 * SP * 128;
#pragma unroll 1
    for (int sub = 0; sub < 2; ++sub) {
    const int tc = 2 * pr + sub, w = tc - 4, s0 = 64 * tc, oc = 2 * pr + 1 - sub;
    const int it0 = wv >> 1;
    bf16x8 Aq[2][4], Bk[2][2][4];
#pragma unroll
    for (int d = 0; d < 2; ++d) { const size_t base = d * DST + ((size_t)(b * 4 + h) * SP + s0) * 128;
#pragma unroll
        for (int ks = 0; ks < 4; ++ks) { Aq[d][ks] = *(const bf16x8*)(QS + base + (size_t)(16 * it0 + fr) * 128 + 32 * ks + 8 * q);
#pragma unroll
            for (int j2 = 0; j2 < 2; ++j2) Bk[d][j2][ks] = *(const bf16x8*)(KS + base + (size_t)(16 * (2 * (wv & 1) + j2) + fr) * 128 + 32 * ks + 8 * q); } }
    bf16x8 Bv[2], Vo[2], SbD[4];
#pragma unroll
    for (int ks = 0; ks < 2; ++ks) Bv[ks] = *(const bf16x8*)(VT + (size_t)((b * 4 + h) * 128 + 16 * wv + fr) * SP + s0 + 32 * ks + 8 * q);
    const int dm = 1 - sub;
#pragma unroll
    for (int ks = 0; ks < 2; ++ks) Vo[ks] = *(const bf16x8*)(VT + (size_t)((b * 4 + h) * 128 + 16 * wv + fr) * SP + 64 * oc + 32 * ks + 8 * q);
    u32x2 sp[8];
    { const size_t sbD = ((size_t)((sub * NB + b) * 4 + h) * NPR + pr) * 4096, sbM = ((size_t)((dm * NB + b) * 4 + h) * NPR + pr) * 4096;
#pragma unroll
        for (int ks = 0; ks < 4; ++ks) SbD[ks] = ld_split8(SPH + (sbD + ((2 * ks) * 8 + wv) * 64 + C.lane) * 4, SPH + (sbD + ((2 * ks + 1) * 8 + wv) * 64 + C.lane) * 4);
#pragma unroll
        for (int at = 0; at < 8; ++at) sp[at] = *(const u32x2*)(SPH + (sbM + (at * 8 + wv) * 64 + C.lane) * 4); }
    const int kr = C.tid >> 3, kc = (C.tid & 7) * 16;
    const bf16* kso = KS + dm * DST + ((size_t)(b * 4 + h) * SP + 64 * oc) * 128 + kr * 128 + kc;
    const u32x4 kt0 = *(const u32x4*)kso, kt1 = *(const u32x4*)(kso + 8);
    const int i = C.lane;
    const size_t row = (size_t)b * SEQ + i * 64 + w;
    const bf16* gp = U + row * NU + 1280 + 2048 + h * 128 + 16 * wv; bf16* yo = Y + row * D + 512 + h * 128 + 16 * wv; const float* nwp = a.hg_norm + h * 128 + 16 * wv;
    const u32x4 gw0 = *(const u32x4*)gp, gw1 = *(const u32x4*)(gp + 8);
    f32x4 nw[4];
#pragma unroll
    for (int c4 = 0; c4 < 4; ++c4) nw[c4] = *(const f32x4*)(nwp + 4 * c4);
    {
        f32x4 P[2] = {(f32x4){0.f, 0.f, 0.f, 0.f}, (f32x4){0.f, 0.f, 0.f, 0.f}};
#pragma unroll
        for (int d = 0; d < 2; ++d) {
#pragma unroll
            for (int ks = 0; ks < 4; ++ks) if ((wv & 1) == 0) *(LAS bf16x8*)(QL + (d * 64 + 16 * it0 + fr) * 136 + 32 * ks + 8 * q) = Aq[d][ks];
#pragma unroll
            for (int j2 = 0; j2 < 2; ++j2) { const int jt = 2 * (wv & 1) + j2; f32x4 S = (f32x4){0.f, 0.f, 0.f, 0.f};
#pragma unroll
                for (int ks = 0; ks < 4; ++ks) S = MFMA16(Aq[d][ks], Bk[d][j2][ks], S);
                const int j = 16 * jt + fr;
#pragma unroll
                for (int r = 0; r < 4; ++r) { const int ii = 16 * it0 + 4 * q + r; const bool keep = d == 0 ? (j <= ii) : (j >= ii); P[j2][r] += keep ? S[r] : 0.f; } } }
#pragma unroll
        for (int j2 = 0; j2 < 2; ++j2) { const int j = 16 * (2 * (wv & 1) + j2) + fr;
#pragma unroll
            for (int r = 0; r < 4; ++r) Pl[(16 * it0 + 4 * q + r) * 72 + j] = (bf16)(cvt_pk_bf16(P[j2][r], 0.f) & 0xffff); }
        *(LAS u32x4*)(KL + kr * 136 + kc) = kt0; *(LAS u32x4*)(KL + kr * 136 + kc + 8) = kt1;
    }
    LDS_BARRIER();
    f32x4 O[4];
#pragma unroll
    for (int it = 0; it < 4; ++it) { O[it] = (f32x4){0.f, 0.f, 0.f, 0.f};
#pragma unroll
        for (int ks = 0; ks < 2; ++ks) { const bf16x8 Pa = *(const LAS bf16x8*)(Pl + (16 * it + fr) * 72 + 32 * ks + 8 * q); O[it] = MFMA16(Pa, Bv[ks], O[it]); } }
    bf16x8 SbM[4];
    { const float* eg = EG + ((size_t)((dm * NB + b) * 4 + h) * NCH + oc) * 128 + 4 * q;
        const LAS bf16* kt = KL + (8 * q + (fr >> 2)) * 136 + 4 * (fr & 3);
#pragma unroll
        for (int ks = 0; ks < 4; ++ks) { unsigned wd[4];
#pragma unroll
            for (int hh = 0; hh < 2; ++hh) { const int at = 2 * ks + hh; f32x4 t4 = (f32x4){bflo(sp[at].x), bfhi(sp[at].x), bflo(sp[at].y), bfhi(sp[at].y)};
#pragma unroll
                for (int k2 = 0; k2 < 2; ++k2) { const s16x4 a0 = lds_tr(kt + (32 * k2) * 136 + 16 * at), a1 = lds_tr(kt + (32 * k2 + 4) * 136 + 16 * at);
                    const s16x8 av = (s16x8){a0[0], a0[1], a0[2], a0[3], a1[0], a1[1], a1[2], a1[3]}; t4 = MFMA16(__builtin_bit_cast(bf16x8, av), Vo[k2], t4); }
                const f32x4 e4 = *(const f32x4*)(eg + 16 * at);
                wd[2 * hh] = cvt_pk_bf16(t4[0] * e4[0], t4[1] * e4[1]); wd[2 * hh + 1] = cvt_pk_bf16(t4[2] * e4[2], t4[3] * e4[3]); }
            const u32x4 ww = (u32x4){wd[0], wd[1], wd[2], wd[3]}; SbM[ks] = __builtin_bit_cast(bf16x8, ww); } }
#pragma unroll
    for (int d = 0; d < 2; ++d)
#pragma unroll
        for (int ks = 0; ks < 4; ++ks) { const bf16x8 sb = d == sub ? SbD[ks] : SbM[ks];
#pragma unroll
            for (int it = 0; it < 4; ++it) { const LAS bf16* qp = QL + (d * 64 + 16 * it + fr) * 136 + 32 * ks + 4 * q;
                const u32x2 lo = *(const LAS u32x2*)qp, hi = *(const LAS u32x2*)(qp + 16); const u32x4 ww = (u32x4){lo.x, lo.y, hi.x, hi.y};
                O[it] = MFMA16(__builtin_bit_cast(bf16x8, ww), sb, O[it]); } }
#pragma unroll
    for (int it = 0; it < 4; ++it)
#pragma unroll
        for (int r = 0; r < 4; ++r) Ol[(16 * it + 4 * q + r) * 132 + 16 * wv + fr] = O[it][r];
    LDS_BARRIER();
    float o[16]; float ss = 0.f;
#pragma unroll
    for (int c4 = 0; c4 < 4; ++c4) { const f32x4 t = *(const LAS f32x4*)(Ol + i * 132 + 16 * wv + 4 * c4);
#pragma unroll
        for (int e = 0; e < 4; ++e) { o[4 * c4 + e] = t[e]; ss += t[e] * t[e]; } }
    red[wv * 64 + i] = ss;
    LDS_BARRIER();
    float tot = 0.f;
#pragma unroll
    for (int s2 = 0; s2 < 8; ++s2) tot += red[s2 * 64 + i];
    const float rstd = rsqrtf(tot * (1.0f / 128.0f) + EPS);
#pragma unroll
    for (int c8 = 0; c8 < 2; ++c8) { const u32x4 gw4 = c8 == 0 ? gw0 : gw1; const unsigned gz[4] = {gw4.x, gw4.y, gw4.z, gw4.w}; unsigned ow[4];
#pragma unroll
        for (int e = 0; e < 4; ++e) { const int k = 8 * c8 + 2 * e; ow[e] = cvt_pk_bf16(o[k] * rstd * nw[k >> 2][k & 3] * siluf(bflo(gz[e])), o[k + 1] * rstd * nw[(k + 1) >> 2][(k + 1) & 3] * siluf(bfhi(gz[e]))); }
        *(u32x4*)(yo + 8 * c8) = (u32x4){ow[0], ow[1], ow[2], ow[3]}; }
    LDS_BARRIER();
    }
}
__device__ __forceinline__ void phase7(CArgs& a, const Ctx& C) {
    for (int u = C.vcu; u < 256; u += C.G) passc_ssd_unit(a, C, u);
    for (int u = C.vcu; u < 512; u += C.G) passc_hg_pair(a, C, u);
}
__device__ __forceinline__ void phase9(CArgs& a, const Ctx& C) {
    constexpr int NR = 4;
    const float* MOD = (const float*)(a.ws + WS_MOD); const bf16* MIX = (const bf16*)(a.ws + WS_MIX); unsigned char* HX = a.ws + WS_XN; bf16* X1 = (bf16*)(a.ws + WS_U);
    int* TOPE = (int*)(a.ws + WS_ROUTE); float* GATE = (float*)(a.ws + WS_ROUTE + 256 * 1024); int* PPOS = (int*)(a.ws + WS_ROUTE + 512 * 1024); int* ROWTOK = (int*)(a.ws + WS_ROWTOK);
    unsigned* gcnt = (unsigned*)(a.ws + WS_CTL) + CW_CNT;
    LAS float* RW = (LAS float*)C.lds;
    LAS float* LG = (LAS float*)(C.lds + 131072) + C.wave * 128;
    LAS unsigned* lcnt = (LAS unsigned*)(C.lds + LCNT_OFF); LAS unsigned* lbase = lcnt + 32;
    for (int k = C.tid; k < D; k += 512) {
#pragma unroll
        for (int e4 = 0; e4 < 8; ++e4) { const f32x4 w = *(const f32x4*)(a.router_w + (size_t)k * NE + 4 * e4);
#pragma unroll
            for (int e = 0; e < 4; ++e) RW[(4 * e4 + e) * D + k] = w[e]; } }
    if (C.tid < 32) lcnt[C.tid] = 0u;
    __syncthreads();
    LAS float* VA = (LAS float*)(C.lds + 131072 + 4096); LAS float* VB = VA + 1024;
    for (int m0 = NR * C.gw; m0 < NLAT; m0 += NR * C.NGW) {
        const int b = m0 >> 12; const float* mb = MOD + b * 6144;
        __syncthreads();
        for (int k = C.tid; k < D; k += 512) { VA[k] = mb[2048 + k] * a.mix_post[k]; VB[k] = a.ffn_pre[k] * (1.0f + mb[4096 + k]); }
        __syncthreads();
        float hv[NR][16];
#pragma unroll
        for (int r = 0; r < NR; ++r) { const size_t ro = (size_t)(m0 + r) * D; float ss = 0.f;
            f32x4 xv[4];
#pragma unroll
            for (int jj = 0; jj < 4; ++jj) { const u32x2 w = NTLOAD((const u32x2*)(MIX + ro + 256 * jj + 4 * C.lane)); xv[jj] = NTLOAD((const f32x4*)(a.x + ro + 256 * jj + 4 * C.lane));
                hv[r][4 * jj] = bflo(w.x); hv[r][4 * jj + 1] = bfhi(w.x); hv[r][4 * jj + 2] = bflo(w.y); hv[r][4 * jj + 3] = bfhi(w.y); }
#pragma unroll
            for (int i = 0; i < 16; ++i) ss += hv[r][i] * hv[r][i];
            const float rstd = rsqrtf(wave_sum(ss) * (1.0f / D) + EPS); float ss2 = 0.f;
#pragma unroll
            for (int jj = 0; jj < 4; ++jj) { const int k0 = 256 * jj + 4 * C.lane; const f32x4 va = *(const LAS f32x4*)(VA + k0);
                f32x4 x1;
#pragma unroll
                for (int e = 0; e < 4; ++e) { x1[e] = xv[jj][e] + va[e] * (hv[r][4 * jj + e] * rstd); hv[r][4 * jj + e] = x1[e]; ss2 += x1[e] * x1[e]; }
                *(u32x2*)(X1 + ro + k0) = (u32x2){cvt_pk_bf16(x1[0], x1[1]), cvt_pk_bf16(x1[2], x1[3])}; }
            const float rstd2 = rsqrtf(wave_sum(ss2) * (1.0f / D) + EPS);
#pragma unroll
            for (int jj = 0; jj < 4; ++jj) { const int k0 = 256 * jj + 4 * C.lane; const f32x4 vb = *(const LAS f32x4*)(VB + k0), s0 = *(const f32x4*)(mb + 3072 + k0);
#pragma unroll
                for (int e = 0; e < 4; ++e) hv[r][4 * jj + e] = hv[r][4 * jj + e] * rstd2 * vb[e] + s0[e];
                *(unsigned*)(HX + ro + k0) = pk4_fp8(hv[r][4 * jj], hv[r][4 * jj + 1], hv[r][4 * jj + 2], hv[r][4 * jj + 3]); }
            if (r & 1) asm volatile("" ::: "memory"); }
#pragma unroll 1
        for (int eg = 0; eg < 4; ++eg) {
            float lg[NR][8];
#pragma unroll
            for (int r = 0; r < NR; ++r)
#pragma unroll
                for (int e = 0; e < 8; ++e) lg[r][e] = 0.f;
#pragma unroll
            for (int e = 0; e < 8; ++e)
#pragma unroll
                for (int jj = 0; jj < 4; ++jj) { const f32x4 w = *(const LAS f32x4*)(RW + (8 * eg + e) * D + 256 * jj + 4 * C.lane);
#pragma unroll
                    for (int r = 0; r < NR; ++r) lg[r][e] += hv[r][4 * jj] * w[0] + hv[r][4 * jj + 1] * w[1] + hv[r][4 * jj + 2] * w[2] + hv[r][4 * jj + 3] * w[3];
                    if (jj == 3 && (e & 1)) asm volatile("" ::: "memory"); }
#pragma unroll
            for (int r = 0; r < NR; ++r) { reduce_scatter<8>(lg[r], C.lane);
                if ((C.lane & 7) == 0) LG[r * 32 + 8 * eg + (C.lane >> 3)] = lg[r][0]; }
        }
        LDS_WAIT(); asm volatile("" ::: "memory");
        if (C.lane < NR) { const int m = m0 + C.lane; float logit[32];
#pragma unroll
            for (int e4 = 0; e4 < 8; ++e4) { const f32x4 v = *(const LAS f32x4*)(LG + C.lane * 32 + 4 * e4), rb = *(const f32x4*)(a.router_b + 4 * e4);
#pragma unroll
                for (int e = 0; e < 4; ++e) logit[4 * e4 + e] = v[e] + rb[e]; }
            int te[4]; float tv[4]; unsigned taken = 0u;
#pragma unroll
            for (int k = 0; k < 4; ++k) { float best = -3.0e38f; int bi = 0;
#pragma unroll
                for (int e = 0; e < 32; ++e) { const bool better = (((taken >> e) & 1u) == 0u) && (logit[e] > best); best = better ? logit[e] : best; bi = better ? e : bi; }
                te[k] = bi; tv[k] = best; taken |= 1u << bi; }
            float ex[4], sum = 0.f;
#pragma unroll
            for (int k = 0; k < 4; ++k) { ex[k] = __expf(tv[k] - tv[0]); sum += ex[k]; }
            const float inv = 1.0f / sum;
#pragma unroll
            for (int k = 0; k < 4; ++k) { const unsigned pos = __hip_atomic_fetch_add(lcnt + te[k], 1u, __ATOMIC_RELAXED, __HIP_MEMORY_SCOPE_WORKGROUP);
                TOPE[m * 4 + k] = te[k]; GATE[m * 4 + k] = ex[k] * inv; PPOS[m * 4 + k] = (int)pos; } }
        LDS_WAIT(); asm volatile("" ::: "memory");
    }
    __syncthreads();
    if (C.tid < 32) lbase[C.tid] = atomicAdd(gcnt + C.tid, lcnt[C.tid]);
    __syncthreads();
    for (int m0 = 4 * C.gw; m0 < NLAT; m0 += 4 * C.NGW) if (C.lane < 4 * NR) { const int idx = m0 * 4 + C.lane; const int e = TOPE[idx]; const int pos = PPOS[idx] + (int)lbase[e]; PPOS[idx] = pos; ROWTOK[e * 16384 + pos] = m0 + (C.lane >> 2); }
}
__device__ __forceinline__ void moe_tables(CArgs& a, const Ctx& C) {
    const unsigned* gcnt = (const unsigned*)(a.ws + WS_CTL) + CW_CNT; LAS int* TS = (LAS int*)(C.lds + TS_OFF); LAS int* CN = TS + 36;
    if (C.tid < 64) { const int e = C.tid & 31; const int c = (int)__hip_atomic_load(gcnt + e, RLX_AGENT); const int nt = (c + 255) >> 8;
        int pre = nt;
#pragma unroll
        for (int o = 1; o < 32; o <<= 1) { const int t = __shfl_up(pre, o, 32); pre += ((C.tid & 31) >= o) ? t : 0; }
        if (C.tid < 32) { TS[e] = pre - nt; CN[e] = c; if (e == 31) TS[NE] = pre; } }
    __syncthreads();
    if (C.tid < 320) { int e = 0;
#pragma unroll
        for (int k = 1; k < NE; ++k) e += (TS[k] <= C.tid) ? 1 : 0;
        TS[80 + C.tid] = e; }
    __syncthreads();
}
__device__ __forceinline__ void phase13(CArgs& a, const Ctx& C) {
    const float* MOD = (const float*)(a.ws + WS_MOD); const unsigned char* Y2 = a.ws + WS_Y2; const bf16* X1 = (const bf16*)(a.ws + WS_U);
    const int* TOPE = (const int*)(a.ws + WS_ROUTE); const float* GATE = (const float*)(a.ws + WS_ROUTE + 256 * 1024); const int* PPOS = (const int*)(a.ws + WS_ROUTE + 512 * 1024);
    moe_tables(a, C); const LAS int* TS = (const LAS int*)(C.lds + TS_OFF);
    for (int m0 = 4 * C.gw; m0 < NLAT; m0 += 4 * C.NGW) {
        const int b = m0 >> 12; const float* gf = MOD + b * 6144 + 5120;
        int slot = 0; float gk = 0.f;
        if (C.lane < 16) { const int idx = m0 * 4 + C.lane; slot = TS[TOPE[idx]] * 256 + PPOS[idx]; gk = GATE[idx] * (1.0f / Y_SCALE); }
        u32x4 yw[4][4];
#pragma unroll
        for (int r = 0; r < 4; ++r)
#pragma unroll
            for (int k = 0; k < 4; ++k) { const int sl = __shfl(slot, 4 * r + k); yw[r][k] = NTLOAD((const u32x4*)(Y2 + (size_t)sl * D + 16 * C.lane)); }
#pragma unroll
        for (int r = 0; r < 4; ++r) { float f[16];
#pragma unroll
            for (int e = 0; e < 16; ++e) f[e] = 0.f;
#pragma unroll
            for (int k = 0; k < 4; ++k) { const float g = __shfl(gk, 4 * r + k); const unsigned ww[4] = {yw[r][k].x, yw[r][k].y, yw[r][k].z, yw[r][k].w};
#pragma unroll
                for (int e = 0; e < 4; ++e) { const f32x2 lo = __builtin_amdgcn_cvt_pk_f32_fp8((int)ww[e], false), hi = __builtin_amdgcn_cvt_pk_f32_fp8((int)ww[e], true);
                    f[4 * e] += g * lo.x; f[4 * e + 1] += g * lo.y; f[4 * e + 2] += g * hi.x; f[4 * e + 3] += g * hi.y; } }
            float ss = 0.f;
#pragma unroll
            for (int e = 0; e < 16; ++e) ss += f[e] * f[e];
            const float rstd = rsqrtf(wave_sum(ss) * (1.0f / D) + EPS);
            const size_t ro = (size_t)(m0 + r) * D; const int k0 = 16 * C.lane;
            const u32x4 xa = NTLOAD((const u32x4*)(X1 + ro + k0)), xb = NTLOAD((const u32x4*)(X1 + ro + k0 + 8)); const unsigned xw[8] = {xa.x, xa.y, xa.z, xa.w, xb.x, xb.y, xb.z, xb.w};
#pragma unroll
            for (int e4 = 0; e4 < 4; ++e4) { const f32x4 w = *(const f32x4*)(a.ffn_post + k0 + 4 * e4), g = *(const f32x4*)(gf + k0 + 4 * e4);
                f32x4 o; o[0] = bflo(xw[2 * e4]) + g[0] * (f[4 * e4] * rstd * w[0]); o[1] = bfhi(xw[2 * e4]) + g[1] * (f[4 * e4 + 1] * rstd * w[1]);
                o[2] = bflo(xw[2 * e4 + 1]) + g[2] * (f[4 * e4 + 2] * rstd * w[2]); o[3] = bfhi(xw[2 * e4 + 1]) + g[3] * (f[4 * e4 + 3] * rstd * w[3]);
                *(f32x4*)(a.out + ro + k0 + 4 * e4) = o; } }
    }
}

__global__ void __launch_bounds__(512, 2) mega_fwd(Args a) {
    extern __shared__ __attribute__((aligned(16))) unsigned char lds_raw[];
#define MKCTX(C) Ctx C; { int t_ = threadIdx.x; asm volatile("" : "+v"(t_)); C.lds = (LAS unsigned char*)lds_raw; C.tid = t_; C.lane = t_ & 63; C.wave = __builtin_amdgcn_readfirstlane(t_ >> 6); \
        C.G = gridDim.x; const int bx_ = blockIdx.x; C.vcu = (C.G % 8 == 0) ? (bx_ % 8) * (C.G / 8) + bx_ / 8 : bx_; C.gw = C.vcu * 8 + C.wave; C.NGW = C.G * 8; }
    MKCTX(C);
    volatile LAS unsigned* MISC = (volatile LAS unsigned*)(C.lds + MISC_OFF);
    for (int u = C.tid; u < (LDS_BYTES - LDSCTL_OFF) / 4; u += 512) ((LAS unsigned*)(C.lds + LDSCTL_OFF))[u] = 0u;
    __syncthreads();
    const int lo = a.ph_lo, hi = a.ph_hi;
    CArgs* const kargs = (CArgs*)__builtin_amdgcn_kernarg_segment_ptr();
#define KA() (*[&]() { CArgs* p_ = kargs; asm volatile("" : "+s"(p_)); return p_; }())
    XcdBarrier bar; bar.bar = (unsigned*)(a.ws + WS_CTL) + CW_BAR; bar.x = 0; bar.st = nullptr;
    if (hi - lo > 1) bar = xcd_barrier_post((unsigned*)(a.ws + WS_CTL) + CW_BAR, MISC + 8);
#define IN(k) (lo <= (k) && (k) < hi)
#define NEXTPH(k) ((k) == 4 ? 6 : ((k) == 9 ? 11 : (k) + 1))
#define SEAM(k) do { if (IN(k) && IN(NEXTPH(k))) xcd_barrier(bar); } while (0)
    if (IN(0)) { MKCTX(C); for (int rp = 0; rp < NREP(0); ++rp) phase0(KA(), C); SEAM(0); }
    if (IN(1)) { MKCTX(C); for (int rp = 0; rp < NREP(1); ++rp) phase1(KA(), C); SEAM(1); }
    if (IN(2)) { MKCTX(C); for (int rp = 0; rp < NREP(2); ++rp) { phase2(KA(), C); __syncthreads(); } SEAM(2); }
    if (IN(3)) { MKCTX(C); pg8::Gemm g{(const bf16*)(KA().ws + WS_XN), (const bf16*)(KA().ws + WS_WINT), D}; pg8::StaticOrder S; S.init(MROWS, NU, C.G, (int)blockIdx.x);
        pg8::EpiBf16 E{(bf16*)(KA().ws + WS_U), NU, nullptr, 0, 1.0f};
        const bool odd = (C.vcu & 1) != 0;
        if (odd) { conv_w1_slice(KA(), C, 0, 1); __syncthreads(); }
        pg8::gemm_phase<false>(C.lds, g, S, E, pg8::DenseRows{}); __syncthreads();
        if (!odd) conv_w1_slice(KA(), C, 0, 1);
        SEAM(3); }
    if (IN(4)) { MKCTX(C); for (int rp = 0; rp < NREP(4); ++rp) phase4(KA(), C); SEAM(4); }

    if (IN(6)) { MKCTX(C); for (int rp = 0; rp < NREP(6); ++rp) phase6(KA(), C); SEAM(6); }
    if (IN(7)) { MKCTX(C); for (int rp = 0; rp < NREP(7); ++rp) phase7(KA(), C); SEAM(7); }
    if (IN(8)) { MKCTX(C); pg8::Gemm g{(const bf16*)(KA().ws + WS_Y), (const bf16*)(KA().ws + WS_WOUTT), D}; pg8::StaticOrder S; S.init(NLAT, D, C.G, (int)blockIdx.x);
        pg8::EpiBf16 E{(bf16*)(KA().ws + WS_MIX), D, nullptr, 0, 1.0f}; for (int rp = 0; rp < NREP(8); ++rp) pg8::gemm_phase<false>(C.lds, g, S, E, pg8::DenseRows{}); SEAM(8); }
    if (IN(9)) { MKCTX(C); phase9(KA(), C); SEAM(9); }
    if (IN(11)) { MKCTX(C); moe_tables(KA(), C); pg8::Gemm g{(const bf16*)(KA().ws + WS_XN), (const bf16*)(KA().ws + WS_W1T), D / 2};   pg8::MoeOrder S; S.init((const LAS int*)(C.lds + TS_OFF), 8, 4, (int)blockIdx.x);
        pg8::EpiSwiglu E{KA().ws + WS_ACT, D, KA().b1, 2048}; LAS unsigned* ROWL = (LAS unsigned*)(C.lds + 131072 + 2048);
        { const int* rowtok = (const int*)(KA().ws + WS_ROWTOK); const LAS int* TSl = (const LAS int*)(C.lds + TS_OFF); const LAS int* CNl = TSl + 36;
          for (int idx = C.tid; idx < 9 * 256; idx += 512) { const int i = idx >> 8, r = idx & 255; pg8::Unit uu;
              if (S.next(i, uu)) { const int p = (uu.pm - TSl[uu.e]) * 256 + r; const int tok = p < CNl[uu.e] ? rowtok[uu.e * 16384 + p] : 0; ROWL[idx] = (unsigned)tok * 1024u; } }
          __syncthreads(); }
        pg8::GatherRows AM{ROWL};
        const bool odd = (C.vcu & 1) != 0;
#pragma unroll 1
        for (int part = 0; part < 2; ++part) {
            if ((odd && part == 0) || (!odd && part == 1)) { conv_w2_slice(KA(), C, 0, 1); __syncthreads(); }
            S.i0 = odd ? 0 : 4 * part; S.n = odd ? (part == 0 ? (1 << 30) : 0) : (part == 0 ? 4 : (1 << 30));
            pg8::gemm_phase<true>(C.lds, g, S, E, AM); __syncthreads(); }
        SEAM(11); }
    if (IN(12)) { MKCTX(C); moe_tables(KA(), C); pg8::Gemm g{(const bf16*)(KA().ws + WS_ACT), (const bf16*)(KA().ws + WS_W2T), D / 2}; pg8::MoeOrder S; S.init((const LAS int*)(C.lds + TS_OFF), 4, 8, (int)blockIdx.x);
        pg8::EpiFp8 E{KA().ws + WS_Y2, D, KA().b2, D, 1.0f / (W_SCALE * ACT_SCALE)}; for (int rp = 0; rp < NREP(12); ++rp) pg8::gemm_phase<true>(C.lds, g, S, E, pg8::DenseRows{}); SEAM(12); }
    if (IN(13)) { MKCTX(C); for (int rp = 0; rp < NREP(13); ++rp) phase13(KA(), C); }
#undef IN
#undef KA
#undef SEAM
}

extern "C" void kernel_launch(void* const* d_in, const int* in_sizes, int n_in, void* d_out, int out_size, void* d_ws, size_t ws_size, hipStream_t stream) {
    static int grid = 0;
    if (grid == 0) {
        if (n_in != 26 || in_sizes[0] != NLAT * D || out_size != NLAT * D || ws_size < WS_END) {
            fprintf(stderr, "kernel_launch: unexpected shapes: n_in %d in0 %d out %d ws %zu (need %zu); nothing launched\n", n_in, n_in > 0 ? in_sizes[0] : -1, out_size, ws_size, (size_t)WS_END); grid = -1; return; }
        int dev = 0, cus = 0, per_cu = 0;
        if (hipGetDevice(&dev) != hipSuccess || hipDeviceGetAttribute(&cus, hipDeviceAttributeMultiprocessorCount, dev) != hipSuccess) { fprintf(stderr, "kernel_launch: device query failed\n"); grid = -1; return; }
        if (hipFuncSetAttribute((const void*)mega_fwd, hipFuncAttributeMaxDynamicSharedMemorySize, LDS_BYTES) != hipSuccess) { fprintf(stderr, "kernel_launch: hipFuncSetAttribute failed\n"); grid = -1; return; }
        if (hipOccupancyMaxActiveBlocksPerMultiprocessor(&per_cu, (const void*)mega_fwd, 512, LDS_BYTES) != hipSuccess || per_cu < 1)
            fprintf(stderr, "kernel_launch: note: occupancy query reports %d workgroups per CU\n", per_cu);
        (void)hipGetLastError();
        grid = cus;
        if (grid != 256) { fprintf(stderr, "kernel_launch: this kernel needs a 256-CU device (got %d)\n", grid); grid = -1; return; }
    }
    if (grid < 0) return;
    (void)hipMemsetAsync((char*)d_ws + WS_CTL, 0, CTL_ZERO_BYTES, stream);
    Args a{};
    const float** ap = (const float**)&a;
    for (int i = 0; i < 26; ++i) ap[i] = (const float*)d_in[i];
    a.out = (float*)d_out; a.ws = (unsigned char*)d_ws;
#if MK_PER_PHASE
    for (int p = 0; p < NPHASE; ++p) { a.ph_lo = p; a.ph_hi = p + 1; hipLaunchKernelGGL(mega_fwd, dim3(grid), dim3(512), LDS_BYTES, stream, a); }
#else
    a.ph_lo = 0; a.ph_hi = NPHASE; hipLaunchKernelGGL(mega_fwd, dim3(grid), dim3(512), LDS_BYTES, stream, a);
#endif
}
```

```cpp
#include <hip/hip_runtime.h>
#include <cstdio>
#include <cstdint>

#ifndef MK_PER_PHASE
#define MK_PER_PHASE 0
#endif

#ifndef PROBE_REP_MASK
#define PROBE_REP_MASK 0u
#endif
#define NREP(k) ((((PROBE_REP_MASK) >> (k)) & 1u) ? 2 : 1)
#define LAS __attribute__((address_space(3)))
typedef unsigned short bf16;
typedef short bf16x8 __attribute__((ext_vector_type(8)));
typedef float f32x4 __attribute__((ext_vector_type(4)));
typedef float f32x2 __attribute__((ext_vector_type(2)));
typedef unsigned u32x4 __attribute__((ext_vector_type(4)));
typedef unsigned u32x2 __attribute__((ext_vector_type(2)));
typedef int i32x4 __attribute__((ext_vector_type(4)));
typedef int i32x8 __attribute__((ext_vector_type(8)));

constexpr int D = 1024, NB = 4, SEQ = 4096, CTXL = 256;
constexpr int NLAT = NB * SEQ, NCTX = NB * CTXL, MROWS = NLAT + NCTX;
constexpr int NU = 3840;
constexpr int W_IN_COLS = 3856;
constexpr int SP = CTXL + SEQ;
constexpr int NCH = SP / 64;
constexpr int NPR = NCH / 2;
constexpr int NE = 32;
constexpr float EPS = 1e-6f;
constexpr int NPHASE = 14;

constexpr size_t MiB = 1u << 20;
constexpr size_t WS_CTL = 0, CTL_ZERO_BYTES = 1 * MiB;
constexpr size_t WS_MODP = 1 * MiB, WS_MOD = 5 * MiB, WS_DTRAW = 6 * MiB, WS_WINT = 8 * MiB, WS_WOUTT = 16 * MiB;
constexpr size_t WS_W1T = 18 * MiB, WS_W2T = 146 * MiB, WS_XN = 210 * MiB, WS_U = 244 * MiB;
constexpr size_t WS_BC = 372 * MiB, WS_XST = 381 * MiB, WS_XSW = 398 * MiB, WS_BT = 432 * MiB, WS_GA = 437 * MiB, WS_DTA = 439 * MiB, WS_GEND = 441 * MiB;
constexpr size_t WS_QS = 442 * MiB, WS_KS = 476 * MiB, WS_KHT = 510 * MiB, WS_VT = 544 * MiB, WS_EG = 561 * MiB;
constexpr size_t WS_DSP = WS_KHT, WS_EGP = WS_EG + 1179648;
constexpr size_t WS_DSS = 563 * MiB, WS_DSH = 631 * MiB, WS_SPS = 767 * MiB, WS_SPH = 801 * MiB, WS_Y = 869 * MiB, WS_MIX = 901 * MiB, WS_ROUTE = 965 * MiB;
constexpr size_t WS_XS = 372 * MiB, WS_ACT = 516 * MiB, WS_Y2 = 660 * MiB;
constexpr size_t WS_ROWTOK = 966 * MiB;
constexpr size_t WS_END = 968 * MiB;
constexpr int CW_BAR = 4096, CW_CNT = 16384;

constexpr int LDS_BYTES = 147456;
constexpr int LDSCTL_OFF = 144896;
constexpr int MISC_OFF = LDSCTL_OFF;
constexpr int TS_OFF = LDSCTL_OFF + 128;
constexpr int LCNT_OFF = LDSCTL_OFF + 2048;

typedef __bf16 bf16x2_t __attribute__((ext_vector_type(2)));
__device__ __forceinline__ unsigned cvt_pk_bf16(float lo, float hi) { const f32x2 v = {lo, hi}; const bf16x2_t b = __builtin_convertvector(v, bf16x2_t); return __builtin_bit_cast(unsigned, b); }
__device__ __forceinline__ unsigned pk4_fp8(float a, float b, float c, float d) { int w = __builtin_amdgcn_cvt_pk_fp8_f32(a, b, 0, false); w = __builtin_amdgcn_cvt_pk_fp8_f32(c, d, w, true); return (unsigned)w; }
constexpr float W_SCALE = 64.0f, ACT_SCALE = 4.0f, Y_SCALE = 16.0f;
__device__ __forceinline__ float bf2f(unsigned short b) { return __uint_as_float(((unsigned)b) << 16); }
__device__ __forceinline__ float bflo(unsigned w) { return __uint_as_float(w << 16); }
__device__ __forceinline__ float bfhi(unsigned w) { return __uint_as_float(w & 0xffff0000u); }
__device__ __forceinline__ float siluf(float x) { return x * __builtin_amdgcn_rcpf(1.0f + __expf(-x)); }
__device__ __forceinline__ float wave_sum(float v) {
#pragma unroll
    for (int o = 1; o < 64; o <<= 1) v += __shfl_xor(v, o);
    return v;
}
#define LDS_WAIT() asm volatile("s_waitcnt lgkmcnt(0)" ::: "memory")
#define VM_WAIT() asm volatile("s_waitcnt vmcnt(0)" ::: "memory")
#define LDS_BARRIER() do { asm volatile("s_waitcnt lgkmcnt(0)" ::: "memory"); __builtin_amdgcn_s_barrier(); asm volatile("" ::: "memory"); } while (0)
#define RLX_AGENT __ATOMIC_RELAXED, __HIP_MEMORY_SCOPE_AGENT
#define NTLOAD(p) __builtin_nontemporal_load(p)
#define MFMA16(a, b, c) __builtin_amdgcn_mfma_f32_16x16x32_bf16((a), (b), (c), 0, 0, 0)

namespace pg8 {
constexpr int BM = 256, BK = 64, HALF = 128, HTB = HALF * BK * 2, STAGE_BYTES = 8 * HTB, NXCD = 8, WGM = 8;
__host__ __device__ __forceinline__ int lds_byte(int r, int c) { const int st = (r >> 4) * 2 + (c >> 5), rr = r & 15, cc = c & 31, ob = rr * 64 + cc * 2; return st * 1024 + (ob ^ (((ob >> 9) & 1) << 5)); }
__host__ __device__ __forceinline__ void stage_rc(int b, int& R, int& C) { const int st = b / 1024, sb = b % 1024, swz = sb ^ (((sb >> 9) & 1) << 5); R = (st >> 1) * 16 + swz / 64; C = (st & 1) * 32 + (swz % 64) / 2; }
__host__ __device__ __forceinline__ int perm32(int rho) { const int n = rho >> 4, i = rho & 15; return 8 * (i >> 2) + 4 * n + (i & 3); }

struct Unit { int pm, pn, pb, e, ord; };
struct Gemm { const bf16* A; const bf16* Bt; int K; };
struct DenseRows {
    __device__ __forceinline__ size_t ubase(const Unit& u, int h, int K) const { return (size_t)(u.pm * BM + h * HALF) * K * 2; }
    __device__ __forceinline__ unsigned lane_off(const Unit&, int, int R, int K) const { return (unsigned)(R * K) * 2u; } };
struct GatherRows { const LAS unsigned* rowl;
    __device__ __forceinline__ size_t ubase(const Unit&, int, int) const { return 0; }
    __device__ __forceinline__ unsigned lane_off(const Unit& u, int h, int R, int) const { return rowl[u.ord * BM + h * HALF + R]; } };

struct StaticOrder {
    int nM, nN, nwg, G, c, i0, n;
    __device__ void init(int M, int N, int G_, int c_) { nM = M / BM; nN = N / BM; nwg = nM * nN; G = G_; c = c_; i0 = 0; n = 1 << 30; }
    __device__ bool next(int i_, Unit& u) const {
        if (i_ >= n) return false; const int i = i_ + i0;
        const long L = (long)i * G + c; if (L >= nwg) return false;
        int wgid = (int)L; { const int q = nwg / NXCD, r = nwg % NXCD, xcd = wgid % NXCD, off = wgid / NXCD; wgid = (xcd < r ? xcd * (q + 1) : r * (q + 1) + (xcd - r) * q) + off; }
        const int nig = WGM * nN, gid = wgid / nig, fm = gid * WGM, gsz = (nM - fm) < WGM ? (nM - fm) : WGM;
        u.pm = fm + ((wgid % nig) % gsz); u.pn = (wgid % nig) / gsz; u.pb = u.pn; u.e = 0; u.ord = i; return true;
    }
};
struct MoeOrder {
    const LAS int* ts; int ntn, mg, x, j, i0, n;
    __device__ void init(const LAS int* ts_, int ntn_, int mg_, int c) { ts = ts_; ntn = ntn_; mg = mg_; x = c & 7; j = c >> 3; i0 = 0; n = 1 << 30; }
    __device__ bool next(int i_, Unit& u) const {
        if (i_ >= n) return false; const int i = i_ + i0;
        const int st = i * 8 + x, mt = mg * st + (j % mg), nt = j / mg;
        if (mt >= ts[NE]) return false;
        const int e = ts[80 + mt];
        u.pm = mt; u.pn = nt; u.e = e; u.pb = e * ntn + nt; u.ord = i; return true;
    }
};

struct EpiF32 {
    static constexpr bool PERM = false;
    float* C; int ldc;
    __device__ __forceinline__ const float* bias_src(const Unit&) const { return nullptr; }
    __device__ __forceinline__ void operator()(const f32x4 (&acc)[2][2][4][2], const Unit& u, int wr, int wc, int fr, int fq, const LAS float*) const {
        const int row0 = u.pm * BM + wr * 64 + fr, col0 = u.pn * BM + wc * 32 + 4 * fq;
#pragma unroll
        for (int ai = 0; ai < 2; ++ai)
#pragma unroll
            for (int m = 0; m < 4; ++m) { float* rowp = C + (size_t)(row0 + ai * HALF + m * 16) * ldc + col0;
#pragma unroll
                for (int bj = 0; bj < 2; ++bj)
#pragma unroll
                    for (int n = 0; n < 2; ++n) *(f32x4*)(rowp + bj * HALF + n * 16) = acc[ai][bj][m][n]; }
    }
};
struct EpiBf16 {
    static constexpr bool PERM = true;
    bf16* O; int ldc; const float* bias; int bias_stride; float scale;
    __device__ __forceinline__ const float* bias_src(const Unit& u) const { return bias ? bias + (size_t)u.e * bias_stride + u.pn * BM : nullptr; }
    __device__ __forceinline__ void operator()(const f32x4 (&acc)[2][2][4][2], const Unit& u, int wr, int wc, int fr, int fq, const LAS float* bl) const {
        const int row0 = u.pm * BM + wr * 64 + fr, col0 = u.pn * BM + wc * 32 + 8 * fq;
        f32x4 bv[2][2];
#pragma unroll
        for (int bj = 0; bj < 2; ++bj)
#pragma unroll
            for (int n = 0; n < 2; ++n) bv[bj][n] = bias ? *(const LAS f32x4*)(bl + wc * 32 + 8 * fq + bj * HALF + 4 * n) : (f32x4){0.f, 0.f, 0.f, 0.f};
#pragma unroll
        for (int ai = 0; ai < 2; ++ai)
#pragma unroll
            for (int m = 0; m < 4; ++m) { bf16* rowp = O + (size_t)(row0 + ai * HALF + m * 16) * ldc + col0;
#pragma unroll
                for (int bj = 0; bj < 2; ++bj) { const f32x4 v0 = acc[ai][bj][m][0] * scale + bv[bj][0], v1 = acc[ai][bj][m][1] * scale + bv[bj][1];
                    u32x4 w; w.x = cvt_pk_bf16(v0[0], v0[1]); w.y = cvt_pk_bf16(v0[2], v0[3]); w.z = cvt_pk_bf16(v1[0], v1[1]); w.w = cvt_pk_bf16(v1[2], v1[3]);
                    *(u32x4*)(rowp + bj * HALF) = w; } }
    }
};
struct EpiFp8 {
    static constexpr bool PERM = true;
    unsigned char* O; int ldc; const float* bias; int bias_stride; float scale;
    __device__ __forceinline__ const float* bias_src(const Unit& u) const { return bias + (size_t)u.e * bias_stride + u.pn * BM; }
    __device__ __forceinline__ void operator()(const f32x4 (&acc)[2][2][4][2], const Unit& u, int wr, int wc, int fr, int fq, const LAS float* bl) const {
        const int row0 = u.pm * BM + wr * 64 + fr, col0 = u.pn * BM + wc * 32 + 8 * fq;
        f32x4 bv[2][2];
#pragma unroll
        for (int bj = 0; bj < 2; ++bj)
#pragma unroll
            for (int n = 0; n < 2; ++n) bv[bj][n] = *(const LAS f32x4*)(bl + wc * 32 + 8 * fq + bj * HALF + 4 * n) * Y_SCALE;
        const float sc = scale * Y_SCALE;
#pragma unroll
        for (int ai = 0; ai < 2; ++ai)
#pragma unroll
            for (int m = 0; m < 4; ++m) { unsigned char* rowp = O + (size_t)(row0 + ai * HALF + m * 16) * ldc + col0;
#pragma unroll
                for (int bj = 0; bj < 2; ++bj) { const f32x4 v0 = acc[ai][bj][m][0] * sc + bv[bj][0], v1 = acc[ai][bj][m][1] * sc + bv[bj][1];
                    *(u32x2*)(rowp + bj * HALF) = (u32x2){pk4_fp8(v0[0], v0[1], v0[2], v0[3]), pk4_fp8(v1[0], v1[1], v1[2], v1[3])}; } }
    }
};
__device__ __forceinline__ float swiglu1(float glu, float lin) {
    const float g = fminf(glu, 7.0f), l = fminf(fmaxf(lin, -7.0f), 7.0f);
    return g * __builtin_amdgcn_rcpf(1.0f + __expf(-1.702f * g)) * (l + 1.0f);
}
struct EpiSwiglu {
    static constexpr bool PERM = true;
    unsigned char* O; int ldc; const float* bias; int bias_stride;
    __device__ __forceinline__ const float* bias_src(const Unit& u) const { return bias + (size_t)u.e * bias_stride + u.pn * BM; }
    __device__ __forceinline__ void operator()(const f32x4 (&acc)[2][2][4][2], const Unit& u, int wr, int wc, int fr, int fq, const LAS float* bl) const {
        const int row0 = u.pm * BM + wr * 64 + fr, col0 = u.pn * BM + wc * 32 + 8 * fq, ocol0 = col0 >> 1;
        f32x4 bv[2][2];
#pragma unroll
        for (int bj = 0; bj < 2; ++bj)
#pragma unroll
            for (int n = 0; n < 2; ++n) bv[bj][n] = *(const LAS f32x4*)(bl + wc * 32 + 8 * fq + bj * HALF + 4 * n);
#pragma unroll
        for (int ai = 0; ai < 2; ++ai)
#pragma unroll
            for (int m = 0; m < 4; ++m) { unsigned char* rowp = O + (size_t)(row0 + ai * HALF + m * 16) * ldc + ocol0;
#pragma unroll
                for (int bj = 0; bj < 2; ++bj) { const f32x4 v0 = acc[ai][bj][m][0] * (1.0f / W_SCALE) + bv[bj][0], v1 = acc[ai][bj][m][1] * (1.0f / W_SCALE) + bv[bj][1];
                    *(unsigned*)(rowp + bj * (HALF / 2)) = pk4_fp8(ACT_SCALE * swiglu1(v0[0], v0[1]), ACT_SCALE * swiglu1(v0[2], v0[3]), ACT_SCALE * swiglu1(v1[0], v1[1]), ACT_SCALE * swiglu1(v1[2], v1[3])); } }
    }
};

template <bool F8, class Epi, class Sched, class AMap>
__device__ __forceinline__ void gemm_phase(LAS unsigned char* lds, const Gemm g, const Sched& S, const Epi& E, const AMap& AM) {
    const int tid = threadIdx.x, wid = __builtin_amdgcn_readfirstlane(tid >> 6), lane = tid & 63, wr = wid >> 2, wc = wid & 3, fr = lane & 15, fq = lane >> 4;
    const int K = g.K, nt = K / BK;
    unsigned voffB[2];
#pragma unroll
    for (int i = 0; i < 2; ++i) { int R, C; stage_rc(tid * 16 + i * 8192, R, C); const int Rb = Epi::PERM ? ((R & ~31) + perm32(R & 31)) : R;
        voffB[i] = (unsigned)(Rb * K + C) * 2u; }
    unsigned vA0[2], vA1[2], nA0[2], nA1[2];
#define PG8_AOFF(u, o0, o1) do { int _t = tid; asm volatile("" : "+v"(_t));   _Pragma("unroll") for (int _i = 0; _i < 2; ++_i) { int _R, _C; stage_rc(_t * 16 + _i * 8192, _R, _C); \
        o0[_i] = AM.lane_off(u, 0, _R, K) + (unsigned)_C * 2u; o1[_i] = AM.lane_off(u, 1, _R, K) + (unsigned)_C * 2u; } } while (0)
    const size_t kstep = (size_t)(BK * 2);
    const size_t hstep = (size_t)HALF * K * 2;
    const size_t tstep = 2 * hstep;
    const unsigned ldsw = (unsigned)wid * 1024u;
    const int aoff = lds_byte(wr * 64 + fr, fq * 8), boff = lds_byte(wc * 32 + fr, fq * 8);
#define PG8_SA(b, h) (((b) * 2 + (h)) * HTB)
#define PG8_SB(b, h) ((4 + (b) * 2 + (h)) * HTB)
#define PG8_STAGE(bufoff, gbase, voff) do { _Pragma("unroll") for (int _i = 0; _i < 2; ++_i) \
        __builtin_amdgcn_global_load_lds((const unsigned*)((const char*)(gbase) + (voff)[_i]), (LAS unsigned*)(lds + (bufoff) + ldsw + _i * 8192), 16, 0, 0); } while (0)
#define PG8_LDA(dst, b, h) do { _Pragma("unroll") for (int m = 0; m < 4; ++m) { const i32x4 _lo = *(const LAS i32x4*)(lds + PG8_SA(b, h) + aoff + m * 2048), _hi = *(const LAS i32x4*)(lds + PG8_SA(b, h) + aoff + m * 2048 + 1024); \
        dst[m] = __builtin_shufflevector(_lo, _hi, 0, 1, 2, 3, 4, 5, 6, 7); } } while (0)
#define PG8_LDB(dst, b, h) do { _Pragma("unroll") for (int n = 0; n < 2; ++n) { const i32x4 _lo = *(const LAS i32x4*)(lds + PG8_SB(b, h) + boff + n * 2048), _hi = *(const LAS i32x4*)(lds + PG8_SB(b, h) + boff + n * 2048 + 1024); \
        dst[n] = __builtin_shufflevector(_lo, _hi, 0, 1, 2, 3, 4, 5, 6, 7); } } while (0)
#define PG8_LO(x) __builtin_bit_cast(bf16x8, __builtin_shufflevector(x, x, 0, 1, 2, 3))
#define PG8_HI(x) __builtin_bit_cast(bf16x8, __builtin_shufflevector(x, x, 4, 5, 6, 7))
#define PG8_MMA(ai, bj, At, Bt) do { __builtin_amdgcn_s_setprio(1); _Pragma("unroll") for (int m = 0; m < 4; ++m) _Pragma("unroll") for (int n = 0; n < 2; ++n) { \
        if constexpr (F8) asm volatile("v_mfma_scale_f32_16x16x128_f8f6f4 %0, %1, %2, %0, %3, %3 op_sel_hi:[0,0,0]" : "+v"(acc[ai][bj][m][n]) : "v"(Bt[n]), "v"(At[m]), "v"(f8scale)); \
        else { acc[ai][bj][m][n] = __builtin_amdgcn_mfma_f32_16x16x32_bf16(PG8_LO(Bt[n]), PG8_LO(At[m]), acc[ai][bj][m][n], 0, 0, 0); \
               acc[ai][bj][m][n] = __builtin_amdgcn_mfma_f32_16x16x32_bf16(PG8_HI(Bt[n]), PG8_HI(At[m]), acc[ai][bj][m][n], 0, 0, 0); } } \
        __builtin_amdgcn_s_setprio(0); } while (0)
#define PG8_WAIT_V(n) asm volatile("s_waitcnt vmcnt(" #n ")" ::: "memory")
#define PG8_WAIT_L(n) asm volatile("s_waitcnt lgkmcnt(" #n ")" ::: "memory")
#define PG8_BAR __builtin_amdgcn_s_barrier()
#define PG8_SCHED __builtin_amdgcn_sched_barrier(0)
    Unit cur, nxt; int ui = 0;
    if (!S.next(0, cur)) return;
    f32x4 acc[2][2][4][2];
#pragma unroll
    for (int a = 0; a < 2; ++a)
#pragma unroll
        for (int b = 0; b < 2; ++b)
#pragma unroll
            for (int m = 0; m < 4; ++m)
#pragma unroll
                for (int n = 0; n < 2; ++n) acc[a][b][m][n] = (f32x4){0.f, 0.f, 0.f, 0.f};
    i32x8 At[4], B0[2], B1[2];
    int f8scale = 0x7F7F7F7F; asm volatile("" : "+v"(f8scale));
    LAS float* const biasl = (LAS float*)(lds + STAGE_BYTES);
#define PG8_BIAS(u, slot) do { const float* _bs = E.bias_src(u); if (_bs != nullptr && wid == 0) { int _ln = lane; asm volatile("" : "+v"(_ln));     \
        __builtin_amdgcn_global_load_lds((const unsigned*)(_bs + _ln * 4), (LAS unsigned*)(biasl + (slot) * 256), 16, 0, 0); } } while (0)
    PG8_BIAS(cur, 0);
    const char* cA0 = (const char*)g.A + AM.ubase(cur, 0, K); const char* cA1 = (const char*)g.A + AM.ubase(cur, 1, K); const char* cB = (const char*)g.Bt + (size_t)cur.pb * tstep;
    PG8_AOFF(cur, vA0, vA1);
    PG8_STAGE(PG8_SB(0, 0), cB, voffB); PG8_STAGE(PG8_SB(0, 1), cB + hstep, voffB); PG8_STAGE(PG8_SA(0, 0), cA0, vA0); PG8_STAGE(PG8_SA(0, 1), cA1, vA1);
    if (wr == 1) PG8_BAR;
    PG8_WAIT_V(2); PG8_BAR;
    PG8_STAGE(PG8_SB(1, 0), cB + kstep, voffB); PG8_STAGE(PG8_SA(1, 0), cA0 + kstep, vA0); PG8_STAGE(PG8_SB(1, 1), cB + hstep + kstep, voffB);
    PG8_WAIT_V(6); PG8_BAR;
    for (;;) {
        const bool has_next = S.next(ui + 1, nxt);
        const char* nB = has_next ? (const char*)g.Bt + (size_t)nxt.pb * tstep : cB;
        const char* nxA0 = has_next ? (const char*)g.A + AM.ubase(nxt, 0, K) : cA0; const char* nxA1 = has_next ? (const char*)g.A + AM.ubase(nxt, 1, K) : cA1;
        if (has_next) { PG8_AOFF(nxt, nA0, nA1); PG8_BIAS(nxt, (ui + 1) & 1); } else { nA0[0] = vA0[0]; nA0[1] = vA0[1]; nA1[0] = vA1[0]; nA1[1] = vA1[1]; }
#pragma unroll 1
        for (int t = 0; t < nt; t += 2) {
            const bool last = (t == nt - 2);
            const char* a1 = cA1 + (size_t)(t + 1) * kstep;
            const char* a2 = last ? nxA0 : cA0 + (size_t)(t + 2) * kstep; const char* a2h = last ? nxA1 : cA1 + (size_t)(t + 2) * kstep; const char* b2 = last ? nB : cB + (size_t)(t + 2) * kstep;
            const char* a3 = a2 + kstep; const char* b3 = b2 + kstep;
            unsigned w0[2], w1[2];
            w0[0] = last ? nA0[0] : vA0[0]; w0[1] = last ? nA0[1] : vA0[1]; w1[0] = last ? nA1[0] : vA1[0]; w1[1] = last ? nA1[1] : vA1[1];
            PG8_LDB(B0, 0, 0); PG8_LDB(B1, 0, 1); PG8_SCHED; PG8_LDA(At, 0, 0); PG8_STAGE(PG8_SA(1, 1), a1, vA1);
            PG8_WAIT_V(8); PG8_WAIT_L(0); PG8_BAR; PG8_MMA(0, 0, At, B0); PG8_MMA(0, 1, At, B1); PG8_BAR; PG8_SCHED;
            PG8_LDA(At, 0, 1); PG8_STAGE(PG8_SB(0, 0), b2, voffB); PG8_STAGE(PG8_SB(0, 1), b2 + hstep, voffB); PG8_STAGE(PG8_SA(0, 0), a2, w0);
            PG8_WAIT_V(8); PG8_WAIT_L(0); PG8_BAR; PG8_MMA(1, 0, At, B0); PG8_MMA(1, 1, At, B1); PG8_BAR; PG8_SCHED;
            PG8_LDB(B0, 1, 0); PG8_LDB(B1, 1, 1); PG8_SCHED; PG8_LDA(At, 1, 0); PG8_STAGE(PG8_SA(0, 1), a2h, w1);
            PG8_WAIT_V(8); PG8_WAIT_L(0); PG8_BAR; PG8_MMA(0, 0, At, B0); PG8_MMA(0, 1, At, B1); PG8_BAR; PG8_SCHED;
            PG8_LDA(At, 1, 1); PG8_STAGE(PG8_SB(1, 0), b3, voffB); PG8_STAGE(PG8_SB(1, 1), b3 + hstep, voffB); PG8_STAGE(PG8_SA(1, 0), a3, w0);
            PG8_WAIT_V(8); PG8_WAIT_L(0); PG8_BAR; PG8_MMA(1, 0, At, B0); PG8_MMA(1, 1, At, B1); PG8_BAR; PG8_SCHED;
        }
        if (wr == 0) PG8_BAR;
        if constexpr (F8) asm volatile("s_nop 15\n\ts_nop 15" ::: "memory");
        E(acc, cur, wr, wc, fr, fq, biasl + (ui & 1) * 256);
        if (!has_next) break;
#pragma unroll
        for (int a = 0; a < 2; ++a)
#pragma unroll
            for (int b = 0; b < 2; ++b)
#pragma unroll
                for (int m = 0; m < 4; ++m)
#pragma unroll
                    for (int n = 0; n < 2; ++n) acc[a][b][m][n] = (f32x4){0.f, 0.f, 0.f, 0.f};
        cur = nxt; cB = nB; cA0 = nxA0; cA1 = nxA1; ++ui; vA0[0] = nA0[0]; vA0[1] = nA0[1]; vA1[0] = nA1[0]; vA1[1] = nA1[1];
        if (wr == 1) PG8_BAR;
    }
    PG8_WAIT_V(0);
    PG8_BAR;
#undef PG8_AOFF
#undef PG8_BIAS
#undef PG8_SA
#undef PG8_SB
#undef PG8_STAGE
#undef PG8_LDA
#undef PG8_LDB
#undef PG8_MMA
#undef PG8_LO
#undef PG8_HI
#undef PG8_WAIT_V
#undef PG8_WAIT_L
#undef PG8_BAR
#undef PG8_SCHED
}
}

#define XB_TMO      128
#define XB_XCNT(j)  (256  + 64 * (j))
#define XB_XSUB(j)  (1280 + 64 * (j))
#define XB_XGEN(j)  (2304 + 64 * (j))
#define XB_TOP      3328
#define XB_TOPGEN   3392
#define XCD_BAR_WORDS 3456
#define XB_SPIN_CAP (1u << 22)
__device__ __forceinline__ unsigned xb_ld(unsigned* p)              { return __hip_atomic_load(p, __ATOMIC_RELAXED, __HIP_MEMORY_SCOPE_AGENT); }
__device__ __forceinline__ unsigned xb_add(unsigned* p, unsigned v) { return __hip_atomic_fetch_add(p, v, __ATOMIC_RELAXED, __HIP_MEMORY_SCOPE_AGENT); }
__device__ __forceinline__ unsigned xb_xcc_id() { return (unsigned)__builtin_amdgcn_s_getreg((3 << 11) | 20) & 0xFu; }
#define XB_SPIN(cond, bar) do { unsigned _sp = 0; while (cond) { __builtin_amdgcn_s_sleep(1); \
    if ((++_sp & 255u) == 0u) { if (xb_ld(&(bar)[XB_TMO])) break; if (_sp > XB_SPIN_CAP) { atomicAdd(&(bar)[XB_TMO], 1u); break; } } } } while (0)
struct XcdBarrier { unsigned* bar; unsigned x; volatile LAS unsigned* st; };
__device__ __forceinline__ XcdBarrier xcd_barrier_post(unsigned* bar, volatile LAS unsigned* st) {
    XcdBarrier b; b.bar = bar; b.x = xb_xcc_id(); b.st = st;
    if (threadIdx.x == 0) (void)xb_add(&bar[XB_XCNT(b.x)], 1u);
    return b;
}
__device__ __forceinline__ void xcd_barrier_complete(unsigned* bar, unsigned x, unsigned& nloc, unsigned& nx) {
    const unsigned G = gridDim.x * gridDim.y * gridDim.z;
    unsigned sum, cnt, mine, sp = 0u;
    for (;;) {
        sum = 0u; cnt = 0u; mine = 0u;
#pragma unroll
        for (unsigned j = 0; j < 16; ++j) { const unsigned c = xb_ld(&bar[XB_XCNT(j)]); sum += c; cnt += (c > 0u) ? 1u : 0u; mine = (j == x) ? c : mine; }
        if (sum == G) break;
        __builtin_amdgcn_s_sleep(1);
        if ((++sp & 255u) == 0u) { if (xb_ld(&bar[XB_TMO])) break; if (sp > XB_SPIN_CAP) { atomicAdd(&bar[XB_TMO], 1u); break; } }
    }
    nloc = mine > 0u ? mine : 1u; nx = cnt > 0u ? cnt : 1u;
}
struct NoWork { __device__ __forceinline__ void operator()() const {} };
template <class F = NoWork> __device__ __forceinline__ void xcd_barrier(const XcdBarrier& b, F work = F{}) {
    asm volatile("s_waitcnt vmcnt(0)" ::: "memory");
    __syncthreads();
    if (threadIdx.x >= 64) work();
    if (threadIdx.x == 0) {
        unsigned* bar = b.bar;
        __builtin_amdgcn_s_waitcnt(0);
        unsigned nloc = b.st[0], nx = b.st[1];
        if (nloc == 0u) { xcd_barrier_complete(bar, b.x, nloc, nx); b.st[0] = nloc; b.st[1] = nx; }
        const unsigned old = xb_add(&bar[XB_XSUB(b.x)], 1u);
        const unsigned gen = old / nloc;
        if (old + 1u == (gen + 1u) * nloc) {
            __builtin_amdgcn_fence(__ATOMIC_RELEASE, "agent");
            asm volatile("s_waitcnt vmcnt(0)" ::: "memory");
            const unsigned og = xb_add(&bar[XB_TOP], 1u);
            const unsigned tg = og / nx;
            if (og + 1u == (tg + 1u) * nx) xb_add(&bar[XB_TOPGEN], 1u);
            else XB_SPIN(xb_ld(&bar[XB_TOPGEN]) == tg, bar);
            __builtin_amdgcn_fence(__ATOMIC_ACQUIRE, "agent");
            xb_add(&bar[XB_XGEN(b.x)], 1u);
            asm volatile("s_waitcnt vmcnt(0)" ::: "memory");
        } else {
            XB_SPIN(xb_ld(&bar[XB_XGEN(b.x)]) == gen, bar);
            __builtin_amdgcn_fence(__ATOMIC_ACQUIRE, "agent");
            asm volatile("s_waitcnt vmcnt(0)" ::: "memory");
        }
    }
    __syncthreads();
}

struct Args {
    const float *x, *c, *ctx, *c_ctx, *ada_w, *ada_b, *mix_pre, *mix_post, *w_in, *w_out, *conv_w, *conv_b, *dt_bias, *a_log, *ssd_d, *ssd_norm,
                *hg_lb, *hg_norm, *ffn_pre, *ffn_post, *router_w, *router_b, *w1, *b1, *w2, *b2;
    float* out; unsigned char* ws; int ph_lo, ph_hi;
};

typedef const Args __attribute__((address_space(4))) CArgs;
struct Ctx { LAS unsigned char* lds; int tid, lane, wave, vcu, G, gw, NGW; };

__device__ __forceinline__ void transpose_item(const float* W, int ldw, int K, bf16* WT, int dst_row0, int nblk, LAS float* scr, int item, int lane) {
    const int kb = item / nblk, nb = item % nblk, k0 = 64 * kb, n0 = 32 * nb;
    float ld[32];
#pragma unroll
    for (int i = 0; i < 32; ++i) ld[i] = W[(size_t)(k0 + 2 * i + (lane >> 5)) * ldw + n0 + (lane & 31)];
#pragma unroll
    for (int i = 0; i < 32; ++i) scr[(2 * i + (lane >> 5)) * 33 + (lane & 31)] = ld[i];
    LDS_WAIT(); asm volatile("" ::: "memory");
    const int c = lane & 7;
#pragma unroll
    for (int j = 0; j < 4; ++j) { const int n = (lane >> 3) + 8 * j; const LAS float* s = scr + (8 * c) * 33 + n;
        u32x4 o; o.x = cvt_pk_bf16(s[0 * 33], s[1 * 33]); o.y = cvt_pk_bf16(s[2 * 33], s[3 * 33]); o.z = cvt_pk_bf16(s[4 * 33], s[5 * 33]); o.w = cvt_pk_bf16(s[6 * 33], s[7 * 33]);
        *(u32x4*)(WT + (size_t)(dst_row0 + n0 + n) * K + k0 + 8 * c) = o; }
    LDS_WAIT(); asm volatile("" ::: "memory");
}
__device__ __forceinline__ void transpose_item_f8(const float* W, int ldw, int K, unsigned char* WT, int nblk, LAS float* scr, int item, int lane, float scale) {
    const int kb = item / nblk, nb = item % nblk, k0 = 64 * kb, n0 = 32 * nb;
    float ld[32];
#pragma unroll
    for (int i = 0; i < 32; ++i) ld[i] = __builtin_nontemporal_load(&W[(size_t)(k0 + 2 * i + (lane >> 5)) * ldw + n0 + (lane & 31)]);
#pragma unroll
    for (int i = 0; i < 32; ++i) scr[(2 * i + (lane >> 5)) * 33 + (lane & 31)] = ld[i] * scale;
    LDS_WAIT(); asm volatile("" ::: "memory");
    const int c = lane & 7;
#pragma unroll
    for (int j = 0; j < 4; ++j) { const int n = (lane >> 3) + 8 * j; const LAS float* sp = scr + (8 * c) * 33 + n;
        u32x2 o; o.x = pk4_fp8(sp[0 * 33], sp[1 * 33], sp[2 * 33], sp[3 * 33]); o.y = pk4_fp8(sp[4 * 33], sp[5 * 33], sp[6 * 33], sp[7 * 33]);
        *(u32x2*)(WT + (size_t)(n0 + n) * K + k0 + 8 * c) = o; }
    LDS_WAIT(); asm volatile("" ::: "memory");
}
__device__ __forceinline__ void phase0(CArgs& a, const Ctx& C) {
    LAS float* scr = (LAS float*)(C.lds + C.wave * 16384);
    bf16* WINT = (bf16*)(a.ws + WS_WINT); bf16* WOUTT = (bf16*)(a.ws + WS_WOUTT);
    float* MODP = (float*)(a.ws + WS_MODP);
    constexpr int I_GEMV = 96 * 32, I_INA = 16 * 40, I_INB = 16 * 80, I_OUT = 16 * 32;
    constexpr int NITEMS = I_GEMV + I_INA + I_INB + I_OUT;
    for (int it = C.gw; it < NITEMS; it += C.NGW) {
        int r = it;
        if (r < I_GEMV) {
            const int cg = r % 96, ks = r / 96, col = 64 * cg + C.lane, k0 = 32 * ks;
            float sv[5];
            { const int kk = C.lane & 31;
#pragma unroll
              for (int b = 0; b < 4; ++b) sv[b] = siluf(a.c[b * D + k0 + kk]);
              sv[4] = siluf(a.c_ctx[k0 + kk]); }
            float acc[5] = {0.f, 0.f, 0.f, 0.f, 0.f};
#pragma unroll 8
            for (int kk = 0; kk < 32; ++kk) { const float w = a.ada_w[(size_t)(k0 + kk) * 6144 + col];
#pragma unroll
                for (int b = 0; b < 5; ++b) acc[b] += __shfl(sv[b], kk) * w; }
#pragma unroll
            for (int b = 0; b < 5; ++b) MODP[(size_t)(ks * 5 + b) * 6144 + col] = acc[b];
            continue;
        }
        r -= I_GEMV;
        if (r < I_INA) { transpose_item(a.w_in, W_IN_COLS, D, WINT, 0, 40, scr, r, C.lane); continue; } r -= I_INA;
        if (r < I_INB) { transpose_item(a.w_in + 1296, W_IN_COLS, D, WINT, 1280, 80, scr, r, C.lane); continue; } r -= I_INB;
        transpose_item(a.w_out, D, D, WOUTT, 0, 32, scr, r, C.lane);
    }
}
__device__ __forceinline__ void conv_w1_slice(CArgs& a, const Ctx& C, int sl, int nsl) {
    LAS float* scr = (LAS float*)(C.lds + C.wave * 16384); unsigned char* W1T = a.ws + WS_W1T;
    const int per = 16 / nsl;
    for (int jx = sl * per; jx < (sl + 1) * per; ++jx) { const int r = C.gw + C.NGW * jx; if (r >= 32 * 16 * 64) break;
        const int e = r / (16 * 64), ri = r % (16 * 64); transpose_item_f8(a.w1 + (size_t)e * D * 2048, 2048, D, W1T + (size_t)e * 2048 * D, 64, scr, ri, C.lane, W_SCALE); }
}
__device__ __forceinline__ void conv_w2_slice(CArgs& a, const Ctx& C, int sl, int nsl) {
    LAS float* scr = (LAS float*)(C.lds + C.wave * 16384); unsigned char* W2T = a.ws + WS_W2T;
    const int per = 8 / nsl;
    for (int jx = sl * per; jx < (sl + 1) * per; ++jx) { const int r = C.gw + C.NGW * jx; if (r >= 32 * 16 * 32) break;
        const int e = r / (16 * 32), ri = r % (16 * 32); transpose_item_f8(a.w2 + (size_t)e * D * D, D, D, W2T + (size_t)e * D * D, 32, scr, ri, C.lane, W_SCALE); }
}
__device__ __forceinline__ void phase1(CArgs& a, const Ctx& C) {
    const float* MODP = (const float*)(a.ws + WS_MODP); float* MOD = (float*)(a.ws + WS_MOD);
    for (int i = C.vcu * 512 + C.tid; i < 5 * 6144; i += C.G * 512) {
        const int col = i % 6144, b = i / 6144; float s = a.ada_b[col];
#pragma unroll 8
        for (int ks = 0; ks < 32; ++ks) s += MODP[(size_t)(ks * 5 + b) * 6144 + col];
        MOD[i] = s;
    }
}
template <int N, int O> struct RS { template <int M> static __device__ __forceinline__ void run(float (&v)[M], int lane) {
    const bool up = (lane & O) != 0;
#pragma unroll
    for (int i = 0; i < N / 2; ++i) { const float keep = up ? v[i + N / 2] : v[i], send = up ? v[i] : v[i + N / 2]; v[i] = keep + __shfl_xor(send, O); }
    RS<N / 2, O / 2>::run(v, lane); } };
template <int O> struct RS<1, O> { template <int M> static __device__ __forceinline__ void run(float (&v)[M], int) { v[0] += __shfl_xor(v[0], O); RS<1, O / 2>::run(v, 0); } };
template <> struct RS<1, 0> { template <int M> static __device__ __forceinline__ void run(float (&)[M], int) {} };
template <int N> __device__ __forceinline__ void reduce_scatter(float (&v)[N], int lane) { RS<N, 32>::run(v, lane); }
__device__ __forceinline__ void phase2_fill(CArgs& a, const Ctx& C, int t0, int nt) {
    LAS f32x4* WD = (LAS f32x4*)C.lds;
    for (int idx = t0; idx < 16 * 4 * 64; idx += nt) { const int ln = idx & 63, cg = (idx >> 6) & 3, je = idx >> 8, j = je >> 3, e = je & 7, k = 8 * ln + 512 * j + e;
        WD[idx] = *(const f32x4*)(a.w_in + (size_t)k * W_IN_COLS + 1280 + 4 * cg); }
}
__device__ __forceinline__ void phase2(CArgs& a, const Ctx& C, bool prefilled) {
    const float* MOD = (const float*)(a.ws + WS_MOD); bf16* XN = (bf16*)(a.ws + WS_XN); float* DTRAW = (float*)(a.ws + WS_DTRAW);
    LAS f32x4* WD = (LAS f32x4*)C.lds;
    const int rbase = (MROWS / 256) * C.vcu; constexpr int NPAIR = MROWS / 256 / 2;
    f32x4 nx[2][2][2];
    { const int m = rbase + 2 * C.wave;
#pragma unroll
      for (int r = 0; r < 2; ++r) { const int mr = m + r; const float* xrow = mr < NLAT ? a.x + (size_t)mr * D : a.ctx + (size_t)(mr - NLAT) * D;
#pragma unroll
        for (int j = 0; j < 2; ++j) { nx[r][j][0] = NTLOAD((const f32x4*)(xrow + 8 * C.lane + 512 * j)); nx[r][j][1] = NTLOAD((const f32x4*)(xrow + 8 * C.lane + 512 * j + 4)); } } }
    if (!prefilled) phase2_fill(a, C, C.tid, 512);
    __syncthreads();
#pragma unroll 1
    for (int p = C.wave; p < NPAIR; p += 8) {
        const int m = rbase + 2 * p, b = m < NLAT ? (m >> 12) : 4;
        const float* sh = MOD + b * 6144, *sc = sh + 1024;
        float h[2][2][8]; float ss[2] = {0.f, 0.f};
#pragma unroll
        for (int r = 0; r < 2; ++r)
#pragma unroll
            for (int j = 0; j < 2; ++j) { const f32x4 v0 = nx[r][j][0], v1 = nx[r][j][1];
#pragma unroll
                for (int e = 0; e < 4; ++e) { h[r][j][e] = v0[e]; h[r][j][4 + e] = v1[e]; ss[r] += v0[e] * v0[e] + v1[e] * v1[e]; } }
        { const int m2 = p + 8 < NPAIR ? m + 16 : m;
#pragma unroll
          for (int r = 0; r < 2; ++r) { const int mr = m2 + r; const float* xrow = mr < NLAT ? a.x + (size_t)mr * D : a.ctx + (size_t)(mr - NLAT) * D;
#pragma unroll
            for (int j = 0; j < 2; ++j) { nx[r][j][0] = NTLOAD((const f32x4*)(xrow + 8 * C.lane + 512 * j)); nx[r][j][1] = NTLOAD((const f32x4*)(xrow + 8 * C.lane + 512 * j + 4)); } } }
        const float rstd[2] = {rsqrtf(wave_sum(ss[0]) * (1.0f / D) + EPS), rsqrtf(wave_sum(ss[1]) * (1.0f / D) + EPS)};
#pragma unroll
        for (int j = 0; j < 2; ++j) { const int k0 = 8 * C.lane + 512 * j;
#pragma unroll
            for (int e4 = 0; e4 < 2; ++e4) { const f32x4 w = *(const f32x4*)(a.mix_pre + k0 + 4 * e4), s1 = *(const f32x4*)(sc + k0 + 4 * e4), s0 = *(const f32x4*)(sh + k0 + 4 * e4);
#pragma unroll
                for (int r = 0; r < 2; ++r)
#pragma unroll
                    for (int e = 0; e < 4; ++e) h[r][j][4 * e4 + e] = h[r][j][4 * e4 + e] * rstd[r] * w[e] * (1.0f + s1[e]) + s0[e]; }
#pragma unroll
            for (int r = 0; r < 2; ++r) { u32x4 o; o.x = cvt_pk_bf16(h[r][j][0], h[r][j][1]); o.y = cvt_pk_bf16(h[r][j][2], h[r][j][3]); o.z = cvt_pk_bf16(h[r][j][4], h[r][j][5]); o.w = cvt_pk_bf16(h[r][j][6], h[r][j][7]);
                *(u32x4*)(XN + (size_t)(m + r) * D + k0) = o; } }
        float acc0[16], acc1[16];
#pragma unroll
        for (int i = 0; i < 16; ++i) { acc0[i] = 0.f; acc1[i] = 0.f; }
#pragma unroll
        for (int j = 0; j < 2; ++j)
#pragma unroll
            for (int e = 0; e < 8; ++e)
#pragma unroll
                for (int cg = 0; cg < 4; ++cg) { const f32x4 w = WD[((j * 8 + e) * 4 + cg) * 64 + C.lane];
#pragma unroll
                    for (int i = 0; i < 4; ++i) { acc0[4 * cg + i] += h[0][j][e] * w[i]; acc1[4 * cg + i] += h[1][j][e] * w[i]; }
                    if (cg == 3 && (e & 1)) asm volatile("" ::: "memory"); }
        reduce_scatter<16>(acc0, C.lane); reduce_scatter<16>(acc1, C.lane);
        if ((C.lane & 3) == 0) { DTRAW[(size_t)m * 16 + (C.lane >> 2)] = acc0[0]; DTRAW[(size_t)(m + 1) * 16 + (C.lane >> 2)] = acc1[0]; }
    }
}
__device__ __forceinline__ void prep_ssd_unit(CArgs& a, const Ctx& C, int unit) {
    const bf16* U = (const bf16*)(a.ws + WS_U); const float* DTRAW = (const float*)(a.ws + WS_DTRAW);
    bf16* BC = (bf16*)(a.ws + WS_BC); bf16* XST = (bf16*)(a.ws + WS_XST);
    float* GA = (float*)(a.ws + WS_GA); float* DTA = (float*)(a.ws + WS_DTA); float* GEND = (float*)(a.ws + WS_GEND); u32x2* DSS = (u32x2*)(a.ws + WS_DSS);
    const int b = unit / NCH, tc = unit % NCH, s0 = 64 * tc; const bool isctx = tc < 4;
    const int rowbase = isctx ? NLAT + b * CTXL + s0 : b * SEQ + (s0 - CTXL);
    const int ilo = isctx ? -s0 : CTXL - s0, ihi = isctx ? CTXL - s0 : SP - s0;
    LAS float* dtl = (LAS float*)C.lds; LAS float* al = dtl + 1024; LAS float* wl = al + 1024;
    LAS bf16* XTl = (LAS bf16*)(C.lds + 12288);
    int ltid = C.tid; asm volatile("" : "+v"(ltid));
    const int ch0 = 2 * ltid;
    unsigned uw[68];
    if (C.tid < 384) { const bf16* up = U + (size_t)rowbase * NU + 512 + ch0;
#pragma unroll
        for (int t = 0; t < 68; ++t) { const int i = t - 2; uw[t] = (i >= ilo && i < ihi) ? *(const unsigned*)(up + (ptrdiff_t)i * NU) : 0u; } }
#pragma unroll
    for (int pi = 0; pi < 2; ++pi) { const int dh = 2 * C.wave + pi, dir = dh >> 3, h = dh & 7, i = C.lane;
        const float xv = DTRAW[(size_t)(rowbase + i) * 16 + dh] + a.dt_bias[dh];
        const float dt = fmaxf(xv, 0.f) + log1pf(__expf(-fabsf(xv)));
        const float av = -dt * __expf(a.a_log[dh]);
        float pre = av;
#pragma unroll
        for (int o = 1; o < 64; o <<= 1) { const float t = __shfl_up(pre, o); pre += (i >= o) ? t : 0.f; }
        const float tot = __shfl(pre, 63);
        const float g = dir == 0 ? pre : tot - pre + av;
        const float gend = tot;
        al[dh * 64 + i] = g; dtl[dh * 64 + i] = dt; wl[dh * 64 + i] = dt * __expf(gend - g);
        const size_t o = (size_t)((b * 2 + dir) * 8 + h) * SP + s0 + i; GA[o] = g; DTA[o] = dt;
        if (i == 0) GEND[((b * 2 + dir) * 8 + h) * NCH + tc] = gend; }
    LDS_BARRIER();
    if (C.tid < 384) {
        f32x2 wk[5];
#pragma unroll
        for (int k = 0; k < 5; ++k) wk[k] = *(const f32x2*)(a.conv_w + k * 768 + ch0);
        const f32x2 cb = *(const f32x2*)(a.conv_b + ch0);
        const int cls = ch0 < 512 ? 0 : (ch0 < 640 ? 1 : 2);
#pragma unroll
        for (int i8 = 0; i8 < 8; ++i8) {
            unsigned t0[4], t1[4]; float pv0 = 0.f, pv1 = 0.f;
#pragma unroll
            for (int ii = 0; ii < 8; ++ii) {
                const int i = 8 * i8 + ii;
                float y0 = cb.x, y1 = cb.y;
#pragma unroll
                for (int k = 0; k < 5; ++k) { y0 += wk[k].x * bflo(uw[i + k]); y1 += wk[k].y * bfhi(uw[i + k]); }
                y0 = siluf(y0); y1 = siluf(y1);
                if (cls != 0) *(unsigned*)(BC + (size_t)(rowbase + i) * 256 + (ch0 - 512)) = cvt_pk_bf16(y0, y1);
                if (ii & 1) { t0[ii >> 1] = cvt_pk_bf16(pv0, y0); t1[ii >> 1] = cvt_pk_bf16(pv1, y1); } else { pv0 = y0; pv1 = y1; }
            }
            if (cls != 2) {
                const u32x4 v0 = (u32x4){t0[0], t0[1], t0[2], t0[3]}, v1 = (u32x4){t1[0], t1[1], t1[2], t1[3]};
                *(LAS u32x4*)(XTl + ch0 * 72 + 8 * i8) = v0; *(LAS u32x4*)(XTl + (ch0 + 1) * 72 + 8 * i8) = v1;
                if (cls == 0) { const size_t r0 = (size_t)(b * 512 + ch0) * SP + s0 + 8 * i8; *(u32x4*)(XST + r0) = v0; *(u32x4*)(XST + r0 + SP) = v1; }
            }
        }
    }
    LDS_BARRIER();
    {
        const int fr = C.lane & 15, q = C.lane >> 4;
#pragma unroll 1
        for (int pi = 0; pi < 2; ++pi) { const int pid = 2 * C.wave + pi, dir = pid >> 3, h = pid & 7, g = h >> 2;
            bf16x8 Bf[4][2]; f32x4 wv[2][2];
#pragma unroll
            for (int ks = 0; ks < 2; ++ks) { wv[ks][0] = *(const LAS f32x4*)(wl + pid * 64 + 32 * ks + 8 * q); wv[ks][1] = *(const LAS f32x4*)(wl + pid * 64 + 32 * ks + 8 * q + 4); }
#pragma unroll
            for (int t = 0; t < 4; ++t)
#pragma unroll
                for (int ks = 0; ks < 2; ++ks) Bf[t][ks] = *(const LAS bf16x8*)(XTl + (h * 64 + 16 * t + fr) * 72 + 32 * ks + 8 * q);
            const size_t ob = ((size_t)((b * 2 + dir) * 8 + h) * NCH + tc) * 1024;
#pragma unroll
            for (int at = 0; at < 4; ++at) { bf16x8 Af[2];
#pragma unroll
                for (int ks = 0; ks < 2; ++ks) { const u32x4 raw = *(const LAS u32x4*)(XTl + (512 + g * 64 + 16 * at + fr) * 72 + 32 * ks + 8 * q); const unsigned rw[4] = {raw.x, raw.y, raw.z, raw.w}; u32x4 o;
                    o.x = cvt_pk_bf16(bflo(rw[0]) * wv[ks][0][0], bfhi(rw[0]) * wv[ks][0][1]); o.y = cvt_pk_bf16(bflo(rw[1]) * wv[ks][0][2], bfhi(rw[1]) * wv[ks][0][3]);
                    o.z = cvt_pk_bf16(bflo(rw[2]) * wv[ks][1][0], bfhi(rw[2]) * wv[ks][1][1]); o.w = cvt_pk_bf16(bflo(rw[3]) * wv[ks][1][2], bfhi(rw[3]) * wv[ks][1][3]);
                    Af[ks] = __builtin_bit_cast(bf16x8, o); }
#pragma unroll
                for (int pt = 0; pt < 4; ++pt) { f32x4 acc = (f32x4){0.f, 0.f, 0.f, 0.f};
                    acc = MFMA16(Af[0], Bf[pt][0], acc); acc = MFMA16(Af[1], Bf[pt][1], acc);
                    DSS[ob + (at * 4 + pt) * 64 + C.lane] = (u32x2){cvt_pk_bf16(acc[0], acc[1]), cvt_pk_bf16(acc[2], acc[3])}; } } }
    }
    LDS_BARRIER();
}
__device__ __forceinline__ void prep_hg_pair(CArgs& a, const Ctx& C, int unit) {
    const bf16* U = (const bf16*)(a.ws + WS_U);
    bf16* QS = (bf16*)(a.ws + WS_QS); bf16* KS = (bf16*)(a.ws + WS_KS); bf16* VT = (bf16*)(a.ws + WS_VT); float* EG = (float*)(a.ws + WS_EG); u32x2* DSP = (u32x2*)(a.ws + WS_DSP); float* EGP = (float*)(a.ws + WS_EGP);
    const int b = unit / (NPR * 4), pr = (unit >> 2) % NPR, h = unit & 3;
    LAS float* ETl = (LAS float*)(C.lds + 63488);
    LAS u32x2* DL = (LAS u32x2*)(C.lds + 65536);
#pragma unroll 1
    for (int sub = 0; sub < 2; ++sub) {
    const int c = 2 * pr + sub, s0 = 64 * c; const bool isctx = c < 4;
    int ltid = C.tid; asm volatile("" : "+v"(ltid));
    const int cp = ltid & 63, tg = ltid >> 6, ch0 = 2 * cp, hc = h * 128 + ch0;
    const int rbase = isctx ? NLAT + b * CTXL + s0 : b * SEQ + (c - 4), rstride = isctx ? 1 : 64;
    const bf16* up = U + (size_t)rbase * NU + 1280 + hc;
    unsigned rq[8], rf[8], rb[8], ri[8];
#pragma unroll
    for (int t = 0; t < 8; ++t) { const bf16* r = up + (size_t)(8 * tg + t) * rstride * NU;
        rq[t] = *(const unsigned*)r; rf[t] = *(const unsigned*)(r + 512); rb[t] = *(const unsigned*)(r + 1024); ri[t] = *(const unsigned*)(r + 1536); }
    LAS float* part = (LAS float*)C.lds;
    LAS bf16* KHl = (LAS bf16*)(C.lds + 8192);
    LAS bf16* VTl = KHl + 2 * 128 * 72;
    f32x2 lbv[2];
#pragma unroll
    for (int d = 0; d < 2; ++d) { lbv[d].x = __builtin_amdgcn_rcpf(1.0f + __expf(a.hg_lb[1024 + d * 512 + hc] - a.hg_lb[d * 512 + hc])); lbv[d].y = __builtin_amdgcn_rcpf(1.0f + __expf(a.hg_lb[1024 + d * 512 + hc + 1] - a.hg_lb[d * 512 + hc + 1])); }
    float la[2][2][8], om[2][2][8];
    float sum[2][2] = {{0.f, 0.f}, {0.f, 0.f}};
#pragma unroll
    for (int t = 0; t < 8; ++t)
#pragma unroll
        for (int d = 0; d < 2; ++d)
#pragma unroll
            for (int e = 0; e < 2; ++e) { const unsigned w = d == 0 ? rf[t] : rb[t]; const float fr_ = e == 0 ? bflo(w) : bfhi(w); const float lb = e == 0 ? lbv[d].x : lbv[d].y;
                const float ex = __builtin_amdgcn_exp2f(fr_ * -1.4426950408889634f); const float t1 = (1.0f - lb) * __builtin_amdgcn_rcpf(1.0f + ex);
                om[d][e][t] = t1 * ex;
                la[d][e][t] = __builtin_amdgcn_logf(lb + t1); sum[d][e] += la[d][e][t]; }
#pragma unroll
    for (int d = 0; d < 2; ++d)
#pragma unroll
        for (int e = 0; e < 2; ++e) part[(tg * 4 + d * 2 + e) * 64 + cp] = sum[d][e];
    LDS_BARRIER();
    float T[2][2], pre[2][2];
#pragma unroll
    for (int d = 0; d < 2; ++d)
#pragma unroll
        for (int e = 0; e < 2; ++e) { float tt = 0.f, pp = 0.f;
#pragma unroll
            for (int g2 = 0; g2 < 8; ++g2) { const float v = part[(g2 * 4 + d * 2 + e) * 64 + cp]; pp += (g2 < tg) ? v : 0.f; tt += v; }
            T[d][e] = tt; pre[d][e] = pp; }
    const size_t DST = (size_t)NB * 4 * SP * 128;
    unsigned khp[2][2][4], vp[2][4];
    float eT[2][2];
#pragma unroll
    for (int d = 0; d < 2; ++d)
#pragma unroll
        for (int e = 0; e < 2; ++e) eT[d][e] = __builtin_amdgcn_exp2f(T[d][e]);
    {
        float runf[2] = {pre[0][0], pre[0][1]}, runb[2] = {pre[1][0], pre[1][1]}, pkf[2] = {0.f, 0.f}, pkb[2] = {0.f, 0.f}, pkv[2] = {0.f, 0.f};
#pragma unroll
        for (int t = 0; t < 8; ++t) { const size_t rm = ((size_t)(b * 4 + h) * SP + s0 + 8 * tg + t) * 128 + ch0;
            const float qv[2] = {siluf(bflo(rq[t])) * 0.08838834764831845f, siluf(bfhi(rq[t])) * 0.08838834764831845f};
            float ktf[2], ktb[2], qtf[2], qtb[2];
#pragma unroll
            for (int e = 0; e < 2; ++e) {
                runf[e] += la[0][e][t]; const float Ef = __builtin_amdgcn_exp2f(-runf[e]);
                const float gb = T[1][e] - runb[e]; runb[e] += la[1][e][t]; const float Eb = __builtin_amdgcn_exp2f(-gb);
                ktf[e] = om[0][e][t] * Ef; ktb[e] = om[1][e][t] * Eb; qtf[e] = qv[e] * __builtin_amdgcn_rcpf(Ef); qtb[e] = qv[e] * __builtin_amdgcn_rcpf(Eb);
                const float khf = ktf[e] * eT[0][e], khb = ktb[e] * eT[1][e], iv = e == 0 ? bflo(ri[t]) : bfhi(ri[t]);
                if (t & 1) { khp[0][e][t >> 1] = cvt_pk_bf16(pkf[e], khf); khp[1][e][t >> 1] = cvt_pk_bf16(pkb[e], khb); vp[e][t >> 1] = cvt_pk_bf16(pkv[e], iv); } else { pkf[e] = khf; pkb[e] = khb; pkv[e] = iv; } }
            *(unsigned*)(QS + rm) = cvt_pk_bf16(qtf[0], qtf[1]); *(unsigned*)(QS + DST + rm) = cvt_pk_bf16(qtb[0], qtb[1]);
            *(unsigned*)(KS + rm) = cvt_pk_bf16(ktf[0], ktf[1]); *(unsigned*)(KS + DST + rm) = cvt_pk_bf16(ktb[0], ktb[1]); }
    }
#pragma unroll
    for (int e = 0; e < 2; ++e) {
        *(LAS u32x4*)(KHl + (0 * 128 + ch0 + e) * 72 + 8 * tg) = (u32x4){khp[0][e][0], khp[0][e][1], khp[0][e][2], khp[0][e][3]};
        *(LAS u32x4*)(KHl + (1 * 128 + ch0 + e) * 72 + 8 * tg) = (u32x4){khp[1][e][0], khp[1][e][1], khp[1][e][2], khp[1][e][3]};
        *(LAS u32x4*)(VTl + (ch0 + e) * 72 + 8 * tg) = (u32x4){vp[e][0], vp[e][1], vp[e][2], vp[e][3]};
        *(u32x4*)(VT + (size_t)((b * 4 + h) * 128 + ch0 + e) * SP + s0 + 8 * tg) = (u32x4){vp[e][0], vp[e][1], vp[e][2], vp[e][3]}; }
    if (tg == 0) {
#pragma unroll
        for (int d = 0; d < 2; ++d) { const f32x2 et = (f32x2){eT[d][0], eT[d][1]};
            *(f32x2*)(EG + ((size_t)((d * 4 + b) * 4 + h) * NCH + c) * 128 + ch0) = et; *(LAS f32x2*)(ETl + (sub * 2 + d) * 128 + ch0) = et;
            if (sub) { const f32x2 e0 = *(const LAS f32x2*)(ETl + d * 128 + ch0); *(f32x2*)(EGP + ((size_t)((d * 4 + b) * 4 + h) * NPR + pr) * 128 + ch0) = (f32x2){e0.x * et.x, e0.y * et.y}; } } }
    LDS_BARRIER();
    {
        const int fr = C.lane & 15, q = C.lane >> 4;
        LAS u32x2* dlb = DL + C.tid; asm volatile("" : "+v"(dlb));
        bf16x8 Bf[2];
#pragma unroll
        for (int ks = 0; ks < 2; ++ks) Bf[ks] = *(const LAS bf16x8*)(VTl + (16 * C.wave + fr) * 72 + 32 * ks + 8 * q);
#pragma unroll
        for (int d = 0; d < 2; ++d) { const int seq = (d * NB + b) * 4 + h;
#pragma unroll
            for (int at = 0; at < 8; ++at) { f32x4 t4 = (f32x4){0.f, 0.f, 0.f, 0.f};
#pragma unroll
                for (int ks = 0; ks < 2; ++ks) { const bf16x8 Af = *(const LAS bf16x8*)(KHl + (d * 128 + 16 * at + fr) * 72 + 32 * ks + 8 * q); t4 = MFMA16(Af, Bf[ks], t4); }
                LAS u32x2* dl = dlb + (d * 8 + at) * 512;
                if (sub == 0) *dl = (u32x2){cvt_pk_bf16(t4[0], t4[1]), cvt_pk_bf16(t4[2], t4[3])};
                else { const u32x2 pw = *dl; const f32x4 pv = (f32x4){bflo(pw.x), bfhi(pw.x), bflo(pw.y), bfhi(pw.y)};
                    const f32x4 r4 = d == 0 ? pv * *(const LAS f32x4*)(ETl + (1 * 2 + 0) * 128 + 16 * at + 4 * q) + t4
                                            : pv + t4 * *(const LAS f32x4*)(ETl + (0 * 2 + 1) * 128 + 16 * at + 4 * q);
                    DSP[((size_t)seq * NPR + pr) * 4096 + (at * 8 + C.wave) * 64 + C.lane] = (u32x2){cvt_pk_bf16(r4[0], r4[1]), cvt_pk_bf16(r4[2], r4[3])}; }
                if (at & 1) asm volatile("" ::: "memory"); } }
    }
    LDS_BARRIER();
    }
}
__device__ __forceinline__ void phase4(CArgs& a, const Ctx& C) {
    constexpr int NHU = NB * NPR * 4;
#pragma unroll 1
    for (int k = 0; k < 4; ++k) { int u; const int v = C.vcu;
        if (k == 0) u = v;
        else if (k == 1) u = v < 208 ? 256 + v : NHU + (v - 208);
        else if (k == 2) u = v < 80 ? 464 + v : (v < 208 ? NHU + 48 + (v - 80) : NHU + 176 + (v - 208));
        else { if (v < 208) break; u = NHU + 224 + (v - 208); }
        if (u < NHU) prep_hg_pair(a, C, u); else prep_ssd_unit(a, C, u - NHU); }
}
__device__ __forceinline__ void phase5(CArgs& a, const Ctx& C) { (void)a; (void)C; }
__device__ __forceinline__ int scan_chunk(int dir, int k) { return dir == 0 ? k : (k < 4 ? 3 - k : 71 - k); }
__device__ __forceinline__ void phase6(CArgs& a, const Ctx& C) {
    const u32x2* DSS = (const u32x2*)(a.ws + WS_DSS); const u32x2* DSP = (const u32x2*)(a.ws + WS_DSP);
    u32x2* SPS = (u32x2*)(a.ws + WS_SPS); u32x2* SPH = (u32x2*)(a.ws + WS_SPH);
    const float* GEND = (const float*)(a.ws + WS_GEND); const float* EGP = (const float*)(a.ws + WS_EGP);
    if (C.vcu < 128) {
        const int task = C.vcu * 512 + C.tid, seq = task >> 10, grp = task & 1023, dir = (seq >> 3) & 1;
        f32x4 S = (f32x4){0.f, 0.f, 0.f, 0.f};
#pragma unroll 1
        for (int kb = 0; kb < NCH; kb += 17) { u32x2 dw[17]; float gd[17];
#pragma unroll
            for (int j = 0; j < 17; ++j) { const int tc = scan_chunk(dir, kb + j); dw[j] = NTLOAD(&DSS[((size_t)seq * NCH + tc) * 1024 + grp]); gd[j] = GEND[seq * NCH + tc]; }
            asm volatile("" ::: "memory");
#pragma unroll
            for (int j = 0; j < 17; ++j) { const int tc = scan_chunk(dir, kb + j);
                if (tc >= 4) SPS[((size_t)seq * NCH + tc) * 1024 + grp] = (u32x2){cvt_pk_bf16(S[0], S[1]), cvt_pk_bf16(S[2], S[3])};
                S = S * __expf(gd[j]) + (f32x4){bflo(dw[j].x), bfhi(dw[j].x), bflo(dw[j].y), bfhi(dw[j].y)}; }
            asm volatile("" ::: "memory"); }
    } else {
#pragma unroll 1
        for (int rep = 0; rep < 2; ++rep) {
            const int t = (C.vcu - 128) * 1024 + rep * 512 + C.tid, seq = t >> 12, grp = t & 4095, d = seq >> 4, tile = grp >> 6, ln = grp & 63, cb = 16 * (tile >> 3) + 4 * (ln >> 4);
            f32x4 S = (f32x4){0.f, 0.f, 0.f, 0.f};
#pragma unroll 1
            for (int kb = 0; kb < NPR; kb += 17) { u32x2 dw[17]; f32x4 dec[17];
#pragma unroll
                for (int j = 0; j < 17; ++j) { const int k = kb + j, tp = d == 0 ? k : (k < 2 ? 1 - k : 35 - k); dw[j] = NTLOAD(&DSP[((size_t)seq * NPR + tp) * 4096 + grp]); dec[j] = *(const f32x4*)(EGP + ((size_t)seq * NPR + tp) * 128 + cb); }
                asm volatile("" ::: "memory");
#pragma unroll
                for (int j = 0; j < 17; ++j) { const int k = kb + j, tp = d == 0 ? k : (k < 2 ? 1 - k : 35 - k);
                    if (tp >= 2) SPH[((size_t)seq * NPR + tp) * 4096 + grp] = (u32x2){cvt_pk_bf16(S[0], S[1]), cvt_pk_bf16(S[2], S[3])};
                    S = S * dec[j] + (f32x4){bflo(dw[j].x), bfhi(dw[j].x), bflo(dw[j].y), bfhi(dw[j].y)}; }
                asm volatile("" ::: "memory"); } }
    }
}
typedef short s16x4 __attribute__((ext_vector_type(4)));
typedef short s16x8 __attribute__((ext_vector_type(8)));
__device__ __forceinline__ s16x4 lds_tr(const LAS bf16* p) { return __builtin_amdgcn_ds_read_tr16_b64_v4i16((LAS s16x4*)p); }
__device__ __forceinline__ bf16x8 ld_split8(const bf16* p0, const bf16* p1) {
    const u32x2 lo = *(const u32x2*)p0, hi = *(const u32x2*)p1; u32x4 w = (u32x4){lo.x, lo.y, hi.x, hi.y}; return __builtin_bit_cast(bf16x8, w);
}
__device__ __forceinline__ void passc_ssd_unit(CArgs& a, const Ctx& C, int unit) {
    const bf16* BC = (const bf16*)(a.ws + WS_BC); const bf16* XST = (const bf16*)(a.ws + WS_XST); const bf16* U = (const bf16*)(a.ws + WS_U);
    const float* GA = (const float*)(a.ws + WS_GA); const float* DTA = (const float*)(a.ws + WS_DTA); const bf16* SPS = (const bf16*)(a.ws + WS_SPS);
    bf16* Y = (bf16*)(a.ws + WS_Y);
    const int b = unit >> 6, tcl = unit & 63, tc = tcl + 4, s0 = 64 * tc, row0 = b * SEQ + 64 * tcl;
    const int h = C.wave, g = h >> 2, fr = C.lane & 15, q = C.lane >> 4;
    LAS unsigned char* wl = C.lds + C.wave * 17408;
    LAS bf16* Ml = (LAS bf16*)wl; LAS float* Yl = (LAS float*)wl; LAS float* red = (LAS float*)(C.lds + 8 * 17408);
    {
        bf16x8 Ca[4][2], Bb[4][2];
#pragma unroll
        for (int t = 0; t < 4; ++t)
#pragma unroll
            for (int ks = 0; ks < 2; ++ks) { const bf16* rp = BC + (size_t)(row0 + 16 * t + fr) * 256 + g * 64 + 32 * ks + 8 * q;
                Bb[t][ks] = *(const bf16x8*)rp; Ca[t][ks] = *(const bf16x8*)(rp + 128); }
        const size_t sf = (size_t)((b * 2 + 0) * 8 + h) * SP + s0, sb = (size_t)((b * 2 + 1) * 8 + h) * SP + s0;
        float gjf[4], gjb[4], dtf[4], dtb[4];
#pragma unroll
        for (int jt = 0; jt < 4; ++jt) { gjf[jt] = GA[sf + 16 * jt + fr]; gjb[jt] = GA[sb + 16 * jt + fr]; dtf[jt] = DTA[sf + 16 * jt + fr]; dtb[jt] = DTA[sb + 16 * jt + fr]; }
        const float Dh = a.ssd_d[h];
#pragma unroll
        for (int it = 0; it < 4; ++it) {
            const f32x4 gif = *(const f32x4*)(GA + sf + 16 * it + 4 * q), gib = *(const f32x4*)(GA + sb + 16 * it + 4 * q);
#pragma unroll
            for (int jt = 0; jt < 4; ++jt) { f32x4 G = (f32x4){0.f, 0.f, 0.f, 0.f};
                G = MFMA16(Ca[it][0], Bb[jt][0], G); G = MFMA16(Ca[it][1], Bb[jt][1], G);
                const int j = 16 * jt + fr;
#pragma unroll
                for (int r = 0; r < 4; ++r) { const int i = 16 * it + 4 * q + r;
                    const float lf = (j <= i) ? dtf[jt] * __expf(fminf(gif[r] - gjf[jt], 0.f)) : 0.f;
                    const float lb = (j >= i) ? dtb[jt] * __expf(fminf(gib[r] - gjb[jt], 0.f)) : 0.f;
                    const float m = G[r] * (lf + lb) + ((i == j) ? Dh : 0.f);
                    Ml[i * 72 + j] = (bf16)(cvt_pk_bf16(m, 0.f) & 0xffff); } } }
    }
    LDS_WAIT(); asm volatile("" ::: "memory");
    bf16x8 Ma[4][2], Cp[4][2];
#pragma unroll
    for (int it = 0; it < 4; ++it)
#pragma unroll
        for (int ks = 0; ks < 2; ++ks) { Ma[it][ks] = *(const LAS bf16x8*)(Ml + (16 * it + fr) * 72 + 32 * ks + 8 * q);
            const bf16* cp = BC + (size_t)(row0 + 16 * it + fr) * 256 + 128 + g * 64 + 32 * ks + 4 * q; Cp[it][ks] = ld_split8(cp, cp + 16); }
    LDS_WAIT(); asm volatile("" ::: "memory");
    f32x4 eg[2][4];
#pragma unroll
    for (int d = 0; d < 2; ++d)
#pragma unroll
        for (int it = 0; it < 4; ++it) { const f32x4 gi = *(const f32x4*)(GA + (size_t)((b * 2 + d) * 8 + h) * SP + s0 + 16 * it + 4 * q);
            eg[d][it] = (f32x4){__expf(gi[0]), __expf(gi[1]), __expf(gi[2]), __expf(gi[3])}; }
#pragma unroll 1
    for (int pt = 0; pt < 4; ++pt) {
        bf16x8 Bx[2];
#pragma unroll
        for (int ks = 0; ks < 2; ++ks) Bx[ks] = *(const bf16x8*)(XST + (size_t)((b * 8 + h) * 64 + 16 * pt + fr) * SP + s0 + 32 * ks + 8 * q);
        f32x4 Yv[4];
#pragma unroll
        for (int it = 0; it < 4; ++it) { Yv[it] = (f32x4){0.f, 0.f, 0.f, 0.f}; Yv[it] = MFMA16(Ma[it][0], Bx[0], Yv[it]); Yv[it] = MFMA16(Ma[it][1], Bx[1], Yv[it]); }
#pragma unroll
        for (int d = 0; d < 2; ++d) { const size_t sbase = ((size_t)((b * 2 + d) * 8 + h) * NCH + tc) * 1024;
            bf16x8 Sb[2];
#pragma unroll
            for (int ks = 0; ks < 2; ++ks) Sb[ks] = ld_split8(SPS + (sbase + ((2 * ks) * 4 + pt) * 64 + C.lane) * 4, SPS + (sbase + ((2 * ks + 1) * 4 + pt) * 64 + C.lane) * 4);
#pragma unroll
            for (int it = 0; it < 4; ++it) { f32x4 T = (f32x4){0.f, 0.f, 0.f, 0.f}; T = MFMA16(Cp[it][0], Sb[0], T); T = MFMA16(Cp[it][1], Sb[1], T); Yv[it] += eg[d][it] * T; } }
#pragma unroll
        for (int it = 0; it < 4; ++it)
#pragma unroll
            for (int r = 0; r < 4; ++r) Yl[(16 * it + 4 * q + r) * 68 + 16 * pt + fr] = Yv[it][r];
    }
    LDS_WAIT(); asm volatile("" ::: "memory");
    const int i = C.lane; float v[64]; float ss = 0.f;
    const bf16* zp = U + (size_t)(row0 + i) * NU + h * 64;
#pragma unroll
    for (int c8 = 0; c8 < 8; ++c8) { const u32x4 zw = *(const u32x4*)(zp + 8 * c8); const f32x4 y0 = *(const LAS f32x4*)(Yl + i * 68 + 8 * c8), y1 = *(const LAS f32x4*)(Yl + i * 68 + 8 * c8 + 4);
        const unsigned zz[4] = {zw.x, zw.y, zw.z, zw.w};
#pragma unroll
        for (int e = 0; e < 4; ++e) { const float ya = e < 2 ? y0[2 * e] : y1[2 * e - 4], yb = e < 2 ? y0[2 * e + 1] : y1[2 * e - 3];
            const float va = ya * siluf(bflo(zz[e])), vb = yb * siluf(bfhi(zz[e])); v[8 * c8 + 2 * e] = va; v[8 * c8 + 2 * e + 1] = vb; ss += va * va + vb * vb; } }
    red[C.wave * 64 + i] = ss;
    LDS_BARRIER();
    float tot = 0.f;
#pragma unroll
    for (int w = 0; w < 8; ++w) tot += red[w * 64 + i];
    const float rstd = rsqrtf(tot * (1.0f / 512.0f) + EPS);
    bf16* yo = Y + (size_t)(row0 + i) * D + h * 64;
#pragma unroll
    for (int c8 = 0; c8 < 8; ++c8) { const f32x4 n0 = *(const f32x4*)(a.ssd_norm + h * 64 + 8 * c8), n1 = *(const f32x4*)(a.ssd_norm + h * 64 + 8 * c8 + 4);
        u32x4 o; o.x = cvt_pk_bf16(v[8 * c8] * rstd * n0[0], v[8 * c8 + 1] * rstd * n0[1]); o.y = cvt_pk_bf16(v[8 * c8 + 2] * rstd * n0[2], v[8 * c8 + 3] * rstd * n0[3]);
        o.z = cvt_pk_bf16(v[8 * c8 + 4] * rstd * n1[0], v[8 * c8 + 5] * rstd * n1[1]); o.w = cvt_pk_bf16(v[8 * c8 + 6] * rstd * n1[2], v[8 * c8 + 7] * rstd * n1[3]);
        *(u32x4*)(yo + 8 * c8) = o; }
    LDS_BARRIER();
}
__device__ __forceinline__ void passc_hg_pair(CArgs& a, const Ctx& C, int unit) {
    const bf16* QS = (const bf16*)(a.ws + WS_QS); const bf16* KS = (const bf16*)(a.ws + WS_KS); const bf16* VT = (const bf16*)(a.ws + WS_VT); const bf16* SPH = (const bf16*)(a.ws + WS_SPH);
    const bf16* U = (const bf16*)(a.ws + WS_U); bf16* Y = (bf16*)(a.ws + WS_Y); const float* EG = (const float*)(a.ws + WS_EG);
    const int b = unit >> 7, pr = 2 + ((unit >> 2) & 31), h = unit & 3;
    const int wv = C.wave, fr = C.lane & 15, q = C.lane >> 4;
    LAS bf16* Pl = (LAS bf16*)C.lds; LAS float* Ol = (LAS float*)(C.lds + 9216); LAS float* red = (LAS float*)(C.lds + 9216 + 64 * 132 * 4);
    LAS bf16* KL = (LAS bf16*)(C.lds + 79872);
    LAS bf16* QL = (LAS bf16*)(C.lds + 45056);
    const size_t DST = (size_t)NB * 4 * SP * 128;
#pragma unroll 1
    for (int sub = 0; sub < 2; ++sub) {
    const int tc = 2 * pr + sub, w = tc - 4, s0 = 64 * tc, oc = 2 * pr + 1 - sub;
    const int it0 = wv >> 1;
    bf16x8 Aq[2][4], Bk[2][2][4];
#pragma unroll
    for (int d = 0; d < 2; ++d) { const size_t base = d * DST + ((size_t)(b * 4 + h) * SP + s0) * 128;
#pragma unroll
        for (int ks = 0; ks < 4; ++ks) { Aq[d][ks] = *(const bf16x8*)(QS + base + (size_t)(16 * it0 + fr) * 128 + 32 * ks + 8 * q);
#pragma unroll
            for (int j2 = 0; j2 < 2; ++j2) Bk[d][j2][ks] = *(const bf16x8*)(KS + base + (size_t)(16 * (2 * (wv & 1) + j2) + fr) * 128 + 32 * ks + 8 * q); } }
    bf16x8 Bv[2], Vo[2], SbD[4];
#pragma unroll
    for (int ks = 0; ks < 2; ++ks) Bv[ks] = *(const bf16x8*)(VT + (size_t)((b * 4 + h) * 128 + 16 * wv + fr) * SP + s0 + 32 * ks + 8 * q);
    const int dm = 1 - sub;
#pragma unroll
    for (int ks = 0; ks < 2; ++ks) Vo[ks] = *(const bf16x8*)(VT + (size_t)((b * 4 + h) * 128 + 16 * wv + fr) * SP + 64 * oc + 32 * ks + 8 * q);
    u32x2 sp[8];
    { const size_t sbD = ((size_t)((sub * NB + b) * 4 + h) * NPR + pr) * 4096, sbM = ((size_t)((dm * NB + b) * 4 + h) * NPR + pr) * 4096;
#pragma unroll
        for (int ks = 0; ks < 4; ++ks) SbD[ks] = ld_split8(SPH + (sbD + ((2 * ks) * 8 + wv) * 64 + C.lane) * 4, SPH + (sbD + ((2 * ks + 1) * 8 + wv) * 64 + C.lane) * 4);
#pragma unroll
        for (int at = 0; at < 8; ++at) sp[at] = *(const u32x2*)(SPH + (sbM + (at * 8 + wv) * 64 + C.lane) * 4); }
    const int kr = C.tid >> 3, kc = (C.tid & 7) * 16;
    const bf16* kso = KS + dm * DST + ((size_t)(b * 4 + h) * SP + 64 * oc) * 128 + kr * 128 + kc;
    const u32x4 kt0 = *(const u32x4*)kso, kt1 = *(const u32x4*)(kso + 8);
    const int i = C.lane;
    const size_t row = (size_t)b * SEQ + i * 64 + w;
    const bf16* gp = U + row * NU + 1280 + 2048 + h * 128 + 16 * wv; bf16* yo = Y + row * D + 512 + h * 128 + 16 * wv; const float* nwp = a.hg_norm + h * 128 + 16 * wv;
    const u32x4 gw0 = *(const u32x4*)gp, gw1 = *(const u32x4*)(gp + 8);
    f32x4 nw[4];
#pragma unroll
    for (int c4 = 0; c4 < 4; ++c4) nw[c4] = *(const f32x4*)(nwp + 4 * c4);
    {
        f32x4 P[2] = {(f32x4){0.f, 0.f, 0.f, 0.f}, (f32x4){0.f, 0.f, 0.f, 0.f}};
#pragma unroll
        for (int d = 0; d < 2; ++d) {
#pragma unroll
            for (int ks = 0; ks < 4; ++ks) if ((wv & 1) == 0) *(LAS bf16x8*)(QL + (d * 64 + 16 * it0 + fr) * 136 + 32 * ks + 8 * q) = Aq[d][ks];
#pragma unroll
            for (int j2 = 0; j2 < 2; ++j2) { const int jt = 2 * (wv & 1) + j2; f32x4 S = (f32x4){0.f, 0.f, 0.f, 0.f};
#pragma unroll
                for (int ks = 0; ks < 4; ++ks) S = MFMA16(Aq[d][ks], Bk[d][j2][ks], S);
                const int j = 16 * jt + fr;
#pragma unroll
                for (int r = 0; r < 4; ++r) { const int ii = 16 * it0 + 4 * q + r; const bool keep = d == 0 ? (j <= ii) : (j >= ii); P[j2][r] += keep ? S[r] : 0.f; } } }
#pragma unroll
        for (int j2 = 0; j2 < 2; ++j2) { const int j = 16 * (2 * (wv & 1) + j2) + fr;
#pragma unroll
            for (int r = 0; r < 4; ++r) Pl[(16 * it0 + 4 * q + r) * 72 + j] = (bf16)(cvt_pk_bf16(P[j2][r], 0.f) & 0xffff); }
        *(LAS u32x4*)(KL + kr * 136 + kc) = kt0; *(LAS u32x4*)(KL + kr * 136 + kc + 8) = kt1;
    }
    LDS_BARRIER();
    f32x4 O[4];
#pragma unroll
    for (int it = 0; it < 4; ++it) { O[it] = (f32x4){0.f, 0.f, 0.f, 0.f};
#pragma unroll
        for (int ks = 0; ks < 2; ++ks) { const bf16x8 Pa = *(const LAS bf16x8*)(Pl + (16 * it + fr) * 72 + 32 * ks + 8 * q); O[it] = MFMA16(Pa, Bv[ks], O[it]); } }
    bf16x8 SbM[4];
    { const float* eg = EG + ((size_t)((dm * NB + b) * 4 + h) * NCH + oc) * 128 + 4 * q;
        const LAS bf16* kt = KL + (8 * q + (fr >> 2)) * 136 + 4 * (fr & 3);
#pragma unroll
        for (int ks = 0; ks < 4; ++ks) { unsigned wd[4];
#pragma unroll
            for (int hh = 0; hh < 2; ++hh) { const int at = 2 * ks + hh; f32x4 t4 = (f32x4){bflo(sp[at].x), bfhi(sp[at].x), bflo(sp[at].y), bfhi(sp[at].y)};
#pragma unroll
                for (int k2 = 0; k2 < 2; ++k2) { const s16x4 a0 = lds_tr(kt + (32 * k2) * 136 + 16 * at), a1 = lds_tr(kt + (32 * k2 + 4) * 136 + 16 * at);
                    const s16x8 av = (s16x8){a0[0], a0[1], a0[2], a0[3], a1[0], a1[1], a1[2], a1[3]}; t4 = MFMA16(__builtin_bit_cast(bf16x8, av), Vo[k2], t4); }
                const f32x4 e4 = *(const f32x4*)(eg + 16 * at);
                wd[2 * hh] = cvt_pk_bf16(t4[0] * e4[0], t4[1] * e4[1]); wd[2 * hh + 1] = cvt_pk_bf16(t4[2] * e4[2], t4[3] * e4[3]); }
            const u32x4 ww = (u32x4){wd[0], wd[1], wd[2], wd[3]}; SbM[ks] = __builtin_bit_cast(bf16x8, ww); } }
#pragma unroll
    for (int d = 0; d < 2; ++d)
#pragma unroll
        for (int ks = 0; ks < 4; ++ks) { const bf16x8 sb = d == sub ? SbD[ks] : SbM[ks];
#pragma unroll
            for (int it = 0; it < 4; ++it) { const LAS bf16* qp = QL + (d * 64 + 16 * it + fr) * 136 + 32 * ks + 4 * q;
                const u32x2 lo = *(const LAS u32x2*)qp, hi = *(const LAS u32x2*)(qp + 16); const u32x4 ww = (u32x4){lo.x, lo.y, hi.x, hi.y};
                O[it] = MFMA16(__builtin_bit_cast(bf16x8, ww), sb, O[it]); } }
#pragma unroll
    for (int it = 0; it < 4; ++it)
#pragma unroll
        for (int r = 0; r < 4; ++r) Ol[(16 * it + 4 * q + r) * 132 + 16 * wv + fr] = O[it][r];
    LDS_BARRIER();
    float o[16]; float ss = 0.f;
#pragma unroll
    for (int c4 = 0; c4 < 4; ++c4) { const f32x4 t = *(const LAS f32x4*)(Ol + i * 132 + 16 * wv + 4 * c4);
#pragma unroll
        for (int e = 0; e < 4; ++e) { o[4 * c4 + e] = t[e]; ss += t[e] * t[e]; } }
    red[wv * 64 + i] = ss;
    LDS_BARRIER();
    float tot = 0.f;
#pragma unroll
    for (int s2 = 0; s2 < 8; ++s2) tot += red[s2 * 64 + i];
    const float rstd = rsqrtf(tot * (1.0f / 128.0f) + EPS);
#pragma unroll
    for (int c8 = 0; c8 < 2; ++c8) { const u32x4 gw4 = c8 == 0 ? gw0 : gw1; const unsigned gz[4] = {gw4.x, gw4.y, gw4.z, gw4.w}; unsigned ow[4];
#pragma unroll
        for (int e = 0; e < 4; ++e) { const int k = 8 * c8 + 2 * e; ow[e] = cvt_pk_bf16(o[k] * rstd * nw[k >> 2][k & 3] * siluf(bflo(gz[e])), o[k + 1] * rstd * nw[(k + 1) >> 2][(k + 1) & 3] * siluf(bfhi(gz[e]))); }
        *(u32x4*)(yo + 8 * c8) = (u32x4){ow[0], ow[1], ow[2], ow[3]}; }
    LDS_BARRIER();
    }
}
__device__ __forceinline__ void phase7(CArgs& a, const Ctx& C) {
    for (int u = C.vcu; u < 256; u += C.G) passc_ssd_unit(a, C, u);
    for (int u = C.vcu; u < 512; u += C.G) passc_hg_pair(a, C, u);
}
__device__ __forceinline__ void phase9_fill(CArgs& a, const Ctx& C, int t0, int nt) {
    LAS float* RW = (LAS float*)C.lds;
    for (int k = t0; k < D; k += nt) {
#pragma unroll
        for (int e4 = 0; e4 < 8; ++e4) { const f32x4 w = *(const f32x4*)(a.router_w + (size_t)k * NE + 4 * e4);
#pragma unroll
            for (int e = 0; e < 4; ++e) RW[(4 * e4 + e) * D + k] = w[e]; } }
}
__device__ __forceinline__ void phase9(CArgs& a, const Ctx& C, bool prefilled) {
    constexpr int NR = 4;
    const float* MOD = (const float*)(a.ws + WS_MOD); const bf16* MIX = (const bf16*)(a.ws + WS_MIX); unsigned char* HX = a.ws + WS_XN; bf16* X1 = (bf16*)(a.ws + WS_U);
    int* TOPE = (int*)(a.ws + WS_ROUTE); float* GATE = (float*)(a.ws + WS_ROUTE + 256 * 1024); int* PPOS = (int*)(a.ws + WS_ROUTE + 512 * 1024); int* ROWTOK = (int*)(a.ws + WS_ROWTOK);
    unsigned* gcnt = (unsigned*)(a.ws + WS_CTL) + CW_CNT;
    LAS float* RW = (LAS float*)C.lds;
    LAS float* LG = (LAS float*)(C.lds + 131072) + C.wave * 128;
    LAS unsigned* lcnt = (LAS unsigned*)(C.lds + LCNT_OFF); LAS unsigned* lbase = lcnt + 32;
    if (!prefilled) phase9_fill(a, C, C.tid, 512);
    if (C.tid < 32) lcnt[C.tid] = 0u;
    __syncthreads();
    LAS float* VA = (LAS float*)(C.lds + 131072 + 4096); LAS float* VB = VA + 1024;
    for (int m0 = NR * C.gw; m0 < NLAT; m0 += NR * C.NGW) {
        const int b = m0 >> 12; const float* mb = MOD + b * 6144;
        __syncthreads();
        for (int k = C.tid; k < D; k += 512) { VA[k] = mb[2048 + k] * a.mix_post[k]; VB[k] = a.ffn_pre[k] * (1.0f + mb[4096 + k]); }
        __syncthreads();
        float hv[NR][16];
#pragma unroll
        for (int r = 0; r < NR; ++r) { const size_t ro = (size_t)(m0 + r) * D; float ss = 0.f;
            f32x4 xv[4];
#pragma unroll
            for (int jj = 0; jj < 4; ++jj) { const u32x2 w = NTLOAD((const u32x2*)(MIX + ro + 256 * jj + 4 * C.lane)); xv[jj] = NTLOAD((const f32x4*)(a.x + ro + 256 * jj + 4 * C.lane));
                hv[r][4 * jj] = bflo(w.x); hv[r][4 * jj + 1] = bfhi(w.x); hv[r][4 * jj + 2] = bflo(w.y); hv[r][4 * jj + 3] = bfhi(w.y); }
#pragma unroll
            for (int i = 0; i < 16; ++i) ss += hv[r][i] * hv[r][i];
            const float rstd = rsqrtf(wave_sum(ss) * (1.0f / D) + EPS); float ss2 = 0.f;
#pragma unroll
            for (int jj = 0; jj < 4; ++jj) { const int k0 = 256 * jj + 4 * C.lane; const f32x4 va = *(const LAS f32x4*)(VA + k0);
                f32x4 x1;
#pragma unroll
                for (int e = 0; e < 4; ++e) { x1[e] = xv[jj][e] + va[e] * (hv[r][4 * jj + e] * rstd); hv[r][4 * jj + e] = x1[e]; ss2 += x1[e] * x1[e]; }
                *(u32x2*)(X1 + ro + k0) = (u32x2){cvt_pk_bf16(x1[0], x1[1]), cvt_pk_bf16(x1[2], x1[3])}; }
            const float rstd2 = rsqrtf(wave_sum(ss2) * (1.0f / D) + EPS);
#pragma unroll
            for (int jj = 0; jj < 4; ++jj) { const int k0 = 256 * jj + 4 * C.lane; const f32x4 vb = *(const LAS f32x4*)(VB + k0), s0 = *(const f32x4*)(mb + 3072 + k0);
#pragma unroll
                for (int e = 0; e < 4; ++e) hv[r][4 * jj + e] = hv[r][4 * jj + e] * rstd2 * vb[e] + s0[e];
                *(unsigned*)(HX + ro + k0) = pk4_fp8(hv[r][4 * jj], hv[r][4 * jj + 1], hv[r][4 * jj + 2], hv[r][4 * jj + 3]); }
            if (r & 1) asm volatile("" ::: "memory"); }
#pragma unroll 1
        for (int eg = 0; eg < 4; ++eg) {
            float lg[NR][8];
#pragma unroll
            for (int r = 0; r < NR; ++r)
#pragma unroll
                for (int e = 0; e < 8; ++e) lg[r][e] = 0.f;
#pragma unroll
            for (int e = 0; e < 8; ++e)
#pragma unroll
                for (int jj = 0; jj < 4; ++jj) { const f32x4 w = *(const LAS f32x4*)(RW + (8 * eg + e) * D + 256 * jj + 4 * C.lane);
#pragma unroll
                    for (int r = 0; r < NR; ++r) lg[r][e] += hv[r][4 * jj] * w[0] + hv[r][4 * jj + 1] * w[1] + hv[r][4 * jj + 2] * w[2] + hv[r][4 * jj + 3] * w[3];
                    if (jj == 3 && (e & 1)) asm volatile("" ::: "memory"); }
#pragma unroll
            for (int r = 0; r < NR; ++r) { reduce_scatter<8>(lg[r], C.lane);
                if ((C.lane & 7) == 0) LG[r * 32 + 8 * eg + (C.lane >> 3)] = lg[r][0]; }
        }
        LDS_WAIT(); asm volatile("" ::: "memory");
        if (C.lane < NR) { const int m = m0 + C.lane; float logit[32];
#pragma unroll
            for (int e4 = 0; e4 < 8; ++e4) { const f32x4 v = *(const LAS f32x4*)(LG + C.lane * 32 + 4 * e4), rb = *(const f32x4*)(a.router_b + 4 * e4);
#pragma unroll
                for (int e = 0; e < 4; ++e) logit[4 * e4 + e] = v[e] + rb[e]; }
            int te[4]; float tv[4]; unsigned taken = 0u;
#pragma unroll
            for (int k = 0; k < 4; ++k) { float best = -3.0e38f; int bi = 0;
#pragma unroll
                for (int e = 0; e < 32; ++e) { const bool better = (((taken >> e) & 1u) == 0u) && (logit[e] > best); best = better ? logit[e] : best; bi = better ? e : bi; }
                te[k] = bi; tv[k] = best; taken |= 1u << bi; }
            float ex[4], sum = 0.f;
#pragma unroll
            for (int k = 0; k < 4; ++k) { ex[k] = __expf(tv[k] - tv[0]); sum += ex[k]; }
            const float inv = 1.0f / sum;
#pragma unroll
            for (int k = 0; k < 4; ++k) { const unsigned pos = __hip_atomic_fetch_add(lcnt + te[k], 1u, __ATOMIC_RELAXED, __HIP_MEMORY_SCOPE_WORKGROUP);
                TOPE[m * 4 + k] = te[k]; GATE[m * 4 + k] = ex[k] * inv; PPOS[m * 4 + k] = (int)pos; } }
        LDS_WAIT(); asm volatile("" ::: "memory");
    }
    __syncthreads();
    if (C.tid < 32) lbase[C.tid] = atomicAdd(gcnt + C.tid, lcnt[C.tid]);
    __syncthreads();
    for (int m0 = 4 * C.gw; m0 < NLAT; m0 += 4 * C.NGW) if (C.lane < 4 * NR) { const int idx = m0 * 4 + C.lane; const int e = TOPE[idx]; const int pos = PPOS[idx] + (int)lbase[e]; PPOS[idx] = pos; ROWTOK[e * 16384 + pos] = m0 + (C.lane >> 2); }
}
__device__ __forceinline__ void moe_tables(CArgs& a, const Ctx& C) {
    const unsigned* gcnt = (const unsigned*)(a.ws + WS_CTL) + CW_CNT; LAS int* TS = (LAS int*)(C.lds + TS_OFF); LAS int* CN = TS + 36;
    if (C.tid < 64) { const int e = C.tid & 31; const int c = (int)__hip_atomic_load(gcnt + e, RLX_AGENT); const int nt = (c + 255) >> 8;
        int pre = nt;
#pragma unroll
        for (int o = 1; o < 32; o <<= 1) { const int t = __shfl_up(pre, o, 32); pre += ((C.tid & 31) >= o) ? t : 0; }
        if (C.tid < 32) { TS[e] = pre - nt; CN[e] = c; if (e == 31) TS[NE] = pre; } }
    __syncthreads();
    if (C.tid < 320) { int e = 0;
#pragma unroll
        for (int k = 1; k < NE; ++k) e += (TS[k] <= C.tid) ? 1 : 0;
        TS[80 + C.tid] = e; }
    __syncthreads();
}
__device__ __forceinline__ void phase13(CArgs& a, const Ctx& C) {
    const float* MOD = (const float*)(a.ws + WS_MOD); const unsigned char* Y2 = a.ws + WS_Y2; const bf16* X1 = (const bf16*)(a.ws + WS_U);
    const int* TOPE = (const int*)(a.ws + WS_ROUTE); const float* GATE = (const float*)(a.ws + WS_ROUTE + 256 * 1024); const int* PPOS = (const int*)(a.ws + WS_ROUTE + 512 * 1024);
    moe_tables(a, C); const LAS int* TS = (const LAS int*)(C.lds + TS_OFF);
    for (int m0 = 4 * C.gw; m0 < NLAT; m0 += 4 * C.NGW) {
        const int b = m0 >> 12; const float* gf = MOD + b * 6144 + 5120;
        int slot = 0; float gk = 0.f;
        if (C.lane < 16) { const int idx = m0 * 4 + C.lane; slot = TS[TOPE[idx]] * 256 + PPOS[idx]; gk = GATE[idx] * (1.0f / Y_SCALE); }
        u32x4 yw[4][4];
#pragma unroll
        for (int r = 0; r < 4; ++r)
#pragma unroll
            for (int k = 0; k < 4; ++k) { const int sl = __shfl(slot, 4 * r + k); yw[r][k] = NTLOAD((const u32x4*)(Y2 + (size_t)sl * D + 16 * C.lane)); }
#pragma unroll
        for (int r = 0; r < 4; ++r) { float f[16];
#pragma unroll
            for (int e = 0; e < 16; ++e) f[e] = 0.f;
#pragma unroll
            for (int k = 0; k < 4; ++k) { const float g = __shfl(gk, 4 * r + k); const unsigned ww[4] = {yw[r][k].x, yw[r][k].y, yw[r][k].z, yw[r][k].w};
#pragma unroll
                for (int e = 0; e < 4; ++e) { const f32x2 lo = __builtin_amdgcn_cvt_pk_f32_fp8((int)ww[e], false), hi = __builtin_amdgcn_cvt_pk_f32_fp8((int)ww[e], true);
                    f[4 * e] += g * lo.x; f[4 * e + 1] += g * lo.y; f[4 * e + 2] += g * hi.x; f[4 * e + 3] += g * hi.y; } }
            float ss = 0.f;
#pragma unroll
            for (int e = 0; e < 16; ++e) ss += f[e] * f[e];
            const float rstd = rsqrtf(wave_sum(ss) * (1.0f / D) + EPS);
            const size_t ro = (size_t)(m0 + r) * D; const int k0 = 16 * C.lane;
            const u32x4 xa = NTLOAD((const u32x4*)(X1 + ro + k0)), xb = NTLOAD((const u32x4*)(X1 + ro + k0 + 8)); const unsigned xw[8] = {xa.x, xa.y, xa.z, xa.w, xb.x, xb.y, xb.z, xb.w};
#pragma unroll
            for (int e4 = 0; e4 < 4; ++e4) { const f32x4 w = *(const f32x4*)(a.ffn_post + k0 + 4 * e4), g = *(const f32x4*)(gf + k0 + 4 * e4);
                f32x4 o; o[0] = bflo(xw[2 * e4]) + g[0] * (f[4 * e4] * rstd * w[0]); o[1] = bfhi(xw[2 * e4]) + g[1] * (f[4 * e4 + 1] * rstd * w[1]);
                o[2] = bflo(xw[2 * e4 + 1]) + g[2] * (f[4 * e4 + 2] * rstd * w[2]); o[3] = bfhi(xw[2 * e4 + 1]) + g[3] * (f[4 * e4 + 3] * rstd * w[3]);
                *(f32x4*)(a.out + ro + k0 + 4 * e4) = o; } }
    }
}

__global__ void __launch_bounds__(512, 2) mega_fwd(Args a) {
    extern __shared__ __attribute__((aligned(16))) unsigned char lds_raw[];
#define MKCTX(C) Ctx C; { int t_ = threadIdx.x; asm volatile("" : "+v"(t_)); C.lds = (LAS unsigned char*)lds_raw; C.tid = t_; C.lane = t_ & 63; C.wave = __builtin_amdgcn_readfirstlane(t_ >> 6); \
        C.G = gridDim.x; const int bx_ = blockIdx.x; C.vcu = (C.G % 8 == 0) ? (bx_ % 8) * (C.G / 8) + bx_ / 8 : bx_; C.gw = C.vcu * 8 + C.wave; C.NGW = C.G * 8; }
    MKCTX(C);
    volatile LAS unsigned* MISC = (volatile LAS unsigned*)(C.lds + MISC_OFF);
    for (int u = C.tid; u < (LDS_BYTES - LDSCTL_OFF) / 4; u += 512) ((LAS unsigned*)(C.lds + LDSCTL_OFF))[u] = 0u;
    __syncthreads();
    const int lo = a.ph_lo, hi = a.ph_hi;
    CArgs* const kargs = (CArgs*)__builtin_amdgcn_kernarg_segment_ptr();
#define KA() (*[&]() { CArgs* p_ = kargs; asm volatile("" : "+s"(p_)); return p_; }())
    XcdBarrier bar; bar.bar = (unsigned*)(a.ws + WS_CTL) + CW_BAR; bar.x = 0; bar.st = nullptr;
    if (hi - lo > 1) bar = xcd_barrier_post((unsigned*)(a.ws + WS_CTL) + CW_BAR, MISC + 8);
#define IN(k) (lo <= (k) && (k) < hi)
#define NEXTPH(k) ((k) == 4 ? 6 : ((k) == 9 ? 11 : (k) + 1))
#define SEAM(k) do { if (IN(k) && IN(NEXTPH(k))) xcd_barrier(bar); } while (0)
#define SEAM_WORK(k, ...) do { if (IN(k) && IN(NEXTPH(k))) xcd_barrier(bar, __VA_ARGS__); } while (0)
    if (IN(0)) { MKCTX(C); for (int rp = 0; rp < NREP(0); ++rp) phase0(KA(), C); SEAM(0); }
    if (IN(1)) { MKCTX(C); for (int rp = 0; rp < NREP(1); ++rp) phase1(KA(), C); SEAM_WORK(1, [&]() { phase2_fill(KA(), C, C.tid - 64, 448); }); }
    if (IN(2)) { MKCTX(C); for (int rp = 0; rp < NREP(2); ++rp) { phase2(KA(), C, IN(1) && rp == 0); __syncthreads(); } SEAM(2); }
    if (IN(3)) { MKCTX(C); pg8::Gemm g{(const bf16*)(KA().ws + WS_XN), (const bf16*)(KA().ws + WS_WINT), D}; pg8::StaticOrder S; S.init(MROWS, NU, C.G, (int)blockIdx.x);
        pg8::EpiBf16 E{(bf16*)(KA().ws + WS_U), NU, nullptr, 0, 1.0f};
        const bool odd = (C.vcu & 1) != 0;
        if (odd) { conv_w1_slice(KA(), C, 0, 1); __syncthreads(); }
        pg8::gemm_phase<false>(C.lds, g, S, E, pg8::DenseRows{}); __syncthreads();
        if (!odd) conv_w1_slice(KA(), C, 0, 1);
        SEAM(3); }
    if (IN(4)) { MKCTX(C); for (int rp = 0; rp < NREP(4); ++rp) phase4(KA(), C); SEAM(4); }

    if (IN(6)) { MKCTX(C); for (int rp = 0; rp < NREP(6); ++rp) phase6(KA(), C); SEAM(6); }
    if (IN(7)) { MKCTX(C); for (int rp = 0; rp < NREP(7); ++rp) phase7(KA(), C); SEAM(7); }
    if (IN(8)) { MKCTX(C); pg8::Gemm g{(const bf16*)(KA().ws + WS_Y), (const bf16*)(KA().ws + WS_WOUTT), D}; pg8::StaticOrder S; S.init(NLAT, D, C.G, (int)blockIdx.x);
        pg8::EpiBf16 E{(bf16*)(KA().ws + WS_MIX), D, nullptr, 0, 1.0f}; for (int rp = 0; rp < NREP(8); ++rp) pg8::gemm_phase<false>(C.lds, g, S, E, pg8::DenseRows{}); SEAM_WORK(8, [&]() { phase9_fill(KA(), C, C.tid - 64, 448); }); }
    if (IN(9)) { MKCTX(C); phase9(KA(), C, IN(8)); SEAM(9); }
    if (IN(11)) { MKCTX(C); moe_tables(KA(), C); pg8::Gemm g{(const bf16*)(KA().ws + WS_XN), (const bf16*)(KA().ws + WS_W1T), D / 2};   pg8::MoeOrder S; S.init((const LAS int*)(C.lds + TS_OFF), 8, 4, (int)blockIdx.x);
        pg8::EpiSwiglu E{KA().ws + WS_ACT, D, KA().b1, 2048}; LAS unsigned* ROWL = (LAS unsigned*)(C.lds + 131072 + 2048);
        { const int* rowtok = (const int*)(KA().ws + WS_ROWTOK); const LAS int* TSl = (const LAS int*)(C.lds + TS_OFF); const LAS int* CNl = TSl + 36;
          for (int idx = C.tid; idx < 9 * 256; idx += 512) { const int i = idx >> 8, r = idx & 255; pg8::Unit uu;
              if (S.next(i, uu)) { const int p = (uu.pm - TSl[uu.e]) * 256 + r; const int tok = p < CNl[uu.e] ? rowtok[uu.e * 16384 + p] : 0; ROWL[idx] = (unsigned)tok * 1024u; } }
          __syncthreads(); }
        pg8::GatherRows AM{ROWL};
        const bool odd = (C.vcu & 1) != 0;
#pragma unroll 1
        for (int part = 0; part < 2; ++part) {
            if ((odd && part == 0) || (!odd && part == 1)) { conv_w2_slice(KA(), C, 0, 1); __syncthreads(); }
            S.i0 = odd ? 0 : 4 * part; S.n = odd ? (part == 0 ? (1 << 30) : 0) : (part == 0 ? 4 : (1 << 30));
            pg8::gemm_phase<true>(C.lds, g, S, E, AM); __syncthreads(); }
        SEAM(11); }
    if (IN(12)) { MKCTX(C); moe_tables(KA(), C); pg8::Gemm g{(const bf16*)(KA().ws + WS_ACT), (const bf16*)(KA().ws + WS_W2T), D / 2}; pg8::MoeOrder S; S.init((const LAS int*)(C.lds + TS_OFF), 4, 8, (int)blockIdx.x);
        pg8::EpiFp8 E{KA().ws + WS_Y2, D, KA().b2, D, 1.0f / (W_SCALE * ACT_SCALE)}; for (int rp = 0; rp < NREP(12); ++rp) pg8::gemm_phase<true>(C.lds, g, S, E, pg8::DenseRows{}); SEAM(12); }
    if (IN(13)) { MKCTX(C); for (int rp = 0; rp < NREP(13); ++rp) phase13(KA(), C); }
#undef IN
#undef KA
#undef SEAM
}

extern "C" void kernel_launch(void* const* d_in, const int* in_sizes, int n_in, void* d_out, int out_size, void* d_ws, size_t ws_size, hipStream_t stream) {
    static int grid = 0;
    if (grid == 0) {
        if (n_in != 26 || in_sizes[0] != NLAT * D || out_size != NLAT * D || ws_size < WS_END) {
            fprintf(stderr, "kernel_launch: unexpected shapes: n_in %d in0 %d out %d ws %zu (need %zu); nothing launched\n", n_in, n_in > 0 ? in_sizes[0] : -1, out_size, ws_size, (size_t)WS_END); grid = -1; return; }
        int dev = 0, cus = 0, per_cu = 0;
        if (hipGetDevice(&dev) != hipSuccess || hipDeviceGetAttribute(&cus, hipDeviceAttributeMultiprocessorCount, dev) != hipSuccess) { fprintf(stderr, "kernel_launch: device query failed\n"); grid = -1; return; }
        if (hipFuncSetAttribute((const void*)mega_fwd, hipFuncAttributeMaxDynamicSharedMemorySize, LDS_BYTES) != hipSuccess) { fprintf(stderr, "kernel_launch: hipFuncSetAttribute failed\n"); grid = -1; return; }
        if (hipOccupancyMaxActiveBlocksPerMultiprocessor(&per_cu, (const void*)mega_fwd, 512, LDS_BYTES) != hipSuccess || per_cu < 1)
            fprintf(stderr, "kernel_launch: note: occupancy query reports %d workgroups per CU\n", per_cu);
        (void)hipGetLastError();
        grid = cus;
        if (grid != 256) { fprintf(stderr, "kernel_launch: this kernel needs a 256-CU device (got %d)\n", grid); grid = -1; return; }
    }
    if (grid < 0) return;
    (void)hipMemsetAsync((char*)d_ws + WS_CTL, 0, CTL_ZERO_BYTES, stream);
    Args a{};
    const float** ap = (const float**)&a;
    for (int i = 0; i < 26; ++i) ap[i] = (const float*)d_in[i];
    a.out = (float*)d_out; a.ws = (unsigned char*)d_ws;
#if MK_PER_PHASE
    for (int p = 0; p < NPHASE; ++p) { a.ph_lo = p; a.ph_hi = p + 1; hipLaunchKernelGGL(mega_fwd, dim3(grid), dim3(512), LDS_BYTES, stream, a); }
#else
    a.ph_lo = 0; a.ph_hi = NPHASE; hipLaunchKernelGGL(mega_fwd, dim3(grid), dim3(512), LDS_BYTES, stream, a);
#endif
}
```

```cpp
#include <hip/hip_runtime.h>
#include <cstdio>
#include <cstdint>

#ifndef MK_PER_PHASE
#define MK_PER_PHASE 0
#endif

#ifndef PROBE_REP_MASK
#define PROBE_REP_MASK 0u
#endif
#define NREP(k) ((((PROBE_REP_MASK) >> (k)) & 1u) ? 2 : 1)
#define LAS __attribute__((address_space(3)))
typedef unsigned short bf16;
typedef short bf16x8 __attribute__((ext_vector_type(8)));
typedef float f32x4 __attribute__((ext_vector_type(4)));
typedef float f32x2 __attribute__((ext_vector_type(2)));
typedef unsigned u32x4 __attribute__((ext_vector_type(4)));
typedef unsigned u32x2 __attribute__((ext_vector_type(2)));
typedef int i32x4 __attribute__((ext_vector_type(4)));
typedef int i32x8 __attribute__((ext_vector_type(8)));

constexpr int D = 1024, NB = 4, SEQ = 4096, CTXL = 256;
constexpr int NLAT = NB * SEQ, NCTX = NB * CTXL, MROWS = NLAT + NCTX;
constexpr int NU = 3840;
constexpr int W_IN_COLS = 3856;
constexpr int SP = CTXL + SEQ;
constexpr int NCH = SP / 64;
constexpr int NPR = NCH / 2;
constexpr int NE = 32;
constexpr float EPS = 1e-6f;
constexpr int NPHASE = 14;

constexpr size_t MiB = 1u << 20;
constexpr size_t WS_CTL = 0, CTL_ZERO_BYTES = 1 * MiB;
constexpr size_t WS_MODP = 1 * MiB, WS_MOD = 5 * MiB, WS_DTRAW = 6 * MiB, WS_WINT = 8 * MiB, WS_WOUTT = 16 * MiB;
constexpr size_t WS_W1T = 18 * MiB, WS_W2T = 146 * MiB, WS_XN = 210 * MiB, WS_U = 244 * MiB;
constexpr size_t WS_BC = 372 * MiB, WS_XST = 381 * MiB, WS_XSW = 398 * MiB, WS_BT = 432 * MiB, WS_GA = 437 * MiB, WS_DTA = 439 * MiB, WS_GEND = 441 * MiB;
constexpr size_t WS_QS = 442 * MiB, WS_KS = 476 * MiB, WS_KHT = 510 * MiB, WS_VT = 544 * MiB, WS_EG = 561 * MiB;
constexpr size_t WS_DSP = WS_KHT, WS_EGP = WS_EG + 1179648;
constexpr size_t WS_DSS = 563 * MiB, WS_DSH = 631 * MiB, WS_SPS = 767 * MiB, WS_SPH = 801 * MiB, WS_Y = 869 * MiB, WS_MIX = 901 * MiB, WS_ROUTE = 965 * MiB;
constexpr size_t WS_XS = 372 * MiB, WS_ACT = 516 * MiB, WS_Y2 = 660 * MiB;
constexpr size_t WS_ROWTOK = 966 * MiB;
constexpr size_t WS_END = 968 * MiB;
constexpr int CW_BAR = 4096, CW_CNT = 16384;

constexpr int LDS_BYTES = 147456;
constexpr int LDSCTL_OFF = 144896;
constexpr int MISC_OFF = LDSCTL_OFF;
constexpr int TS_OFF = LDSCTL_OFF + 128;
constexpr int LCNT_OFF = LDSCTL_OFF + 2048;

typedef __bf16 bf16x2_t __attribute__((ext_vector_type(2)));
__device__ __forceinline__ unsigned cvt_pk_bf16(float lo, float hi) { const f32x2 v = {lo, hi}; const bf16x2_t b = __builtin_convertvector(v, bf16x2_t); return __builtin_bit_cast(unsigned, b); }
__device__ __forceinline__ unsigned pk4_fp8(float a, float b, float c, float d) { int w = __builtin_amdgcn_cvt_pk_fp8_f32(a, b, 0, false); w = __builtin_amdgcn_cvt_pk_fp8_f32(c, d, w, true); return (unsigned)w; }
constexpr float W_SCALE = 64.0f, ACT_SCALE = 4.0f, Y_SCALE = 16.0f;
__device__ __forceinline__ float bf2f(unsigned short b) { return __uint_as_float(((unsigned)b) << 16); }
__device__ __forceinline__ float bflo(unsigned w) { return __uint_as_float(w << 16); }
__device__ __forceinline__ float bfhi(unsigned w) { return __uint_as_float(w & 0xffff0000u); }
__device__ __forceinline__ float siluf(float x) { return x * __builtin_amdgcn_rcpf(1.0f + __expf(-x)); }
__device__ __forceinline__ float wave_sum(float v) {
#pragma unroll
    for (int o = 1; o < 64; o <<= 1) v += __shfl_xor(v, o);
    return v;
}
#define LDS_WAIT() asm volatile("s_waitcnt lgkmcnt(0)" ::: "memory")
#define VM_WAIT() asm volatile("s_waitcnt vmcnt(0)" ::: "memory")
#define LDS_BARRIER() do { asm volatile("s_waitcnt lgkmcnt(0)" ::: "memory"); __builtin_amdgcn_s_barrier(); asm volatile("" ::: "memory"); } while (0)
#define RLX_AGENT __ATOMIC_RELAXED, __HIP_MEMORY_SCOPE_AGENT
#define NTLOAD(p) __builtin_nontemporal_load(p)
#define MFMA16(a, b, c) __builtin_amdgcn_mfma_f32_16x16x32_bf16((a), (b), (c), 0, 0, 0)

namespace pg8 {
constexpr int BM = 256, BK = 64, HALF = 128, HTB = HALF * BK * 2, STAGE_BYTES = 8 * HTB, NXCD = 8, WGM = 8;
__host__ __device__ __forceinline__ int lds_byte(int r, int c) { const int st = (r >> 4) * 2 + (c >> 5), rr = r & 15, cc = c & 31, ob = rr * 64 + cc * 2; return st * 1024 + (ob ^ (((ob >> 9) & 1) << 5)); }
__host__ __device__ __forceinline__ void stage_rc(int b, int& R, int& C) { const int st = b / 1024, sb = b % 1024, swz = sb ^ (((sb >> 9) & 1) << 5); R = (st >> 1) * 16 + swz / 64; C = (st & 1) * 32 + (swz % 64) / 2; }
__host__ __device__ __forceinline__ int perm32(int rho) { const int n = rho >> 4, i = rho & 15; return 8 * (i >> 2) + 4 * n + (i & 3); }

struct Unit { int pm, pn, pb, e, ord; };
struct Gemm { const bf16* A; const bf16* Bt; int K; };
struct DenseRows {
    __device__ __forceinline__ size_t ubase(const Unit& u, int h, int K) const { return (size_t)(u.pm * BM + h * HALF) * K * 2; }
    __device__ __forceinline__ unsigned lane_off(const Unit&, int, int R, int K) const { return (unsigned)(R * K) * 2u; } };
struct GatherRows { const LAS unsigned* rowl;
    __device__ __forceinline__ size_t ubase(const Unit&, int, int) const { return 0; }
    __device__ __forceinline__ unsigned lane_off(const Unit& u, int h, int R, int) const { return rowl[u.ord * BM + h * HALF + R]; } };

struct StaticOrder {
    int nM, nN, nwg, G, c, i0, n;
    __device__ __forceinline__ void init(int M, int N, int G_, int c_) { nM = M / BM; nN = N / BM; nwg = nM * nN; G = G_; c = c_; i0 = 0; n = 1 << 30; }
    __device__ __forceinline__ bool next(int i_, Unit& u) const {
        if (i_ >= n) return false; const int i = i_ + i0;
        const long L = (long)i * G + c; if (L >= nwg) return false;
        int wgid = (int)L; { const int q = nwg / NXCD, r = nwg % NXCD, xcd = wgid % NXCD, off = wgid / NXCD; wgid = (xcd < r ? xcd * (q + 1) : r * (q + 1) + (xcd - r) * q) + off; }
        const int nig = WGM * nN, gid = wgid / nig, fm = gid * WGM, gsz = (nM - fm) < WGM ? (nM - fm) : WGM;
        u.pm = fm + ((wgid % nig) % gsz); u.pn = (wgid % nig) / gsz; u.pb = u.pn; u.e = 0; u.ord = i; return true;
    }
};
struct MoeOrder {
    const LAS int* ts; int ntn, mg, x, j, i0, n;
    __device__ __forceinline__ void init(const LAS int* ts_, int ntn_, int mg_, int c) { ts = ts_; ntn = ntn_; mg = mg_; x = c & 7; j = c >> 3; i0 = 0; n = 1 << 30; }
    __device__ __forceinline__ bool next(int i_, Unit& u) const {
        if (i_ >= n) return false; const int i = i_ + i0;
        const int st = i * 8 + x, mt = mg * st + (j % mg), nt = j / mg;
        if (mt >= ts[NE]) return false;
        const int e = ts[80 + mt];
        u.pm = mt; u.pn = nt; u.e = e; u.pb = e * ntn + nt; u.ord = i; return true;
    }
};

struct EpiF32 {
    static constexpr bool PERM = false;
    float* C; int ldc;
    __device__ __forceinline__ const float* bias_src(const Unit&) const { return nullptr; }
    __device__ __forceinline__ void operator()(const f32x4 (&acc)[2][2][4][2], const Unit& u, int wr, int wc, int fr, int fq, const LAS float*) const {
        const int row0 = u.pm * BM + wr * 64 + fr, col0 = u.pn * BM + wc * 32 + 4 * fq;
#pragma unroll
        for (int ai = 0; ai < 2; ++ai)
#pragma unroll
            for (int m = 0; m < 4; ++m) { float* rowp = C + (size_t)(row0 + ai * HALF + m * 16) * ldc + col0;
#pragma unroll
                for (int bj = 0; bj < 2; ++bj)
#pragma unroll
                    for (int n = 0; n < 2; ++n) *(f32x4*)(rowp + bj * HALF + n * 16) = acc[ai][bj][m][n]; }
    }
};
struct EpiBf16 {
    static constexpr bool PERM = true;
    bf16* O; int ldc; const float* bias; int bias_stride; float scale;
    __device__ __forceinline__ const float* bias_src(const Unit& u) const { return bias ? bias + (size_t)u.e * bias_stride + u.pn * BM : nullptr; }
    __device__ __forceinline__ void operator()(const f32x4 (&acc)[2][2][4][2], const Unit& u, int wr, int wc, int fr, int fq, const LAS float* bl) const {
        const int row0 = u.pm * BM + wr * 64 + fr, col0 = u.pn * BM + wc * 32 + 8 * fq;
        f32x4 bv[2][2];
#pragma unroll
        for (int bj = 0; bj < 2; ++bj)
#pragma unroll
            for (int n = 0; n < 2; ++n) bv[bj][n] = bias ? *(const LAS f32x4*)(bl + wc * 32 + 8 * fq + bj * HALF + 4 * n) : (f32x4){0.f, 0.f, 0.f, 0.f};
#pragma unroll
        for (int ai = 0; ai < 2; ++ai)
#pragma unroll
            for (int m = 0; m < 4; ++m) { bf16* rowp = O + (size_t)(row0 + ai * HALF + m * 16) * ldc + col0;
#pragma unroll
                for (int bj = 0; bj < 2; ++bj) { const f32x4 v0 = acc[ai][bj][m][0] * scale + bv[bj][0], v1 = acc[ai][bj][m][1] * scale + bv[bj][1];
                    u32x4 w; w.x = cvt_pk_bf16(v0[0], v0[1]); w.y = cvt_pk_bf16(v0[2], v0[3]); w.z = cvt_pk_bf16(v1[0], v1[1]); w.w = cvt_pk_bf16(v1[2], v1[3]);
                    *(u32x4*)(rowp + bj * HALF) = w; } }
    }
};
struct EpiFp8 {
    static constexpr bool PERM = true;
    unsigned char* O; int ldc; const float* bias; int bias_stride; float scale;
    __device__ __forceinline__ const float* bias_src(const Unit& u) const { return bias + (size_t)u.e * bias_stride + u.pn * BM; }
    __device__ __forceinline__ void operator()(const f32x4 (&acc)[2][2][4][2], const Unit& u, int wr, int wc, int fr, int fq, const LAS float* bl) const {
        const int row0 = u.pm * BM + wr * 64 + fr, col0 = u.pn * BM + wc * 32 + 8 * fq;
        f32x4 bv[2][2];
#pragma unroll
        for (int bj = 0; bj < 2; ++bj)
#pragma unroll
            for (int n = 0; n < 2; ++n) bv[bj][n] = *(const LAS f32x4*)(bl + wc * 32 + 8 * fq + bj * HALF + 4 * n) * Y_SCALE;
        const float sc = scale * Y_SCALE;
#pragma unroll
        for (int ai = 0; ai < 2; ++ai)
#pragma unroll
            for (int m = 0; m < 4; ++m) { unsigned char* rowp = O + (size_t)(row0 + ai * HALF + m * 16) * ldc + col0;
#pragma unroll
                for (int bj = 0; bj < 2; ++bj) { const f32x4 v0 = acc[ai][bj][m][0] * sc + bv[bj][0], v1 = acc[ai][bj][m][1] * sc + bv[bj][1];
                    *(u32x2*)(rowp + bj * HALF) = (u32x2){pk4_fp8(v0[0], v0[1], v0[2], v0[3]), pk4_fp8(v1[0], v1[1], v1[2], v1[3])}; } }
    }
};
__device__ __forceinline__ float swiglu1(float glu, float lin) {
    const float g = fminf(glu, 7.0f), l = fminf(fmaxf(lin, -7.0f), 7.0f);
    return g * __builtin_amdgcn_rcpf(1.0f + __expf(-1.702f * g)) * (l + 1.0f);
}
struct EpiSwiglu {
    static constexpr bool PERM = true;
    unsigned char* O; int ldc; const float* bias; int bias_stride;
    __device__ __forceinline__ const float* bias_src(const Unit& u) const { return bias + (size_t)u.e * bias_stride + u.pn * BM; }
    __device__ __forceinline__ void operator()(const f32x4 (&acc)[2][2][4][2], const Unit& u, int wr, int wc, int fr, int fq, const LAS float* bl) const {
        const int row0 = u.pm * BM + wr * 64 + fr, col0 = u.pn * BM + wc * 32 + 8 * fq, ocol0 = col0 >> 1;
        f32x4 bv[2][2];
#pragma unroll
        for (int bj = 0; bj < 2; ++bj)
#pragma unroll
            for (int n = 0; n < 2; ++n) bv[bj][n] = *(const LAS f32x4*)(bl + wc * 32 + 8 * fq + bj * HALF + 4 * n);
#pragma unroll
        for (int ai = 0; ai < 2; ++ai)
#pragma unroll
            for (int m = 0; m < 4; ++m) { unsigned char* rowp = O + (size_t)(row0 + ai * HALF + m * 16) * ldc + ocol0;
#pragma unroll
                for (int bj = 0; bj < 2; ++bj) { const f32x4 v0 = acc[ai][bj][m][0] * (1.0f / W_SCALE) + bv[bj][0], v1 = acc[ai][bj][m][1] * (1.0f / W_SCALE) + bv[bj][1];
                    *(unsigned*)(rowp + bj * (HALF / 2)) = pk4_fp8(ACT_SCALE * swiglu1(v0[0], v0[1]), ACT_SCALE * swiglu1(v0[2], v0[3]), ACT_SCALE * swiglu1(v1[0], v1[1]), ACT_SCALE * swiglu1(v1[2], v1[3])); } }
    }
};

template <bool F8, class Epi, class Sched, class AMap>
__device__ __forceinline__ void gemm_phase(LAS unsigned char* lds, const Gemm g, const Sched& S, const Epi& E, const AMap& AM) {
    const int tid = threadIdx.x, wid = __builtin_amdgcn_readfirstlane(tid >> 6), lane = tid & 63, wr = wid >> 2, wc = wid & 3, fr = lane & 15, fq = lane >> 4;
    const int K = g.K, nt = K / BK;
    unsigned voffB[2];
#pragma unroll
    for (int i = 0; i < 2; ++i) { int R, C; stage_rc(tid * 16 + i * 8192, R, C); const int Rb = Epi::PERM ? ((R & ~31) + perm32(R & 31)) : R;
        voffB[i] = (unsigned)(Rb * K + C) * 2u; }
    unsigned vA0[2], vA1[2], nA0[2], nA1[2];
#define PG8_AOFF(u, o0, o1) do { int _t = tid; asm volatile("" : "+v"(_t));   _Pragma("unroll") for (int _i = 0; _i < 2; ++_i) { int _R, _C; stage_rc(_t * 16 + _i * 8192, _R, _C); \
        o0[_i] = AM.lane_off(u, 0, _R, K) + (unsigned)_C * 2u; o1[_i] = AM.lane_off(u, 1, _R, K) + (unsigned)_C * 2u; } } while (0)
    const size_t kstep = (size_t)(BK * 2);
    const size_t hstep = (size_t)HALF * K * 2;
    const size_t tstep = 2 * hstep;
    const unsigned ldsw = (unsigned)wid * 1024u;
    const int aoff = lds_byte(wr * 64 + fr, fq * 8), boff = lds_byte(wc * 32 + fr, fq * 8);
#define PG8_SA(b, h) (((b) * 2 + (h)) * HTB)
#define PG8_SB(b, h) ((4 + (b) * 2 + (h)) * HTB)
#define PG8_STAGE(bufoff, gbase, voff) do { _Pragma("unroll") for (int _i = 0; _i < 2; ++_i) \
        __builtin_amdgcn_global_load_lds((const unsigned*)((const char*)(gbase) + (voff)[_i]), (LAS unsigned*)(lds + (bufoff) + ldsw + _i * 8192), 16, 0, 0); } while (0)
#define PG8_LDA(dst, b, h) do { _Pragma("unroll") for (int m = 0; m < 4; ++m) { const i32x4 _lo = *(const LAS i32x4*)(lds + PG8_SA(b, h) + aoff + m * 2048), _hi = *(const LAS i32x4*)(lds + PG8_SA(b, h) + aoff + m * 2048 + 1024); \
        dst[m] = __builtin_shufflevector(_lo, _hi, 0, 1, 2, 3, 4, 5, 6, 7); } } while (0)
#define PG8_LDB(dst, b, h) do { _Pragma("unroll") for (int n = 0; n < 2; ++n) { const i32x4 _lo = *(const LAS i32x4*)(lds + PG8_SB(b, h) + boff + n * 2048), _hi = *(const LAS i32x4*)(lds + PG8_SB(b, h) + boff + n * 2048 + 1024); \
        dst[n] = __builtin_shufflevector(_lo, _hi, 0, 1, 2, 3, 4, 5, 6, 7); } } while (0)
#define PG8_LO(x) __builtin_bit_cast(bf16x8, __builtin_shufflevector(x, x, 0, 1, 2, 3))
#define PG8_HI(x) __builtin_bit_cast(bf16x8, __builtin_shufflevector(x, x, 4, 5, 6, 7))
#define PG8_MMA(ai, bj, At, Bt) do { __builtin_amdgcn_s_setprio(1); _Pragma("unroll") for (int m = 0; m < 4; ++m) _Pragma("unroll") for (int n = 0; n < 2; ++n) { \
        if constexpr (F8) asm volatile("v_mfma_scale_f32_16x16x128_f8f6f4 %0, %1, %2, %0, %3, %3 op_sel_hi:[0,0,0]" : "+v"(acc[ai][bj][m][n]) : "v"(Bt[n]), "v"(At[m]), "v"(f8scale)); \
        else { acc[ai][bj][m][n] = __builtin_amdgcn_mfma_f32_16x16x32_bf16(PG8_LO(Bt[n]), PG8_LO(At[m]), acc[ai][bj][m][n], 0, 0, 0); \
               acc[ai][bj][m][n] = __builtin_amdgcn_mfma_f32_16x16x32_bf16(PG8_HI(Bt[n]), PG8_HI(At[m]), acc[ai][bj][m][n], 0, 0, 0); } } \
        __builtin_amdgcn_s_setprio(0); } while (0)
#define PG8_WAIT_V(n) asm volatile("s_waitcnt vmcnt(" #n ")" ::: "memory")
#define PG8_WAIT_L(n) asm volatile("s_waitcnt lgkmcnt(" #n ")" ::: "memory")
#define PG8_BAR __builtin_amdgcn_s_barrier()
#define PG8_SCHED __builtin_amdgcn_sched_barrier(0)
    Unit cur, nxt; int ui = 0;
    if (!S.next(0, cur)) return;
    f32x4 acc[2][2][4][2];
#pragma unroll
    for (int a = 0; a < 2; ++a)
#pragma unroll
        for (int b = 0; b < 2; ++b)
#pragma unroll
            for (int m = 0; m < 4; ++m)
#pragma unroll
                for (int n = 0; n < 2; ++n) acc[a][b][m][n] = (f32x4){0.f, 0.f, 0.f, 0.f};
    i32x8 At[4], B0[2], B1[2];
    int f8scale = 0x7F7F7F7F; asm volatile("" : "+v"(f8scale));
    LAS float* const biasl = (LAS float*)(lds + STAGE_BYTES);
#define PG8_BIAS(u, slot) do { const float* _bs = E.bias_src(u); if (_bs != nullptr && wid == 0) { int _ln = lane; asm volatile("" : "+v"(_ln));     \
        __builtin_amdgcn_global_load_lds((const unsigned*)(_bs + _ln * 4), (LAS unsigned*)(biasl + (slot) * 256), 16, 0, 0); } } while (0)
    PG8_BIAS(cur, 0);
    const char* cA0 = (const char*)g.A + AM.ubase(cur, 0, K); const char* cA1 = (const char*)g.A + AM.ubase(cur, 1, K); const char* cB = (const char*)g.Bt + (size_t)cur.pb * tstep;
    PG8_AOFF(cur, vA0, vA1);
    PG8_STAGE(PG8_SB(0, 0), cB, voffB); PG8_STAGE(PG8_SB(0, 1), cB + hstep, voffB); PG8_STAGE(PG8_SA(0, 0), cA0, vA0); PG8_STAGE(PG8_SA(0, 1), cA1, vA1);
    if (wr == 1) PG8_BAR;
    PG8_WAIT_V(2); PG8_BAR;
    PG8_STAGE(PG8_SB(1, 0), cB + kstep, voffB); PG8_STAGE(PG8_SA(1, 0), cA0 + kstep, vA0); PG8_STAGE(PG8_SB(1, 1), cB + hstep + kstep, voffB);
    PG8_WAIT_V(6); PG8_BAR;
    for (;;) {
        const bool has_next = S.next(ui + 1, nxt);
        const char* nB = has_next ? (const char*)g.Bt + (size_t)nxt.pb * tstep : cB;
        const char* nxA0 = has_next ? (const char*)g.A + AM.ubase(nxt, 0, K) : cA0; const char* nxA1 = has_next ? (const char*)g.A + AM.ubase(nxt, 1, K) : cA1;
        if (has_next) { PG8_AOFF(nxt, nA0, nA1); PG8_BIAS(nxt, (ui + 1) & 1); } else { nA0[0] = vA0[0]; nA0[1] = vA0[1]; nA1[0] = vA1[0]; nA1[1] = vA1[1]; }
#pragma unroll 1
        for (int t = 0; t < nt; t += 2) {
            const bool last = (t == nt - 2);
            const char* a1 = cA1 + (size_t)(t + 1) * kstep;
            const char* a2 = last ? nxA0 : cA0 + (size_t)(t + 2) * kstep; const char* a2h = last ? nxA1 : cA1 + (size_t)(t + 2) * kstep; const char* b2 = last ? nB : cB + (size_t)(t + 2) * kstep;
            const char* a3 = a2 + kstep; const char* b3 = b2 + kstep;
            unsigned w0[2], w1[2];
            w0[0] = last ? nA0[0] : vA0[0]; w0[1] = last ? nA0[1] : vA0[1]; w1[0] = last ? nA1[0] : vA1[0]; w1[1] = last ? nA1[1] : vA1[1];
            PG8_LDB(B0, 0, 0); PG8_LDB(B1, 0, 1); PG8_SCHED; PG8_LDA(At, 0, 0); PG8_STAGE(PG8_SA(1, 1), a1, vA1);
            PG8_WAIT_V(8); PG8_WAIT_L(0); PG8_BAR; PG8_MMA(0, 0, At, B0); PG8_MMA(0, 1, At, B1); PG8_BAR; PG8_SCHED;
            PG8_LDA(At, 0, 1); PG8_STAGE(PG8_SB(0, 0), b2, voffB); PG8_STAGE(PG8_SB(0, 1), b2 + hstep, voffB); PG8_STAGE(PG8_SA(0, 0), a2, w0);
            PG8_WAIT_V(8); PG8_WAIT_L(0); PG8_BAR; PG8_MMA(1, 0, At, B0); PG8_MMA(1, 1, At, B1); PG8_BAR; PG8_SCHED;
            PG8_LDB(B0, 1, 0); PG8_LDB(B1, 1, 1); PG8_SCHED; PG8_LDA(At, 1, 0); PG8_STAGE(PG8_SA(0, 1), a2h, w1);
            PG8_WAIT_V(8); PG8_WAIT_L(0); PG8_BAR; PG8_MMA(0, 0, At, B0); PG8_MMA(0, 1, At, B1); PG8_BAR; PG8_SCHED;
            PG8_LDA(At, 1, 1); PG8_STAGE(PG8_SB(1, 0), b3, voffB); PG8_STAGE(PG8_SB(1, 1), b3 + hstep, voffB); PG8_STAGE(PG8_SA(1, 0), a3, w0);
            PG8_WAIT_V(8); PG8_WAIT_L(0); PG8_BAR; PG8_MMA(1, 0, At, B0); PG8_MMA(1, 1, At, B1); PG8_BAR; PG8_SCHED;
        }
        if (wr == 0) PG8_BAR;
        if constexpr (F8) asm volatile("s_nop 15\n\ts_nop 15" ::: "memory");
        { int ln_e = lane; asm volatile("" : "+v"(ln_e));
          E(acc, cur, wr, wc, ln_e & 15, ln_e >> 4, biasl + (ui & 1) * 256); }
        if (!has_next) break;
#pragma unroll
        for (int a = 0; a < 2; ++a)
#pragma unroll
            for (int b = 0; b < 2; ++b)
#pragma unroll
                for (int m = 0; m < 4; ++m)
#pragma unroll
                    for (int n = 0; n < 2; ++n) acc[a][b][m][n] = (f32x4){0.f, 0.f, 0.f, 0.f};
        cur = nxt; cB = nB; cA0 = nxA0; cA1 = nxA1; ++ui; vA0[0] = nA0[0]; vA0[1] = nA0[1]; vA1[0] = nA1[0]; vA1[1] = nA1[1];
        if (wr == 1) PG8_BAR;
    }
    PG8_WAIT_V(0);
    PG8_BAR;
#undef PG8_AOFF
#undef PG8_BIAS
#undef PG8_SA
#undef PG8_SB
#undef PG8_STAGE
#undef PG8_LDA
#undef PG8_LDB
#undef PG8_MMA
#undef PG8_LO
#undef PG8_HI
#undef PG8_WAIT_V
#undef PG8_WAIT_L
#undef PG8_BAR
#undef PG8_SCHED
}
}

#define XB_TMO      128
#define XB_XCNT(j)  (256  + 64 * (j))
#define XB_XSUB(j)  (1280 + 64 * (j))
#define XB_XGEN(j)  (2304 + 64 * (j))
#define XB_TOP      3328
#define XB_TOPGEN   3392
#define XCD_BAR_WORDS 3456
#define XB_SPIN_CAP (1u << 22)
__device__ __forceinline__ unsigned xb_ld(unsigned* p)              { return __hip_atomic_load(p, __ATOMIC_RELAXED, __HIP_MEMORY_SCOPE_AGENT); }
__device__ __forceinline__ unsigned xb_add(unsigned* p, unsigned v) { return __hip_atomic_fetch_add(p, v, __ATOMIC_RELAXED, __HIP_MEMORY_SCOPE_AGENT); }
__device__ __forceinline__ unsigned xb_xcc_id() { return (unsigned)__builtin_amdgcn_s_getreg((3 << 11) | 20) & 0xFu; }
#define XB_SPIN(cond, bar) do { unsigned _sp = 0; while (cond) { __builtin_amdgcn_s_sleep(1); \
    if ((++_sp & 255u) == 0u) { if (xb_ld(&(bar)[XB_TMO])) break; if (_sp > XB_SPIN_CAP) { atomicAdd(&(bar)[XB_TMO], 1u); break; } } } } while (0)
struct XcdBarrier { unsigned* bar; unsigned x; volatile LAS unsigned* st; };
__device__ __forceinline__ XcdBarrier xcd_barrier_post(unsigned* bar, volatile LAS unsigned* st) {
    XcdBarrier b; b.bar = bar; b.x = xb_xcc_id(); b.st = st;
    if (threadIdx.x == 0) (void)xb_add(&bar[XB_XCNT(b.x)], 1u);
    return b;
}
__device__ __forceinline__ void xcd_barrier_complete(unsigned* bar, unsigned x, unsigned& nloc, unsigned& nx) {
    const unsigned G = gridDim.x * gridDim.y * gridDim.z;
    unsigned sum, cnt, mine, sp = 0u;
    for (;;) {
        sum = 0u; cnt = 0u; mine = 0u;
#pragma unroll
        for (unsigned j = 0; j < 16; ++j) { const unsigned c = xb_ld(&bar[XB_XCNT(j)]); sum += c; cnt += (c > 0u) ? 1u : 0u; mine = (j == x) ? c : mine; }
        if (sum == G) break;
        __builtin_amdgcn_s_sleep(1);
        if ((++sp & 255u) == 0u) { if (xb_ld(&bar[XB_TMO])) break; if (sp > XB_SPIN_CAP) { atomicAdd(&bar[XB_TMO], 1u); break; } }
    }
    nloc = mine > 0u ? mine : 1u; nx = cnt > 0u ? cnt : 1u;
}
struct NoWork { __device__ __forceinline__ void operator()() const {} };
template <class F = NoWork> __device__ __forceinline__ void xcd_barrier(const XcdBarrier& b, F work = F{}) {
    asm volatile("s_waitcnt vmcnt(0)" ::: "memory");
    __syncthreads();
    if (threadIdx.x >= 64) work();
    if (threadIdx.x == 0) {
        unsigned* bar = b.bar;
        __builtin_amdgcn_s_waitcnt(0);
        unsigned nloc = b.st[0], nx = b.st[1];
        if (nloc == 0u) { xcd_barrier_complete(bar, b.x, nloc, nx); b.st[0] = nloc; b.st[1] = nx; }
        const unsigned old = xb_add(&bar[XB_XSUB(b.x)], 1u);
        const unsigned gen = old / nloc;
        if (old + 1u == (gen + 1u) * nloc) {
            __builtin_amdgcn_fence(__ATOMIC_RELEASE, "agent");
            asm volatile("s_waitcnt vmcnt(0)" ::: "memory");
            const unsigned og = xb_add(&bar[XB_TOP], 1u);
            const unsigned tg = og / nx;
            if (og + 1u == (tg + 1u) * nx) xb_add(&bar[XB_TOPGEN], 1u);
            else XB_SPIN(xb_ld(&bar[XB_TOPGEN]) == tg, bar);
            __builtin_amdgcn_fence(__ATOMIC_ACQUIRE, "agent");
            xb_add(&bar[XB_XGEN(b.x)], 1u);
            asm volatile("s_waitcnt vmcnt(0)" ::: "memory");
        } else {
            XB_SPIN(xb_ld(&bar[XB_XGEN(b.x)]) == gen, bar);
            __builtin_amdgcn_fence(__ATOMIC_ACQUIRE, "agent");
            asm volatile("s_waitcnt vmcnt(0)" ::: "memory");
        }
    }
    __syncthreads();
}

struct Args {
    const float *x, *c, *ctx, *c_ctx, *ada_w, *ada_b, *mix_pre, *mix_post, *w_in, *w_out, *conv_w, *conv_b, *dt_bias, *a_log, *ssd_d, *ssd_norm,
                *hg_lb, *hg_norm, *ffn_pre, *ffn_post, *router_w, *router_b, *w1, *b1, *w2, *b2;
    float* out; unsigned char* ws; int ph_lo, ph_hi;
};

typedef const Args __attribute__((address_space(4))) CArgs;
struct Ctx { LAS unsigned char* lds; int tid, lane, wave, vcu, G, gw, NGW; };

__device__ __forceinline__ void transpose_item(const float* W, int ldw, int K, bf16* WT, int dst_row0, int nblk, LAS float* scr, int item, int lane) {
    const int kb = item / nblk, nb = item % nblk, k0 = 64 * kb, n0 = 32 * nb;
    float ld[32];
#pragma unroll
    for (int i = 0; i < 32; ++i) ld[i] = W[(size_t)(k0 + 2 * i + (lane >> 5)) * ldw + n0 + (lane & 31)];
#pragma unroll
    for (int i = 0; i < 32; ++i) scr[(2 * i + (lane >> 5)) * 33 + (lane & 31)] = ld[i];
    LDS_WAIT(); asm volatile("" ::: "memory");
    const int c = lane & 7;
#pragma unroll
    for (int j = 0; j < 4; ++j) { const int n = (lane >> 3) + 8 * j; const LAS float* s = scr + (8 * c) * 33 + n;
        u32x4 o; o.x = cvt_pk_bf16(s[0 * 33], s[1 * 33]); o.y = cvt_pk_bf16(s[2 * 33], s[3 * 33]); o.z = cvt_pk_bf16(s[4 * 33], s[5 * 33]); o.w = cvt_pk_bf16(s[6 * 33], s[7 * 33]);
        *(u32x4*)(WT + (size_t)(dst_row0 + n0 + n) * K + k0 + 8 * c) = o; }
    LDS_WAIT(); asm volatile("" ::: "memory");
}
__device__ __forceinline__ void transpose_item_f8(const float* W, int ldw, int K, unsigned char* WT, int nblk, LAS float* scr, int item, int lane, float scale) {
    const int kb = item / nblk, nb = item % nblk, k0 = 64 * kb, n0 = 32 * nb;
    float ld[32];
#pragma unroll
    for (int i = 0; i < 32; ++i) ld[i] = __builtin_nontemporal_load(&W[(size_t)(k0 + 2 * i + (lane >> 5)) * ldw + n0 + (lane & 31)]);
#pragma unroll
    for (int i = 0; i < 32; ++i) scr[(2 * i + (lane >> 5)) * 33 + (lane & 31)] = ld[i] * scale;
    LDS_WAIT(); asm volatile("" ::: "memory");
    const int c = lane & 7;
#pragma unroll
    for (int j = 0; j < 4; ++j) { const int n = (lane >> 3) + 8 * j; const LAS float* sp = scr + (8 * c) * 33 + n;
        u32x2 o; o.x = pk4_fp8(sp[0 * 33], sp[1 * 33], sp[2 * 33], sp[3 * 33]); o.y = pk4_fp8(sp[4 * 33], sp[5 * 33], sp[6 * 33], sp[7 * 33]);
        *(u32x2*)(WT + (size_t)(n0 + n) * K + k0 + 8 * c) = o; }
    LDS_WAIT(); asm volatile("" ::: "memory");
}
__device__ __forceinline__ void phase0(CArgs& a, const Ctx& C) {
    LAS float* scr = (LAS float*)(C.lds + C.wave * 16384);
    bf16* WINT = (bf16*)(a.ws + WS_WINT); bf16* WOUTT = (bf16*)(a.ws + WS_WOUTT);
    float* MODP = (float*)(a.ws + WS_MODP);
    constexpr int I_GEMV = 96 * 32, I_INA = 16 * 40, I_INB = 16 * 80, I_OUT = 16 * 32;
    constexpr int NITEMS = I_GEMV + I_INA + I_INB + I_OUT;
    for (int it = C.gw; it < NITEMS; it += C.NGW) {
        int r = it;
        if (r < I_GEMV) {
            const int cg = r % 96, ks = r / 96, col = 64 * cg + C.lane, k0 = 32 * ks;
            float sv[5];
            { const int kk = C.lane & 31;
#pragma unroll
              for (int b = 0; b < 4; ++b) sv[b] = siluf(a.c[b * D + k0 + kk]);
              sv[4] = siluf(a.c_ctx[k0 + kk]); }
            float acc[5] = {0.f, 0.f, 0.f, 0.f, 0.f};
#pragma unroll 8
            for (int kk = 0; kk < 32; ++kk) { const float w = a.ada_w[(size_t)(k0 + kk) * 6144 + col];
#pragma unroll
                for (int b = 0; b < 5; ++b) acc[b] += __shfl(sv[b], kk) * w; }
#pragma unroll
            for (int b = 0; b < 5; ++b) MODP[(size_t)(ks * 5 + b) * 6144 + col] = acc[b];
            continue;
        }
        r -= I_GEMV;
        if (r < I_INA) { transpose_item(a.w_in, W_IN_COLS, D, WINT, 0, 40, scr, r, C.lane); continue; } r -= I_INA;
        if (r < I_INB) { transpose_item(a.w_in + 1296, W_IN_COLS, D, WINT, 1280, 80, scr, r, C.lane); continue; } r -= I_INB;
        transpose_item(a.w_out, D, D, WOUTT, 0, 32, scr, r, C.lane);
    }
}
#ifndef CONV_SH
#define CONV_SH 2
#endif
constexpr int NIT1 = 32 * 16 * 64, NIT2 = 32 * 16 * 32, CONV_B = 256 * 7 * CONV_SH;
constexpr int CONV_SH_END = 7 * CONV_B;
constexpr int CONV_W1_HOST = CONV_SH_END < NIT1 ? CONV_SH_END : NIT1;
constexpr int CONV_S9 = CONV_SH_END > NIT1 ? CONV_SH_END : NIT1;
__device__ __forceinline__ void conv_item(CArgs& a, LAS float* scr, int lane, int it) {
    const bool w1 = it < NIT1; const int r = w1 ? it : it - NIT1, per = w1 ? 16 * 64 : 16 * 32, e = r / per, ri = r % per;
    const float* W = w1 ? a.w1 + (size_t)e * D * 2048 : a.w2 + (size_t)e * D * D; unsigned char* WT = w1 ? a.ws + WS_W1T + (size_t)e * 2048 * D : a.ws + WS_W2T + (size_t)e * D * D;
    transpose_item_f8(W, w1 ? 2048 : D, D, WT, w1 ? 64 : 32, scr, ri, lane, W_SCALE);
}
__device__ __forceinline__ void conv_range(CArgs& a, const Ctx& C, int lo, int hi) {
    LAS float* scr = (LAS float*)(C.lds + C.wave * 16384);
#pragma unroll 1
    for (int it = lo + C.gw; it < hi; it += C.NGW) conv_item(a, scr, C.lane, it);
}
__device__ __forceinline__ void conv_shadow(CArgs& a, const Ctx& C, int first, LAS unsigned char* scr_base, int scr_stride) {
    LAS float* scr = (LAS float*)(scr_base + (C.wave - 1) * scr_stride);
    const int it0 = first + (C.vcu * 7 + (C.wave - 1)) * CONV_SH;
#pragma unroll 1
    for (int j = 0; j < CONV_SH; ++j) if (it0 + j < NIT1 + NIT2) conv_item(a, scr, C.lane, it0 + j);
}
__device__ __forceinline__ void phase1(CArgs& a, const Ctx& C) {
    const float* MODP = (const float*)(a.ws + WS_MODP); float* MOD = (float*)(a.ws + WS_MOD);
    for (int i = C.vcu * 512 + C.tid; i < 5 * 6144; i += C.G * 512) {
        const int col = i % 6144, b = i / 6144; float s = a.ada_b[col];
#pragma unroll 8
        for (int ks = 0; ks < 32; ++ks) s += MODP[(size_t)(ks * 5 + b) * 6144 + col];
        MOD[i] = s;
    }
}
template <int N, int O> struct RS { template <int M> static __device__ __forceinline__ void run(float (&v)[M], int lane) {
    const bool up = (lane & O) != 0;
#pragma unroll
    for (int i = 0; i < N / 2; ++i) { const float keep = up ? v[i + N / 2] : v[i], send = up ? v[i] : v[i + N / 2]; v[i] = keep + __shfl_xor(send, O); }
    RS<N / 2, O / 2>::run(v, lane); } };
template <int O> struct RS<1, O> { template <int M> static __device__ __forceinline__ void run(float (&v)[M], int) { v[0] += __shfl_xor(v[0], O); RS<1, O / 2>::run(v, 0); } };
template <> struct RS<1, 0> { template <int M> static __device__ __forceinline__ void run(float (&)[M], int) {} };
template <int N> __device__ __forceinline__ void reduce_scatter(float (&v)[N], int lane) { RS<N, 32>::run(v, lane); }
__device__ __forceinline__ void phase2_fill(CArgs& a, const Ctx& C, int t0, int nt) {
    LAS f32x4* WD = (LAS f32x4*)C.lds;
    for (int idx = t0; idx < 16 * 4 * 64; idx += nt) { const int ln = idx & 63, cg = (idx >> 6) & 3, je = idx >> 8, j = je >> 3, e = je & 7, k = 8 * ln + 512 * j + e;
        WD[idx] = *(const f32x4*)(a.w_in + (size_t)k * W_IN_COLS + 1280 + 4 * cg); }
}
__device__ __forceinline__ void phase2(CArgs& a, const Ctx& C, bool prefilled) {
    const float* MOD = (const float*)(a.ws + WS_MOD); bf16* XN = (bf16*)(a.ws + WS_XN); float* DTRAW = (float*)(a.ws + WS_DTRAW);
    LAS f32x4* WD = (LAS f32x4*)C.lds;
    const int rbase = (MROWS / 256) * C.vcu; constexpr int NPAIR = MROWS / 256 / 2;
    f32x4 nx[2][2][2];
    { const int m = rbase + 2 * C.wave;
#pragma unroll
      for (int r = 0; r < 2; ++r) { const int mr = m + r; const float* xrow = mr < NLAT ? a.x + (size_t)mr * D : a.ctx + (size_t)(mr - NLAT) * D;
#pragma unroll
        for (int j = 0; j < 2; ++j) { nx[r][j][0] = NTLOAD((const f32x4*)(xrow + 8 * C.lane + 512 * j)); nx[r][j][1] = NTLOAD((const f32x4*)(xrow + 8 * C.lane + 512 * j + 4)); } } }
    if (!prefilled) phase2_fill(a, C, C.tid, 512);
    __syncthreads();
#pragma unroll 1
    for (int p = C.wave; p < NPAIR; p += 8) {
        const int m = rbase + 2 * p, b = m < NLAT ? (m >> 12) : 4;
        const float* sh = MOD + b * 6144, *sc = sh + 1024;
        float h[2][2][8]; float ss[2] = {0.f, 0.f};
#pragma unroll
        for (int r = 0; r < 2; ++r)
#pragma unroll
            for (int j = 0; j < 2; ++j) { const f32x4 v0 = nx[r][j][0], v1 = nx[r][j][1];
#pragma unroll
                for (int e = 0; e < 4; ++e) { h[r][j][e] = v0[e]; h[r][j][4 + e] = v1[e]; ss[r] += v0[e] * v0[e] + v1[e] * v1[e]; } }
        { const int m2 = p + 8 < NPAIR ? m + 16 : m;
#pragma unroll
          for (int r = 0; r < 2; ++r) { const int mr = m2 + r; const float* xrow = mr < NLAT ? a.x + (size_t)mr * D : a.ctx + (size_t)(mr - NLAT) * D;
#pragma unroll
            for (int j = 0; j < 2; ++j) { nx[r][j][0] = NTLOAD((const f32x4*)(xrow + 8 * C.lane + 512 * j)); nx[r][j][1] = NTLOAD((const f32x4*)(xrow + 8 * C.lane + 512 * j + 4)); } } }
        const float rstd[2] = {rsqrtf(wave_sum(ss[0]) * (1.0f / D) + EPS), rsqrtf(wave_sum(ss[1]) * (1.0f / D) + EPS)};
#pragma unroll
        for (int j = 0; j < 2; ++j) { const int k0 = 8 * C.lane + 512 * j;
#pragma unroll
            for (int e4 = 0; e4 < 2; ++e4) { const f32x4 w = *(const f32x4*)(a.mix_pre + k0 + 4 * e4), s1 = *(const f32x4*)(sc + k0 + 4 * e4), s0 = *(const f32x4*)(sh + k0 + 4 * e4);
#pragma unroll
                for (int r = 0; r < 2; ++r)
#pragma unroll
                    for (int e = 0; e < 4; ++e) h[r][j][4 * e4 + e] = h[r][j][4 * e4 + e] * rstd[r] * w[e] * (1.0f + s1[e]) + s0[e]; }
#pragma unroll
            for (int r = 0; r < 2; ++r) { u32x4 o; o.x = cvt_pk_bf16(h[r][j][0], h[r][j][1]); o.y = cvt_pk_bf16(h[r][j][2], h[r][j][3]); o.z = cvt_pk_bf16(h[r][j][4], h[r][j][5]); o.w = cvt_pk_bf16(h[r][j][6], h[r][j][7]);
                *(u32x4*)(XN + (size_t)(m + r) * D + k0) = o; } }
        float acc0[16], acc1[16];
#pragma unroll
        for (int i = 0; i < 16; ++i) { acc0[i] = 0.f; acc1[i] = 0.f; }
#pragma unroll
        for (int j = 0; j < 2; ++j)
#pragma unroll
            for (int e = 0; e < 8; ++e)
#pragma unroll
                for (int cg = 0; cg < 4; ++cg) { const f32x4 w = WD[((j * 8 + e) * 4 + cg) * 64 + C.lane];
#pragma unroll
                    for (int i = 0; i < 4; ++i) { acc0[4 * cg + i] += h[0][j][e] * w[i]; acc1[4 * cg + i] += h[1][j][e] * w[i]; }
                    if (cg == 3 && (e & 1)) asm volatile("" ::: "memory"); }
        reduce_scatter<16>(acc0, C.lane); reduce_scatter<16>(acc1, C.lane);
        if ((C.lane & 3) == 0) { DTRAW[(size_t)m * 16 + (C.lane >> 2)] = acc0[0]; DTRAW[(size_t)(m + 1) * 16 + (C.lane >> 2)] = acc1[0]; }
    }
}
__device__ __forceinline__ void prep_ssd_unit(CArgs& a, const Ctx& C, int unit) {
    const bf16* U = (const bf16*)(a.ws + WS_U); const float* DTRAW = (const float*)(a.ws + WS_DTRAW);
    bf16* BC = (bf16*)(a.ws + WS_BC); bf16* XST = (bf16*)(a.ws + WS_XST);
    float* GA = (float*)(a.ws + WS_GA); float* DTA = (float*)(a.ws + WS_DTA); float* GEND = (float*)(a.ws + WS_GEND); u32x2* DSS = (u32x2*)(a.ws + WS_DSS);
    const int b = unit / NCH, tc = unit % NCH, s0 = 64 * tc; const bool isctx = tc < 4;
    const int rowbase = isctx ? NLAT + b * CTXL + s0 : b * SEQ + (s0 - CTXL);
    const int ilo = isctx ? -s0 : CTXL - s0, ihi = isctx ? CTXL - s0 : SP - s0;
    LAS float* dtl = (LAS float*)C.lds; LAS float* al = dtl + 1024; LAS float* wl = al + 1024;
    LAS bf16* XTl = (LAS bf16*)(C.lds + 12288);
    int ltid = C.tid; asm volatile("" : "+v"(ltid));
    const int ch0 = 2 * ltid;
    unsigned uw[68];
    if (C.tid < 384) { const bf16* up = U + (size_t)rowbase * NU + 512 + ch0;
#pragma unroll
        for (int t = 0; t < 68; ++t) { const int i = t - 2; uw[t] = (i >= ilo && i < ihi) ? *(const unsigned*)(up + (ptrdiff_t)i * NU) : 0u; } }
#pragma unroll
    for (int pi = 0; pi < 2; ++pi) { const int dh = 2 * C.wave + pi, dir = dh >> 3, h = dh & 7, i = C.lane;
        const float xv = DTRAW[(size_t)(rowbase + i) * 16 + dh] + a.dt_bias[dh];
        const float dt = fmaxf(xv, 0.f) + log1pf(__expf(-fabsf(xv)));
        const float av = -dt * __expf(a.a_log[dh]);
        float pre = av;
#pragma unroll
        for (int o = 1; o < 64; o <<= 1) { const float t = __shfl_up(pre, o); pre += (i >= o) ? t : 0.f; }
        const float tot = __shfl(pre, 63);
        const float g = dir == 0 ? pre : tot - pre + av;
        const float gend = tot;
        al[dh * 64 + i] = g; dtl[dh * 64 + i] = dt; wl[dh * 64 + i] = dt * __expf(gend - g);
        const size_t o = (size_t)((b * 2 + dir) * 8 + h) * SP + s0 + i; GA[o] = g; DTA[o] = dt;
        if (i == 0) GEND[((b * 2 + dir) * 8 + h) * NCH + tc] = gend; }
    LDS_BARRIER();
    if (C.tid < 384) {
        f32x2 wk[5];
#pragma unroll
        for (int k = 0; k < 5; ++k) wk[k] = *(const f32x2*)(a.conv_w + k * 768 + ch0);
        const f32x2 cb = *(const f32x2*)(a.conv_b + ch0);
        const int cls = ch0 < 512 ? 0 : (ch0 < 640 ? 1 : 2);
#pragma unroll
        for (int i8 = 0; i8 < 8; ++i8) {
            unsigned t0[4], t1[4]; float pv0 = 0.f, pv1 = 0.f;
#pragma unroll
            for (int ii = 0; ii < 8; ++ii) {
                const int i = 8 * i8 + ii;
                float y0 = cb.x, y1 = cb.y;
#pragma unroll
                for (int k = 0; k < 5; ++k) { y0 += wk[k].x * bflo(uw[i + k]); y1 += wk[k].y * bfhi(uw[i + k]); }
                y0 = siluf(y0); y1 = siluf(y1);
                if (cls != 0) *(unsigned*)(BC + (size_t)(rowbase + i) * 256 + (ch0 - 512)) = cvt_pk_bf16(y0, y1);
                if (ii & 1) { t0[ii >> 1] = cvt_pk_bf16(pv0, y0); t1[ii >> 1] = cvt_pk_bf16(pv1, y1); } else { pv0 = y0; pv1 = y1; }
            }
            if (cls != 2) {
                const u32x4 v0 = (u32x4){t0[0], t0[1], t0[2], t0[3]}, v1 = (u32x4){t1[0], t1[1], t1[2], t1[3]};
                *(LAS u32x4*)(XTl + ch0 * 72 + 8 * i8) = v0; *(LAS u32x4*)(XTl + (ch0 + 1) * 72 + 8 * i8) = v1;
                if (cls == 0) { const size_t r0 = (size_t)(b * 512 + ch0) * SP + s0 + 8 * i8; *(u32x4*)(XST + r0) = v0; *(u32x4*)(XST + r0 + SP) = v1; }
            }
        }
    }
    LDS_BARRIER();
    {
        const int fr = C.lane & 15, q = C.lane >> 4;
#pragma unroll 1
        for (int pi = 0; pi < 2; ++pi) { const int pid = 2 * C.wave + pi, dir = pid >> 3, h = pid & 7, g = h >> 2;
            bf16x8 Bf[4][2]; f32x4 wv[2][2];
#pragma unroll
            for (int ks = 0; ks < 2; ++ks) { wv[ks][0] = *(const LAS f32x4*)(wl + pid * 64 + 32 * ks + 8 * q); wv[ks][1] = *(const LAS f32x4*)(wl + pid * 64 + 32 * ks + 8 * q + 4); }
#pragma unroll
            for (int t = 0; t < 4; ++t)
#pragma unroll
                for (int ks = 0; ks < 2; ++ks) Bf[t][ks] = *(const LAS bf16x8*)(XTl + (h * 64 + 16 * t + fr) * 72 + 32 * ks + 8 * q);
            const size_t ob = ((size_t)((b * 2 + dir) * 8 + h) * NCH + tc) * 1024;
#pragma unroll
            for (int at = 0; at < 4; ++at) { bf16x8 Af[2];
#pragma unroll
                for (int ks = 0; ks < 2; ++ks) { const u32x4 raw = *(const LAS u32x4*)(XTl + (512 + g * 64 + 16 * at + fr) * 72 + 32 * ks + 8 * q); const unsigned rw[4] = {raw.x, raw.y, raw.z, raw.w}; u32x4 o;
                    o.x = cvt_pk_bf16(bflo(rw[0]) * wv[ks][0][0], bfhi(rw[0]) * wv[ks][0][1]); o.y = cvt_pk_bf16(bflo(rw[1]) * wv[ks][0][2], bfhi(rw[1]) * wv[ks][0][3]);
                    o.z = cvt_pk_bf16(bflo(rw[2]) * wv[ks][1][0], bfhi(rw[2]) * wv[ks][1][1]); o.w = cvt_pk_bf16(bflo(rw[3]) * wv[ks][1][2], bfhi(rw[3]) * wv[ks][1][3]);
                    Af[ks] = __builtin_bit_cast(bf16x8, o); }
#pragma unroll
                for (int pt = 0; pt < 4; ++pt) { f32x4 acc = (f32x4){0.f, 0.f, 0.f, 0.f};
                    acc = MFMA16(Af[0], Bf[pt][0], acc); acc = MFMA16(Af[1], Bf[pt][1], acc);
                    DSS[ob + (at * 4 + pt) * 64 + C.lane] = (u32x2){cvt_pk_bf16(acc[0], acc[1]), cvt_pk_bf16(acc[2], acc[3])}; } } }
    }
    LDS_BARRIER();
}
__device__ __forceinline__ void prep_hg_pair(CArgs& a, const Ctx& C, int unit) {
    const bf16* U = (const bf16*)(a.ws + WS_U);
    bf16* QS = (bf16*)(a.ws + WS_QS); bf16* KS = (bf16*)(a.ws + WS_KS); bf16* VT = (bf16*)(a.ws + WS_VT); float* EG = (float*)(a.ws + WS_EG); u32x2* DSP = (u32x2*)(a.ws + WS_DSP); float* EGP = (float*)(a.ws + WS_EGP);
    const int b = unit / (NPR * 4), pr = (unit >> 2) % NPR, h = unit & 3;
    LAS float* ETl = (LAS float*)(C.lds + 63488);
    LAS u32x2* DL = (LAS u32x2*)(C.lds + 65536);
#pragma unroll 1
    for (int sub = 0; sub < 2; ++sub) {
    const int c = 2 * pr + sub, s0 = 64 * c; const bool isctx = c < 4;
    int ltid = C.tid; asm volatile("" : "+v"(ltid));
    const int cp = ltid & 63, tg = ltid >> 6, ch0 = 2 * cp, hc = h * 128 + ch0;
    const int rbase = isctx ? NLAT + b * CTXL + s0 : b * SEQ + (c - 4), rstride = isctx ? 1 : 64;
    const bf16* up = U + (size_t)rbase * NU + 1280 + hc;
    unsigned rq[8], rf[8], rb[8], ri[8];
#pragma unroll
    for (int t = 0; t < 8; ++t) { const bf16* r = up + (size_t)(8 * tg + t) * rstride * NU;
        rq[t] = *(const unsigned*)r; rf[t] = *(const unsigned*)(r + 512); rb[t] = *(const unsigned*)(r + 1024); ri[t] = *(const unsigned*)(r + 1536); }
    LAS float* part = (LAS float*)C.lds;
    LAS bf16* KHl = (LAS bf16*)(C.lds + 8192);
    LAS bf16* VTl = KHl + 2 * 128 * 72;
    f32x2 lbv[2];
#pragma unroll
    for (int d = 0; d < 2; ++d) { lbv[d].x = __builtin_amdgcn_rcpf(1.0f + __expf(a.hg_lb[1024 + d * 512 + hc] - a.hg_lb[d * 512 + hc])); lbv[d].y = __builtin_amdgcn_rcpf(1.0f + __expf(a.hg_lb[1024 + d * 512 + hc + 1] - a.hg_lb[d * 512 + hc + 1])); }
    float la[2][2][8], om[2][2][8];
    float sum[2][2] = {{0.f, 0.f}, {0.f, 0.f}};
#pragma unroll
    for (int t = 0; t < 8; ++t)
#pragma unroll
        for (int d = 0; d < 2; ++d)
#pragma unroll
            for (int e = 0; e < 2; ++e) { const unsigned w = d == 0 ? rf[t] : rb[t]; const float fr_ = e == 0 ? bflo(w) : bfhi(w); const float lb = e == 0 ? lbv[d].x : lbv[d].y;
                const float ex = __builtin_amdgcn_exp2f(fr_ * -1.4426950408889634f); const float t1 = (1.0f - lb) * __builtin_amdgcn_rcpf(1.0f + ex);
                om[d][e][t] = t1 * ex;
                la[d][e][t] = __builtin_amdgcn_logf(lb + t1); sum[d][e] += la[d][e][t]; }
#pragma unroll
    for (int d = 0; d < 2; ++d)
#pragma unroll
        for (int e = 0; e < 2; ++e) part[(tg * 4 + d * 2 + e) * 64 + cp] = sum[d][e];
    LDS_BARRIER();
    float T[2][2], pre[2][2];
#pragma unroll
    for (int d = 0; d < 2; ++d)
#pragma unroll
        for (int e = 0; e < 2; ++e) { float tt = 0.f, pp = 0.f;
#pragma unroll
            for (int g2 = 0; g2 < 8; ++g2) { const float v = part[(g2 * 4 + d * 2 + e) * 64 + cp]; pp += (g2 < tg) ? v : 0.f; tt += v; }
            T[d][e] = tt; pre[d][e] = pp; }
    const size_t DST = (size_t)NB * 4 * SP * 128;
    unsigned khp[2][2][4], vp[2][4];
    float eT[2][2];
#pragma unroll
    for (int d = 0; d < 2; ++d)
#pragma unroll
        for (int e = 0; e < 2; ++e) eT[d][e] = __builtin_amdgcn_exp2f(T[d][e]);
    {
        float runf[2] = {pre[0][0], pre[0][1]}, runb[2] = {pre[1][0], pre[1][1]}, pkf[2] = {0.f, 0.f}, pkb[2] = {0.f, 0.f}, pkv[2] = {0.f, 0.f};
#pragma unroll
        for (int t = 0; t < 8; ++t) { const size_t rm = ((size_t)(b * 4 + h) * SP + s0 + 8 * tg + t) * 128 + ch0;
            const float qv[2] = {siluf(bflo(rq[t])) * 0.08838834764831845f, siluf(bfhi(rq[t])) * 0.08838834764831845f};
            float ktf[2], ktb[2], qtf[2], qtb[2];
#pragma unroll
            for (int e = 0; e < 2; ++e) {
                runf[e] += la[0][e][t]; const float Ef = __builtin_amdgcn_exp2f(-runf[e]);
                const float gb = T[1][e] - runb[e]; runb[e] += la[1][e][t]; const float Eb = __builtin_amdgcn_exp2f(-gb);
                ktf[e] = om[0][e][t] * Ef; ktb[e] = om[1][e][t] * Eb; qtf[e] = qv[e] * __builtin_amdgcn_rcpf(Ef); qtb[e] = qv[e] * __builtin_amdgcn_rcpf(Eb);
                const float khf = ktf[e] * eT[0][e], khb = ktb[e] * eT[1][e], iv = e == 0 ? bflo(ri[t]) : bfhi(ri[t]);
                if (t & 1) { khp[0][e][t >> 1] = cvt_pk_bf16(pkf[e], khf); khp[1][e][t >> 1] = cvt_pk_bf16(pkb[e], khb); vp[e][t >> 1] = cvt_pk_bf16(pkv[e], iv); } else { pkf[e] = khf; pkb[e] = khb; pkv[e] = iv; } }
            *(unsigned*)(QS + rm) = cvt_pk_bf16(qtf[0], qtf[1]); *(unsigned*)(QS + DST + rm) = cvt_pk_bf16(qtb[0], qtb[1]);
            *(unsigned*)(KS + rm) = cvt_pk_bf16(ktf[0], ktf[1]); *(unsigned*)(KS + DST + rm) = cvt_pk_bf16(ktb[0], ktb[1]); }
    }
#pragma unroll
    for (int e = 0; e < 2; ++e) {
        *(LAS u32x4*)(KHl + (0 * 128 + ch0 + e) * 72 + 8 * tg) = (u32x4){khp[0][e][0], khp[0][e][1], khp[0][e][2], khp[0][e][3]};
        *(LAS u32x4*)(KHl + (1 * 128 + ch0 + e) * 72 + 8 * tg) = (u32x4){khp[1][e][0], khp[1][e][1], khp[1][e][2], khp[1][e][3]};
        *(LAS u32x4*)(VTl + (ch0 + e) * 72 + 8 * tg) = (u32x4){vp[e][0], vp[e][1], vp[e][2], vp[e][3]};
        *(u32x4*)(VT + (size_t)((b * 4 + h) * 128 + ch0 + e) * SP + s0 + 8 * tg) = (u32x4){vp[e][0], vp[e][1], vp[e][2], vp[e][3]}; }
    if (tg == 0) {
#pragma unroll
        for (int d = 0; d < 2; ++d) { const f32x2 et = (f32x2){eT[d][0], eT[d][1]};
            *(f32x2*)(EG + ((size_t)((d * 4 + b) * 4 + h) * NCH + c) * 128 + ch0) = et; *(LAS f32x2*)(ETl + (sub * 2 + d) * 128 + ch0) = et;
            if (sub) { const f32x2 e0 = *(const LAS f32x2*)(ETl + d * 128 + ch0); *(f32x2*)(EGP + ((size_t)((d * 4 + b) * 4 + h) * NPR + pr) * 128 + ch0) = (f32x2){e0.x * et.x, e0.y * et.y}; } } }
    LDS_BARRIER();
    {
        const int fr = C.lane & 15, q = C.lane >> 4;
        LAS u32x2* dlb = DL + C.tid; asm volatile("" : "+v"(dlb));
        bf16x8 Bf[2];
#pragma unroll
        for (int ks = 0; ks < 2; ++ks) Bf[ks] = *(const LAS bf16x8*)(VTl + (16 * C.wave + fr) * 72 + 32 * ks + 8 * q);
#pragma unroll
        for (int d = 0; d < 2; ++d) { const int seq = (d * NB + b) * 4 + h;
#pragma unroll
            for (int at = 0; at < 8; ++at) { f32x4 t4 = (f32x4){0.f, 0.f, 0.f, 0.f};
#pragma unroll
                for (int ks = 0; ks < 2; ++ks) { const bf16x8 Af = *(const LAS bf16x8*)(KHl + (d * 128 + 16 * at + fr) * 72 + 32 * ks + 8 * q); t4 = MFMA16(Af, Bf[ks], t4); }
                LAS u32x2* dl = dlb + (d * 8 + at) * 512;
                if (sub == 0) *dl = (u32x2){cvt_pk_bf16(t4[0], t4[1]), cvt_pk_bf16(t4[2], t4[3])};
                else { const u32x2 pw = *dl; const f32x4 pv = (f32x4){bflo(pw.x), bfhi(pw.x), bflo(pw.y), bfhi(pw.y)};
                    const f32x4 r4 = d == 0 ? pv * *(const LAS f32x4*)(ETl + (1 * 2 + 0) * 128 + 16 * at + 4 * q) + t4
                                            : pv + t4 * *(const LAS f32x4*)(ETl + (0 * 2 + 1) * 128 + 16 * at + 4 * q);
                    DSP[((size_t)seq * NPR + pr) * 4096 + (at * 8 + C.wave) * 64 + C.lane] = (u32x2){cvt_pk_bf16(r4[0], r4[1]), cvt_pk_bf16(r4[2], r4[3])}; }
                if (at & 1) asm volatile("" ::: "memory"); } }
    }
    LDS_BARRIER();
    }
}
__device__ __forceinline__ void phase4(CArgs& a, const Ctx& C) {
    constexpr int NHU = NB * NPR * 4;
#pragma unroll 1
    for (int k = 0; k < 4; ++k) { int u; const int v = C.vcu;
        if (k == 0) u = v;
        else if (k == 1) u = v < 208 ? 256 + v : NHU + (v - 208);
        else if (k == 2) u = v < 80 ? 464 + v : (v < 208 ? NHU + 48 + (v - 80) : NHU + 176 + (v - 208));
        else { if (v < 208) break; u = NHU + 224 + (v - 208); }
        if (u < NHU) prep_hg_pair(a, C, u); else prep_ssd_unit(a, C, u - NHU); }
}
__device__ __forceinline__ void phase5(CArgs& a, const Ctx& C) { (void)a; (void)C; }
__device__ __forceinline__ int scan_chunk(int dir, int k) { return dir == 0 ? k : (k < 4 ? 3 - k : 71 - k); }
__device__ __forceinline__ void phase6(CArgs& a, const Ctx& C) {
    const u32x2* DSS = (const u32x2*)(a.ws + WS_DSS); const u32x2* DSP = (const u32x2*)(a.ws + WS_DSP);
    u32x2* SPS = (u32x2*)(a.ws + WS_SPS); u32x2* SPH = (u32x2*)(a.ws + WS_SPH);
    const float* GEND = (const float*)(a.ws + WS_GEND); const float* EGP = (const float*)(a.ws + WS_EGP);
    if (C.vcu < 128) {
        const int task = C.vcu * 512 + C.tid, seq = task >> 10, grp = task & 1023, dir = (seq >> 3) & 1;
        f32x4 S = (f32x4){0.f, 0.f, 0.f, 0.f};
#pragma unroll 1
        for (int kb = 0; kb < NCH; kb += 17) { u32x2 dw[17]; float gd[17];
#pragma unroll
            for (int j = 0; j < 17; ++j) { const int tc = scan_chunk(dir, kb + j); dw[j] = NTLOAD(&DSS[((size_t)seq * NCH + tc) * 1024 + grp]); gd[j] = GEND[seq * NCH + tc]; }
            asm volatile("" ::: "memory");
#pragma unroll
            for (int j = 0; j < 17; ++j) { const int tc = scan_chunk(dir, kb + j);
                if (tc >= 4) SPS[((size_t)seq * NCH + tc) * 1024 + grp] = (u32x2){cvt_pk_bf16(S[0], S[1]), cvt_pk_bf16(S[2], S[3])};
                S = S * __expf(gd[j]) + (f32x4){bflo(dw[j].x), bfhi(dw[j].x), bflo(dw[j].y), bfhi(dw[j].y)}; }
            asm volatile("" ::: "memory"); }
    } else {
#pragma unroll 1
        for (int rep = 0; rep < 2; ++rep) {
            const int t = (C.vcu - 128) * 1024 + rep * 512 + C.tid, seq = t >> 12, grp = t & 4095, d = seq >> 4, tile = grp >> 6, ln = grp & 63, cb = 16 * (tile >> 3) + 4 * (ln >> 4);
            f32x4 S = (f32x4){0.f, 0.f, 0.f, 0.f};
#pragma unroll 1
            for (int kb = 0; kb < NPR; kb += 17) { u32x2 dw[17]; f32x4 dec[17];
#pragma unroll
                for (int j = 0; j < 17; ++j) { const int k = kb + j, tp = d == 0 ? k : (k < 2 ? 1 - k : 35 - k); dw[j] = NTLOAD(&DSP[((size_t)seq * NPR + tp) * 4096 + grp]); dec[j] = *(const f32x4*)(EGP + ((size_t)seq * NPR + tp) * 128 + cb); }
                asm volatile("" ::: "memory");
#pragma unroll
                for (int j = 0; j < 17; ++j) { const int k = kb + j, tp = d == 0 ? k : (k < 2 ? 1 - k : 35 - k);
                    if (tp >= 2) SPH[((size_t)seq * NPR + tp) * 4096 + grp] = (u32x2){cvt_pk_bf16(S[0], S[1]), cvt_pk_bf16(S[2], S[3])};
                    S = S * dec[j] + (f32x4){bflo(dw[j].x), bfhi(dw[j].x), bflo(dw[j].y), bfhi(dw[j].y)}; }
                asm volatile("" ::: "memory"); } }
    }
}
typedef short s16x4 __attribute__((ext_vector_type(4)));
typedef short s16x8 __attribute__((ext_vector_type(8)));
__device__ __forceinline__ s16x4 lds_tr(const LAS bf16* p) { return __builtin_amdgcn_ds_read_tr16_b64_v4i16((LAS s16x4*)p); }
__device__ __forceinline__ bf16x8 ld_split8(const bf16* p0, const bf16* p1) {
    const u32x2 lo = *(const u32x2*)p0, hi = *(const u32x2*)p1; u32x4 w = (u32x4){lo.x, lo.y, hi.x, hi.y}; return __builtin_bit_cast(bf16x8, w);
}
__device__ __forceinline__ void passc_ssd_unit(CArgs& a, const Ctx& C, int unit) {
    const bf16* BC = (const bf16*)(a.ws + WS_BC); const bf16* XST = (const bf16*)(a.ws + WS_XST); const bf16* U = (const bf16*)(a.ws + WS_U);
    const float* GA = (const float*)(a.ws + WS_GA); const float* DTA = (const float*)(a.ws + WS_DTA); const bf16* SPS = (const bf16*)(a.ws + WS_SPS);
    bf16* Y = (bf16*)(a.ws + WS_Y);
    const int b = unit >> 6, tcl = unit & 63, tc = tcl + 4, s0 = 64 * tc, row0 = b * SEQ + 64 * tcl;
    const int h = C.wave, g = h >> 2, fr = C.lane & 15, q = C.lane >> 4;
    LAS unsigned char* wl = C.lds + C.wave * 17408;
    LAS bf16* Ml = (LAS bf16*)wl; LAS float* Yl = (LAS float*)wl; LAS float* red = (LAS float*)(C.lds + 8 * 17408);
    {
        bf16x8 Ca[4][2], Bb[4][2];
#pragma unroll
        for (int t = 0; t < 4; ++t)
#pragma unroll
            for (int ks = 0; ks < 2; ++ks) { const bf16* rp = BC + (size_t)(row0 + 16 * t + fr) * 256 + g * 64 + 32 * ks + 8 * q;
                Bb[t][ks] = *(const bf16x8*)rp; Ca[t][ks] = *(const bf16x8*)(rp + 128); }
        const size_t sf = (size_t)((b * 2 + 0) * 8 + h) * SP + s0, sb = (size_t)((b * 2 + 1) * 8 + h) * SP + s0;
        float gjf[4], gjb[4], dtf[4], dtb[4];
#pragma unroll
        for (int jt = 0; jt < 4; ++jt) { gjf[jt] = GA[sf + 16 * jt + fr]; gjb[jt] = GA[sb + 16 * jt + fr]; dtf[jt] = DTA[sf + 16 * jt + fr]; dtb[jt] = DTA[sb + 16 * jt + fr]; }
        const float Dh = a.ssd_d[h];
#pragma unroll
        for (int it = 0; it < 4; ++it) {
            const f32x4 gif = *(const f32x4*)(GA + sf + 16 * it + 4 * q), gib = *(const f32x4*)(GA + sb + 16 * it + 4 * q);
#pragma unroll
            for (int jt = 0; jt < 4; ++jt) { f32x4 G = (f32x4){0.f, 0.f, 0.f, 0.f};
                G = MFMA16(Ca[it][0], Bb[jt][0], G); G = MFMA16(Ca[it][1], Bb[jt][1], G);
                const int j = 16 * jt + fr;
#pragma unroll
                for (int r = 0; r < 4; ++r) { const int i = 16 * it + 4 * q + r;
                    const float lf = (j <= i) ? dtf[jt] * __expf(fminf(gif[r] - gjf[jt], 0.f)) : 0.f;
                    const float lb = (j >= i) ? dtb[jt] * __expf(fminf(gib[r] - gjb[jt], 0.f)) : 0.f;
                    const float m = G[r] * (lf + lb) + ((i == j) ? Dh : 0.f);
                    Ml[i * 72 + j] = (bf16)(cvt_pk_bf16(m, 0.f) & 0xffff); } } }
    }
    LDS_WAIT(); asm volatile("" ::: "memory");
    bf16x8 Ma[4][2], Cp[4][2];
#pragma unroll
    for (int it = 0; it < 4; ++it)
#pragma unroll
        for (int ks = 0; ks < 2; ++ks) { Ma[it][ks] = *(const LAS bf16x8*)(Ml + (16 * it + fr) * 72 + 32 * ks + 8 * q);
            const bf16* cp = BC + (size_t)(row0 + 16 * it + fr) * 256 + 128 + g * 64 + 32 * ks + 4 * q; Cp[it][ks] = ld_split8(cp, cp + 16); }
    LDS_WAIT(); asm volatile("" ::: "memory");
    f32x4 eg[2][4];
#pragma unroll
    for (int d = 0; d < 2; ++d)
#pragma unroll
        for (int it = 0; it < 4; ++it) { const f32x4 gi = *(const f32x4*)(GA + (size_t)((b * 2 + d) * 8 + h) * SP + s0 + 16 * it + 4 * q);
            eg[d][it] = (f32x4){__expf(gi[0]), __expf(gi[1]), __expf(gi[2]), __expf(gi[3])}; }
#pragma unroll 1
    for (int pt = 0; pt < 4; ++pt) {
        bf16x8 Bx[2];
#pragma unroll
        for (int ks = 0; ks < 2; ++ks) Bx[ks] = *(const bf16x8*)(XST + (size_t)((b * 8 + h) * 64 + 16 * pt + fr) * SP + s0 + 32 * ks + 8 * q);
        f32x4 Yv[4];
#pragma unroll
        for (int it = 0; it < 4; ++it) { Yv[it] = (f32x4){0.f, 0.f, 0.f, 0.f}; Yv[it] = MFMA16(Ma[it][0], Bx[0], Yv[it]); Yv[it] = MFMA16(Ma[it][1], Bx[1], Yv[it]); }
#pragma unroll
        for (int d = 0; d < 2; ++d) { const size_t sbase = ((size_t)((b * 2 + d) * 8 + h) * NCH + tc) * 1024;
            bf16x8 Sb[2];
#pragma unroll
            for (int ks = 0; ks < 2; ++ks) Sb[ks] = ld_split8(SPS + (sbase + ((2 * ks) * 4 + pt) * 64 + C.lane) * 4, SPS + (sbase + ((2 * ks + 1) * 4 + pt) * 64 + C.lane) * 4);
#pragma unroll
            for (int it = 0; it < 4; ++it) { f32x4 T = (f32x4){0.f, 0.f, 0.f, 0.f}; T = MFMA16(Cp[it][0], Sb[0], T); T = MFMA16(Cp[it][1], Sb[1], T); Yv[it] += eg[d][it] * T; } }
#pragma unroll
        for (int it = 0; it < 4; ++it)
#pragma unroll
            for (int r = 0; r < 4; ++r) Yl[(16 * it + 4 * q + r) * 68 + 16 * pt + fr] = Yv[it][r];
    }
    LDS_WAIT(); asm volatile("" ::: "memory");
    const int i = C.lane; float v[64]; float ss = 0.f;
    const bf16* zp = U + (size_t)(row0 + i) * NU + h * 64;
#pragma unroll
    for (int c8 = 0; c8 < 8; ++c8) { const u32x4 zw = *(const u32x4*)(zp + 8 * c8); const f32x4 y0 = *(const LAS f32x4*)(Yl + i * 68 + 8 * c8), y1 = *(const LAS f32x4*)(Yl + i * 68 + 8 * c8 + 4);
        const unsigned zz[4] = {zw.x, zw.y, zw.z, zw.w};
#pragma unroll
        for (int e = 0; e < 4; ++e) { const float ya = e < 2 ? y0[2 * e] : y1[2 * e - 4], yb = e < 2 ? y0[2 * e + 1] : y1[2 * e - 3];
            const float va = ya * siluf(bflo(zz[e])), vb = yb * siluf(bfhi(zz[e])); v[8 * c8 + 2 * e] = va; v[8 * c8 + 2 * e + 1] = vb; ss += va * va + vb * vb; } }
    red[C.wave * 64 + i] = ss;
    LDS_BARRIER();
    float tot = 0.f;
#pragma unroll
    for (int w = 0; w < 8; ++w) tot += red[w * 64 + i];
    const float rstd = rsqrtf(tot * (1.0f / 512.0f) + EPS);
    bf16* yo = Y + (size_t)(row0 + i) * D + h * 64;
#pragma unroll
    for (int c8 = 0; c8 < 8; ++c8) { const f32x4 n0 = *(const f32x4*)(a.ssd_norm + h * 64 + 8 * c8), n1 = *(const f32x4*)(a.ssd_norm + h * 64 + 8 * c8 + 4);
        u32x4 o; o.x = cvt_pk_bf16(v[8 * c8] * rstd * n0[0], v[8 * c8 + 1] * rstd * n0[1]); o.y = cvt_pk_bf16(v[8 * c8 + 2] * rstd * n0[2], v[8 * c8 + 3] * rstd * n0[3]);
        o.z = cvt_pk_bf16(v[8 * c8 + 4] * rstd * n1[0], v[8 * c8 + 5] * rstd * n1[1]); o.w = cvt_pk_bf16(v[8 * c8 + 6] * rstd * n1[2], v[8 * c8 + 7] * rstd * n1[3]);
        *(u32x4*)(yo + 8 * c8) = o; }
    LDS_BARRIER();
}
__device__ __forceinline__ void passc_hg_pair(CArgs& a, const Ctx& C, int unit) {
    const bf16* QS = (const bf16*)(a.ws + WS_QS); const bf16* KS = (const bf16*)(a.ws + WS_KS); const bf16* VT = (const bf16*)(a.ws + WS_VT); const bf16* SPH = (const bf16*)(a.ws + WS_SPH);
    const bf16* U = (const bf16*)(a.ws + WS_U); bf16* Y = (bf16*)(a.ws + WS_Y); const float* EG = (const float*)(a.ws + WS_EG);
    const int b = unit >> 7, pr = 2 + ((unit >> 2) & 31), h = unit & 3;
    const int wv = C.wave, fr = C.lane & 15, q = C.lane >> 4;
    LAS bf16* Pl = (LAS bf16*)C.lds; LAS float* Ol = (LAS float*)(C.lds + 9216); LAS float* red = (LAS float*)(C.lds + 9216 + 64 * 132 * 4);
    LAS bf16* KL = (LAS bf16*)(C.lds + 79872);
    LAS bf16* QL = (LAS bf16*)(C.lds + 45056);
    const size_t DST = (size_t)NB * 4 * SP * 128;
#pragma unroll 1
    for (int sub = 0; sub < 2; ++sub) {
    const int tc = 2 * pr + sub, w = tc - 4, s0 = 64 * tc, oc = 2 * pr + 1 - sub;
    const int it0 = wv >> 1;
    bf16x8 Aq[2][4], Bk[2][2][4];
#pragma unroll
    for (int d = 0; d < 2; ++d) { const size_t base = d * DST + ((size_t)(b * 4 + h) * SP + s0) * 128;
#pragma unroll
        for (int ks = 0; ks < 4; ++ks) { Aq[d][ks] = *(const bf16x8*)(QS + base + (size_t)(16 * it0 + fr) * 128 + 32 * ks + 8 * q);
#pragma unroll
            for (int j2 = 0; j2 < 2; ++j2) Bk[d][j2][ks] = *(const bf16x8*)(KS + base + (size_t)(16 * (2 * (wv & 1) + j2) + fr) * 128 + 32 * ks + 8 * q); } }
    bf16x8 Bv[2], Vo[2], SbD[4];
#pragma unroll
    for (int ks = 0; ks < 2; ++ks) Bv[ks] = *(const bf16x8*)(VT + (size_t)((b * 4 + h) * 128 + 16 * wv + fr) * SP + s0 + 32 * ks + 8 * q);
    const int dm = 1 - sub;
#pragma unroll
    for (int ks = 0; ks < 2; ++ks) Vo[ks] = *(const bf16x8*)(VT + (size_t)((b * 4 + h) * 128 + 16 * wv + fr) * SP + 64 * oc + 32 * ks + 8 * q);
    u32x2 sp[8];
    { const size_t sbD = ((size_t)((sub * NB + b) * 4 + h) * NPR + pr) * 4096, sbM = ((size_t)((dm * NB + b) * 4 + h) * NPR + pr) * 4096;
#pragma unroll
        for (int ks = 0; ks < 4; ++ks) SbD[ks] = ld_split8(SPH + (sbD + ((2 * ks) * 8 + wv) * 64 + C.lane) * 4, SPH + (sbD + ((2 * ks + 1) * 8 + wv) * 64 + C.lane) * 4);
#pragma unroll
        for (int at = 0; at < 8; ++at) sp[at] = *(const u32x2*)(SPH + (sbM + (at * 8 + wv) * 64 + C.lane) * 4); }
    const int kr = C.tid >> 3, kc = (C.tid & 7) * 16;
    const bf16* kso = KS + dm * DST + ((size_t)(b * 4 + h) * SP + 64 * oc) * 128 + kr * 128 + kc;
    const u32x4 kt0 = *(const u32x4*)kso, kt1 = *(const u32x4*)(kso + 8);
    const int i = C.lane;
    const size_t row = (size_t)b * SEQ + i * 64 + w;
    const bf16* gp = U + row * NU + 1280 + 2048 + h * 128 + 16 * wv; bf16* yo = Y + row * D + 512 + h * 128 + 16 * wv; const float* nwp = a.hg_norm + h * 128 + 16 * wv;
    const u32x4 gw0 = *(const u32x4*)gp, gw1 = *(const u32x4*)(gp + 8);
    f32x4 nw[4];
#pragma unroll
    for (int c4 = 0; c4 < 4; ++c4) nw[c4] = *(const f32x4*)(nwp + 4 * c4);
    {
        f32x4 P[2] = {(f32x4){0.f, 0.f, 0.f, 0.f}, (f32x4){0.f, 0.f, 0.f, 0.f}};
#pragma unroll
        for (int d = 0; d < 2; ++d) {
#pragma unroll
            for (int ks = 0; ks < 4; ++ks) if ((wv & 1) == 0) *(LAS bf16x8*)(QL + (d * 64 + 16 * it0 + fr) * 136 + 32 * ks + 8 * q) = Aq[d][ks];
#pragma unroll
            for (int j2 = 0; j2 < 2; ++j2) { const int jt = 2 * (wv & 1) + j2; f32x4 S = (f32x4){0.f, 0.f, 0.f, 0.f};
#pragma unroll
                for (int ks = 0; ks < 4; ++ks) S = MFMA16(Aq[d][ks], Bk[d][j2][ks], S);
                const int j = 16 * jt + fr;
#pragma unroll
                for (int r = 0; r < 4; ++r) { const int ii = 16 * it0 + 4 * q + r; const bool keep = d == 0 ? (j <= ii) : (j >= ii); P[j2][r] += keep ? S[r] : 0.f; } } }
#pragma unroll
        for (int j2 = 0; j2 < 2; ++j2) { const int j = 16 * (2 * (wv & 1) + j2) + fr;
#pragma unroll
            for (int r = 0; r < 4; ++r) Pl[(16 * it0 + 4 * q + r) * 72 + j] = (bf16)(cvt_pk_bf16(P[j2][r], 0.f) & 0xffff); }
        *(LAS u32x4*)(KL + kr * 136 + kc) = kt0; *(LAS u32x4*)(KL + kr * 136 + kc + 8) = kt1;
    }
    LDS_BARRIER();
    f32x4 O[4];
#pragma unroll
    for (int it = 0; it < 4; ++it) { O[it] = (f32x4){0.f, 0.f, 0.f, 0.f};
#pragma unroll
        for (int ks = 0; ks < 2; ++ks) { const bf16x8 Pa = *(const LAS bf16x8*)(Pl + (16 * it + fr) * 72 + 32 * ks + 8 * q); O[it] = MFMA16(Pa, Bv[ks], O[it]); } }
    bf16x8 SbM[4];
    { const float* eg = EG + ((size_t)((dm * NB + b) * 4 + h) * NCH + oc) * 128 + 4 * q;
        const LAS bf16* kt = KL + (8 * q + (fr >> 2)) * 136 + 4 * (fr & 3);
#pragma unroll
        for (int ks = 0; ks < 4; ++ks) { unsigned wd[4];
#pragma unroll
            for (int hh = 0; hh < 2; ++hh) { const int at = 2 * ks + hh; f32x4 t4 = (f32x4){bflo(sp[at].x), bfhi(sp[at].x), bflo(sp[at].y), bfhi(sp[at].y)};
#pragma unroll
                for (int k2 = 0; k2 < 2; ++k2) { const s16x4 a0 = lds_tr(kt + (32 * k2) * 136 + 16 * at), a1 = lds_tr(kt + (32 * k2 + 4) * 136 + 16 * at);
                    const s16x8 av = (s16x8){a0[0], a0[1], a0[2], a0[3], a1[0], a1[1], a1[2], a1[3]}; t4 = MFMA16(__builtin_bit_cast(bf16x8, av), Vo[k2], t4); }
                const f32x4 e4 = *(const f32x4*)(eg + 16 * at);
                wd[2 * hh] = cvt_pk_bf16(t4[0] * e4[0], t4[1] * e4[1]); wd[2 * hh + 1] = cvt_pk_bf16(t4[2] * e4[2], t4[3] * e4[3]); }
            const u32x4 ww = (u32x4){wd[0], wd[1], wd[2], wd[3]}; SbM[ks] = __builtin_bit_cast(bf16x8, ww); } }
#pragma unroll
    for (int d = 0; d < 2; ++d)
#pragma unroll
        for (int ks = 0; ks < 4; ++ks) { const bf16x8 sb = d == sub ? SbD[ks] : SbM[ks];
#pragma unroll
            for (int it = 0; it < 4; ++it) { const LAS bf16* qp = QL + (d * 64 + 16 * it + fr) * 136 + 32 * ks + 4 * q;
                const u32x2 lo = *(const LAS u32x2*)qp, hi = *(const LAS u32x2*)(qp + 16); const u32x4 ww = (u32x4){lo.x, lo.y, hi.x, hi.y};
                O[it] = MFMA16(__builtin_bit_cast(bf16x8, ww), sb, O[it]); } }
#pragma unroll
    for (int it = 0; it < 4; ++it)
#pragma unroll
        for (int r = 0; r < 4; ++r) Ol[(16 * it + 4 * q + r) * 132 + 16 * wv + fr] = O[it][r];
    LDS_BARRIER();
    float o[16]; float ss = 0.f;
#pragma unroll
    for (int c4 = 0; c4 < 4; ++c4) { const f32x4 t = *(const LAS f32x4*)(Ol + i * 132 + 16 * wv + 4 * c4);
#pragma unroll
        for (int e = 0; e < 4; ++e) { o[4 * c4 + e] = t[e]; ss += t[e] * t[e]; } }
    red[wv * 64 + i] = ss;
    LDS_BARRIER();
    float tot = 0.f;
#pragma unroll
    for (int s2 = 0; s2 < 8; ++s2) tot += red[s2 * 64 + i];
    const float rstd = rsqrtf(tot * (1.0f / 128.0f) + EPS);
#pragma unroll
    for (int c8 = 0; c8 < 2; ++c8) { const u32x4 gw4 = c8 == 0 ? gw0 : gw1; const unsigned gz[4] = {gw4.x, gw4.y, gw4.z, gw4.w}; unsigned ow[4];
#pragma unroll
        for (int e = 0; e < 4; ++e) { const int k = 8 * c8 + 2 * e; ow[e] = cvt_pk_bf16(o[k] * rstd * nw[k >> 2][k & 3] * siluf(bflo(gz[e])), o[k + 1] * rstd * nw[(k + 1) >> 2][(k + 1) & 3] * siluf(bfhi(gz[e]))); }
        *(u32x4*)(yo + 8 * c8) = (u32x4){ow[0], ow[1], ow[2], ow[3]}; }
    LDS_BARRIER();
    }
}
__device__ __forceinline__ void phase7(CArgs& a, const Ctx& C) {
    for (int u = C.vcu; u < 256; u += C.G) passc_ssd_unit(a, C, u);
    for (int u = C.vcu; u < 512; u += C.G) passc_hg_pair(a, C, u);
}
__device__ __forceinline__ void phase9_fill(CArgs& a, const Ctx& C, int t0, int nt) {
    LAS float* RW = (LAS float*)C.lds;
    for (int k = t0; k < D; k += nt) {
#pragma unroll
        for (int e4 = 0; e4 < 8; ++e4) { const f32x4 w = *(const f32x4*)(a.router_w + (size_t)k * NE + 4 * e4);
#pragma unroll
            for (int e = 0; e < 4; ++e) RW[(4 * e4 + e) * D + k] = w[e]; } }
}
__device__ __forceinline__ void phase9(CArgs& a, const Ctx& C, bool prefilled) {
    constexpr int NR = 4;
    const float* MOD = (const float*)(a.ws + WS_MOD); const bf16* MIX = (const bf16*)(a.ws + WS_MIX); unsigned char* HX = a.ws + WS_XN; bf16* X1 = (bf16*)(a.ws + WS_U);
    int* TOPE = (int*)(a.ws + WS_ROUTE); float* GATE = (float*)(a.ws + WS_ROUTE + 256 * 1024); int* PPOS = (int*)(a.ws + WS_ROUTE + 512 * 1024); int* ROWTOK = (int*)(a.ws + WS_ROWTOK);
    unsigned* gcnt = (unsigned*)(a.ws + WS_CTL) + CW_CNT;
    LAS float* RW = (LAS float*)C.lds;
    LAS float* LG = (LAS float*)(C.lds + 131072) + C.wave * 128;
    LAS unsigned* lcnt = (LAS unsigned*)(C.lds + LCNT_OFF); LAS unsigned* lbase = lcnt + 32;
    if (!prefilled) phase9_fill(a, C, C.tid, 512);
    if (C.tid < 32) lcnt[C.tid] = 0u;
    __syncthreads();
    LAS float* VA = (LAS float*)(C.lds + 131072 + 4096); LAS float* VB = VA + 1024;
    for (int m0 = NR * C.gw; m0 < NLAT; m0 += NR * C.NGW) {
        const int b = m0 >> 12; const float* mb = MOD + b * 6144;
        __syncthreads();
        for (int k = C.tid; k < D; k += 512) { VA[k] = mb[2048 + k] * a.mix_post[k]; VB[k] = a.ffn_pre[k] * (1.0f + mb[4096 + k]); }
        __syncthreads();
        float hv[NR][16];
#pragma unroll
        for (int r = 0; r < NR; ++r) { const size_t ro = (size_t)(m0 + r) * D; float ss = 0.f;
            f32x4 xv[4];
#pragma unroll
            for (int jj = 0; jj < 4; ++jj) { const u32x2 w = NTLOAD((const u32x2*)(MIX + ro + 256 * jj + 4 * C.lane)); xv[jj] = NTLOAD((const f32x4*)(a.x + ro + 256 * jj + 4 * C.lane));
                hv[r][4 * jj] = bflo(w.x); hv[r][4 * jj + 1] = bfhi(w.x); hv[r][4 * jj + 2] = bflo(w.y); hv[r][4 * jj + 3] = bfhi(w.y); }
#pragma unroll
            for (int i = 0; i < 16; ++i) ss += hv[r][i] * hv[r][i];
            const float rstd = rsqrtf(wave_sum(ss) * (1.0f / D) + EPS); float ss2 = 0.f;
#pragma unroll
            for (int jj = 0; jj < 4; ++jj) { const int k0 = 256 * jj + 4 * C.lane; const f32x4 va = *(const LAS f32x4*)(VA + k0);
                f32x4 x1;
#pragma unroll
                for (int e = 0; e < 4; ++e) { x1[e] = xv[jj][e] + va[e] * (hv[r][4 * jj + e] * rstd); hv[r][4 * jj + e] = x1[e]; ss2 += x1[e] * x1[e]; }
                *(u32x2*)(X1 + ro + k0) = (u32x2){cvt_pk_bf16(x1[0], x1[1]), cvt_pk_bf16(x1[2], x1[3])}; }
            const float rstd2 = rsqrtf(wave_sum(ss2) * (1.0f / D) + EPS);
#pragma unroll
            for (int jj = 0; jj < 4; ++jj) { const int k0 = 256 * jj + 4 * C.lane; const f32x4 vb = *(const LAS f32x4*)(VB + k0), s0 = *(const f32x4*)(mb + 3072 + k0);
#pragma unroll
                for (int e = 0; e < 4; ++e) hv[r][4 * jj + e] = hv[r][4 * jj + e] * rstd2 * vb[e] + s0[e];
                *(unsigned*)(HX + ro + k0) = pk4_fp8(hv[r][4 * jj], hv[r][4 * jj + 1], hv[r][4 * jj + 2], hv[r][4 * jj + 3]); }
            if (r & 1) asm volatile("" ::: "memory"); }
#pragma unroll 1
        for (int eg = 0; eg < 4; ++eg) {
            float lg[NR][8];
#pragma unroll
            for (int r = 0; r < NR; ++r)
#pragma unroll
                for (int e = 0; e < 8; ++e) lg[r][e] = 0.f;
#pragma unroll
            for (int e = 0; e < 8; ++e)
#pragma unroll
                for (int jj = 0; jj < 4; ++jj) { const f32x4 w = *(const LAS f32x4*)(RW + (8 * eg + e) * D + 256 * jj + 4 * C.lane);
#pragma unroll
                    for (int r = 0; r < NR; ++r) lg[r][e] += hv[r][4 * jj] * w[0] + hv[r][4 * jj + 1] * w[1] + hv[r][4 * jj + 2] * w[2] + hv[r][4 * jj + 3] * w[3];
                    if (jj == 3 && (e & 1)) asm volatile("" ::: "memory"); }
#pragma unroll
            for (int r = 0; r < NR; ++r) { reduce_scatter<8>(lg[r], C.lane);
                if ((C.lane & 7) == 0) LG[r * 32 + 8 * eg + (C.lane >> 3)] = lg[r][0]; }
        }
        LDS_WAIT(); asm volatile("" ::: "memory");
        if (C.lane < NR) { const int m = m0 + C.lane; float logit[32];
#pragma unroll
            for (int e4 = 0; e4 < 8; ++e4) { const f32x4 v = *(const LAS f32x4*)(LG + C.lane * 32 + 4 * e4), rb = *(const f32x4*)(a.router_b + 4 * e4);
#pragma unroll
                for (int e = 0; e < 4; ++e) logit[4 * e4 + e] = v[e] + rb[e]; }
            int te[4]; float tv[4]; unsigned taken = 0u;
#pragma unroll
            for (int k = 0; k < 4; ++k) { float best = -3.0e38f; int bi = 0;
#pragma unroll
                for (int e = 0; e < 32; ++e) { const bool better = (((taken >> e) & 1u) == 0u) && (logit[e] > best); best = better ? logit[e] : best; bi = better ? e : bi; }
                te[k] = bi; tv[k] = best; taken |= 1u << bi; }
            float ex[4], sum = 0.f;
#pragma unroll
            for (int k = 0; k < 4; ++k) { ex[k] = __expf(tv[k] - tv[0]); sum += ex[k]; }
            const float inv = 1.0f / sum;
#pragma unroll
            for (int k = 0; k < 4; ++k) { const unsigned pos = __hip_atomic_fetch_add(lcnt + te[k], 1u, __ATOMIC_RELAXED, __HIP_MEMORY_SCOPE_WORKGROUP);
                TOPE[m * 4 + k] = te[k]; GATE[m * 4 + k] = ex[k] * inv; PPOS[m * 4 + k] = (int)pos; } }
        LDS_WAIT(); asm volatile("" ::: "memory");
    }
    __syncthreads();
    if (C.tid < 32) lbase[C.tid] = atomicAdd(gcnt + C.tid, lcnt[C.tid]);
    __syncthreads();
    for (int m0 = 4 * C.gw; m0 < NLAT; m0 += 4 * C.NGW) if (C.lane < 4 * NR) { const int idx = m0 * 4 + C.lane; const int e = TOPE[idx]; const int pos = PPOS[idx] + (int)lbase[e]; PPOS[idx] = pos; ROWTOK[e * 16384 + pos] = m0 + (C.lane >> 2); }
}
__device__ __forceinline__ void moe_tables(CArgs& a, const Ctx& C) {
    const unsigned* gcnt = (const unsigned*)(a.ws + WS_CTL) + CW_CNT; LAS int* TS = (LAS int*)(C.lds + TS_OFF); LAS int* CN = TS + 36;
    if (C.tid < 64) { const int e = C.tid & 31; const int c = (int)__hip_atomic_load(gcnt + e, RLX_AGENT); const int nt = (c + 255) >> 8;
        int pre = nt;
#pragma unroll
        for (int o = 1; o < 32; o <<= 1) { const int t = __shfl_up(pre, o, 32); pre += ((C.tid & 31) >= o) ? t : 0; }
        if (C.tid < 32) { TS[e] = pre - nt; CN[e] = c; if (e == 31) TS[NE] = pre; } }
    __syncthreads();
    if (C.tid < 320) { int e = 0;
#pragma unroll
        for (int k = 1; k < NE; ++k) e += (TS[k] <= C.tid) ? 1 : 0;
        TS[80 + C.tid] = e; }
    __syncthreads();
}
__device__ __forceinline__ void phase13(CArgs& a, const Ctx& C) {
    const float* MOD = (const float*)(a.ws + WS_MOD); const unsigned char* Y2 = a.ws + WS_Y2; const bf16* X1 = (const bf16*)(a.ws + WS_U);
    const int* TOPE = (const int*)(a.ws + WS_ROUTE); const float* GATE = (const float*)(a.ws + WS_ROUTE + 256 * 1024); const int* PPOS = (const int*)(a.ws + WS_ROUTE + 512 * 1024);
    moe_tables(a, C); const LAS int* TS = (const LAS int*)(C.lds + TS_OFF);
    for (int m0 = 4 * C.gw; m0 < NLAT; m0 += 4 * C.NGW) {
        const int b = m0 >> 12; const float* gf = MOD + b * 6144 + 5120;
        int slot = 0; float gk = 0.f;
        if (C.lane < 16) { const int idx = m0 * 4 + C.lane; slot = TS[TOPE[idx]] * 256 + PPOS[idx]; gk = GATE[idx] * (1.0f / Y_SCALE); }
        u32x4 yw[4][4];
#pragma unroll
        for (int r = 0; r < 4; ++r)
#pragma unroll
            for (int k = 0; k < 4; ++k) { const int sl = __shfl(slot, 4 * r + k); yw[r][k] = NTLOAD((const u32x4*)(Y2 + (size_t)sl * D + 16 * C.lane)); }
#pragma unroll
        for (int r = 0; r < 4; ++r) { float f[16];
#pragma unroll
            for (int e = 0; e < 16; ++e) f[e] = 0.f;
#pragma unroll
            for (int k = 0; k < 4; ++k) { const float g = __shfl(gk, 4 * r + k); const unsigned ww[4] = {yw[r][k].x, yw[r][k].y, yw[r][k].z, yw[r][k].w};
#pragma unroll
                for (int e = 0; e < 4; ++e) { const f32x2 lo = __builtin_amdgcn_cvt_pk_f32_fp8((int)ww[e], false), hi = __builtin_amdgcn_cvt_pk_f32_fp8((int)ww[e], true);
                    f[4 * e] += g * lo.x; f[4 * e + 1] += g * lo.y; f[4 * e + 2] += g * hi.x; f[4 * e + 3] += g * hi.y; } }
            float ss = 0.f;
#pragma unroll
            for (int e = 0; e < 16; ++e) ss += f[e] * f[e];
            const float rstd = rsqrtf(wave_sum(ss) * (1.0f / D) + EPS);
            const size_t ro = (size_t)(m0 + r) * D; const int k0 = 16 * C.lane;
            const u32x4 xa = NTLOAD((const u32x4*)(X1 + ro + k0)), xb = NTLOAD((const u32x4*)(X1 + ro + k0 + 8)); const unsigned xw[8] = {xa.x, xa.y, xa.z, xa.w, xb.x, xb.y, xb.z, xb.w};
#pragma unroll
            for (int e4 = 0; e4 < 4; ++e4) { const f32x4 w = *(const f32x4*)(a.ffn_post + k0 + 4 * e4), g = *(const f32x4*)(gf + k0 + 4 * e4);
                f32x4 o; o[0] = bflo(xw[2 * e4]) + g[0] * (f[4 * e4] * rstd * w[0]); o[1] = bfhi(xw[2 * e4]) + g[1] * (f[4 * e4 + 1] * rstd * w[1]);
                o[2] = bflo(xw[2 * e4 + 1]) + g[2] * (f[4 * e4 + 2] * rstd * w[2]); o[3] = bfhi(xw[2 * e4 + 1]) + g[3] * (f[4 * e4 + 3] * rstd * w[3]);
                *(f32x4*)(a.out + ro + k0 + 4 * e4) = o; } }
    }
}

struct ShadowWork { CArgs* ka; const Ctx* C; int fill, first, scr_off, scr_stride;
    __device__ __forceinline__ void operator()() const {
        if (fill == 2) phase2_fill(*ka, *C, C->tid - 64, 448);
        if (fill == 9) phase9_fill(*ka, *C, C->tid - 64, 448);
        if (first >= 0) conv_shadow(*ka, *C, first, C->lds + scr_off, scr_stride); } };
__global__ void __launch_bounds__(512, 2) mega_fwd(Args a) {
    extern __shared__ __attribute__((aligned(16))) unsigned char lds_raw[];
#define MKCTX(C) Ctx C; { int t_ = threadIdx.x; asm volatile("" : "+v"(t_)); C.lds = (LAS unsigned char*)lds_raw; C.tid = t_; C.lane = t_ & 63; C.wave = __builtin_amdgcn_readfirstlane(t_ >> 6); \
        C.G = gridDim.x; const int bx_ = blockIdx.x; C.vcu = (C.G % 8 == 0) ? (bx_ % 8) * (C.G / 8) + bx_ / 8 : bx_; C.gw = C.vcu * 8 + C.wave; C.NGW = C.G * 8; }
    MKCTX(C);
    volatile LAS unsigned* MISC = (volatile LAS unsigned*)(C.lds + MISC_OFF);
    for (int u = C.tid; u < (LDS_BYTES - LDSCTL_OFF) / 4; u += 512) ((LAS unsigned*)(C.lds + LDSCTL_OFF))[u] = 0u;
    __syncthreads();
    const int lo = a.ph_lo, hi = a.ph_hi;
    CArgs* const kargs = (CArgs*)__builtin_amdgcn_kernarg_segment_ptr();
#define KA() (*[&]() { CArgs* p_ = kargs; asm volatile("" : "+s"(p_)); return p_; }())
    if (hi - lo > 1) (void)xcd_barrier_post((unsigned*)(a.ws + WS_CTL) + CW_BAR, MISC + 8);
#define BAR() XcdBarrier{(unsigned*)(KA().ws + WS_CTL) + CW_BAR, xb_xcc_id(), (volatile LAS unsigned*)(C.lds + MISC_OFF) + 8}
#define IN(k) (lo <= (k) && (k) < hi)
#define NEXTPH(k) ((k) == 4 ? 6 : ((k) == 9 ? 11 : (k) + 1))
#define SEAM(k) do { if (IN(k) && IN(NEXTPH(k))) xcd_barrier(BAR()); } while (0)
#define SEAM_WORK(k, ...) do { if (IN(k) && IN(NEXTPH(k))) xcd_barrier(BAR(), __VA_ARGS__); } while (0)
#define SHADOW(sh) ShadowWork{&KA(), &C, 0, (sh) * CONV_B, 16384, 16384}
    if (IN(0)) { MKCTX(C); for (int rp = 0; rp < NREP(0); ++rp) phase0(KA(), C); SEAM_WORK(0, SHADOW(0)); }
    if (IN(1)) { MKCTX(C); for (int rp = 0; rp < NREP(1); ++rp) phase1(KA(), C); SEAM_WORK(1, ShadowWork{&KA(), &C, 2, 1 * CONV_B, 65536, 8448}); }
    if (IN(2)) { MKCTX(C); for (int rp = 0; rp < NREP(2); ++rp) { phase2(KA(), C, IN(1) && rp == 0); __syncthreads(); } SEAM_WORK(2, SHADOW(2)); }
    if (IN(3)) { MKCTX(C); pg8::Gemm g{(const bf16*)(KA().ws + WS_XN), (const bf16*)(KA().ws + WS_WINT), D}; pg8::StaticOrder S; S.init(MROWS, NU, C.G, (int)blockIdx.x);
        pg8::EpiBf16 E{(bf16*)(KA().ws + WS_U), NU, nullptr, 0, 1.0f};
        const bool odd = (C.vcu & 1) != 0;
        if (odd) { conv_range(KA(), C, CONV_W1_HOST, NIT1); __syncthreads(); }
        pg8::gemm_phase<false>(C.lds, g, S, E, pg8::DenseRows{}); __syncthreads();
        if (!odd) conv_range(KA(), C, CONV_W1_HOST, NIT1);
        SEAM_WORK(3, SHADOW(3)); }
    if (IN(4)) { MKCTX(C); for (int rp = 0; rp < NREP(4); ++rp) phase4(KA(), C); SEAM_WORK(4, SHADOW(4)); }

    if (IN(6)) { MKCTX(C); for (int rp = 0; rp < NREP(6); ++rp) phase6(KA(), C); SEAM_WORK(6, SHADOW(5)); }
    if (IN(7)) { MKCTX(C); for (int rp = 0; rp < NREP(7); ++rp) phase7(KA(), C); SEAM_WORK(7, SHADOW(6)); }
    if (IN(8)) { MKCTX(C); pg8::Gemm g{(const bf16*)(KA().ws + WS_Y), (const bf16*)(KA().ws + WS_WOUTT), D}; pg8::StaticOrder S; S.init(NLAT, D, C.G, (int)blockIdx.x);
        pg8::EpiBf16 E{(bf16*)(KA().ws + WS_MIX), D, nullptr, 0, 1.0f}; for (int rp = 0; rp < NREP(8); ++rp) pg8::gemm_phase<false>(C.lds, g, S, E, pg8::DenseRows{}); SEAM_WORK(8, ShadowWork{&KA(), &C, 9, -1, 0, 0}); }
    if (IN(9)) { MKCTX(C); phase9(KA(), C, IN(8)); SEAM_WORK(9, ShadowWork{&KA(), &C, 0, CONV_S9, 16384, 16384}); }
    if (IN(11)) { MKCTX(C); moe_tables(KA(), C); pg8::Gemm g{(const bf16*)(KA().ws + WS_XN), (const bf16*)(KA().ws + WS_W1T), D / 2};   pg8::MoeOrder S; S.init((const LAS int*)(C.lds + TS_OFF), 8, 4, (int)blockIdx.x);
        pg8::EpiSwiglu E{KA().ws + WS_ACT, D, KA().b1, 2048}; LAS unsigned* ROWL = (LAS unsigned*)(C.lds + 131072 + 2048);
        { const int* rowtok = (const int*)(KA().ws + WS_ROWTOK); const LAS int* TSl = (const LAS int*)(C.lds + TS_OFF); const LAS int* CNl = TSl + 36;
          for (int idx = C.tid; idx < 9 * 256; idx += 512) { const int i = idx >> 8, r = idx & 255; pg8::Unit uu;
              if (S.next(i, uu)) { const int p = (uu.pm - TSl[uu.e]) * 256 + r; const int tok = p < CNl[uu.e] ? rowtok[uu.e * 16384 + p] : 0; ROWL[idx] = (unsigned)tok * 1024u; } }
          __syncthreads(); }
        pg8::GatherRows AM{ROWL};
        const bool odd = (C.vcu & 1) != 0;
#pragma unroll 1
        for (int part = 0; part < 2; ++part) {
            if ((odd && part == 0) || (!odd && part == 1)) { conv_range(KA(), C, CONV_S9 + CONV_B, NIT1 + NIT2); __syncthreads(); }
            S.i0 = odd ? 0 : 4 * part; S.n = odd ? (part == 0 ? (1 << 30) : 0) : (part == 0 ? 4 : (1 << 30));
            pg8::gemm_phase<true>(C.lds, g, S, E, AM); __syncthreads(); }
        SEAM_WORK(11, ShadowWork{&KA(), &C, 0, -1, 0, 0}); }
    if (IN(12)) { MKCTX(C); moe_tables(KA(), C); pg8::Gemm g{(const bf16*)(KA().ws + WS_ACT), (const bf16*)(KA().ws + WS_W2T), D / 2}; pg8::MoeOrder S; S.init((const LAS int*)(C.lds + TS_OFF), 4, 8, (int)blockIdx.x);
        pg8::EpiFp8 E{KA().ws + WS_Y2, D, KA().b2, D, 1.0f / (W_SCALE * ACT_SCALE)}; for (int rp = 0; rp < NREP(12); ++rp) pg8::gemm_phase<true>(C.lds, g, S, E, pg8::DenseRows{}); SEAM(12); }
    if (IN(13)) { MKCTX(C); for (int rp = 0; rp < NREP(13); ++rp) phase13(KA(), C); }
#undef IN
#undef KA
#undef SEAM
}

extern "C" void kernel_launch(void* const* d_in, const int* in_sizes, int n_in, void* d_out, int out_size, void* d_ws, size_t ws_size, hipStream_t stream) {
    static int grid = 0;
    if (grid == 0) {
        if (n_in != 26 || in_sizes[0] != NLAT * D || out_size != NLAT * D || ws_size < WS_END) {
            fprintf(stderr, "kernel_launch: unexpected shapes: n_in %d in0 %d out %d ws %zu (need %zu); nothing launched\n", n_in, n_in > 0 ? in_sizes[0] : -1, out_size, ws_size, (size_t)WS_END); grid = -1; return; }
        int dev = 0, cus = 0, per_cu = 0;
        if (hipGetDevice(&dev) != hipSuccess || hipDeviceGetAttribute(&cus, hipDeviceAttributeMultiprocessorCount, dev) != hipSuccess) { fprintf(stderr, "kernel_launch: device query failed\n"); grid = -1; return; }
        if (hipFuncSetAttribute((const void*)mega_fwd, hipFuncAttributeMaxDynamicSharedMemorySize, LDS_BYTES) != hipSuccess) { fprintf(stderr, "kernel_launch: hipFuncSetAttribute failed\n"); grid = -1; return; }
        if (hipOccupancyMaxActiveBlocksPerMultiprocessor(&per_cu, (const void*)mega_fwd, 512, LDS_BYTES) != hipSuccess || per_cu < 1)
            fprintf(stderr, "kernel_launch: note: occupancy query reports %d workgroups per CU\n", per_cu);
        (void)hipGetLastError();
        grid = cus;
        if (grid != 256) { fprintf(stderr, "kernel_launch: this kernel needs a 256-CU device (got %d)\n", grid); grid = -1; return; }
    }
    if (grid < 0) return;
    (void)hipMemsetAsync((char*)d_ws + WS_CTL, 0, CTL_ZERO_BYTES, stream);
    Args a{};
    const float** ap = (const float**)&a;
    for (int i = 0; i < 26; ++i) ap[i] = (const float*)d_in[i];
    a.out = (float*)d_out; a.ws = (unsigned char*)d_ws;
#if MK_PER_PHASE
    for (int p = 0; p < NPHASE; ++p) { a.ph_lo = p; a.ph_hi = p + 1; hipLaunchKernelGGL(mega_fwd, dim3(grid), dim3(512), LDS_BYTES, stream, a); }
#else
    a.ph_lo = 0; a.ph_hi = NPHASE; hipLaunchKernelGGL(mega_fwd, dim3(grid), dim3(512), LDS_BYTES, stream, a);
#endif
}
```

```cpp
#include <hip/hip_runtime.h>
#include <cstdio>
#include <cstdint>

#ifndef MK_PER_PHASE
#define MK_PER_PHASE 0
#endif

#ifndef PROBE_REP_MASK
#define PROBE_REP_MASK 0u
#endif
#define NREP(k) ((((PROBE_REP_MASK) >> (k)) & 1u) ? 2 : 1)
#define LAS __attribute__((address_space(3)))
typedef unsigned short bf16;
typedef short bf16x8 __attribute__((ext_vector_type(8)));
typedef float f32x4 __attribute__((ext_vector_type(4)));
typedef float f32x2 __attribute__((ext_vector_type(2)));
typedef unsigned u32x4 __attribute__((ext_vector_type(4)));
typedef unsigned u32x2 __attribute__((ext_vector_type(2)));
typedef int i32x4 __attribute__((ext_vector_type(4)));
typedef int i32x8 __attribute__((ext_vector_type(8)));

constexpr int D = 1024, NB = 4, SEQ = 4096, CTXL = 256;
constexpr int NLAT = NB * SEQ, NCTX = NB * CTXL, MROWS = NLAT + NCTX;
constexpr int NU = 3840;
constexpr int W_IN_COLS = 3856;
constexpr int SP = CTXL + SEQ;
constexpr int NCH = SP / 64;
constexpr int NPR = NCH / 2;
constexpr int NE = 32;
constexpr float EPS = 1e-6f;
constexpr int NPHASE = 14;

constexpr size_t MiB = 1u << 20;
constexpr size_t WS_CTL = 0, CTL_ZERO_BYTES = 1 * MiB;
constexpr size_t WS_MODP = 1 * MiB, WS_MOD = 5 * MiB, WS_DTRAW = 6 * MiB, WS_WINT = 8 * MiB, WS_WOUTT = 16 * MiB;
constexpr size_t WS_W1T = 18 * MiB, WS_W2T = 146 * MiB, WS_XN = 210 * MiB, WS_U = 244 * MiB;
constexpr size_t WS_BC = 372 * MiB, WS_XST = 381 * MiB, WS_XSW = 398 * MiB, WS_BT = 432 * MiB, WS_GA = 437 * MiB, WS_DTA = 439 * MiB, WS_GEND = 441 * MiB;
constexpr size_t WS_QS = 442 * MiB, WS_KS = 476 * MiB, WS_KHT = 510 * MiB, WS_VT = 544 * MiB, WS_EG = 561 * MiB;
constexpr size_t WS_DSP = WS_KHT, WS_EGP = WS_EG + 1179648;
constexpr size_t WS_DSS = 563 * MiB, WS_DSH = 631 * MiB, WS_SPS = 767 * MiB, WS_SPH = 801 * MiB, WS_Y = 869 * MiB, WS_MIX = 901 * MiB, WS_ROUTE = 965 * MiB;
constexpr size_t WS_XS = 372 * MiB, WS_ACT = 516 * MiB, WS_Y2 = 660 * MiB;
constexpr size_t WS_ROWTOK = 966 * MiB;
constexpr size_t WS_END = 968 * MiB;
constexpr int CW_BAR = 4096, CW_CNT = 16384;

constexpr int LDS_BYTES = 147456;
constexpr int LDSCTL_OFF = 144896;
constexpr int MISC_OFF = LDSCTL_OFF;
constexpr int TS_OFF = LDSCTL_OFF + 128;
constexpr int LCNT_OFF = LDSCTL_OFF + 2048;

typedef __bf16 bf16x2_t __attribute__((ext_vector_type(2)));
__device__ __forceinline__ unsigned cvt_pk_bf16(float lo, float hi) { const f32x2 v = {lo, hi}; const bf16x2_t b = __builtin_convertvector(v, bf16x2_t); return __builtin_bit_cast(unsigned, b); }
__device__ __forceinline__ unsigned pk4_fp8(float a, float b, float c, float d) { int w = __builtin_amdgcn_cvt_pk_fp8_f32(a, b, 0, false); w = __builtin_amdgcn_cvt_pk_fp8_f32(c, d, w, true); return (unsigned)w; }
constexpr float W_SCALE = 64.0f, ACT_SCALE = 4.0f, Y_SCALE = 16.0f;
__device__ __forceinline__ float bf2f(unsigned short b) { return __uint_as_float(((unsigned)b) << 16); }
__device__ __forceinline__ float bflo(unsigned w) { return __uint_as_float(w << 16); }
__device__ __forceinline__ float bfhi(unsigned w) { return __uint_as_float(w & 0xffff0000u); }
__device__ __forceinline__ float siluf(float x) { return x * __builtin_amdgcn_rcpf(1.0f + __expf(-x)); }
__device__ __forceinline__ float wave_sum(float v) {
#pragma unroll
    for (int o = 1; o < 64; o <<= 1) v += __shfl_xor(v, o);
    return v;
}
#define LDS_WAIT() asm volatile("s_waitcnt lgkmcnt(0)" ::: "memory")
#define VM_WAIT() asm volatile("s_waitcnt vmcnt(0)" ::: "memory")
#define LDS_BARRIER() do { asm volatile("s_waitcnt lgkmcnt(0)" ::: "memory"); __builtin_amdgcn_s_barrier(); asm volatile("" ::: "memory"); } while (0)
#define RLX_AGENT __ATOMIC_RELAXED, __HIP_MEMORY_SCOPE_AGENT
#define NTLOAD(p) __builtin_nontemporal_load(p)
#define MFMA16(a, b, c) __builtin_amdgcn_mfma_f32_16x16x32_bf16((a), (b), (c), 0, 0, 0)

namespace pg8 {
constexpr int BM = 256, BK = 64, HALF = 128, HTB = HALF * BK * 2, STAGE_BYTES = 8 * HTB, NXCD = 8, WGM = 8;
__host__ __device__ __forceinline__ int lds_byte(int r, int c) { const int st = (r >> 4) * 2 + (c >> 5), rr = r & 15, cc = c & 31, ob = rr * 64 + cc * 2; return st * 1024 + (ob ^ (((ob >> 9) & 1) << 5)); }
__host__ __device__ __forceinline__ void stage_rc(int b, int& R, int& C) { const int st = b / 1024, sb = b % 1024, swz = sb ^ (((sb >> 9) & 1) << 5); R = (st >> 1) * 16 + swz / 64; C = (st & 1) * 32 + (swz % 64) / 2; }
__host__ __device__ __forceinline__ int perm32(int rho) { const int n = rho >> 4, i = rho & 15; return 8 * (i >> 2) + 4 * n + (i & 3); }

struct Unit { int pm, pn, pb, e, ord; };
struct Gemm { const bf16* A; const bf16* Bt; int K; };
struct DenseRows {
    __device__ __forceinline__ size_t ubase(const Unit& u, int h, int K) const { return (size_t)(u.pm * BM + h * HALF) * K * 2; }
    __device__ __forceinline__ unsigned lane_off(const Unit&, int, int R, int K) const { return (unsigned)(R * K) * 2u; } };
struct GatherRows { const LAS unsigned* rowl;
    __device__ __forceinline__ size_t ubase(const Unit&, int, int) const { return 0; }
    __device__ __forceinline__ unsigned lane_off(const Unit& u, int h, int R, int) const { return rowl[u.ord * BM + h * HALF + R]; } };

struct StaticOrder {
    int nM, nN, nwg, G, c, i0, n;
    __device__ __forceinline__ void init(int M, int N, int G_, int c_) { nM = M / BM; nN = N / BM; nwg = nM * nN; G = G_; c = c_; i0 = 0; n = 1 << 30; }
    __device__ __forceinline__ bool next(int i_, Unit& u) const {
        if (i_ >= n) return false; const int i = i_ + i0;
        const long L = (long)i * G + c; if (L >= nwg) return false;
        int wgid = (int)L; { const int q = nwg / NXCD, r = nwg % NXCD, xcd = wgid % NXCD, off = wgid / NXCD; wgid = (xcd < r ? xcd * (q + 1) : r * (q + 1) + (xcd - r) * q) + off; }
        const int nig = WGM * nN, gid = wgid / nig, fm = gid * WGM, gsz = (nM - fm) < WGM ? (nM - fm) : WGM;
        u.pm = fm + ((wgid % nig) % gsz); u.pn = (wgid % nig) / gsz; u.pb = u.pn; u.e = 0; u.ord = i; return true;
    }
};
struct MoeOrder {
    const LAS int* ts; int ntn, mg, x, j, i0, n, nfull, tmt, tnt;
    __device__ __forceinline__ void init(const LAS int* ts_, int ntn_, int mg_, int c) { ts = ts_; ntn = ntn_; mg = mg_; x = c & 7; j = c >> 3; i0 = 0; n = 1 << 30;
        const int full = __builtin_amdgcn_readfirstlane(ts[NE]), per = mg * 8; nfull = full / per;
        const int rem = full - nfull * per, q = (rem + 7) >> 3; tmt = -1; tnt = 0;
        if (rem > 0) { const int nt = j / q, mt = nfull * per + x * q + (j - nt * q); if (nt < ntn && mt < full) { tmt = mt; tnt = nt; } } }
    __device__ __forceinline__ bool next(int i_, Unit& u) const {
        if (i_ >= n) return false; const int i = i_ + i0;
        int mt, nt;
        if (i < nfull) { mt = mg * (i * 8 + x) + (j % mg); nt = j / mg; }
        else if (i == nfull && tmt >= 0) { mt = tmt; nt = tnt; }
        else return false;
        const int e = __builtin_amdgcn_readfirstlane(ts[80 + mt]);
        u.pm = mt; u.pn = nt; u.e = e; u.pb = e * ntn + nt; u.ord = i; return true;
    }
};

struct EpiF32 {
    static constexpr bool PERM = false, SWZ = false;
    float* C; int ldc;
    __device__ __forceinline__ const float* bias_src(const Unit&) const { return nullptr; }
    __device__ __forceinline__ void operator()(const f32x4 (&acc)[2][2][4][2], const Unit& u, int wr, int wc, int fr, int fq, const LAS float*) const {
        const int row0 = u.pm * BM + wr * 64 + fr, col0 = u.pn * BM + wc * 32 + 4 * fq;
#pragma unroll
        for (int ai = 0; ai < 2; ++ai)
#pragma unroll
            for (int m = 0; m < 4; ++m) { float* rowp = C + (size_t)(row0 + ai * HALF + m * 16) * ldc + col0;
#pragma unroll
                for (int bj = 0; bj < 2; ++bj)
#pragma unroll
                    for (int n = 0; n < 2; ++n) *(f32x4*)(rowp + bj * HALF + n * 16) = acc[ai][bj][m][n]; }
    }
};
struct EpiBf16 {
    static constexpr bool PERM = true, SWZ = false;
    bf16* O; int ldc; const float* bias; int bias_stride; float scale;
    __device__ __forceinline__ const float* bias_src(const Unit& u) const { return bias ? bias + (size_t)u.e * bias_stride + u.pn * BM : nullptr; }
    __device__ __forceinline__ void operator()(const f32x4 (&acc)[2][2][4][2], const Unit& u, int wr, int wc, int fr, int fq, const LAS float* bl) const {
        const int row0 = u.pm * BM + wr * 64 + fr, col0 = u.pn * BM + wc * 32 + 8 * fq;
        f32x4 bv[2][2];
#pragma unroll
        for (int bj = 0; bj < 2; ++bj)
#pragma unroll
            for (int n = 0; n < 2; ++n) bv[bj][n] = bias ? *(const LAS f32x4*)(bl + wc * 32 + 8 * fq + bj * HALF + 4 * n) : (f32x4){0.f, 0.f, 0.f, 0.f};
#pragma unroll
        for (int ai = 0; ai < 2; ++ai)
#pragma unroll
            for (int m = 0; m < 4; ++m) { bf16* rowp = O + (size_t)(row0 + ai * HALF + m * 16) * ldc + col0;
#pragma unroll
                for (int bj = 0; bj < 2; ++bj) { const f32x4 v0 = acc[ai][bj][m][0] * scale + bv[bj][0], v1 = acc[ai][bj][m][1] * scale + bv[bj][1];
                    u32x4 w; w.x = cvt_pk_bf16(v0[0], v0[1]); w.y = cvt_pk_bf16(v0[2], v0[3]); w.z = cvt_pk_bf16(v1[0], v1[1]); w.w = cvt_pk_bf16(v1[2], v1[3]);
                    *(u32x4*)(rowp + bj * HALF) = w; } }
    }
};
struct EpiFp8 {
    static constexpr bool PERM = true, SWZ = false;
    unsigned char* O; int ldc; const float* bias; int bias_stride; float scale;
    __device__ __forceinline__ const float* bias_src(const Unit& u) const { return bias + (size_t)u.e * bias_stride + u.pn * BM; }
    __device__ __forceinline__ void operator()(const f32x4 (&acc)[2][2][4][2], const Unit& u, int wr, int wc, int fr, int fq, const LAS float* bl) const {
        const int row0 = u.pm * BM + wr * 64 + fr, col0 = u.pn * BM + wc * 32 + 8 * fq;
        f32x4 bv[2][2];
#pragma unroll
        for (int bj = 0; bj < 2; ++bj)
#pragma unroll
            for (int n = 0; n < 2; ++n) bv[bj][n] = *(const LAS f32x4*)(bl + wc * 32 + 8 * fq + bj * HALF + 4 * n) * Y_SCALE;
        const float sc = scale * Y_SCALE;
#pragma unroll
        for (int ai = 0; ai < 2; ++ai)
#pragma unroll
            for (int m = 0; m < 4; ++m) { unsigned char* rowp = O + (size_t)(row0 + ai * HALF + m * 16) * ldc + col0;
#pragma unroll
                for (int bj = 0; bj < 2; ++bj) { const f32x4 v0 = acc[ai][bj][m][0] * sc + bv[bj][0], v1 = acc[ai][bj][m][1] * sc + bv[bj][1];
                    *(u32x2*)(rowp + bj * HALF) = (u32x2){pk4_fp8(v0[0], v0[1], v0[2], v0[3]), pk4_fp8(v1[0], v1[1], v1[2], v1[3])}; } }
    }
};
__device__ __forceinline__ f32x2 swiglu2(f32x2 glu, f32x2 lin) {
    const f32x2 g = (f32x2){fminf(glu.x, 7.0f), fminf(glu.y, 7.0f)}, l = (f32x2){__builtin_amdgcn_fmed3f(lin.x, -7.0f, 7.0f), __builtin_amdgcn_fmed3f(lin.y, -7.0f, 7.0f)};
    const f32x2 ea = g * (-1.702f * 1.4426950408889634f);
    const f32x2 den = (f32x2){__builtin_amdgcn_exp2f(ea.x), __builtin_amdgcn_exp2f(ea.y)} + 1.0f;
    const f32x2 r = (f32x2){__builtin_amdgcn_rcpf(den.x), __builtin_amdgcn_rcpf(den.y)};
    return (g * r) * (l * ACT_SCALE + ACT_SCALE);
}
struct EpiSwiglu {
    static constexpr bool PERM = true, SWZ = true;
    unsigned char* O; int ldc; const float* bias; int bias_stride;
    __device__ __forceinline__ const float* bias_src(const Unit& u) const { return bias + (size_t)u.e * bias_stride + u.pn * BM; }
    __device__ __forceinline__ void operator()(const f32x4 (&acc)[2][2][4][2], const Unit& u, int wr, int wc, int fr, int fq, const LAS float* bl) const {
        const int row0 = u.pm * BM + wr * 64 + fr, col0 = u.pn * BM + wc * 32 + 8 * fq, ocol0 = col0 >> 1;
        f32x4 bv[2][2];
#pragma unroll
        for (int bj = 0; bj < 2; ++bj)
#pragma unroll
            for (int n = 0; n < 2; ++n) { const f32x4 t = *(const LAS f32x4*)(bl + wc * 32 + 8 * fq + bj * HALF + 4 * n); bv[bj][n] = (f32x4){t[0], t[2], t[1], t[3]}; }
#pragma unroll
        for (int ai = 0; ai < 2; ++ai)
#pragma unroll
            for (int m = 0; m < 4; ++m) { unsigned char* rowp = O + (size_t)(row0 + ai * HALF + m * 16) * ldc + ocol0;
#pragma unroll
                for (int bj = 0; bj < 2; ++bj) { const f32x4 v0 = acc[ai][bj][m][0] * (1.0f / W_SCALE) + bv[bj][0], v1 = acc[ai][bj][m][1] * (1.0f / W_SCALE) + bv[bj][1];
                    const f32x2 o0 = swiglu2((f32x2){v0[0], v0[1]}, (f32x2){v0[2], v0[3]}), o1 = swiglu2((f32x2){v1[0], v1[1]}, (f32x2){v1[2], v1[3]});
                    *(unsigned*)(rowp + bj * (HALF / 2)) = pk4_fp8(o0.x, o0.y, o1.x, o1.y); } }
    }
};

template <bool F8, class Epi, class Sched, class AMap>
__device__ __forceinline__ void gemm_phase(LAS unsigned char* lds, const Gemm g, const Sched& S, const Epi& E, const AMap& AM) {
    const int tid = threadIdx.x, wid = __builtin_amdgcn_readfirstlane(tid >> 6), lane = tid & 63, wr = wid >> 2, wc = wid & 3, fr = lane & 15, fq = lane >> 4;
    const int K = g.K, nt = K / BK;
    unsigned voffB[2];
#pragma unroll
    for (int i = 0; i < 2; ++i) { int R, C; stage_rc(tid * 16 + i * 8192, R, C); int Rb = Epi::PERM ? ((R & ~31) + perm32(R & 31)) : R; if constexpr (Epi::SWZ) Rb = (Rb & ~3) | ((Rb & 1) << 1) | ((Rb >> 1) & 1);
        voffB[i] = (unsigned)(Rb * K + C) * 2u; }
    unsigned vA0[2], vA1[2], nA0[2], nA1[2];
#define PG8_AOFF(u, o0, o1) do { int _t = tid; asm volatile("" : "+v"(_t));   _Pragma("unroll") for (int _i = 0; _i < 2; ++_i) { int _R, _C; stage_rc(_t * 16 + _i * 8192, _R, _C); \
        o0[_i] = AM.lane_off(u, 0, _R, K) + (unsigned)_C * 2u; o1[_i] = AM.lane_off(u, 1, _R, K) + (unsigned)_C * 2u; } } while (0)
    const size_t kstep = (size_t)(BK * 2);
    const size_t hstep = (size_t)HALF * K * 2;
    const size_t tstep = 2 * hstep;
    const unsigned ldsw = (unsigned)wid * 1024u;
    const int aoff = lds_byte(wr * 64 + fr, fq * 8), boff = lds_byte(wc * 32 + fr, fq * 8);
#define PG8_SA(b, h) (((b) * 2 + (h)) * HTB)
#define PG8_SB(b, h) ((4 + (b) * 2 + (h)) * HTB)
#define PG8_STAGE(bufoff, gbase, voff) do { _Pragma("unroll") for (int _i = 0; _i < 2; ++_i) \
        __builtin_amdgcn_global_load_lds((const unsigned*)((const char*)(gbase) + (voff)[_i]), (LAS unsigned*)(lds + (bufoff) + ldsw + _i * 8192), 16, 0, 0); } while (0)
#define PG8_LDA(dst, b, h) do { _Pragma("unroll") for (int m = 0; m < 4; ++m) { const i32x4 _lo = *(const LAS i32x4*)(lds + PG8_SA(b, h) + aoff + m * 2048), _hi = *(const LAS i32x4*)(lds + PG8_SA(b, h) + aoff + m * 2048 + 1024); \
        dst[m] = __builtin_shufflevector(_lo, _hi, 0, 1, 2, 3, 4, 5, 6, 7); } } while (0)
#define PG8_LDB(dst, b, h) do { _Pragma("unroll") for (int n = 0; n < 2; ++n) { const i32x4 _lo = *(const LAS i32x4*)(lds + PG8_SB(b, h) + boff + n * 2048), _hi = *(const LAS i32x4*)(lds + PG8_SB(b, h) + boff + n * 2048 + 1024); \
        dst[n] = __builtin_shufflevector(_lo, _hi, 0, 1, 2, 3, 4, 5, 6, 7); } } while (0)
#define PG8_LO(x) __builtin_bit_cast(bf16x8, __builtin_shufflevector(x, x, 0, 1, 2, 3))
#define PG8_HI(x) __builtin_bit_cast(bf16x8, __builtin_shufflevector(x, x, 4, 5, 6, 7))
#define PG8_MMA(ai, bj, At, Bt) do { __builtin_amdgcn_s_setprio(1); _Pragma("unroll") for (int m = 0; m < 4; ++m) _Pragma("unroll") for (int n = 0; n < 2; ++n) { \
        if constexpr (F8) asm volatile("v_mfma_scale_f32_16x16x128_f8f6f4 %0, %1, %2, %0, %3, %3 op_sel_hi:[0,0,0]" : "+v"(acc[ai][bj][m][n]) : "v"(Bt[n]), "v"(At[m]), "v"(f8scale)); \
        else { acc[ai][bj][m][n] = __builtin_amdgcn_mfma_f32_16x16x32_bf16(PG8_LO(Bt[n]), PG8_LO(At[m]), acc[ai][bj][m][n], 0, 0, 0); \
               acc[ai][bj][m][n] = __builtin_amdgcn_mfma_f32_16x16x32_bf16(PG8_HI(Bt[n]), PG8_HI(At[m]), acc[ai][bj][m][n], 0, 0, 0); } } \
        __builtin_amdgcn_s_setprio(0); } while (0)
#define PG8_WAIT_V(n) asm volatile("s_waitcnt vmcnt(" #n ")" ::: "memory")
#define PG8_WAIT_L(n) asm volatile("s_waitcnt lgkmcnt(" #n ")" ::: "memory")
#define PG8_BAR __builtin_amdgcn_s_barrier()
#define PG8_SCHED __builtin_amdgcn_sched_barrier(0)
    Unit cur, nxt; int ui = 0;
    if (!S.next(0, cur)) return;
    f32x4 acc[2][2][4][2];
#pragma unroll
    for (int a = 0; a < 2; ++a)
#pragma unroll
        for (int b = 0; b < 2; ++b)
#pragma unroll
            for (int m = 0; m < 4; ++m)
#pragma unroll
                for (int n = 0; n < 2; ++n) acc[a][b][m][n] = (f32x4){0.f, 0.f, 0.f, 0.f};
    i32x8 At[4], B0[2], B1[2];
    int f8scale = 0x7F7F7F7F; asm volatile("" : "+v"(f8scale));
    LAS float* const biasl = (LAS float*)(lds + STAGE_BYTES);
#define PG8_BIAS(u, slot) do { const float* _bs = E.bias_src(u); if (_bs != nullptr && wid == 0) { int _ln = lane; asm volatile("" : "+v"(_ln));     \
        __builtin_amdgcn_global_load_lds((const unsigned*)(_bs + _ln * 4), (LAS unsigned*)(biasl + (slot) * 256), 16, 0, 0); } } while (0)
    PG8_BIAS(cur, 0);
    const char* cA0 = (const char*)g.A + AM.ubase(cur, 0, K); const char* cA1 = (const char*)g.A + AM.ubase(cur, 1, K); const char* cB = (const char*)g.Bt + (size_t)cur.pb * tstep;
    PG8_AOFF(cur, vA0, vA1);
    PG8_STAGE(PG8_SB(0, 0), cB, voffB); PG8_STAGE(PG8_SB(0, 1), cB + hstep, voffB); PG8_STAGE(PG8_SA(0, 0), cA0, vA0); PG8_STAGE(PG8_SA(0, 1), cA1, vA1);
    if (wr == 1) PG8_BAR;
    PG8_WAIT_V(2); PG8_BAR;
    PG8_STAGE(PG8_SB(1, 0), cB + kstep, voffB); PG8_STAGE(PG8_SA(1, 0), cA0 + kstep, vA0); PG8_STAGE(PG8_SB(1, 1), cB + hstep + kstep, voffB);
    PG8_WAIT_V(6); PG8_BAR;
    for (;;) {
        const bool has_next = S.next(ui + 1, nxt);
        const char* nB = has_next ? (const char*)g.Bt + (size_t)nxt.pb * tstep : cB;
        const char* nxA0 = has_next ? (const char*)g.A + AM.ubase(nxt, 0, K) : cA0; const char* nxA1 = has_next ? (const char*)g.A + AM.ubase(nxt, 1, K) : cA1;
        if (has_next) { PG8_AOFF(nxt, nA0, nA1); PG8_BIAS(nxt, (ui + 1) & 1); } else { nA0[0] = vA0[0]; nA0[1] = vA0[1]; nA1[0] = vA1[0]; nA1[1] = vA1[1]; }
#pragma unroll 1
        for (int t = 0; t < nt; t += 2) {
            const bool last = (t == nt - 2);
            const char* a1 = cA1 + (size_t)(t + 1) * kstep;
            const char* a2 = last ? nxA0 : cA0 + (size_t)(t + 2) * kstep; const char* a2h = last ? nxA1 : cA1 + (size_t)(t + 2) * kstep; const char* b2 = last ? nB : cB + (size_t)(t + 2) * kstep;
            const char* a3 = a2 + kstep; const char* b3 = b2 + kstep;
            unsigned w0[2], w1[2];
            w0[0] = last ? nA0[0] : vA0[0]; w0[1] = last ? nA0[1] : vA0[1]; w1[0] = last ? nA1[0] : vA1[0]; w1[1] = last ? nA1[1] : vA1[1];
            PG8_LDB(B0, 0, 0); PG8_LDB(B1, 0, 1); PG8_SCHED; PG8_LDA(At, 0, 0); PG8_STAGE(PG8_SA(1, 1), a1, vA1);
            PG8_WAIT_V(8); PG8_WAIT_L(0); PG8_BAR; PG8_MMA(0, 0, At, B0); PG8_MMA(0, 1, At, B1); PG8_BAR; PG8_SCHED;
            PG8_LDA(At, 0, 1); PG8_STAGE(PG8_SB(0, 0), b2, voffB); PG8_STAGE(PG8_SB(0, 1), b2 + hstep, voffB); PG8_STAGE(PG8_SA(0, 0), a2, w0);
            PG8_WAIT_V(8); PG8_WAIT_L(0); PG8_BAR; PG8_MMA(1, 0, At, B0); PG8_MMA(1, 1, At, B1); PG8_BAR; PG8_SCHED;
            PG8_LDB(B0, 1, 0); PG8_LDB(B1, 1, 1); PG8_SCHED; PG8_LDA(At, 1, 0); PG8_STAGE(PG8_SA(0, 1), a2h, w1);
            PG8_WAIT_V(8); PG8_WAIT_L(0); PG8_BAR; PG8_MMA(0, 0, At, B0); PG8_MMA(0, 1, At, B1); PG8_BAR; PG8_SCHED;
            PG8_LDA(At, 1, 1); PG8_STAGE(PG8_SB(1, 0), b3, voffB); PG8_STAGE(PG8_SB(1, 1), b3 + hstep, voffB); PG8_STAGE(PG8_SA(1, 0), a3, w0);
            PG8_WAIT_V(8); PG8_WAIT_L(0); PG8_BAR; PG8_MMA(1, 0, At, B0); PG8_MMA(1, 1, At, B1); PG8_BAR; PG8_SCHED;
        }
        if (wr == 0) PG8_BAR;
        if constexpr (F8) asm volatile("s_nop 15\n\ts_nop 15" ::: "memory");
        { int ln_e = lane; asm volatile("" : "+v"(ln_e));
          E(acc, cur, wr, wc, ln_e & 15, ln_e >> 4, biasl + (ui & 1) * 256); }
        if (!has_next) break;
#pragma unroll
        for (int a = 0; a < 2; ++a)
#pragma unroll
            for (int b = 0; b < 2; ++b)
#pragma unroll
                for (int m = 0; m < 4; ++m)
#pragma unroll
                    for (int n = 0; n < 2; ++n) acc[a][b][m][n] = (f32x4){0.f, 0.f, 0.f, 0.f};
        cur = nxt; cB = nB; cA0 = nxA0; cA1 = nxA1; ++ui; vA0[0] = nA0[0]; vA0[1] = nA0[1]; vA1[0] = nA1[0]; vA1[1] = nA1[1];
        if (wr == 1) PG8_BAR;
    }
    PG8_WAIT_V(0);
    PG8_BAR;
#undef PG8_AOFF
#undef PG8_BIAS
#undef PG8_SA
#undef PG8_SB
#undef PG8_STAGE
#undef PG8_LDA
#undef PG8_LDB
#undef PG8_MMA
#undef PG8_LO
#undef PG8_HI
#undef PG8_WAIT_V
#undef PG8_WAIT_L
#undef PG8_BAR
#undef PG8_SCHED
}
}

#define XB_TMO      128
#define XB_XCNT(j)  (256  + 64 * (j))
#define XB_XSUB(j)  (1280 + 64 * (j))
#define XB_XGEN(j)  (2304 + 64 * (j))
#define XB_TOP      3328
#define XB_TOPGEN   3392
#define XCD_BAR_WORDS 3456
#define XB_SPIN_CAP (1u << 22)
__device__ __forceinline__ unsigned xb_ld(unsigned* p)              { return __hip_atomic_load(p, __ATOMIC_RELAXED, __HIP_MEMORY_SCOPE_AGENT); }
__device__ __forceinline__ unsigned xb_add(unsigned* p, unsigned v) { return __hip_atomic_fetch_add(p, v, __ATOMIC_RELAXED, __HIP_MEMORY_SCOPE_AGENT); }
__device__ __forceinline__ unsigned xb_xcc_id() { return (unsigned)__builtin_amdgcn_s_getreg((3 << 11) | 20) & 0xFu; }
#define XB_SPIN(cond, bar) do { unsigned _sp = 0; while (cond) { __builtin_amdgcn_s_sleep(1); \
    if ((++_sp & 255u) == 0u) { if (xb_ld(&(bar)[XB_TMO])) break; if (_sp > XB_SPIN_CAP) { atomicAdd(&(bar)[XB_TMO], 1u); break; } } } } while (0)
struct XcdBarrier { unsigned* bar; unsigned x; volatile LAS unsigned* st; };
__device__ __forceinline__ XcdBarrier xcd_barrier_post(unsigned* bar, volatile LAS unsigned* st) {
    XcdBarrier b; b.bar = bar; b.x = xb_xcc_id(); b.st = st;
    if (threadIdx.x == 0) (void)xb_add(&bar[XB_XCNT(b.x)], 1u);
    return b;
}
__device__ __forceinline__ void xcd_barrier_complete(unsigned* bar, unsigned x, unsigned& nloc, unsigned& nx) {
    const unsigned G = gridDim.x * gridDim.y * gridDim.z;
    unsigned sum, cnt, mine, sp = 0u;
    for (;;) {
        sum = 0u; cnt = 0u; mine = 0u;
#pragma unroll
        for (unsigned j = 0; j < 16; ++j) { const unsigned c = xb_ld(&bar[XB_XCNT(j)]); sum += c; cnt += (c > 0u) ? 1u : 0u; mine = (j == x) ? c : mine; }
        if (sum == G) break;
        __builtin_amdgcn_s_sleep(1);
        if ((++sp & 255u) == 0u) { if (xb_ld(&bar[XB_TMO])) break; if (sp > XB_SPIN_CAP) { atomicAdd(&bar[XB_TMO], 1u); break; } }
    }
    nloc = mine > 0u ? mine : 1u; nx = cnt > 0u ? cnt : 1u;
}
struct NoWork { __device__ __forceinline__ void operator()() const {} };
template <class F = NoWork> __device__ __forceinline__ void xcd_barrier(const XcdBarrier& b, F work = F{}) {
    asm volatile("s_waitcnt vmcnt(0)" ::: "memory");
    __syncthreads();
    if (threadIdx.x >= 64) work();
    if (threadIdx.x == 0) {
        unsigned* bar = b.bar;
        __builtin_amdgcn_s_waitcnt(0);
        unsigned nloc = b.st[0], nx = b.st[1];
        if (nloc == 0u) { xcd_barrier_complete(bar, b.x, nloc, nx); b.st[0] = nloc; b.st[1] = nx; }
        const unsigned old = xb_add(&bar[XB_XSUB(b.x)], 1u);
        const unsigned gen = old / nloc;
        if (old + 1u == (gen + 1u) * nloc) {
            __builtin_amdgcn_fence(__ATOMIC_RELEASE, "agent");
            asm volatile("s_waitcnt vmcnt(0)" ::: "memory");
            const unsigned og = xb_add(&bar[XB_TOP], 1u);
            const unsigned tg = og / nx;
            if (og + 1u == (tg + 1u) * nx) xb_add(&bar[XB_TOPGEN], 1u);
            else XB_SPIN(xb_ld(&bar[XB_TOPGEN]) == tg, bar);
            __builtin_amdgcn_fence(__ATOMIC_ACQUIRE, "agent");
            xb_add(&bar[XB_XGEN(b.x)], 1u);
            asm volatile("s_waitcnt vmcnt(0)" ::: "memory");
        } else {
            XB_SPIN(xb_ld(&bar[XB_XGEN(b.x)]) == gen, bar);
            __builtin_amdgcn_fence(__ATOMIC_ACQUIRE, "agent");
            asm volatile("s_waitcnt vmcnt(0)" ::: "memory");
        }
    }
    __syncthreads();
}

struct Args {
    const float *x, *c, *ctx, *c_ctx, *ada_w, *ada_b, *mix_pre, *mix_post, *w_in, *w_out, *conv_w, *conv_b, *dt_bias, *a_log, *ssd_d, *ssd_norm,
                *hg_lb, *hg_norm, *ffn_pre, *ffn_post, *router_w, *router_b, *w1, *b1, *w2, *b2;
    float* out; unsigned char* ws; int ph_lo, ph_hi;
};

typedef const Args __attribute__((address_space(4))) CArgs;
struct Ctx { LAS unsigned char* lds; int tid, lane, wave, vcu, G, gw, NGW; };

__device__ __forceinline__ void transpose_item(const float* W, int ldw, int K, bf16* WT, int dst_row0, int nblk, LAS float* scr, int item, int lane) {
    const int kb = item / nblk, nb = item % nblk, k0 = 64 * kb, n0 = 32 * nb;
    float ld[32];
#pragma unroll
    for (int i = 0; i < 32; ++i) ld[i] = W[(size_t)(k0 + 2 * i + (lane >> 5)) * ldw + n0 + (lane & 31)];
#pragma unroll
    for (int i = 0; i < 32; ++i) scr[(2 * i + (lane >> 5)) * 33 + (lane & 31)] = ld[i];
    LDS_WAIT(); asm volatile("" ::: "memory");
    const int c = lane & 7;
#pragma unroll
    for (int j = 0; j < 4; ++j) { const int n = (lane >> 3) + 8 * j; const LAS float* s = scr + (8 * c) * 33 + n;
        u32x4 o; o.x = cvt_pk_bf16(s[0 * 33], s[1 * 33]); o.y = cvt_pk_bf16(s[2 * 33], s[3 * 33]); o.z = cvt_pk_bf16(s[4 * 33], s[5 * 33]); o.w = cvt_pk_bf16(s[6 * 33], s[7 * 33]);
        *(u32x4*)(WT + (size_t)(dst_row0 + n0 + n) * K + k0 + 8 * c) = o; }
    LDS_WAIT(); asm volatile("" ::: "memory");
}
__device__ __forceinline__ void transpose_item_f8(const float* W, int ldw, int K, unsigned char* WT, int nblk, LAS float* scr, int item, int lane, float scale) {
    const int kb = item / nblk, nb = item % nblk, k0 = 64 * kb, n0 = 32 * nb;
    float ld[32];
#pragma unroll
    for (int i = 0; i < 32; ++i) ld[i] = __builtin_nontemporal_load(&W[(size_t)(k0 + 2 * i + (lane >> 5)) * ldw + n0 + (lane & 31)]);
#pragma unroll
    for (int i = 0; i < 32; ++i) scr[(2 * i + (lane >> 5)) * 33 + (lane & 31)] = ld[i] * scale;
    LDS_WAIT(); asm volatile("" ::: "memory");
    const int c = lane & 7;
#pragma unroll
    for (int j = 0; j < 4; ++j) { const int n = (lane >> 3) + 8 * j; const LAS float* sp = scr + (8 * c) * 33 + n;
        u32x2 o; o.x = pk4_fp8(sp[0 * 33], sp[1 * 33], sp[2 * 33], sp[3 * 33]); o.y = pk4_fp8(sp[4 * 33], sp[5 * 33], sp[6 * 33], sp[7 * 33]);
        *(u32x2*)(WT + (size_t)(n0 + n) * K + k0 + 8 * c) = o; }
    LDS_WAIT(); asm volatile("" ::: "memory");
}
__device__ __forceinline__ void phase0(CArgs& a, const Ctx& C) {
    LAS float* scr = (LAS float*)(C.lds + C.wave * 16384);
    bf16* WINT = (bf16*)(a.ws + WS_WINT); bf16* WOUTT = (bf16*)(a.ws + WS_WOUTT);
    float* MODP = (float*)(a.ws + WS_MODP);
    constexpr int I_GEMV = 96 * 32, I_INA = 16 * 40, I_INB = 16 * 80, I_OUT = 16 * 32;
    constexpr int NITEMS = I_GEMV + I_INA + I_INB + I_OUT;
    for (int it = C.gw; it < NITEMS; it += C.NGW) {
        int r = it;
        if (r < I_GEMV) {
            const int cg = r % 96, ks = r / 96, col = 64 * cg + C.lane, k0 = 32 * ks;
            float sv[5];
            { const int kk = C.lane & 31;
#pragma unroll
              for (int b = 0; b < 4; ++b) sv[b] = siluf(a.c[b * D + k0 + kk]);
              sv[4] = siluf(a.c_ctx[k0 + kk]); }
            float acc[5] = {0.f, 0.f, 0.f, 0.f, 0.f};
#pragma unroll 8
            for (int kk = 0; kk < 32; ++kk) { const float w = a.ada_w[(size_t)(k0 + kk) * 6144 + col];
#pragma unroll
                for (int b = 0; b < 5; ++b) acc[b] += __shfl(sv[b], kk) * w; }
#pragma unroll
            for (int b = 0; b < 5; ++b) MODP[(size_t)(ks * 5 + b) * 6144 + col] = acc[b];
            continue;
        }
        r -= I_GEMV;
        if (r < I_INA) { transpose_item(a.w_in, W_IN_COLS, D, WINT, 0, 40, scr, r, C.lane); continue; } r -= I_INA;
        if (r < I_INB) { transpose_item(a.w_in + 1296, W_IN_COLS, D, WINT, 1280, 80, scr, r, C.lane); continue; } r -= I_INB;
        transpose_item(a.w_out, D, D, WOUTT, 0, 32, scr, r, C.lane);
    }
}
#ifndef CONV_SH
#define CONV_SH 2
#endif
constexpr int NIT1 = 32 * 16 * 64, NIT2 = 32 * 16 * 32, CONV_B = 256 * 7 * CONV_SH;
constexpr int CONV_SH_END = 7 * CONV_B;
constexpr int CONV_W1_HOST = CONV_SH_END < NIT1 ? CONV_SH_END : NIT1;
constexpr int CONV_S9 = CONV_SH_END > NIT1 ? CONV_SH_END : NIT1;
__device__ __forceinline__ void conv_item(CArgs& a, LAS float* scr, int lane, int it) {
    const bool w1 = it < NIT1; const int r = w1 ? it : it - NIT1, per = w1 ? 16 * 64 : 16 * 32, e = r / per, ri = r % per;
    const float* W = w1 ? a.w1 + (size_t)e * D * 2048 : a.w2 + (size_t)e * D * D; unsigned char* WT = w1 ? a.ws + WS_W1T + (size_t)e * 2048 * D : a.ws + WS_W2T + (size_t)e * D * D;
    transpose_item_f8(W, w1 ? 2048 : D, D, WT, w1 ? 64 : 32, scr, ri, lane, W_SCALE);
}
__device__ __forceinline__ void conv_range(CArgs& a, const Ctx& C, int lo, int hi) {
    LAS float* scr = (LAS float*)(C.lds + C.wave * 16384);
#pragma unroll 1
    for (int it = lo + C.gw; it < hi; it += C.NGW) conv_item(a, scr, C.lane, it);
}
__device__ __forceinline__ void conv_shadow(CArgs& a, const Ctx& C, int first, LAS unsigned char* scr_base, int scr_stride) {
    LAS float* scr = (LAS float*)(scr_base + (C.wave - 1) * scr_stride);
    const int it0 = first + (C.vcu * 7 + (C.wave - 1)) * CONV_SH;
#pragma unroll 1
    for (int j = 0; j < CONV_SH; ++j) if (it0 + j < NIT1 + NIT2) conv_item(a, scr, C.lane, it0 + j);
}
__device__ __forceinline__ void phase1(CArgs& a, const Ctx& C) {
    const float* MODP = (const float*)(a.ws + WS_MODP); float* MOD = (float*)(a.ws + WS_MOD);
    for (int i = C.vcu * 512 + C.tid; i < 5 * 6144; i += C.G * 512) {
        const int col = i % 6144, b = i / 6144; float s = a.ada_b[col];
#pragma unroll 8
        for (int ks = 0; ks < 32; ++ks) s += MODP[(size_t)(ks * 5 + b) * 6144 + col];
        MOD[i] = s;
    }
}
template <int N, int O> struct RS { template <int M> static __device__ __forceinline__ void run(float (&v)[M], int lane) {
    const bool up = (lane & O) != 0;
#pragma unroll
    for (int i = 0; i < N / 2; ++i) { const float keep = up ? v[i + N / 2] : v[i], send = up ? v[i] : v[i + N / 2]; v[i] = keep + __shfl_xor(send, O); }
    RS<N / 2, O / 2>::run(v, lane); } };
template <int O> struct RS<1, O> { template <int M> static __device__ __forceinline__ void run(float (&v)[M], int) { v[0] += __shfl_xor(v[0], O); RS<1, O / 2>::run(v, 0); } };
template <> struct RS<1, 0> { template <int M> static __device__ __forceinline__ void run(float (&)[M], int) {} };
template <int N> __device__ __forceinline__ void reduce_scatter(float (&v)[N], int lane) { RS<N, 32>::run(v, lane); }
__device__ __forceinline__ void phase2_fill(CArgs& a, const Ctx& C, int t0, int nt) {
    LAS f32x4* WD = (LAS f32x4*)C.lds;
    for (int idx = t0; idx < 16 * 4 * 64; idx += nt) { const int ln = idx & 63, cg = (idx >> 6) & 3, je = idx >> 8, j = je >> 3, e = je & 7, k = 8 * ln + 512 * j + e;
        WD[idx] = *(const f32x4*)(a.w_in + (size_t)k * W_IN_COLS + 1280 + 4 * cg); }
}
__device__ __forceinline__ void phase2(CArgs& a, const Ctx& C, bool prefilled) {
    const float* MOD = (const float*)(a.ws + WS_MOD); bf16* XN = (bf16*)(a.ws + WS_XN); float* DTRAW = (float*)(a.ws + WS_DTRAW);
    LAS f32x4* WD = (LAS f32x4*)C.lds;
    const int rbase = (MROWS / 256) * C.vcu; constexpr int NPAIR = MROWS / 256 / 2;
    f32x4 nx[2][2][2];
    { const int m = rbase + 2 * C.wave;
#pragma unroll
      for (int r = 0; r < 2; ++r) { const int mr = m + r; const float* xrow = mr < NLAT ? a.x + (size_t)mr * D : a.ctx + (size_t)(mr - NLAT) * D;
#pragma unroll
        for (int j = 0; j < 2; ++j) { nx[r][j][0] = NTLOAD((const f32x4*)(xrow + 8 * C.lane + 512 * j)); nx[r][j][1] = NTLOAD((const f32x4*)(xrow + 8 * C.lane + 512 * j + 4)); } } }
    if (!prefilled) phase2_fill(a, C, C.tid, 512);
    __syncthreads();
#pragma unroll 1
    for (int p = C.wave; p < NPAIR; p += 8) {
        const int m = rbase + 2 * p, b = m < NLAT ? (m >> 12) : 4;
        const float* sh = MOD + b * 6144, *sc = sh + 1024;
        float h[2][2][8]; float ss[2] = {0.f, 0.f};
#pragma unroll
        for (int r = 0; r < 2; ++r)
#pragma unroll
            for (int j = 0; j < 2; ++j) { const f32x4 v0 = nx[r][j][0], v1 = nx[r][j][1];
#pragma unroll
                for (int e = 0; e < 4; ++e) { h[r][j][e] = v0[e]; h[r][j][4 + e] = v1[e]; ss[r] += v0[e] * v0[e] + v1[e] * v1[e]; } }
        { const int m2 = p + 8 < NPAIR ? m + 16 : m;
#pragma unroll
          for (int r = 0; r < 2; ++r) { const int mr = m2 + r; const float* xrow = mr < NLAT ? a.x + (size_t)mr * D : a.ctx + (size_t)(mr - NLAT) * D;
#pragma unroll
            for (int j = 0; j < 2; ++j) { nx[r][j][0] = NTLOAD((const f32x4*)(xrow + 8 * C.lane + 512 * j)); nx[r][j][1] = NTLOAD((const f32x4*)(xrow + 8 * C.lane + 512 * j + 4)); } } }
        const float rstd[2] = {rsqrtf(wave_sum(ss[0]) * (1.0f / D) + EPS), rsqrtf(wave_sum(ss[1]) * (1.0f / D) + EPS)};
#pragma unroll
        for (int j = 0; j < 2; ++j) { const int k0 = 8 * C.lane + 512 * j;
#pragma unroll
            for (int e4 = 0; e4 < 2; ++e4) { const f32x4 w = *(const f32x4*)(a.mix_pre + k0 + 4 * e4), s1 = *(const f32x4*)(sc + k0 + 4 * e4), s0 = *(const f32x4*)(sh + k0 + 4 * e4);
#pragma unroll
                for (int r = 0; r < 2; ++r)
#pragma unroll
                    for (int e = 0; e < 4; ++e) h[r][j][4 * e4 + e] = h[r][j][4 * e4 + e] * rstd[r] * w[e] * (1.0f + s1[e]) + s0[e]; }
#pragma unroll
            for (int r = 0; r < 2; ++r) { u32x4 o; o.x = cvt_pk_bf16(h[r][j][0], h[r][j][1]); o.y = cvt_pk_bf16(h[r][j][2], h[r][j][3]); o.z = cvt_pk_bf16(h[r][j][4], h[r][j][5]); o.w = cvt_pk_bf16(h[r][j][6], h[r][j][7]);
                *(u32x4*)(XN + (size_t)(m + r) * D + k0) = o; } }
        float acc0[16], acc1[16];
#pragma unroll
        for (int i = 0; i < 16; ++i) { acc0[i] = 0.f; acc1[i] = 0.f; }
#pragma unroll
        for (int j = 0; j < 2; ++j)
#pragma unroll
            for (int e = 0; e < 8; ++e)
#pragma unroll
                for (int cg = 0; cg < 4; ++cg) { const f32x4 w = WD[((j * 8 + e) * 4 + cg) * 64 + C.lane];
#pragma unroll
                    for (int i = 0; i < 4; ++i) { acc0[4 * cg + i] += h[0][j][e] * w[i]; acc1[4 * cg + i] += h[1][j][e] * w[i]; }
                    if (cg == 3 && (e & 1)) asm volatile("" ::: "memory"); }
        reduce_scatter<16>(acc0, C.lane); reduce_scatter<16>(acc1, C.lane);
        if ((C.lane & 3) == 0) { DTRAW[(size_t)m * 16 + (C.lane >> 2)] = acc0[0]; DTRAW[(size_t)(m + 1) * 16 + (C.lane >> 2)] = acc1[0]; }
    }
}
__device__ __forceinline__ void prep_ssd_unit(CArgs& a, const Ctx& C, int unit) {
    const bf16* U = (const bf16*)(a.ws + WS_U); const float* DTRAW = (const float*)(a.ws + WS_DTRAW);
    bf16* BC = (bf16*)(a.ws + WS_BC); bf16* XST = (bf16*)(a.ws + WS_XST);
    float* GA = (float*)(a.ws + WS_GA); float* DTA = (float*)(a.ws + WS_DTA); float* GEND = (float*)(a.ws + WS_GEND); u32x2* DSS = (u32x2*)(a.ws + WS_DSS);
    const int b = unit / NCH, tc = unit % NCH, s0 = 64 * tc; const bool isctx = tc < 4;
    const int rowbase = isctx ? NLAT + b * CTXL + s0 : b * SEQ + (s0 - CTXL);
    const int ilo = isctx ? -s0 : CTXL - s0, ihi = isctx ? CTXL - s0 : SP - s0;
    LAS float* dtl = (LAS float*)C.lds; LAS float* al = dtl + 1024; LAS float* wl = al + 1024;
    LAS bf16* XTl = (LAS bf16*)(C.lds + 12288);
    int ltid = C.tid; asm volatile("" : "+v"(ltid));
    const int ch0 = 2 * ltid;
    unsigned uw[68];
    if (C.tid < 384) { const bf16* up = U + (size_t)rowbase * NU + 512 + ch0;
#pragma unroll
        for (int t = 0; t < 68; ++t) { const int i = t - 2; uw[t] = (i >= ilo && i < ihi) ? *(const unsigned*)(up + (ptrdiff_t)i * NU) : 0u; } }
#pragma unroll
    for (int pi = 0; pi < 2; ++pi) { const int dh = 2 * C.wave + pi, dir = dh >> 3, h = dh & 7, i = C.lane;
        const float xv = DTRAW[(size_t)(rowbase + i) * 16 + dh] + a.dt_bias[dh];
        const float dt = fmaxf(xv, 0.f) + log1pf(__expf(-fabsf(xv)));
        const float av = -dt * __expf(a.a_log[dh]);
        float pre = av;
#pragma unroll
        for (int o = 1; o < 64; o <<= 1) { const float t = __shfl_up(pre, o); pre += (i >= o) ? t : 0.f; }
        const float tot = __shfl(pre, 63);
        const float g = dir == 0 ? pre : tot - pre + av;
        const float gend = tot;
        al[dh * 64 + i] = g; dtl[dh * 64 + i] = dt; wl[dh * 64 + i] = dt * __expf(gend - g);
        const size_t o = (size_t)((b * 2 + dir) * 8 + h) * SP + s0 + i; GA[o] = g; DTA[o] = dt;
        if (i == 0) GEND[((b * 2 + dir) * 8 + h) * NCH + tc] = gend; }
    LDS_BARRIER();
    if (C.tid < 384) {
        f32x2 wk[5];
#pragma unroll
        for (int k = 0; k < 5; ++k) wk[k] = *(const f32x2*)(a.conv_w + k * 768 + ch0);
        const f32x2 cb = *(const f32x2*)(a.conv_b + ch0);
        const int cls = ch0 < 512 ? 0 : (ch0 < 640 ? 1 : 2);
#pragma unroll
        for (int i8 = 0; i8 < 8; ++i8) {
            unsigned t0[4], t1[4]; float pv0 = 0.f, pv1 = 0.f;
#pragma unroll
            for (int ii = 0; ii < 8; ++ii) {
                const int i = 8 * i8 + ii;
                float y0 = cb.x, y1 = cb.y;
#pragma unroll
                for (int k = 0; k < 5; ++k) { y0 += wk[k].x * bflo(uw[i + k]); y1 += wk[k].y * bfhi(uw[i + k]); }
                y0 = siluf(y0); y1 = siluf(y1);
                if (cls != 0) *(unsigned*)(BC + (size_t)(rowbase + i) * 256 + (ch0 - 512)) = cvt_pk_bf16(y0, y1);
                if (ii & 1) { t0[ii >> 1] = cvt_pk_bf16(pv0, y0); t1[ii >> 1] = cvt_pk_bf16(pv1, y1); } else { pv0 = y0; pv1 = y1; }
            }
            if (cls != 2) {
                const u32x4 v0 = (u32x4){t0[0], t0[1], t0[2], t0[3]}, v1 = (u32x4){t1[0], t1[1], t1[2], t1[3]};
                *(LAS u32x4*)(XTl + ch0 * 72 + 8 * i8) = v0; *(LAS u32x4*)(XTl + (ch0 + 1) * 72 + 8 * i8) = v1;
                if (cls == 0) { const size_t r0 = (size_t)(b * 512 + ch0) * SP + s0 + 8 * i8; *(u32x4*)(XST + r0) = v0; *(u32x4*)(XST + r0 + SP) = v1; }
            }
        }
    }
    LDS_BARRIER();
    {
        const int fr = C.lane & 15, q = C.lane >> 4;
#pragma unroll 1
        for (int pi = 0; pi < 2; ++pi) { const int pid = 2 * C.wave + pi, dir = pid >> 3, h = pid & 7, g = h >> 2;
            bf16x8 Bf[4][2]; f32x4 wv[2][2];
#pragma unroll
            for (int ks = 0; ks < 2; ++ks) { wv[ks][0] = *(const LAS f32x4*)(wl + pid * 64 + 32 * ks + 8 * q); wv[ks][1] = *(const LAS f32x4*)(wl + pid * 64 + 32 * ks + 8 * q + 4); }
#pragma unroll
            for (int t = 0; t < 4; ++t)
#pragma unroll
                for (int ks = 0; ks < 2; ++ks) Bf[t][ks] = *(const LAS bf16x8*)(XTl + (h * 64 + 16 * t + fr) * 72 + 32 * ks + 8 * q);
            const size_t ob = ((size_t)((b * 2 + dir) * 8 + h) * NCH + tc) * 1024;
#pragma unroll
            for (int at = 0; at < 4; ++at) { bf16x8 Af[2];
#pragma unroll
                for (int ks = 0; ks < 2; ++ks) { const u32x4 raw = *(const LAS u32x4*)(XTl + (512 + g * 64 + 16 * at + fr) * 72 + 32 * ks + 8 * q); const unsigned rw[4] = {raw.x, raw.y, raw.z, raw.w}; u32x4 o;
                    o.x = cvt_pk_bf16(bflo(rw[0]) * wv[ks][0][0], bfhi(rw[0]) * wv[ks][0][1]); o.y = cvt_pk_bf16(bflo(rw[1]) * wv[ks][0][2], bfhi(rw[1]) * wv[ks][0][3]);
                    o.z = cvt_pk_bf16(bflo(rw[2]) * wv[ks][1][0], bfhi(rw[2]) * wv[ks][1][1]); o.w = cvt_pk_bf16(bflo(rw[3]) * wv[ks][1][2], bfhi(rw[3]) * wv[ks][1][3]);
                    Af[ks] = __builtin_bit_cast(bf16x8, o); }
#pragma unroll
                for (int pt = 0; pt < 4; ++pt) { f32x4 acc = (f32x4){0.f, 0.f, 0.f, 0.f};
                    acc = MFMA16(Af[0], Bf[pt][0], acc); acc = MFMA16(Af[1], Bf[pt][1], acc);
                    DSS[ob + (at * 4 + pt) * 64 + C.lane] = (u32x2){cvt_pk_bf16(acc[0], acc[1]), cvt_pk_bf16(acc[2], acc[3])}; } } }
    }
    LDS_BARRIER();
}
__device__ __forceinline__ void prep_hg_pair(CArgs& a, const Ctx& C, int unit) {
    const bf16* U = (const bf16*)(a.ws + WS_U);
    bf16* QS = (bf16*)(a.ws + WS_QS); bf16* KS = (bf16*)(a.ws + WS_KS); bf16* VT = (bf16*)(a.ws + WS_VT); float* EG = (float*)(a.ws + WS_EG); u32x2* DSP = (u32x2*)(a.ws + WS_DSP); float* EGP = (float*)(a.ws + WS_EGP);
    const int b = unit / (NPR * 4), pr = (unit >> 2) % NPR, h = unit & 3;
    LAS float* ETl = (LAS float*)(C.lds + 63488);
    LAS u32x2* DL = (LAS u32x2*)(C.lds + 65536);
#pragma unroll 1
    for (int sub = 0; sub < 2; ++sub) {
    const int c = 2 * pr + sub, s0 = 64 * c; const bool isctx = c < 4;
    int ltid = C.tid; asm volatile("" : "+v"(ltid));
    const int cp = ltid & 63, tg = ltid >> 6, ch0 = 2 * cp, hc = h * 128 + ch0;
    const int rbase = isctx ? NLAT + b * CTXL + s0 : b * SEQ + (c - 4), rstride = isctx ? 1 : 64;
    const bf16* up = U + (size_t)rbase * NU + 1280 + hc;
    unsigned rq[8], rf[8], rb[8], ri[8];
#pragma unroll
    for (int t = 0; t < 8; ++t) { const bf16* r = up + (size_t)(8 * tg + t) * rstride * NU;
        rq[t] = *(const unsigned*)r; rf[t] = *(const unsigned*)(r + 512); rb[t] = *(const unsigned*)(r + 1024); ri[t] = *(const unsigned*)(r + 1536); }
    LAS float* part = (LAS float*)C.lds;
    LAS bf16* KHl = (LAS bf16*)(C.lds + 8192);
    LAS bf16* VTl = KHl + 2 * 128 * 72;
    f32x2 lbv[2];
#pragma unroll
    for (int d = 0; d < 2; ++d) { lbv[d].x = __builtin_amdgcn_rcpf(1.0f + __expf(a.hg_lb[1024 + d * 512 + hc] - a.hg_lb[d * 512 + hc])); lbv[d].y = __builtin_amdgcn_rcpf(1.0f + __expf(a.hg_lb[1024 + d * 512 + hc + 1] - a.hg_lb[d * 512 + hc + 1])); }
    float la[2][2][8], om[2][2][8];
    float sum[2][2] = {{0.f, 0.f}, {0.f, 0.f}};
#pragma unroll
    for (int t = 0; t < 8; ++t)
#pragma unroll
        for (int d = 0; d < 2; ++d)
#pragma unroll
            for (int e = 0; e < 2; ++e) { const unsigned w = d == 0 ? rf[t] : rb[t]; const float fr_ = e == 0 ? bflo(w) : bfhi(w); const float lb = e == 0 ? lbv[d].x : lbv[d].y;
                const float ex = __builtin_amdgcn_exp2f(fr_ * -1.4426950408889634f); const float t1 = (1.0f - lb) * __builtin_amdgcn_rcpf(1.0f + ex);
                om[d][e][t] = t1 * ex;
                la[d][e][t] = __builtin_amdgcn_logf(lb + t1); sum[d][e] += la[d][e][t]; }
#pragma unroll
    for (int d = 0; d < 2; ++d)
#pragma unroll
        for (int e = 0; e < 2; ++e) part[(tg * 4 + d * 2 + e) * 64 + cp] = sum[d][e];
    LDS_BARRIER();
    float T[2][2], pre[2][2];
#pragma unroll
    for (int d = 0; d < 2; ++d)
#pragma unroll
        for (int e = 0; e < 2; ++e) { float tt = 0.f, pp = 0.f;
#pragma unroll
            for (int g2 = 0; g2 < 8; ++g2) { const float v = part[(g2 * 4 + d * 2 + e) * 64 + cp]; pp += (g2 < tg) ? v : 0.f; tt += v; }
            T[d][e] = tt; pre[d][e] = pp; }
    const size_t DST = (size_t)NB * 4 * SP * 128;
    unsigned khp[2][2][4], vp[2][4];
    float eT[2][2];
#pragma unroll
    for (int d = 0; d < 2; ++d)
#pragma unroll
        for (int e = 0; e < 2; ++e) eT[d][e] = __builtin_amdgcn_exp2f(T[d][e]);
    {
        float runf[2] = {pre[0][0], pre[0][1]}, runb[2] = {pre[1][0], pre[1][1]}, pkf[2] = {0.f, 0.f}, pkb[2] = {0.f, 0.f}, pkv[2] = {0.f, 0.f};
#pragma unroll
        for (int t = 0; t < 8; ++t) { const size_t rm = ((size_t)(b * 4 + h) * SP + s0 + 8 * tg + t) * 128 + ch0;
            const float qv[2] = {siluf(bflo(rq[t])) * 0.08838834764831845f, siluf(bfhi(rq[t])) * 0.08838834764831845f};
            float ktf[2], ktb[2], qtf[2], qtb[2];
#pragma unroll
            for (int e = 0; e < 2; ++e) {
                runf[e] += la[0][e][t]; const float Ef = __builtin_amdgcn_exp2f(-runf[e]);
                const float gb = T[1][e] - runb[e]; runb[e] += la[1][e][t]; const float Eb = __builtin_amdgcn_exp2f(-gb);
                ktf[e] = om[0][e][t] * Ef; ktb[e] = om[1][e][t] * Eb; qtf[e] = qv[e] * __builtin_amdgcn_rcpf(Ef); qtb[e] = qv[e] * __builtin_amdgcn_rcpf(Eb);
                const float khf = ktf[e] * eT[0][e], khb = ktb[e] * eT[1][e], iv = e == 0 ? bflo(ri[t]) : bfhi(ri[t]);
                if (t & 1) { khp[0][e][t >> 1] = cvt_pk_bf16(pkf[e], khf); khp[1][e][t >> 1] = cvt_pk_bf16(pkb[e], khb); vp[e][t >> 1] = cvt_pk_bf16(pkv[e], iv); } else { pkf[e] = khf; pkb[e] = khb; pkv[e] = iv; } }
            *(unsigned*)(QS + rm) = cvt_pk_bf16(qtf[0], qtf[1]); *(unsigned*)(QS + DST + rm) = cvt_pk_bf16(qtb[0], qtb[1]);
            *(unsigned*)(KS + rm) = cvt_pk_bf16(ktf[0], ktf[1]); *(unsigned*)(KS + DST + rm) = cvt_pk_bf16(ktb[0], ktb[1]); }
    }
#pragma unroll
    for (int e = 0; e < 2; ++e) {
        *(LAS u32x4*)(KHl + (0 * 128 + ch0 + e) * 72 + 8 * tg) = (u32x4){khp[0][e][0], khp[0][e][1], khp[0][e][2], khp[0][e][3]};
        *(LAS u32x4*)(KHl + (1 * 128 + ch0 + e) * 72 + 8 * tg) = (u32x4){khp[1][e][0], khp[1][e][1], khp[1][e][2], khp[1][e][3]};
        *(LAS u32x4*)(VTl + (ch0 + e) * 72 + 8 * tg) = (u32x4){vp[e][0], vp[e][1], vp[e][2], vp[e][3]};
        *(u32x4*)(VT + (size_t)((b * 4 + h) * 128 + ch0 + e) * SP + s0 + 8 * tg) = (u32x4){vp[e][0], vp[e][1], vp[e][2], vp[e][3]}; }
    if (tg == 0) {
#pragma unroll
        for (int d = 0; d < 2; ++d) { const f32x2 et = (f32x2){eT[d][0], eT[d][1]};
            *(f32x2*)(EG + ((size_t)((d * 4 + b) * 4 + h) * NCH + c) * 128 + ch0) = et; *(LAS f32x2*)(ETl + (sub * 2 + d) * 128 + ch0) = et;
            if (sub) { const f32x2 e0 = *(const LAS f32x2*)(ETl + d * 128 + ch0); *(f32x2*)(EGP + ((size_t)((d * 4 + b) * 4 + h) * NPR + pr) * 128 + ch0) = (f32x2){e0.x * et.x, e0.y * et.y}; } } }
    LDS_BARRIER();
    {
        const int fr = C.lane & 15, q = C.lane >> 4;
        LAS u32x2* dlb = DL + C.tid; asm volatile("" : "+v"(dlb));
        bf16x8 Bf[2];
#pragma unroll
        for (int ks = 0; ks < 2; ++ks) Bf[ks] = *(const LAS bf16x8*)(VTl + (16 * C.wave + fr) * 72 + 32 * ks + 8 * q);
#pragma unroll
        for (int d = 0; d < 2; ++d) { const int seq = (d * NB + b) * 4 + h;
#pragma unroll
            for (int at = 0; at < 8; ++at) { f32x4 t4 = (f32x4){0.f, 0.f, 0.f, 0.f};
#pragma unroll
                for (int ks = 0; ks < 2; ++ks) { const bf16x8 Af = *(const LAS bf16x8*)(KHl + (d * 128 + 16 * at + fr) * 72 + 32 * ks + 8 * q); t4 = MFMA16(Af, Bf[ks], t4); }
                LAS u32x2* dl = dlb + (d * 8 + at) * 512;
                if (sub == 0) *dl = (u32x2){cvt_pk_bf16(t4[0], t4[1]), cvt_pk_bf16(t4[2], t4[3])};
                else { const u32x2 pw = *dl; const f32x4 pv = (f32x4){bflo(pw.x), bfhi(pw.x), bflo(pw.y), bfhi(pw.y)};
                    const f32x4 r4 = d == 0 ? pv * *(const LAS f32x4*)(ETl + (1 * 2 + 0) * 128 + 16 * at + 4 * q) + t4
                                            : pv + t4 * *(const LAS f32x4*)(ETl + (0 * 2 + 1) * 128 + 16 * at + 4 * q);
                    DSP[((size_t)seq * NPR + pr) * 4096 + (at * 8 + C.wave) * 64 + C.lane] = (u32x2){cvt_pk_bf16(r4[0], r4[1]), cvt_pk_bf16(r4[2], r4[3])}; }
                if (at & 1) asm volatile("" ::: "memory"); } }
    }
    LDS_BARRIER();
    }
}
__device__ __forceinline__ void phase4(CArgs& a, const Ctx& C) {
    constexpr int NHU = NB * NPR * 4;
#pragma unroll 1
    for (int k = 0; k < 4; ++k) { int u; const int v = C.vcu;
        if (k == 0) u = v;
        else if (k == 1) u = v < 208 ? 256 + v : NHU + (v - 208);
        else if (k == 2) u = v < 80 ? 464 + v : (v < 208 ? NHU + 48 + (v - 80) : NHU + 176 + (v - 208));
        else { if (v < 208) break; u = NHU + 224 + (v - 208); }
        if (u < NHU) prep_hg_pair(a, C, u); else prep_ssd_unit(a, C, u - NHU); }
}
__device__ __forceinline__ void phase5(CArgs& a, const Ctx& C) { (void)a; (void)C; }
__device__ __forceinline__ int scan_chunk(int dir, int k) { return dir == 0 ? k : (k < 4 ? 3 - k : 71 - k); }
__device__ __forceinline__ void phase6(CArgs& a, const Ctx& C) {
    const u32x2* DSS = (const u32x2*)(a.ws + WS_DSS); const u32x2* DSP = (const u32x2*)(a.ws + WS_DSP);
    u32x2* SPS = (u32x2*)(a.ws + WS_SPS); u32x2* SPH = (u32x2*)(a.ws + WS_SPH);
    const float* GEND = (const float*)(a.ws + WS_GEND); const float* EGP = (const float*)(a.ws + WS_EGP);
    if (C.vcu < 128) {
        const int task = C.vcu * 512 + C.tid, seq = task >> 10, grp = task & 1023, dir = (seq >> 3) & 1;
        f32x4 S = (f32x4){0.f, 0.f, 0.f, 0.f};
#pragma unroll 1
        for (int kb = 0; kb < NCH; kb += 17) { u32x2 dw[17]; float gd[17];
#pragma unroll
            for (int j = 0; j < 17; ++j) { const int tc = scan_chunk(dir, kb + j); dw[j] = NTLOAD(&DSS[((size_t)seq * NCH + tc) * 1024 + grp]); gd[j] = GEND[seq * NCH + tc]; }
            asm volatile("" ::: "memory");
#pragma unroll
            for (int j = 0; j < 17; ++j) { const int tc = scan_chunk(dir, kb + j);
                if (tc >= 4) SPS[((size_t)seq * NCH + tc) * 1024 + grp] = (u32x2){cvt_pk_bf16(S[0], S[1]), cvt_pk_bf16(S[2], S[3])};
                S = S * __expf(gd[j]) + (f32x4){bflo(dw[j].x), bfhi(dw[j].x), bflo(dw[j].y), bfhi(dw[j].y)}; }
            asm volatile("" ::: "memory"); }
    } else {
#pragma unroll 1
        for (int rep = 0; rep < 2; ++rep) {
            const int t = (C.vcu - 128) * 1024 + rep * 512 + C.tid, seq = t >> 12, grp = t & 4095, d = seq >> 4, tile = grp >> 6, ln = grp & 63, cb = 16 * (tile >> 3) + 4 * (ln >> 4);
            f32x4 S = (f32x4){0.f, 0.f, 0.f, 0.f};
#pragma unroll 1
            for (int kb = 0; kb < NPR; kb += 17) { u32x2 dw[17]; f32x4 dec[17];
#pragma unroll
                for (int j = 0; j < 17; ++j) { const int k = kb + j, tp = d == 0 ? k : (k < 2 ? 1 - k : 35 - k); dw[j] = NTLOAD(&DSP[((size_t)seq * NPR + tp) * 4096 + grp]); dec[j] = *(const f32x4*)(EGP + ((size_t)seq * NPR + tp) * 128 + cb); }
                asm volatile("" ::: "memory");
#pragma unroll
                for (int j = 0; j < 17; ++j) { const int k = kb + j, tp = d == 0 ? k : (k < 2 ? 1 - k : 35 - k);
                    if (tp >= 2) SPH[((size_t)seq * NPR + tp) * 4096 + grp] = (u32x2){cvt_pk_bf16(S[0], S[1]), cvt_pk_bf16(S[2], S[3])};
                    S = S * dec[j] + (f32x4){bflo(dw[j].x), bfhi(dw[j].x), bflo(dw[j].y), bfhi(dw[j].y)}; }
                asm volatile("" ::: "memory"); } }
    }
}
typedef short s16x4 __attribute__((ext_vector_type(4)));
typedef short s16x8 __attribute__((ext_vector_type(8)));
__device__ __forceinline__ s16x4 lds_tr(const LAS bf16* p) { return __builtin_amdgcn_ds_read_tr16_b64_v4i16((LAS s16x4*)p); }
__device__ __forceinline__ bf16x8 ld_split8(const bf16* p0, const bf16* p1) {
    const u32x2 lo = *(const u32x2*)p0, hi = *(const u32x2*)p1; u32x4 w = (u32x4){lo.x, lo.y, hi.x, hi.y}; return __builtin_bit_cast(bf16x8, w);
}
__device__ __forceinline__ void passc_ssd_unit(CArgs& a, const Ctx& C, int unit) {
    const bf16* BC = (const bf16*)(a.ws + WS_BC); const bf16* XST = (const bf16*)(a.ws + WS_XST); const bf16* U = (const bf16*)(a.ws + WS_U);
    const float* GA = (const float*)(a.ws + WS_GA); const float* DTA = (const float*)(a.ws + WS_DTA); const bf16* SPS = (const bf16*)(a.ws + WS_SPS);
    bf16* Y = (bf16*)(a.ws + WS_Y);
    const int b = unit >> 6, tcl = unit & 63, tc = tcl + 4, s0 = 64 * tc, row0 = b * SEQ + 64 * tcl;
    const int h = C.wave, g = h >> 2, fr = C.lane & 15, q = C.lane >> 4;
    LAS unsigned char* wl = C.lds + C.wave * 17408;
    LAS bf16* Ml = (LAS bf16*)wl; LAS float* Yl = (LAS float*)wl; LAS float* red = (LAS float*)(C.lds + 8 * 17408);
    {
        bf16x8 Ca[4][2], Bb[4][2];
#pragma unroll
        for (int t = 0; t < 4; ++t)
#pragma unroll
            for (int ks = 0; ks < 2; ++ks) { const bf16* rp = BC + (size_t)(row0 + 16 * t + fr) * 256 + g * 64 + 32 * ks + 8 * q;
                Bb[t][ks] = *(const bf16x8*)rp; Ca[t][ks] = *(const bf16x8*)(rp + 128); }
        const size_t sf = (size_t)((b * 2 + 0) * 8 + h) * SP + s0, sb = (size_t)((b * 2 + 1) * 8 + h) * SP + s0;
        float gjf[4], gjb[4], dtf[4], dtb[4];
#pragma unroll
        for (int jt = 0; jt < 4; ++jt) { gjf[jt] = GA[sf + 16 * jt + fr]; gjb[jt] = GA[sb + 16 * jt + fr]; dtf[jt] = DTA[sf + 16 * jt + fr]; dtb[jt] = DTA[sb + 16 * jt + fr]; }
        const float Dh = a.ssd_d[h];
#pragma unroll
        for (int it = 0; it < 4; ++it) {
            const f32x4 gif = *(const f32x4*)(GA + sf + 16 * it + 4 * q), gib = *(const f32x4*)(GA + sb + 16 * it + 4 * q);
#pragma unroll
            for (int jt = 0; jt < 4; ++jt) { f32x4 G = (f32x4){0.f, 0.f, 0.f, 0.f};
                G = MFMA16(Ca[it][0], Bb[jt][0], G); G = MFMA16(Ca[it][1], Bb[jt][1], G);
                const int j = 16 * jt + fr;
#pragma unroll
                for (int r = 0; r < 4; ++r) { const int i = 16 * it + 4 * q + r;
                    const float lf = (j <= i) ? dtf[jt] * __expf(fminf(gif[r] - gjf[jt], 0.f)) : 0.f;
                    const float lb = (j >= i) ? dtb[jt] * __expf(fminf(gib[r] - gjb[jt], 0.f)) : 0.f;
                    const float m = G[r] * (lf + lb) + ((i == j) ? Dh : 0.f);
                    Ml[i * 72 + j] = (bf16)(cvt_pk_bf16(m, 0.f) & 0xffff); } } }
    }
    LDS_WAIT(); asm volatile("" ::: "memory");
    bf16x8 Ma[4][2], Cp[4][2];
#pragma unroll
    for (int it = 0; it < 4; ++it)
#pragma unroll
        for (int ks = 0; ks < 2; ++ks) { Ma[it][ks] = *(const LAS bf16x8*)(Ml + (16 * it + fr) * 72 + 32 * ks + 8 * q);
            const bf16* cp = BC + (size_t)(row0 + 16 * it + fr) * 256 + 128 + g * 64 + 32 * ks + 4 * q; Cp[it][ks] = ld_split8(cp, cp + 16); }
    LDS_WAIT(); asm volatile("" ::: "memory");
    f32x4 eg[2][4];
#pragma unroll
    for (int d = 0; d < 2; ++d)
#pragma unroll
        for (int it = 0; it < 4; ++it) { const f32x4 gi = *(const f32x4*)(GA + (size_t)((b * 2 + d) * 8 + h) * SP + s0 + 16 * it + 4 * q);
            eg[d][it] = (f32x4){__expf(gi[0]), __expf(gi[1]), __expf(gi[2]), __expf(gi[3])}; }
#pragma unroll 1
    for (int pt = 0; pt < 4; ++pt) {
        bf16x8 Bx[2];
#pragma unroll
        for (int ks = 0; ks < 2; ++ks) Bx[ks] = *(const bf16x8*)(XST + (size_t)((b * 8 + h) * 64 + 16 * pt + fr) * SP + s0 + 32 * ks + 8 * q);
        f32x4 Yv[4];
#pragma unroll
        for (int it = 0; it < 4; ++it) { Yv[it] = (f32x4){0.f, 0.f, 0.f, 0.f}; Yv[it] = MFMA16(Ma[it][0], Bx[0], Yv[it]); Yv[it] = MFMA16(Ma[it][1], Bx[1], Yv[it]); }
#pragma unroll
        for (int d = 0; d < 2; ++d) { const size_t sbase = ((size_t)((b * 2 + d) * 8 + h) * NCH + tc) * 1024;
            bf16x8 Sb[2];
#pragma unroll
            for (int ks = 0; ks < 2; ++ks) Sb[ks] = ld_split8(SPS + (sbase + ((2 * ks) * 4 + pt) * 64 + C.lane) * 4, SPS + (sbase + ((2 * ks + 1) * 4 + pt) * 64 + C.lane) * 4);
#pragma unroll
            for (int it = 0; it < 4; ++it) { f32x4 T = (f32x4){0.f, 0.f, 0.f, 0.f}; T = MFMA16(Cp[it][0], Sb[0], T); T = MFMA16(Cp[it][1], Sb[1], T); Yv[it] += eg[d][it] * T; } }
#pragma unroll
        for (int it = 0; it < 4; ++it)
#pragma unroll
            for (int r = 0; r < 4; ++r) Yl[(16 * it + 4 * q + r) * 68 + 16 * pt + fr] = Yv[it][r];
    }
    LDS_WAIT(); asm volatile("" ::: "memory");
    const int i = C.lane; float v[64]; float ss = 0.f;
    const bf16* zp = U + (size_t)(row0 + i) * NU + h * 64;
#pragma unroll
    for (int c8 = 0; c8 < 8; ++c8) { const u32x4 zw = *(const u32x4*)(zp + 8 * c8); const f32x4 y0 = *(const LAS f32x4*)(Yl + i * 68 + 8 * c8), y1 = *(const LAS f32x4*)(Yl + i * 68 + 8 * c8 + 4);
        const unsigned zz[4] = {zw.x, zw.y, zw.z, zw.w};
#pragma unroll
        for (int e = 0; e < 4; ++e) { const float ya = e < 2 ? y0[2 * e] : y1[2 * e - 4], yb = e < 2 ? y0[2 * e + 1] : y1[2 * e - 3];
            const float va = ya * siluf(bflo(zz[e])), vb = yb * siluf(bfhi(zz[e])); v[8 * c8 + 2 * e] = va; v[8 * c8 + 2 * e + 1] = vb; ss += va * va + vb * vb; } }
    red[C.wave * 64 + i] = ss;
    LDS_BARRIER();
    float tot = 0.f;
#pragma unroll
    for (int w = 0; w < 8; ++w) tot += red[w * 64 + i];
    const float rstd = rsqrtf(tot * (1.0f / 512.0f) + EPS);
    bf16* yo = Y + (size_t)(row0 + i) * D + h * 64;
#pragma unroll
    for (int c8 = 0; c8 < 8; ++c8) { const f32x4 n0 = *(const f32x4*)(a.ssd_norm + h * 64 + 8 * c8), n1 = *(const f32x4*)(a.ssd_norm + h * 64 + 8 * c8 + 4);
        u32x4 o; o.x = cvt_pk_bf16(v[8 * c8] * rstd * n0[0], v[8 * c8 + 1] * rstd * n0[1]); o.y = cvt_pk_bf16(v[8 * c8 + 2] * rstd * n0[2], v[8 * c8 + 3] * rstd * n0[3]);
        o.z = cvt_pk_bf16(v[8 * c8 + 4] * rstd * n1[0], v[8 * c8 + 5] * rstd * n1[1]); o.w = cvt_pk_bf16(v[8 * c8 + 6] * rstd * n1[2], v[8 * c8 + 7] * rstd * n1[3]);
        *(u32x4*)(yo + 8 * c8) = o; }
    LDS_BARRIER();
}
__device__ __forceinline__ void passc_hg_pair(CArgs& a, const Ctx& C, int unit) {
    const bf16* QS = (const bf16*)(a.ws + WS_QS); const bf16* KS = (const bf16*)(a.ws + WS_KS); const bf16* VT = (const bf16*)(a.ws + WS_VT); const bf16* SPH = (const bf16*)(a.ws + WS_SPH);
    const bf16* U = (const bf16*)(a.ws + WS_U); bf16* Y = (bf16*)(a.ws + WS_Y); const float* EG = (const float*)(a.ws + WS_EG);
    const int b = unit >> 7, pr = 2 + ((unit >> 2) & 31), h = unit & 3;
    const int wv = C.wave, fr = C.lane & 15, q = C.lane >> 4;
    LAS bf16* Pl = (LAS bf16*)C.lds; LAS float* Ol = (LAS float*)(C.lds + 9216); LAS float* red = (LAS float*)(C.lds + 9216 + 64 * 132 * 4);
    LAS bf16* KL = (LAS bf16*)(C.lds + 79872);
    LAS bf16* QL = (LAS bf16*)(C.lds + 45056);
    const size_t DST = (size_t)NB * 4 * SP * 128;
#pragma unroll 1
    for (int sub = 0; sub < 2; ++sub) {
    const int tc = 2 * pr + sub, w = tc - 4, s0 = 64 * tc, oc = 2 * pr + 1 - sub;
    const int it0 = wv >> 1;
    bf16x8 Aq[2][4], Bk[2][2][4];
#pragma unroll
    for (int d = 0; d < 2; ++d) { const size_t base = d * DST + ((size_t)(b * 4 + h) * SP + s0) * 128;
#pragma unroll
        for (int ks = 0; ks < 4; ++ks) { Aq[d][ks] = *(const bf16x8*)(QS + base + (size_t)(16 * it0 + fr) * 128 + 32 * ks + 8 * q);
#pragma unroll
            for (int j2 = 0; j2 < 2; ++j2) Bk[d][j2][ks] = *(const bf16x8*)(KS + base + (size_t)(16 * (2 * (wv & 1) + j2) + fr) * 128 + 32 * ks + 8 * q); } }
    bf16x8 Bv[2], Vo[2], SbD[4];
#pragma unroll
    for (int ks = 0; ks < 2; ++ks) Bv[ks] = *(const bf16x8*)(VT + (size_t)((b * 4 + h) * 128 + 16 * wv + fr) * SP + s0 + 32 * ks + 8 * q);
    const int dm = 1 - sub;
#pragma unroll
    for (int ks = 0; ks < 2; ++ks) Vo[ks] = *(const bf16x8*)(VT + (size_t)((b * 4 + h) * 128 + 16 * wv + fr) * SP + 64 * oc + 32 * ks + 8 * q);
    u32x2 sp[8];
    { const size_t sbD = ((size_t)((sub * NB + b) * 4 + h) * NPR + pr) * 4096, sbM = ((size_t)((dm * NB + b) * 4 + h) * NPR + pr) * 4096;
#pragma unroll
        for (int ks = 0; ks < 4; ++ks) SbD[ks] = ld_split8(SPH + (sbD + ((2 * ks) * 8 + wv) * 64 + C.lane) * 4, SPH + (sbD + ((2 * ks + 1) * 8 + wv) * 64 + C.lane) * 4);
#pragma unroll
        for (int at = 0; at < 8; ++at) sp[at] = *(const u32x2*)(SPH + (sbM + (at * 8 + wv) * 64 + C.lane) * 4); }
    const int kr = C.tid >> 3, kc = (C.tid & 7) * 16;
    const bf16* kso = KS + dm * DST + ((size_t)(b * 4 + h) * SP + 64 * oc) * 128 + kr * 128 + kc;
    const u32x4 kt0 = *(const u32x4*)kso, kt1 = *(const u32x4*)(kso + 8);
    const int i = C.lane;
    const size_t row = (size_t)b * SEQ + i * 64 + w;
    const bf16* gp = U + row * NU + 1280 + 2048 + h * 128 + 16 * wv; bf16* yo = Y + row * D + 512 + h * 128 + 16 * wv; const float* nwp = a.hg_norm + h * 128 + 16 * wv;
    const u32x4 gw0 = *(const u32x4*)gp, gw1 = *(const u32x4*)(gp + 8);
    f32x4 nw[4];
#pragma unroll
    for (int c4 = 0; c4 < 4; ++c4) nw[c4] = *(const f32x4*)(nwp + 4 * c4);
    {
        f32x4 P[2] = {(f32x4){0.f, 0.f, 0.f, 0.f}, (f32x4){0.f, 0.f, 0.f, 0.f}};
#pragma unroll
        for (int d = 0; d < 2; ++d) {
#pragma unroll
            for (int ks = 0; ks < 4; ++ks) if ((wv & 1) == 0) *(LAS bf16x8*)(QL + (d * 64 + 16 * it0 + fr) * 136 + 32 * ks + 8 * q) = Aq[d][ks];
#pragma unroll
            for (int j2 = 0; j2 < 2; ++j2) { const int jt = 2 * (wv & 1) + j2; f32x4 S = (f32x4){0.f, 0.f, 0.f, 0.f};
#pragma unroll
                for (int ks = 0; ks < 4; ++ks) S = MFMA16(Aq[d][ks], Bk[d][j2][ks], S);
                const int j = 16 * jt + fr;
#pragma unroll
                for (int r = 0; r < 4; ++r) { const int ii = 16 * it0 + 4 * q + r; const bool keep = d == 0 ? (j <= ii) : (j >= ii); P[j2][r] += keep ? S[r] : 0.f; } } }
#pragma unroll
        for (int j2 = 0; j2 < 2; ++j2) { const int j = 16 * (2 * (wv & 1) + j2) + fr;
#pragma unroll
            for (int r = 0; r < 4; ++r) Pl[(16 * it0 + 4 * q + r) * 72 + j] = (bf16)(cvt_pk_bf16(P[j2][r], 0.f) & 0xffff); }
        *(LAS u32x4*)(KL + kr * 136 + kc) = kt0; *(LAS u32x4*)(KL + kr * 136 + kc + 8) = kt1;
    }
    LDS_BARRIER();
    f32x4 O[4];
#pragma unroll
    for (int it = 0; it < 4; ++it) { O[it] = (f32x4){0.f, 0.f, 0.f, 0.f};
#pragma unroll
        for (int ks = 0; ks < 2; ++ks) { const bf16x8 Pa = *(const LAS bf16x8*)(Pl + (16 * it + fr) * 72 + 32 * ks + 8 * q); O[it] = MFMA16(Pa, Bv[ks], O[it]); } }
    bf16x8 SbM[4];
    { const float* eg = EG + ((size_t)((dm * NB + b) * 4 + h) * NCH + oc) * 128 + 4 * q;
        const LAS bf16* kt = KL + (8 * q + (fr >> 2)) * 136 + 4 * (fr & 3);
#pragma unroll
        for (int ks = 0; ks < 4; ++ks) { unsigned wd[4];
#pragma unroll
            for (int hh = 0; hh < 2; ++hh) { const int at = 2 * ks + hh; f32x4 t4 = (f32x4){bflo(sp[at].x), bfhi(sp[at].x), bflo(sp[at].y), bfhi(sp[at].y)};
#pragma unroll
                for (int k2 = 0; k2 < 2; ++k2) { const s16x4 a0 = lds_tr(kt + (32 * k2) * 136 + 16 * at), a1 = lds_tr(kt + (32 * k2 + 4) * 136 + 16 * at);
                    const s16x8 av = (s16x8){a0[0], a0[1], a0[2], a0[3], a1[0], a1[1], a1[2], a1[3]}; t4 = MFMA16(__builtin_bit_cast(bf16x8, av), Vo[k2], t4); }
                const f32x4 e4 = *(const f32x4*)(eg + 16 * at);
                wd[2 * hh] = cvt_pk_bf16(t4[0] * e4[0], t4[1] * e4[1]); wd[2 * hh + 1] = cvt_pk_bf16(t4[2] * e4[2], t4[3] * e4[3]); }
            const u32x4 ww = (u32x4){wd[0], wd[1], wd[2], wd[3]}; SbM[ks] = __builtin_bit_cast(bf16x8, ww); } }
#pragma unroll
    for (int d = 0; d < 2; ++d)
#pragma unroll
        for (int ks = 0; ks < 4; ++ks) { const bf16x8 sb = d == sub ? SbD[ks] : SbM[ks];
#pragma unroll
            for (int it = 0; it < 4; ++it) { const LAS bf16* qp = QL + (d * 64 + 16 * it + fr) * 136 + 32 * ks + 4 * q;
                const u32x2 lo = *(const LAS u32x2*)qp, hi = *(const LAS u32x2*)(qp + 16); const u32x4 ww = (u32x4){lo.x, lo.y, hi.x, hi.y};
                O[it] = MFMA16(__builtin_bit_cast(bf16x8, ww), sb, O[it]); } }
#pragma unroll
    for (int it = 0; it < 4; ++it)
#pragma unroll
        for (int r = 0; r < 4; ++r) Ol[(16 * it + 4 * q + r) * 132 + 16 * wv + fr] = O[it][r];
    LDS_BARRIER();
    float o[16]; float ss = 0.f;
#pragma unroll
    for (int c4 = 0; c4 < 4; ++c4) { const f32x4 t = *(const LAS f32x4*)(Ol + i * 132 + 16 * wv + 4 * c4);
#pragma unroll
        for (int e = 0; e < 4; ++e) { o[4 * c4 + e] = t[e]; ss += t[e] * t[e]; } }
    red[wv * 64 + i] = ss;
    LDS_BARRIER();
    float tot = 0.f;
#pragma unroll
    for (int s2 = 0; s2 < 8; ++s2) tot += red[s2 * 64 + i];
    const float rstd = rsqrtf(tot * (1.0f / 128.0f) + EPS);
#pragma unroll
    for (int c8 = 0; c8 < 2; ++c8) { const u32x4 gw4 = c8 == 0 ? gw0 : gw1; const unsigned gz[4] = {gw4.x, gw4.y, gw4.z, gw4.w}; unsigned ow[4];
#pragma unroll
        for (int e = 0; e < 4; ++e) { const int k = 8 * c8 + 2 * e; ow[e] = cvt_pk_bf16(o[k] * rstd * nw[k >> 2][k & 3] * siluf(bflo(gz[e])), o[k + 1] * rstd * nw[(k + 1) >> 2][(k + 1) & 3] * siluf(bfhi(gz[e]))); }
        *(u32x4*)(yo + 8 * c8) = (u32x4){ow[0], ow[1], ow[2], ow[3]}; }
    LDS_BARRIER();
    }
}
__device__ __forceinline__ void phase7(CArgs& a, const Ctx& C) {
    for (int u = C.vcu; u < 256; u += C.G) passc_ssd_unit(a, C, u);
    for (int u = C.vcu; u < 512; u += C.G) passc_hg_pair(a, C, u);
}
__device__ __forceinline__ void phase9_fill(CArgs& a, const Ctx& C, int t0, int nt) {
    LAS float* RW = (LAS float*)C.lds;
    for (int k = t0; k < D; k += nt) {
#pragma unroll
        for (int e4 = 0; e4 < 8; ++e4) { const f32x4 w = *(const f32x4*)(a.router_w + (size_t)k * NE + 4 * e4);
#pragma unroll
            for (int e = 0; e < 4; ++e) RW[(4 * e4 + e) * D + k] = w[e]; } }
}
__device__ __forceinline__ void phase9(CArgs& a, const Ctx& C, bool prefilled) {
    constexpr int NR = 4;
    const float* MOD = (const float*)(a.ws + WS_MOD); const bf16* MIX = (const bf16*)(a.ws + WS_MIX); unsigned char* HX = a.ws + WS_XN; bf16* X1 = (bf16*)(a.ws + WS_U);
    int* TOPE = (int*)(a.ws + WS_ROUTE); float* GATE = (float*)(a.ws + WS_ROUTE + 256 * 1024); int* PPOS = (int*)(a.ws + WS_ROUTE + 512 * 1024); int* ROWTOK = (int*)(a.ws + WS_ROWTOK);
    unsigned* gcnt = (unsigned*)(a.ws + WS_CTL) + CW_CNT;
    LAS float* RW = (LAS float*)C.lds;
    LAS float* LG = (LAS float*)(C.lds + 131072) + C.wave * 128;
    LAS unsigned* lcnt = (LAS unsigned*)(C.lds + LCNT_OFF); LAS unsigned* lbase = lcnt + 32;
    if (!prefilled) phase9_fill(a, C, C.tid, 512);
    if (C.tid < 32) lcnt[C.tid] = 0u;
    __syncthreads();
    LAS float* VA = (LAS float*)(C.lds + 131072 + 4096); LAS float* VB = VA + 1024;
    for (int m0 = NR * C.gw; m0 < NLAT; m0 += NR * C.NGW) {
        const int b = m0 >> 12; const float* mb = MOD + b * 6144;
        __syncthreads();
        for (int k = C.tid; k < D; k += 512) { VA[k] = mb[2048 + k] * a.mix_post[k]; VB[k] = a.ffn_pre[k] * (1.0f + mb[4096 + k]); }
        __syncthreads();
        float hv[NR][16];
#pragma unroll
        for (int r = 0; r < NR; ++r) { const size_t ro = (size_t)(m0 + r) * D; float ss = 0.f;
            f32x4 xv[4];
#pragma unroll
            for (int jj = 0; jj < 4; ++jj) { const u32x2 w = NTLOAD((const u32x2*)(MIX + ro + 256 * jj + 4 * C.lane)); xv[jj] = NTLOAD((const f32x4*)(a.x + ro + 256 * jj + 4 * C.lane));
                hv[r][4 * jj] = bflo(w.x); hv[r][4 * jj + 1] = bfhi(w.x); hv[r][4 * jj + 2] = bflo(w.y); hv[r][4 * jj + 3] = bfhi(w.y); }
#pragma unroll
            for (int i = 0; i < 16; ++i) ss += hv[r][i] * hv[r][i];
            const float rstd = rsqrtf(wave_sum(ss) * (1.0f / D) + EPS); float ss2 = 0.f;
#pragma unroll
            for (int jj = 0; jj < 4; ++jj) { const int k0 = 256 * jj + 4 * C.lane; const f32x4 va = *(const LAS f32x4*)(VA + k0);
                f32x4 x1;
#pragma unroll
                for (int e = 0; e < 4; ++e) { x1[e] = xv[jj][e] + va[e] * (hv[r][4 * jj + e] * rstd); hv[r][4 * jj + e] = x1[e]; ss2 += x1[e] * x1[e]; }
                *(u32x2*)(X1 + ro + k0) = (u32x2){cvt_pk_bf16(x1[0], x1[1]), cvt_pk_bf16(x1[2], x1[3])}; }
            const float rstd2 = rsqrtf(wave_sum(ss2) * (1.0f / D) + EPS);
#pragma unroll
            for (int jj = 0; jj < 4; ++jj) { const int k0 = 256 * jj + 4 * C.lane; const f32x4 vb = *(const LAS f32x4*)(VB + k0), s0 = *(const f32x4*)(mb + 3072 + k0);
#pragma unroll
                for (int e = 0; e < 4; ++e) hv[r][4 * jj + e] = hv[r][4 * jj + e] * rstd2 * vb[e] + s0[e];
                *(unsigned*)(HX + ro + k0) = pk4_fp8(hv[r][4 * jj], hv[r][4 * jj + 1], hv[r][4 * jj + 2], hv[r][4 * jj + 3]); }
            if (r & 1) asm volatile("" ::: "memory"); }
#pragma unroll 1
        for (int eg = 0; eg < 4; ++eg) {
            float lg[NR][8];
#pragma unroll
            for (int r = 0; r < NR; ++r)
#pragma unroll
                for (int e = 0; e < 8; ++e) lg[r][e] = 0.f;
#pragma unroll
            for (int e = 0; e < 8; ++e)
#pragma unroll
                for (int jj = 0; jj < 4; ++jj) { const f32x4 w = *(const LAS f32x4*)(RW + (8 * eg + e) * D + 256 * jj + 4 * C.lane);
#pragma unroll
                    for (int r = 0; r < NR; ++r) lg[r][e] += hv[r][4 * jj] * w[0] + hv[r][4 * jj + 1] * w[1] + hv[r][4 * jj + 2] * w[2] + hv[r][4 * jj + 3] * w[3];
                    if (jj == 3 && (e & 1)) asm volatile("" ::: "memory"); }
#pragma unroll
            for (int r = 0; r < NR; ++r) { reduce_scatter<8>(lg[r], C.lane);
                if ((C.lane & 7) == 0) LG[r * 32 + 8 * eg + (C.lane >> 3)] = lg[r][0]; }
        }
        LDS_WAIT(); asm volatile("" ::: "memory");
        if (C.lane < NR) { const int m = m0 + C.lane; float logit[32];
#pragma unroll
            for (int e4 = 0; e4 < 8; ++e4) { const f32x4 v = *(const LAS f32x4*)(LG + C.lane * 32 + 4 * e4), rb = *(const f32x4*)(a.router_b + 4 * e4);
#pragma unroll
                for (int e = 0; e < 4; ++e) logit[4 * e4 + e] = v[e] + rb[e]; }
            int te[4]; float tv[4]; unsigned taken = 0u;
#pragma unroll
            for (int k = 0; k < 4; ++k) { float best = -3.0e38f; int bi = 0;
#pragma unroll
                for (int e = 0; e < 32; ++e) { const bool better = (((taken >> e) & 1u) == 0u) && (logit[e] > best); best = better ? logit[e] : best; bi = better ? e : bi; }
                te[k] = bi; tv[k] = best; taken |= 1u << bi; }
            float ex[4], sum = 0.f;
#pragma unroll
            for (int k = 0; k < 4; ++k) { ex[k] = __expf(tv[k] - tv[0]); sum += ex[k]; }
            const float inv = 1.0f / sum;
#pragma unroll
            for (int k = 0; k < 4; ++k) { const unsigned pos = __hip_atomic_fetch_add(lcnt + te[k], 1u, __ATOMIC_RELAXED, __HIP_MEMORY_SCOPE_WORKGROUP);
                TOPE[m * 4 + k] = te[k]; GATE[m * 4 + k] = ex[k] * inv; PPOS[m * 4 + k] = (int)pos; } }
        LDS_WAIT(); asm volatile("" ::: "memory");
    }
    __syncthreads();
    if (C.tid < 32) lbase[C.tid] = atomicAdd(gcnt + C.tid, lcnt[C.tid]);
    __syncthreads();
    for (int m0 = 4 * C.gw; m0 < NLAT; m0 += 4 * C.NGW) if (C.lane < 4 * NR) { const int idx = m0 * 4 + C.lane; const int e = TOPE[idx]; const int pos = PPOS[idx] + (int)lbase[e]; PPOS[idx] = pos; ROWTOK[e * 16384 + pos] = m0 + (C.lane >> 2); }
}
__device__ __forceinline__ void moe_tables(CArgs& a, const Ctx& C) {
    const unsigned* gcnt = (const unsigned*)(a.ws + WS_CTL) + CW_CNT; LAS int* TS = (LAS int*)(C.lds + TS_OFF); LAS int* CN = TS + 36;
    if (C.tid < 64) { const int e = C.tid & 31; const int c = (int)__hip_atomic_load(gcnt + e, RLX_AGENT); const int nt = (c + 255) >> 8;
        int pre = nt;
#pragma unroll
        for (int o = 1; o < 32; o <<= 1) { const int t = __shfl_up(pre, o, 32); pre += ((C.tid & 31) >= o) ? t : 0; }
        if (C.tid < 32) { TS[e] = pre - nt; CN[e] = c; if (e == 31) TS[NE] = pre; } }
    __syncthreads();
    if (C.tid < 320) { int e = 0;
#pragma unroll
        for (int k = 1; k < NE; ++k) e += (TS[k] <= C.tid) ? 1 : 0;
        TS[80 + C.tid] = e; }
    __syncthreads();
}
__device__ __forceinline__ void phase13(CArgs& a, const Ctx& C) {
    const float* MOD = (const float*)(a.ws + WS_MOD); const unsigned char* Y2 = a.ws + WS_Y2; const bf16* X1 = (const bf16*)(a.ws + WS_U);
    const int* TOPE = (const int*)(a.ws + WS_ROUTE); const float* GATE = (const float*)(a.ws + WS_ROUTE + 256 * 1024); const int* PPOS = (const int*)(a.ws + WS_ROUTE + 512 * 1024);
    moe_tables(a, C); const LAS int* TS = (const LAS int*)(C.lds + TS_OFF);
    for (int m0 = 4 * C.gw; m0 < NLAT; m0 += 4 * C.NGW) {
        const int b = m0 >> 12; const float* gf = MOD + b * 6144 + 5120;
        int slot = 0; float gk = 0.f;
        if (C.lane < 16) { const int idx = m0 * 4 + C.lane; slot = TS[TOPE[idx]] * 256 + PPOS[idx]; gk = GATE[idx] * (1.0f / Y_SCALE); }
        u32x4 yw[4][4];
#pragma unroll
        for (int r = 0; r < 4; ++r)
#pragma unroll
            for (int k = 0; k < 4; ++k) { const int sl = __shfl(slot, 4 * r + k); yw[r][k] = NTLOAD((const u32x4*)(Y2 + (size_t)sl * D + 16 * C.lane)); }
#pragma unroll
        for (int r = 0; r < 4; ++r) { float f[16];
#pragma unroll
            for (int e = 0; e < 16; ++e) f[e] = 0.f;
#pragma unroll
            for (int k = 0; k < 4; ++k) { const float g = __shfl(gk, 4 * r + k); const unsigned ww[4] = {yw[r][k].x, yw[r][k].y, yw[r][k].z, yw[r][k].w};
#pragma unroll
                for (int e = 0; e < 4; ++e) { const f32x2 lo = __builtin_amdgcn_cvt_pk_f32_fp8((int)ww[e], false), hi = __builtin_amdgcn_cvt_pk_f32_fp8((int)ww[e], true);
                    f[4 * e] += g * lo.x; f[4 * e + 1] += g * lo.y; f[4 * e + 2] += g * hi.x; f[4 * e + 3] += g * hi.y; } }
            float ss = 0.f;
#pragma unroll
            for (int e = 0; e < 16; ++e) ss += f[e] * f[e];
            const float rstd = rsqrtf(wave_sum(ss) * (1.0f / D) + EPS);
            const size_t ro = (size_t)(m0 + r) * D; const int k0 = 16 * C.lane;
            const u32x4 xa = NTLOAD((const u32x4*)(X1 + ro + k0)), xb = NTLOAD((const u32x4*)(X1 + ro + k0 + 8)); const unsigned xw[8] = {xa.x, xa.y, xa.z, xa.w, xb.x, xb.y, xb.z, xb.w};
#pragma unroll
            for (int e4 = 0; e4 < 4; ++e4) { const f32x4 w = *(const f32x4*)(a.ffn_post + k0 + 4 * e4), g = *(const f32x4*)(gf + k0 + 4 * e4);
                f32x4 o; o[0] = bflo(xw[2 * e4]) + g[0] * (f[4 * e4] * rstd * w[0]); o[1] = bfhi(xw[2 * e4]) + g[1] * (f[4 * e4 + 1] * rstd * w[1]);
                o[2] = bflo(xw[2 * e4 + 1]) + g[2] * (f[4 * e4 + 2] * rstd * w[2]); o[3] = bfhi(xw[2 * e4 + 1]) + g[3] * (f[4 * e4 + 3] * rstd * w[3]);
                *(f32x4*)(a.out + ro + k0 + 4 * e4) = o; } }
    }
}

struct ShadowWork { CArgs* ka; const Ctx* C; int fill, first, scr_off, scr_stride;
    __device__ __forceinline__ void operator()() const {
        if (fill == 2) phase2_fill(*ka, *C, C->tid - 64, 448);
        if (fill == 9) phase9_fill(*ka, *C, C->tid - 64, 448);
        if (first >= 0) conv_shadow(*ka, *C, first, C->lds + scr_off, scr_stride); } };
__global__ void __launch_bounds__(512, 2) mega_fwd(Args a) {
    extern __shared__ __attribute__((aligned(16))) unsigned char lds_raw[];
#define MKCTX(C) Ctx C; { int t_ = threadIdx.x; asm volatile("" : "+v"(t_)); C.lds = (LAS unsigned char*)lds_raw; C.tid = t_; C.lane = t_ & 63; C.wave = __builtin_amdgcn_readfirstlane(t_ >> 6); \
        C.G = gridDim.x; const int bx_ = blockIdx.x; C.vcu = (C.G % 8 == 0) ? (bx_ % 8) * (C.G / 8) + bx_ / 8 : bx_; C.gw = C.vcu * 8 + C.wave; C.NGW = C.G * 8; }
    MKCTX(C);
    volatile LAS unsigned* MISC = (volatile LAS unsigned*)(C.lds + MISC_OFF);
    for (int u = C.tid; u < (LDS_BYTES - LDSCTL_OFF) / 4; u += 512) ((LAS unsigned*)(C.lds + LDSCTL_OFF))[u] = 0u;
    __syncthreads();
    const int lo = a.ph_lo, hi = a.ph_hi;
    CArgs* const kargs = (CArgs*)__builtin_amdgcn_kernarg_segment_ptr();
#define KA() (*[&]() { CArgs* p_ = kargs; asm volatile("" : "+s"(p_)); return p_; }())
    if (hi - lo > 1) (void)xcd_barrier_post((unsigned*)(a.ws + WS_CTL) + CW_BAR, MISC + 8);
#define BAR() XcdBarrier{(unsigned*)(KA().ws + WS_CTL) + CW_BAR, xb_xcc_id(), (volatile LAS unsigned*)(C.lds + MISC_OFF) + 8}
#define IN(k) (lo <= (k) && (k) < hi)
#define NEXTPH(k) ((k) == 4 ? 6 : ((k) == 9 ? 11 : (k) + 1))
#define SEAM(k) do { if (IN(k) && IN(NEXTPH(k))) xcd_barrier(BAR()); } while (0)
#define SEAM_WORK(k, ...) do { if (IN(k) && IN(NEXTPH(k))) xcd_barrier(BAR(), __VA_ARGS__); } while (0)
#define SHADOW(sh) ShadowWork{&KA(), &C, 0, (sh) * CONV_B, 16384, 16384}
    if (IN(0)) { MKCTX(C); for (int rp = 0; rp < NREP(0); ++rp) phase0(KA(), C); SEAM_WORK(0, SHADOW(0)); }
    if (IN(1)) { MKCTX(C); for (int rp = 0; rp < NREP(1); ++rp) phase1(KA(), C); SEAM_WORK(1, ShadowWork{&KA(), &C, 2, 1 * CONV_B, 65536, 8448}); }
    if (IN(2)) { MKCTX(C); for (int rp = 0; rp < NREP(2); ++rp) { phase2(KA(), C, IN(1) && rp == 0); __syncthreads(); } SEAM_WORK(2, SHADOW(2)); }
    if (IN(3)) { MKCTX(C); pg8::Gemm g{(const bf16*)(KA().ws + WS_XN), (const bf16*)(KA().ws + WS_WINT), D}; pg8::StaticOrder S; S.init(MROWS, NU, C.G, (int)blockIdx.x);
        pg8::EpiBf16 E{(bf16*)(KA().ws + WS_U), NU, nullptr, 0, 1.0f};
        const bool odd = (C.vcu & 1) != 0;
        if (odd) { conv_range(KA(), C, CONV_W1_HOST, NIT1); __syncthreads(); }
        pg8::gemm_phase<false>(C.lds, g, S, E, pg8::DenseRows{}); __syncthreads();
        if (!odd) conv_range(KA(), C, CONV_W1_HOST, NIT1);
        SEAM_WORK(3, SHADOW(3)); }
    if (IN(4)) { MKCTX(C); for (int rp = 0; rp < NREP(4); ++rp) phase4(KA(), C); SEAM_WORK(4, SHADOW(4)); }

    if (IN(6)) { MKCTX(C); for (int rp = 0; rp < NREP(6); ++rp) phase6(KA(), C); SEAM_WORK(6, SHADOW(5)); }
    if (IN(7)) { MKCTX(C); for (int rp = 0; rp < NREP(7); ++rp) phase7(KA(), C); SEAM_WORK(7, SHADOW(6)); }
    if (IN(8)) { MKCTX(C); pg8::Gemm g{(const bf16*)(KA().ws + WS_Y), (const bf16*)(KA().ws + WS_WOUTT), D}; pg8::StaticOrder S; S.init(NLAT, D, C.G, (int)blockIdx.x);
        pg8::EpiBf16 E{(bf16*)(KA().ws + WS_MIX), D, nullptr, 0, 1.0f}; for (int rp = 0; rp < NREP(8); ++rp) pg8::gemm_phase<false>(C.lds, g, S, E, pg8::DenseRows{}); SEAM_WORK(8, ShadowWork{&KA(), &C, 9, -1, 0, 0}); }
    if (IN(9)) { MKCTX(C); phase9(KA(), C, IN(8)); SEAM_WORK(9, ShadowWork{&KA(), &C, 0, CONV_S9, 16384, 16384}); }
    if (IN(11)) { MKCTX(C); moe_tables(KA(), C); pg8::Gemm g{(const bf16*)(KA().ws + WS_XN), (const bf16*)(KA().ws + WS_W1T), D / 2};   pg8::MoeOrder S; S.init((const LAS int*)(C.lds + TS_OFF), 8, 4, (int)blockIdx.x);
        pg8::EpiSwiglu E{KA().ws + WS_ACT, D, KA().b1, 2048}; LAS unsigned* ROWL = (LAS unsigned*)(C.lds + 131072 + 2048);
        { const int* rowtok = (const int*)(KA().ws + WS_ROWTOK); const LAS int* TSl = (const LAS int*)(C.lds + TS_OFF); const LAS int* CNl = TSl + 36;
          for (int idx = C.tid; idx < 9 * 256; idx += 512) { const int i = idx >> 8, r = idx & 255; pg8::Unit uu;
              if (S.next(i, uu)) { const int p = (uu.pm - TSl[uu.e]) * 256 + r; const int tok = p < CNl[uu.e] ? rowtok[uu.e * 16384 + p] : 0; ROWL[idx] = (unsigned)tok * 1024u; } }
          __syncthreads(); }
        pg8::GatherRows AM{ROWL};
        const bool odd = (C.vcu & 1) != 0;
#pragma unroll 1
        for (int part = 0; part < 2; ++part) {
            if ((odd && part == 0) || (!odd && part == 1)) { conv_range(KA(), C, CONV_S9 + CONV_B, NIT1 + NIT2); __syncthreads(); }
            S.i0 = odd ? 0 : 4 * part; S.n = odd ? (part == 0 ? (1 << 30) : 0) : (part == 0 ? 4 : (1 << 30));
            pg8::gemm_phase<true>(C.lds, g, S, E, AM); __syncthreads(); }
        SEAM_WORK(11, ShadowWork{&KA(), &C, 0, -1, 0, 0}); }
    if (IN(12)) { MKCTX(C); moe_tables(KA(), C); pg8::Gemm g{(const bf16*)(KA().ws + WS_ACT), (const bf16*)(KA().ws + WS_W2T), D / 2}; pg8::MoeOrder S; S.init((const LAS int*)(C.lds + TS_OFF), 4, 8, (int)blockIdx.x);
        pg8::EpiFp8 E{KA().ws + WS_Y2, D, KA().b2, D, 1.0f / (W_SCALE * ACT_SCALE)}; for (int rp = 0; rp < NREP(12); ++rp) pg8::gemm_phase<true>(C.lds, g, S, E, pg8::DenseRows{}); SEAM(12); }
    if (IN(13)) { MKCTX(C); for (int rp = 0; rp < NREP(13); ++rp) phase13(KA(), C); }
#undef IN
#undef KA
#undef SEAM
}

extern "C" void kernel_launch(void* const* d_in, const int* in_sizes, int n_in, void* d_out, int out_size, void* d_ws, size_t ws_size, hipStream_t stream) {
    static int grid = 0;
    if (grid == 0) {
        if (n_in != 26 || in_sizes[0] != NLAT * D || out_size != NLAT * D || ws_size < WS_END) {
            fprintf(stderr, "kernel_launch: unexpected shapes: n_in %d in0 %d out %d ws %zu (need %zu); nothing launched\n", n_in, n_in > 0 ? in_sizes[0] : -1, out_size, ws_size, (size_t)WS_END); grid = -1; return; }
        int dev = 0, cus = 0, per_cu = 0;
        if (hipGetDevice(&dev) != hipSuccess || hipDeviceGetAttribute(&cus, hipDeviceAttributeMultiprocessorCount, dev) != hipSuccess) { fprintf(stderr, "kernel_launch: device query failed\n"); grid = -1; return; }
        if (hipFuncSetAttribute((const void*)mega_fwd, hipFuncAttributeMaxDynamicSharedMemorySize, LDS_BYTES) != hipSuccess) { fprintf(stderr, "kernel_launch: hipFuncSetAttribute failed\n"); grid = -1; return; }
        if (hipOccupancyMaxActiveBlocksPerMultiprocessor(&per_cu, (const void*)mega_fwd, 512, LDS_BYTES) != hipSuccess || per_cu < 1)
            fprintf(stderr, "kernel_launch: note: occupancy query reports %d workgroups per CU\n", per_cu);
        (void)hipGetLastError();
        grid = cus;
        if (grid != 256) { fprintf(stderr, "kernel_launch: this kernel needs a 256-CU device (got %d)\n", grid); grid = -1; return; }
    }
    if (grid < 0) return;
    (void)hipMemsetAsync((char*)d_ws + WS_CTL, 0, CTL_ZERO_BYTES, stream);
    Args a{};
    const float** ap = (const float**)&a;
    for (int i = 0; i < 26; ++i) ap[i] = (const float*)d_in[i];
    a.out = (float*)d_out; a.ws = (unsigned char*)d_ws;
#if MK_PER_PHASE
    for (int p = 0; p < NPHASE; ++p) { a.ph_lo = p; a.ph_hi = p + 1; hipLaunchKernelGGL(mega_fwd, dim3(grid), dim3(512), LDS_BYTES, stream, a); }
#else
    a.ph_lo = 0; a.ph_hi = NPHASE; hipLaunchKernelGGL(mega_fwd, dim3(grid), dim3(512), LDS_BYTES, stream, a);
#endif
}
```

```cpp
#include <hip/hip_runtime.h>
#include <cstdio>
#include <cstdint>

#ifndef MK_PER_PHASE
#define MK_PER_PHASE 0
#endif

#ifndef PROBE_REP_MASK
#define PROBE_REP_MASK 0u
#endif
#define NREP(k) ((((PROBE_REP_MASK) >> (k)) & 1u) ? 2 : 1)
#define LAS __attribute__((address_space(3)))
typedef unsigned short bf16;
typedef short bf16x8 __attribute__((ext_vector_type(8)));
typedef float f32x4 __attribute__((ext_vector_type(4)));
typedef float f32x2 __attribute__((ext_vector_type(2)));
typedef unsigned u32x4 __attribute__((ext_vector_type(4)));
typedef unsigned u32x2 __attribute__((ext_vector_type(2)));
typedef int i32x4 __attribute__((ext_vector_type(4)));
typedef int i32x8 __attribute__((ext_vector_type(8)));

constexpr int D = 1024, NB = 4, SEQ = 4096, CTXL = 256;
constexpr int NLAT = NB * SEQ, NCTX = NB * CTXL, MROWS = NLAT + NCTX;
constexpr int NU = 3840;
constexpr int W_IN_COLS = 3856;
constexpr int SP = CTXL + SEQ;
constexpr int NCH = SP / 64;
constexpr int NPR = NCH / 2;
constexpr int NE = 32;
constexpr float EPS = 1e-6f;
constexpr int NPHASE = 14;

constexpr size_t MiB = 1u << 20;
constexpr size_t WS_CTL = 0, CTL_ZERO_BYTES = 1 * MiB;
constexpr size_t WS_MODP = 1 * MiB, WS_MOD = 5 * MiB, WS_DTRAW = 6 * MiB, WS_WINT = 8 * MiB, WS_WOUTT = 16 * MiB;
constexpr size_t WS_W1T = 18 * MiB, WS_W2T = 146 * MiB, WS_XN = 210 * MiB, WS_U = 244 * MiB;
constexpr size_t WS_BC = 372 * MiB, WS_XST = 381 * MiB, WS_XSW = 398 * MiB, WS_BT = 432 * MiB, WS_GA = 437 * MiB, WS_DTA = 439 * MiB, WS_GEND = 441 * MiB;
constexpr size_t WS_QS = 442 * MiB, WS_KS = 476 * MiB, WS_KHT = 510 * MiB, WS_VT = 544 * MiB, WS_EG = 561 * MiB;
constexpr size_t WS_DSP = WS_KHT, WS_EGP = WS_EG + 1179648;
constexpr size_t WS_DSS = 563 * MiB, WS_DSH = 631 * MiB, WS_SPS = 767 * MiB, WS_SPH = 801 * MiB, WS_Y = 869 * MiB, WS_MIX = 901 * MiB, WS_ROUTE = 965 * MiB;
constexpr size_t WS_XS = 372 * MiB, WS_ACT = 516 * MiB, WS_Y2 = 660 * MiB;
constexpr size_t WS_ROWTOK = 966 * MiB;
constexpr size_t WS_END = 968 * MiB;
constexpr int CW_BAR = 4096, CW_CNT = 16384;

constexpr int LDS_BYTES = 147456;
constexpr int LDSCTL_OFF = 144896;
constexpr int MISC_OFF = LDSCTL_OFF;
constexpr int TS_OFF = LDSCTL_OFF + 128;
constexpr int LCNT_OFF = LDSCTL_OFF + 2048;

typedef __bf16 bf16x2_t __attribute__((ext_vector_type(2)));
__device__ __forceinline__ unsigned cvt_pk_bf16(float lo, float hi) { const f32x2 v = {lo, hi}; const bf16x2_t b = __builtin_convertvector(v, bf16x2_t); return __builtin_bit_cast(unsigned, b); }
__device__ __forceinline__ unsigned pk4_fp8(float a, float b, float c, float d) { int w = __builtin_amdgcn_cvt_pk_fp8_f32(a, b, 0, false); w = __builtin_amdgcn_cvt_pk_fp8_f32(c, d, w, true); return (unsigned)w; }
constexpr float W_SCALE = 64.0f, ACT_SCALE = 4.0f, Y_SCALE = 16.0f;
__device__ __forceinline__ float bf2f(unsigned short b) { return __uint_as_float(((unsigned)b) << 16); }
__device__ __forceinline__ float bflo(unsigned w) { return __uint_as_float(w << 16); }
__device__ __forceinline__ float bfhi(unsigned w) { return __uint_as_float(w & 0xffff0000u); }
__device__ __forceinline__ float siluf(float x) { return x * __builtin_amdgcn_rcpf(1.0f + __expf(-x)); }
__device__ __forceinline__ float wave_sum(float v) {
#pragma unroll
    for (int o = 1; o < 64; o <<= 1) v += __shfl_xor(v, o);
    return v;
}
#define LDS_WAIT() asm volatile("s_waitcnt lgkmcnt(0)" ::: "memory")
#define VM_WAIT() asm volatile("s_waitcnt vmcnt(0)" ::: "memory")
#define LDS_BARRIER() do { asm volatile("s_waitcnt lgkmcnt(0)" ::: "memory"); __builtin_amdgcn_s_barrier(); asm volatile("" ::: "memory"); } while (0)
#define RLX_AGENT __ATOMIC_RELAXED, __HIP_MEMORY_SCOPE_AGENT
#define NTLOAD(p) __builtin_nontemporal_load(p)
#define MFMA16(a, b, c) __builtin_amdgcn_mfma_f32_16x16x32_bf16((a), (b), (c), 0, 0, 0)

namespace pg8 {
constexpr int BM = 256, BK = 64, HALF = 128, HTB = HALF * BK * 2, STAGE_BYTES = 8 * HTB, NXCD = 8, WGM = 8;
__host__ __device__ __forceinline__ int lds_byte(int r, int c) { const int st = (r >> 4) * 2 + (c >> 5), rr = r & 15, cc = c & 31, ob = rr * 64 + cc * 2; return st * 1024 + (ob ^ (((ob >> 9) & 1) << 5)); }
__host__ __device__ __forceinline__ void stage_rc(int b, int& R, int& C) { const int st = b / 1024, sb = b % 1024, swz = sb ^ (((sb >> 9) & 1) << 5); R = (st >> 1) * 16 + swz / 64; C = (st & 1) * 32 + (swz % 64) / 2; }
__host__ __device__ __forceinline__ int perm32(int rho) { const int n = rho >> 4, i = rho & 15; return 8 * (i >> 2) + 4 * n + (i & 3); }

struct Unit { int pm, pn, pb, e, ord; };
struct Gemm { const bf16* A; const bf16* Bt; int K; };
struct DenseRows {
    __device__ __forceinline__ size_t ubase(const Unit& u, int h, int K) const { return (size_t)(u.pm * BM + h * HALF) * K * 2; }
    __device__ __forceinline__ unsigned lane_off(const Unit&, int, int R, int K) const { return (unsigned)(R * K) * 2u; } };
struct GatherRows { const LAS unsigned* rowl;
    __device__ __forceinline__ size_t ubase(const Unit&, int, int) const { return 0; }
    __device__ __forceinline__ unsigned lane_off(const Unit& u, int h, int R, int) const { return rowl[u.ord * BM + h * HALF + R]; } };

struct StaticOrder {
    int nM, nN, nwg, G, c, i0, n;
    __device__ __forceinline__ void init(int M, int N, int G_, int c_) { nM = M / BM; nN = N / BM; nwg = nM * nN; G = G_; c = c_; i0 = 0; n = 1 << 30; }
    __device__ __forceinline__ bool next(int i_, Unit& u) const {
        if (i_ >= n) return false; const int i = i_ + i0;
        const long L = (long)i * G + c; if (L >= nwg) return false;
        int wgid = (int)L; { const int q = nwg / NXCD, r = nwg % NXCD, xcd = wgid % NXCD, off = wgid / NXCD; wgid = (xcd < r ? xcd * (q + 1) : r * (q + 1) + (xcd - r) * q) + off; }
        const int nig = WGM * nN, gid = wgid / nig, fm = gid * WGM, gsz = (nM - fm) < WGM ? (nM - fm) : WGM;
        u.pm = fm + ((wgid % nig) % gsz); u.pn = (wgid % nig) / gsz; u.pb = u.pn; u.e = 0; u.ord = i; return true;
    }
};
struct MoeOrder {
    const LAS int* ts; int ntn, mg, x, j, i0, n, nfull, tmt, tnt, nidle, irank;
    __device__ __forceinline__ void init(const LAS int* ts_, int ntn_, int mg_, int c) { ts = ts_; ntn = ntn_; mg = mg_; x = c & 7; j = c >> 3; i0 = 0; n = 1 << 30;
        const int full = __builtin_amdgcn_readfirstlane(ts[NE]), per = mg * 8; nfull = full / per;
        const int rem = full - nfull * per, q = (rem + 7) >> 3; tmt = -1; tnt = 0;
        if (rem > 0) { const int nt = j / q, mt = nfull * per + x * q + (j - nt * q); if (nt < ntn && mt < full) { tmt = mt; tnt = nt; } }
        nidle = 0; irank = -1;
#pragma unroll
        for (int xx = 0; xx < 8; ++xx) { int mx = rem - xx * q; mx = mx < 0 ? 0 : (mx > q ? q : mx);
            if (xx == x && tmt < 0) { const int jj = j < q * ntn ? j : q * ntn; const int tb = q > 0 ? (jj / q) * mx + ((jj % q) < mx ? (jj % q) : mx) : 0; irank = nidle + (j - tb); }
            nidle += 32 - ntn * mx; } }
    __device__ __forceinline__ bool next(int i_, Unit& u) const {
        if (i_ >= n) return false; const int i = i_ + i0;
        int mt, nt;
        if (i < nfull) { mt = mg * (i * 8 + x) + (j % mg); nt = j / mg; }
        else if (i == nfull && tmt >= 0) { mt = tmt; nt = tnt; }
        else return false;
        const int e = __builtin_amdgcn_readfirstlane(ts[80 + mt]);
        u.pm = mt; u.pn = nt; u.e = e; u.pb = e * ntn + nt; u.ord = i; return true;
    }
};

struct EpiF32 {
    static constexpr bool PERM = false, SWZ = false;
    float* C; int ldc;
    __device__ __forceinline__ const float* bias_src(const Unit&) const { return nullptr; }
    __device__ __forceinline__ void operator()(const f32x4 (&acc)[2][2][4][2], const Unit& u, int wr, int wc, int fr, int fq, const LAS float*) const {
        const int row0 = u.pm * BM + wr * 64 + fr, col0 = u.pn * BM + wc * 32 + 4 * fq;
#pragma unroll
        for (int ai = 0; ai < 2; ++ai)
#pragma unroll
            for (int m = 0; m < 4; ++m) { float* rowp = C + (size_t)(row0 + ai * HALF + m * 16) * ldc + col0;
#pragma unroll
                for (int bj = 0; bj < 2; ++bj)
#pragma unroll
                    for (int n = 0; n < 2; ++n) *(f32x4*)(rowp + bj * HALF + n * 16) = acc[ai][bj][m][n]; }
    }
};
struct EpiBf16 {
    static constexpr bool PERM = true, SWZ = false;
    bf16* O; int ldc; const float* bias; int bias_stride; float scale;
    __device__ __forceinline__ const float* bias_src(const Unit& u) const { return bias ? bias + (size_t)u.e * bias_stride + u.pn * BM : nullptr; }
    __device__ __forceinline__ void operator()(const f32x4 (&acc)[2][2][4][2], const Unit& u, int wr, int wc, int fr, int fq, const LAS float* bl) const {
        const int row0 = u.pm * BM + wr * 64 + fr, col0 = u.pn * BM + wc * 32 + 8 * fq;
        f32x4 bv[2][2];
#pragma unroll
        for (int bj = 0; bj < 2; ++bj)
#pragma unroll
            for (int n = 0; n < 2; ++n) bv[bj][n] = bias ? *(const LAS f32x4*)(bl + wc * 32 + 8 * fq + bj * HALF + 4 * n) : (f32x4){0.f, 0.f, 0.f, 0.f};
#pragma unroll
        for (int ai = 0; ai < 2; ++ai)
#pragma unroll
            for (int m = 0; m < 4; ++m) { bf16* rowp = O + (size_t)(row0 + ai * HALF + m * 16) * ldc + col0;
#pragma unroll
                for (int bj = 0; bj < 2; ++bj) { const f32x4 v0 = acc[ai][bj][m][0] * scale + bv[bj][0], v1 = acc[ai][bj][m][1] * scale + bv[bj][1];
                    u32x4 w; w.x = cvt_pk_bf16(v0[0], v0[1]); w.y = cvt_pk_bf16(v0[2], v0[3]); w.z = cvt_pk_bf16(v1[0], v1[1]); w.w = cvt_pk_bf16(v1[2], v1[3]);
                    *(u32x4*)(rowp + bj * HALF) = w; } }
    }
};
struct EpiFp8 {
    static constexpr bool PERM = true, SWZ = false;
    unsigned char* O; int ldc; const float* bias; int bias_stride; float scale;
    __device__ __forceinline__ const float* bias_src(const Unit& u) const { return bias + (size_t)u.e * bias_stride + u.pn * BM; }
    __device__ __forceinline__ void operator()(const f32x4 (&acc)[2][2][4][2], const Unit& u, int wr, int wc, int fr, int fq, const LAS float* bl) const {
        const int row0 = u.pm * BM + wr * 64 + fr, col0 = u.pn * BM + wc * 32 + 8 * fq;
        f32x4 bv[2][2];
#pragma unroll
        for (int bj = 0; bj < 2; ++bj)
#pragma unroll
            for (int n = 0; n < 2; ++n) bv[bj][n] = *(const LAS f32x4*)(bl + wc * 32 + 8 * fq + bj * HALF + 4 * n) * Y_SCALE;
        const float sc = scale * Y_SCALE;
#pragma unroll
        for (int ai = 0; ai < 2; ++ai)
#pragma unroll
            for (int m = 0; m < 4; ++m) { unsigned char* rowp = O + (size_t)(row0 + ai * HALF + m * 16) * ldc + col0;
#pragma unroll
                for (int bj = 0; bj < 2; ++bj) { const f32x4 v0 = acc[ai][bj][m][0] * sc + bv[bj][0], v1 = acc[ai][bj][m][1] * sc + bv[bj][1];
                    *(u32x2*)(rowp + bj * HALF) = (u32x2){pk4_fp8(v0[0], v0[1], v0[2], v0[3]), pk4_fp8(v1[0], v1[1], v1[2], v1[3])}; } }
    }
};
__device__ __forceinline__ f32x2 swiglu2(f32x2 glu, f32x2 lin) {
    const f32x2 g = (f32x2){fminf(glu.x, 7.0f), fminf(glu.y, 7.0f)}, l = (f32x2){__builtin_amdgcn_fmed3f(lin.x, -7.0f, 7.0f), __builtin_amdgcn_fmed3f(lin.y, -7.0f, 7.0f)};
    const f32x2 ea = g * (-1.702f * 1.4426950408889634f);
    const f32x2 den = (f32x2){__builtin_amdgcn_exp2f(ea.x), __builtin_amdgcn_exp2f(ea.y)} + 1.0f;
    const f32x2 r = (f32x2){__builtin_amdgcn_rcpf(den.x), __builtin_amdgcn_rcpf(den.y)};
    return (g * r) * (l * ACT_SCALE + ACT_SCALE);
}
struct EpiSwiglu {
    static constexpr bool PERM = true, SWZ = true;
    unsigned char* O; int ldc; const float* bias; int bias_stride;
    __device__ __forceinline__ const float* bias_src(const Unit& u) const { return bias + (size_t)u.e * bias_stride + u.pn * BM; }
    __device__ __forceinline__ void operator()(const f32x4 (&acc)[2][2][4][2], const Unit& u, int wr, int wc, int fr, int fq, const LAS float* bl) const {
        const int row0 = u.pm * BM + wr * 64 + fr, col0 = u.pn * BM + wc * 32 + 8 * fq, ocol0 = col0 >> 1;
        f32x4 bv[2][2];
#pragma unroll
        for (int bj = 0; bj < 2; ++bj)
#pragma unroll
            for (int n = 0; n < 2; ++n) { const f32x4 t = *(const LAS f32x4*)(bl + wc * 32 + 8 * fq + bj * HALF + 4 * n); bv[bj][n] = (f32x4){t[0], t[2], t[1], t[3]}; }
#pragma unroll
        for (int ai = 0; ai < 2; ++ai)
#pragma unroll
            for (int m = 0; m < 4; ++m) { unsigned char* rowp = O + (size_t)(row0 + ai * HALF + m * 16) * ldc + ocol0;
#pragma unroll
                for (int bj = 0; bj < 2; ++bj) { const f32x4 v0 = acc[ai][bj][m][0] * (1.0f / W_SCALE) + bv[bj][0], v1 = acc[ai][bj][m][1] * (1.0f / W_SCALE) + bv[bj][1];
                    const f32x2 o0 = swiglu2((f32x2){v0[0], v0[1]}, (f32x2){v0[2], v0[3]}), o1 = swiglu2((f32x2){v1[0], v1[1]}, (f32x2){v1[2], v1[3]});
                    *(unsigned*)(rowp + bj * (HALF / 2)) = pk4_fp8(o0.x, o0.y, o1.x, o1.y); } }
    }
};

template <bool F8, class Epi, class Sched, class AMap>
__device__ __forceinline__ void gemm_phase(LAS unsigned char* lds, const Gemm g, const Sched& S, const Epi& E, const AMap& AM) {
    const int tid = threadIdx.x, wid = __builtin_amdgcn_readfirstlane(tid >> 6), lane = tid & 63, wr = wid >> 2, wc = wid & 3, fr = lane & 15, fq = lane >> 4;
    const int K = g.K, nt = K / BK;
    unsigned voffB[2];
#pragma unroll
    for (int i = 0; i < 2; ++i) { int R, C; stage_rc(tid * 16 + i * 8192, R, C); int Rb = Epi::PERM ? ((R & ~31) + perm32(R & 31)) : R; if constexpr (Epi::SWZ) Rb = (Rb & ~3) | ((Rb & 1) << 1) | ((Rb >> 1) & 1);
        voffB[i] = (unsigned)(Rb * K + C) * 2u; }
    unsigned vA0[2], vA1[2], nA0[2], nA1[2];
#define PG8_AOFF(u, o0, o1) do { int _t = tid; asm volatile("" : "+v"(_t));   _Pragma("unroll") for (int _i = 0; _i < 2; ++_i) { int _R, _C; stage_rc(_t * 16 + _i * 8192, _R, _C); \
        o0[_i] = AM.lane_off(u, 0, _R, K) + (unsigned)_C * 2u; o1[_i] = AM.lane_off(u, 1, _R, K) + (unsigned)_C * 2u; } } while (0)
    const size_t kstep = (size_t)(BK * 2);
    const size_t hstep = (size_t)HALF * K * 2;
    const size_t tstep = 2 * hstep;
    const unsigned ldsw = (unsigned)wid * 1024u;
    const int aoff = lds_byte(wr * 64 + fr, fq * 8), boff = lds_byte(wc * 32 + fr, fq * 8);
#define PG8_SA(b, h) (((b) * 2 + (h)) * HTB)
#define PG8_SB(b, h) ((4 + (b) * 2 + (h)) * HTB)
#define PG8_STAGE(bufoff, gbase, voff) do { _Pragma("unroll") for (int _i = 0; _i < 2; ++_i) \
        __builtin_amdgcn_global_load_lds((const unsigned*)((const char*)(gbase) + (voff)[_i]), (LAS unsigned*)(lds + (bufoff) + ldsw + _i * 8192), 16, 0, 0); } while (0)
#define PG8_LDA(dst, b, h) do { _Pragma("unroll") for (int m = 0; m < 4; ++m) { const i32x4 _lo = *(const LAS i32x4*)(lds + PG8_SA(b, h) + aoff + m * 2048), _hi = *(const LAS i32x4*)(lds + PG8_SA(b, h) + aoff + m * 2048 + 1024); \
        dst[m] = __builtin_shufflevector(_lo, _hi, 0, 1, 2, 3, 4, 5, 6, 7); } } while (0)
#define PG8_LDB(dst, b, h) do { _Pragma("unroll") for (int n = 0; n < 2; ++n) { const i32x4 _lo = *(const LAS i32x4*)(lds + PG8_SB(b, h) + boff + n * 2048), _hi = *(const LAS i32x4*)(lds + PG8_SB(b, h) + boff + n * 2048 + 1024); \
        dst[n] = __builtin_shufflevector(_lo, _hi, 0, 1, 2, 3, 4, 5, 6, 7); } } while (0)
#define PG8_LO(x) __builtin_bit_cast(bf16x8, __builtin_shufflevector(x, x, 0, 1, 2, 3))
#define PG8_HI(x) __builtin_bit_cast(bf16x8, __builtin_shufflevector(x, x, 4, 5, 6, 7))
#define PG8_MMA(ai, bj, At, Bt) do { __builtin_amdgcn_s_setprio(1); _Pragma("unroll") for (int m = 0; m < 4; ++m) _Pragma("unroll") for (int n = 0; n < 2; ++n) { \
        if constexpr (F8) asm volatile("v_mfma_scale_f32_16x16x128_f8f6f4 %0, %1, %2, %0, %3, %3 op_sel_hi:[0,0,0]" : "+v"(acc[ai][bj][m][n]) : "v"(Bt[n]), "v"(At[m]), "v"(f8scale)); \
        else { acc[ai][bj][m][n] = __builtin_amdgcn_mfma_f32_16x16x32_bf16(PG8_LO(Bt[n]), PG8_LO(At[m]), acc[ai][bj][m][n], 0, 0, 0); \
               acc[ai][bj][m][n] = __builtin_amdgcn_mfma_f32_16x16x32_bf16(PG8_HI(Bt[n]), PG8_HI(At[m]), acc[ai][bj][m][n], 0, 0, 0); } } \
        __builtin_amdgcn_s_setprio(0); } while (0)
#define PG8_WAIT_V(n) asm volatile("s_waitcnt vmcnt(" #n ")" ::: "memory")
#define PG8_WAIT_L(n) asm volatile("s_waitcnt lgkmcnt(" #n ")" ::: "memory")
#define PG8_BAR __builtin_amdgcn_s_barrier()
#define PG8_SCHED __builtin_amdgcn_sched_barrier(0)
    Unit cur, nxt; int ui = 0;
    if (!S.next(0, cur)) return;
    f32x4 acc[2][2][4][2];
#pragma unroll
    for (int a = 0; a < 2; ++a)
#pragma unroll
        for (int b = 0; b < 2; ++b)
#pragma unroll
            for (int m = 0; m < 4; ++m)
#pragma unroll
                for (int n = 0; n < 2; ++n) acc[a][b][m][n] = (f32x4){0.f, 0.f, 0.f, 0.f};
    i32x8 At[4], B0[2], B1[2];
    int f8scale = 0x7F7F7F7F; asm volatile("" : "+v"(f8scale));
    LAS float* const biasl = (LAS float*)(lds + STAGE_BYTES);
#define PG8_BIAS(u, slot) do { const float* _bs = E.bias_src(u); if (_bs != nullptr && wid == 0) { int _ln = lane; asm volatile("" : "+v"(_ln));     \
        __builtin_amdgcn_global_load_lds((const unsigned*)(_bs + _ln * 4), (LAS unsigned*)(biasl + (slot) * 256), 16, 0, 0); } } while (0)
    PG8_BIAS(cur, 0);
    const char* cA0 = (const char*)g.A + AM.ubase(cur, 0, K); const char* cA1 = (const char*)g.A + AM.ubase(cur, 1, K); const char* cB = (const char*)g.Bt + (size_t)cur.pb * tstep;
    PG8_AOFF(cur, vA0, vA1);
    PG8_STAGE(PG8_SB(0, 0), cB, voffB); PG8_STAGE(PG8_SB(0, 1), cB + hstep, voffB); PG8_STAGE(PG8_SA(0, 0), cA0, vA0); PG8_STAGE(PG8_SA(0, 1), cA1, vA1);
    if (wr == 1) PG8_BAR;
    PG8_WAIT_V(2); PG8_BAR;
    PG8_STAGE(PG8_SB(1, 0), cB + kstep, voffB); PG8_STAGE(PG8_SA(1, 0), cA0 + kstep, vA0); PG8_STAGE(PG8_SB(1, 1), cB + hstep + kstep, voffB);
    PG8_WAIT_V(6); PG8_BAR;
    for (;;) {
        const bool has_next = S.next(ui + 1, nxt);
        const char* nB = has_next ? (const char*)g.Bt + (size_t)nxt.pb * tstep : cB;
        const char* nxA0 = has_next ? (const char*)g.A + AM.ubase(nxt, 0, K) : cA0; const char* nxA1 = has_next ? (const char*)g.A + AM.ubase(nxt, 1, K) : cA1;
        if (has_next) { PG8_AOFF(nxt, nA0, nA1); PG8_BIAS(nxt, (ui + 1) & 1); } else { nA0[0] = vA0[0]; nA0[1] = vA0[1]; nA1[0] = vA1[0]; nA1[1] = vA1[1]; }
#pragma unroll 1
        for (int t = 0; t < nt; t += 2) {
            const bool last = (t == nt - 2);
            const char* a1 = cA1 + (size_t)(t + 1) * kstep;
            const char* a2 = last ? nxA0 : cA0 + (size_t)(t + 2) * kstep; const char* a2h = last ? nxA1 : cA1 + (size_t)(t + 2) * kstep; const char* b2 = last ? nB : cB + (size_t)(t + 2) * kstep;
            const char* a3 = a2 + kstep; const char* b3 = b2 + kstep;
            unsigned w0[2], w1[2];
            w0[0] = last ? nA0[0] : vA0[0]; w0[1] = last ? nA0[1] : vA0[1]; w1[0] = last ? nA1[0] : vA1[0]; w1[1] = last ? nA1[1] : vA1[1];
            PG8_LDB(B0, 0, 0); PG8_LDB(B1, 0, 1); PG8_SCHED; PG8_LDA(At, 0, 0); PG8_STAGE(PG8_SA(1, 1), a1, vA1);
            PG8_WAIT_V(8); PG8_WAIT_L(0); PG8_BAR; PG8_MMA(0, 0, At, B0); PG8_MMA(0, 1, At, B1); PG8_BAR; PG8_SCHED;
            PG8_LDA(At, 0, 1); PG8_STAGE(PG8_SB(0, 0), b2, voffB); PG8_STAGE(PG8_SB(0, 1), b2 + hstep, voffB); PG8_STAGE(PG8_SA(0, 0), a2, w0);
            PG8_WAIT_V(8); PG8_WAIT_L(0); PG8_BAR; PG8_MMA(1, 0, At, B0); PG8_MMA(1, 1, At, B1); PG8_BAR; PG8_SCHED;
            PG8_LDB(B0, 1, 0); PG8_LDB(B1, 1, 1); PG8_SCHED; PG8_LDA(At, 1, 0); PG8_STAGE(PG8_SA(0, 1), a2h, w1);
            PG8_WAIT_V(8); PG8_WAIT_L(0); PG8_BAR; PG8_MMA(0, 0, At, B0); PG8_MMA(0, 1, At, B1); PG8_BAR; PG8_SCHED;
            PG8_LDA(At, 1, 1); PG8_STAGE(PG8_SB(1, 0), b3, voffB); PG8_STAGE(PG8_SB(1, 1), b3 + hstep, voffB); PG8_STAGE(PG8_SA(1, 0), a3, w0);
            PG8_WAIT_V(8); PG8_WAIT_L(0); PG8_BAR; PG8_MMA(1, 0, At, B0); PG8_MMA(1, 1, At, B1); PG8_BAR; PG8_SCHED;
        }
        if (wr == 0) PG8_BAR;
        if constexpr (F8) asm volatile("s_nop 15\n\ts_nop 15" ::: "memory");
        { int ln_e = lane; asm volatile("" : "+v"(ln_e));
          E(acc, cur, wr, wc, ln_e & 15, ln_e >> 4, biasl + (ui & 1) * 256); }
        if (!has_next) break;
#pragma unroll
        for (int a = 0; a < 2; ++a)
#pragma unroll
            for (int b = 0; b < 2; ++b)
#pragma unroll
                for (int m = 0; m < 4; ++m)
#pragma unroll
                    for (int n = 0; n < 2; ++n) acc[a][b][m][n] = (f32x4){0.f, 0.f, 0.f, 0.f};
        cur = nxt; cB = nB; cA0 = nxA0; cA1 = nxA1; ++ui; vA0[0] = nA0[0]; vA0[1] = nA0[1]; vA1[0] = nA1[0]; vA1[1] = nA1[1];
        if (wr == 1) PG8_BAR;
    }
    PG8_WAIT_V(0);
    PG8_BAR;
#undef PG8_AOFF
#undef PG8_BIAS
#undef PG8_SA
#undef PG8_SB
#undef PG8_STAGE
#undef PG8_LDA
#undef PG8_LDB
#undef PG8_MMA
#undef PG8_LO
#undef PG8_HI
#undef PG8_WAIT_V
#undef PG8_WAIT_L
#undef PG8_BAR
#undef PG8_SCHED
}
}

#define XB_TMO      128
#define XB_XCNT(j)  (256  + 64 * (j))
#define XB_XSUB(j)  (1280 + 64 * (j))
#define XB_XGEN(j)  (2304 + 64 * (j))
#define XB_TOP      3328
#define XB_TOPGEN   3392
#define XCD_BAR_WORDS 3456
#define XB_SPIN_CAP (1u << 22)
__device__ __forceinline__ unsigned xb_ld(unsigned* p)              { return __hip_atomic_load(p, __ATOMIC_RELAXED, __HIP_MEMORY_SCOPE_AGENT); }
__device__ __forceinline__ unsigned xb_add(unsigned* p, unsigned v) { return __hip_atomic_fetch_add(p, v, __ATOMIC_RELAXED, __HIP_MEMORY_SCOPE_AGENT); }
__device__ __forceinline__ unsigned xb_xcc_id() { return (unsigned)__builtin_amdgcn_s_getreg((3 << 11) | 20) & 0xFu; }
#define XB_SPIN(cond, bar) do { unsigned _sp = 0; while (cond) { __builtin_amdgcn_s_sleep(1); \
    if ((++_sp & 255u) == 0u) { if (xb_ld(&(bar)[XB_TMO])) break; if (_sp > XB_SPIN_CAP) { atomicAdd(&(bar)[XB_TMO], 1u); break; } } } } while (0)
struct XcdBarrier { unsigned* bar; unsigned x; volatile LAS unsigned* st; };
__device__ __forceinline__ XcdBarrier xcd_barrier_post(unsigned* bar, volatile LAS unsigned* st) {
    XcdBarrier b; b.bar = bar; b.x = xb_xcc_id(); b.st = st;
    if (threadIdx.x == 0) (void)xb_add(&bar[XB_XCNT(b.x)], 1u);
    return b;
}
__device__ __forceinline__ void xcd_barrier_complete(unsigned* bar, unsigned x, unsigned& nloc, unsigned& nx) {
    const unsigned G = gridDim.x * gridDim.y * gridDim.z;
    unsigned sum, cnt, mine, sp = 0u;
    for (;;) {
        sum = 0u; cnt = 0u; mine = 0u;
#pragma unroll
        for (unsigned j = 0; j < 16; ++j) { const unsigned c = xb_ld(&bar[XB_XCNT(j)]); sum += c; cnt += (c > 0u) ? 1u : 0u; mine = (j == x) ? c : mine; }
        if (sum == G) break;
        __builtin_amdgcn_s_sleep(1);
        if ((++sp & 255u) == 0u) { if (xb_ld(&bar[XB_TMO])) break; if (sp > XB_SPIN_CAP) { atomicAdd(&bar[XB_TMO], 1u); break; } }
    }
    nloc = mine > 0u ? mine : 1u; nx = cnt > 0u ? cnt : 1u;
}
struct NoWork { __device__ __forceinline__ void operator()() const {} };
template <class F = NoWork> __device__ __forceinline__ void xcd_barrier(const XcdBarrier& b, F work = F{}) {
    asm volatile("s_waitcnt vmcnt(0)" ::: "memory");
    __syncthreads();
    if (threadIdx.x >= 64) work();
    if (threadIdx.x == 0) {
        unsigned* bar = b.bar;
        __builtin_amdgcn_s_waitcnt(0);
        unsigned nloc = b.st[0], nx = b.st[1];
        if (nloc == 0u) { xcd_barrier_complete(bar, b.x, nloc, nx); b.st[0] = nloc; b.st[1] = nx; }
        const unsigned old = xb_add(&bar[XB_XSUB(b.x)], 1u);
        const unsigned gen = old / nloc;
        if (old + 1u == (gen + 1u) * nloc) {
            __builtin_amdgcn_fence(__ATOMIC_RELEASE, "agent");
            asm volatile("s_waitcnt vmcnt(0)" ::: "memory");
            const unsigned og = xb_add(&bar[XB_TOP], 1u);
            const unsigned tg = og / nx;
            if (og + 1u == (tg + 1u) * nx) xb_add(&bar[XB_TOPGEN], 1u);
            else XB_SPIN(xb_ld(&bar[XB_TOPGEN]) == tg, bar);
            __builtin_amdgcn_fence(__ATOMIC_ACQUIRE, "agent");
            xb_add(&bar[XB_XGEN(b.x)], 1u);
            asm volatile("s_waitcnt vmcnt(0)" ::: "memory");
        } else {
            XB_SPIN(xb_ld(&bar[XB_XGEN(b.x)]) == gen, bar);
            __builtin_amdgcn_fence(__ATOMIC_ACQUIRE, "agent");
            asm volatile("s_waitcnt vmcnt(0)" ::: "memory");
        }
    }
    __syncthreads();
}

struct Args {
    const float *x, *c, *ctx, *c_ctx, *ada_w, *ada_b, *mix_pre, *mix_post, *w_in, *w_out, *conv_w, *conv_b, *dt_bias, *a_log, *ssd_d, *ssd_norm,
                *hg_lb, *hg_norm, *ffn_pre, *ffn_post, *router_w, *router_b, *w1, *b1, *w2, *b2;
    float* out; unsigned char* ws; int ph_lo, ph_hi;
};

typedef const Args __attribute__((address_space(4))) CArgs;
struct Ctx { LAS unsigned char* lds; int tid, lane, wave, vcu, G, gw, NGW; };

__device__ __forceinline__ void transpose_item(const float* W, int ldw, int K, bf16* WT, int dst_row0, int nblk, LAS float* scr, int item, int lane) {
    const int kb = item / nblk, nb = item % nblk, k0 = 64 * kb, n0 = 32 * nb;
    float ld[32];
#pragma unroll
    for (int i = 0; i < 32; ++i) ld[i] = W[(size_t)(k0 + 2 * i + (lane >> 5)) * ldw + n0 + (lane & 31)];
#pragma unroll
    for (int i = 0; i < 32; ++i) scr[(2 * i + (lane >> 5)) * 33 + (lane & 31)] = ld[i];
    LDS_WAIT(); asm volatile("" ::: "memory");
    const int c = lane & 7;
#pragma unroll
    for (int j = 0; j < 4; ++j) { const int n = (lane >> 3) + 8 * j; const LAS float* s = scr + (8 * c) * 33 + n;
        u32x4 o; o.x = cvt_pk_bf16(s[0 * 33], s[1 * 33]); o.y = cvt_pk_bf16(s[2 * 33], s[3 * 33]); o.z = cvt_pk_bf16(s[4 * 33], s[5 * 33]); o.w = cvt_pk_bf16(s[6 * 33], s[7 * 33]);
        *(u32x4*)(WT + (size_t)(dst_row0 + n0 + n) * K + k0 + 8 * c) = o; }
    LDS_WAIT(); asm volatile("" ::: "memory");
}
__device__ __forceinline__ void transpose_item_f8(const float* W, int ldw, int K, unsigned char* WT, int nblk, LAS float* scr, int item, int lane, float scale) {
    const int kb = item / nblk, nb = item % nblk, k0 = 64 * kb, n0 = 32 * nb;
    float ld[32];
#pragma unroll
    for (int i = 0; i < 32; ++i) ld[i] = __builtin_nontemporal_load(&W[(size_t)(k0 + 2 * i + (lane >> 5)) * ldw + n0 + (lane & 31)]);
#pragma unroll
    for (int i = 0; i < 32; ++i) scr[(2 * i + (lane >> 5)) * 33 + (lane & 31)] = ld[i] * scale;
    LDS_WAIT(); asm volatile("" ::: "memory");
    const int c = lane & 7;
#pragma unroll
    for (int j = 0; j < 4; ++j) { const int n = (lane >> 3) + 8 * j; const LAS float* sp = scr + (8 * c) * 33 + n;
        u32x2 o; o.x = pk4_fp8(sp[0 * 33], sp[1 * 33], sp[2 * 33], sp[3 * 33]); o.y = pk4_fp8(sp[4 * 33], sp[5 * 33], sp[6 * 33], sp[7 * 33]);
        *(u32x2*)(WT + (size_t)(n0 + n) * K + k0 + 8 * c) = o; }
    LDS_WAIT(); asm volatile("" ::: "memory");
}
__device__ __forceinline__ void phase0(CArgs& a, const Ctx& C) {
    LAS float* scr = (LAS float*)(C.lds + C.wave * 16384);
    bf16* WINT = (bf16*)(a.ws + WS_WINT); bf16* WOUTT = (bf16*)(a.ws + WS_WOUTT);
    float* MODP = (float*)(a.ws + WS_MODP);
    constexpr int I_GEMV = 96 * 32, I_INA = 16 * 40, I_INB = 16 * 80, I_OUT = 16 * 32;
    constexpr int NITEMS = I_GEMV + I_INA + I_INB + I_OUT;
    for (int it = C.gw; it < NITEMS; it += C.NGW) {
        int r = it;
        if (r < I_GEMV) {
            const int cg = r % 96, ks = r / 96, col = 64 * cg + C.lane, k0 = 32 * ks;
            float sv[5];
            { const int kk = C.lane & 31;
#pragma unroll
              for (int b = 0; b < 4; ++b) sv[b] = siluf(a.c[b * D + k0 + kk]);
              sv[4] = siluf(a.c_ctx[k0 + kk]); }
            float acc[5] = {0.f, 0.f, 0.f, 0.f, 0.f};
#pragma unroll 8
            for (int kk = 0; kk < 32; ++kk) { const float w = a.ada_w[(size_t)(k0 + kk) * 6144 + col];
#pragma unroll
                for (int b = 0; b < 5; ++b) acc[b] += __shfl(sv[b], kk) * w; }
#pragma unroll
            for (int b = 0; b < 5; ++b) MODP[(size_t)(ks * 5 + b) * 6144 + col] = acc[b];
            continue;
        }
        r -= I_GEMV;
        if (r < I_INA) { transpose_item(a.w_in, W_IN_COLS, D, WINT, 0, 40, scr, r, C.lane); continue; } r -= I_INA;
        if (r < I_INB) { transpose_item(a.w_in + 1296, W_IN_COLS, D, WINT, 1280, 80, scr, r, C.lane); continue; } r -= I_INB;
        transpose_item(a.w_out, D, D, WOUTT, 0, 32, scr, r, C.lane);
    }
}
#ifndef CONV_SH
#define CONV_SH 2
#endif
constexpr int NIT1 = 32 * 16 * 64, NIT2 = 32 * 16 * 32, CONV_B = 256 * 7 * CONV_SH;
constexpr int CONV_SH_END = 7 * CONV_B;
constexpr int CONV_W1_HOST = CONV_SH_END < NIT1 ? CONV_SH_END : NIT1;
constexpr int CONV_S9 = CONV_SH_END > NIT1 ? CONV_SH_END : NIT1;
__device__ __forceinline__ void conv_item(CArgs& a, LAS float* scr, int lane, int it) {
    const bool w1 = it < NIT1; const int r = w1 ? it : it - NIT1, per = w1 ? 16 * 64 : 16 * 32, e = r / per, ri = r % per;
    const float* W = w1 ? a.w1 + (size_t)e * D * 2048 : a.w2 + (size_t)e * D * D; unsigned char* WT = w1 ? a.ws + WS_W1T + (size_t)e * 2048 * D : a.ws + WS_W2T + (size_t)e * D * D;
    transpose_item_f8(W, w1 ? 2048 : D, D, WT, w1 ? 64 : 32, scr, ri, lane, W_SCALE);
}
__device__ __forceinline__ void conv_range(CArgs& a, const Ctx& C, int lo, int hi) {
    LAS float* scr = (LAS float*)(C.lds + C.wave * 16384);
#pragma unroll 1
    for (int it = lo + C.gw; it < hi; it += C.NGW) conv_item(a, scr, C.lane, it);
}
__device__ __forceinline__ void conv_shadow(CArgs& a, const Ctx& C, int first, LAS unsigned char* scr_base, int scr_stride) {
    LAS float* scr = (LAS float*)(scr_base + (C.wave - 1) * scr_stride);
    const int it0 = first + (C.vcu * 7 + (C.wave - 1)) * CONV_SH;
#pragma unroll 1
    for (int j = 0; j < CONV_SH; ++j) if (it0 + j < NIT1 + NIT2) conv_item(a, scr, C.lane, it0 + j);
}
__device__ __forceinline__ void phase1(CArgs& a, const Ctx& C) {
    const float* MODP = (const float*)(a.ws + WS_MODP); float* MOD = (float*)(a.ws + WS_MOD);
    for (int i = C.vcu * 512 + C.tid; i < 5 * 6144; i += C.G * 512) {
        const int col = i % 6144, b = i / 6144; float s = a.ada_b[col];
#pragma unroll 8
        for (int ks = 0; ks < 32; ++ks) s += MODP[(size_t)(ks * 5 + b) * 6144 + col];
        MOD[i] = s;
    }
}
template <int N, int O> struct RS { template <int M> static __device__ __forceinline__ void run(float (&v)[M], int lane) {
    const bool up = (lane & O) != 0;
#pragma unroll
    for (int i = 0; i < N / 2; ++i) { const float keep = up ? v[i + N / 2] : v[i], send = up ? v[i] : v[i + N / 2]; v[i] = keep + __shfl_xor(send, O); }
    RS<N / 2, O / 2>::run(v, lane); } };
template <int O> struct RS<1, O> { template <int M> static __device__ __forceinline__ void run(float (&v)[M], int) { v[0] += __shfl_xor(v[0], O); RS<1, O / 2>::run(v, 0); } };
template <> struct RS<1, 0> { template <int M> static __device__ __forceinline__ void run(float (&)[M], int) {} };
template <int N> __device__ __forceinline__ void reduce_scatter(float (&v)[N], int lane) { RS<N, 32>::run(v, lane); }
__device__ __forceinline__ void phase2_fill(CArgs& a, const Ctx& C, int t0, int nt) {
    LAS f32x4* WD = (LAS f32x4*)C.lds;
    for (int idx = t0; idx < 16 * 4 * 64; idx += nt) { const int ln = idx & 63, cg = (idx >> 6) & 3, je = idx >> 8, j = je >> 3, e = je & 7, k = 8 * ln + 512 * j + e;
        WD[idx] = *(const f32x4*)(a.w_in + (size_t)k * W_IN_COLS + 1280 + 4 * cg); }
}
__device__ __forceinline__ void phase2(CArgs& a, const Ctx& C, bool prefilled) {
    const float* MOD = (const float*)(a.ws + WS_MOD); bf16* XN = (bf16*)(a.ws + WS_XN); float* DTRAW = (float*)(a.ws + WS_DTRAW);
    LAS f32x4* WD = (LAS f32x4*)C.lds;
    const int rbase = (MROWS / 256) * C.vcu; constexpr int NPAIR = MROWS / 256 / 2;
    f32x4 nx[2][2][2];
    { const int m = rbase + 2 * C.wave;
#pragma unroll
      for (int r = 0; r < 2; ++r) { const int mr = m + r; const float* xrow = mr < NLAT ? a.x + (size_t)mr * D : a.ctx + (size_t)(mr - NLAT) * D;
#pragma unroll
        for (int j = 0; j < 2; ++j) { nx[r][j][0] = NTLOAD((const f32x4*)(xrow + 8 * C.lane + 512 * j)); nx[r][j][1] = NTLOAD((const f32x4*)(xrow + 8 * C.lane + 512 * j + 4)); } } }
    if (!prefilled) phase2_fill(a, C, C.tid, 512);
    __syncthreads();
#pragma unroll 1
    for (int p = C.wave; p < NPAIR; p += 8) {
        const int m = rbase + 2 * p, b = m < NLAT ? (m >> 12) : 4;
        const float* sh = MOD + b * 6144, *sc = sh + 1024;
        float h[2][2][8]; float ss[2] = {0.f, 0.f};
#pragma unroll
        for (int r = 0; r < 2; ++r)
#pragma unroll
            for (int j = 0; j < 2; ++j) { const f32x4 v0 = nx[r][j][0], v1 = nx[r][j][1];
#pragma unroll
                for (int e = 0; e < 4; ++e) { h[r][j][e] = v0[e]; h[r][j][4 + e] = v1[e]; ss[r] += v0[e] * v0[e] + v1[e] * v1[e]; } }
        { const int m2 = p + 8 < NPAIR ? m + 16 : m;
#pragma unroll
          for (int r = 0; r < 2; ++r) { const int mr = m2 + r; const float* xrow = mr < NLAT ? a.x + (size_t)mr * D : a.ctx + (size_t)(mr - NLAT) * D;
#pragma unroll
            for (int j = 0; j < 2; ++j) { nx[r][j][0] = NTLOAD((const f32x4*)(xrow + 8 * C.lane + 512 * j)); nx[r][j][1] = NTLOAD((const f32x4*)(xrow + 8 * C.lane + 512 * j + 4)); } } }
        const float rstd[2] = {rsqrtf(wave_sum(ss[0]) * (1.0f / D) + EPS), rsqrtf(wave_sum(ss[1]) * (1.0f / D) + EPS)};
#pragma unroll
        for (int j = 0; j < 2; ++j) { const int k0 = 8 * C.lane + 512 * j;
#pragma unroll
            for (int e4 = 0; e4 < 2; ++e4) { const f32x4 w = *(const f32x4*)(a.mix_pre + k0 + 4 * e4), s1 = *(const f32x4*)(sc + k0 + 4 * e4), s0 = *(const f32x4*)(sh + k0 + 4 * e4);
#pragma unroll
                for (int r = 0; r < 2; ++r)
#pragma unroll
                    for (int e = 0; e < 4; ++e) h[r][j][4 * e4 + e] = h[r][j][4 * e4 + e] * rstd[r] * w[e] * (1.0f + s1[e]) + s0[e]; }
#pragma unroll
            for (int r = 0; r < 2; ++r) { u32x4 o; o.x = cvt_pk_bf16(h[r][j][0], h[r][j][1]); o.y = cvt_pk_bf16(h[r][j][2], h[r][j][3]); o.z = cvt_pk_bf16(h[r][j][4], h[r][j][5]); o.w = cvt_pk_bf16(h[r][j][6], h[r][j][7]);
                *(u32x4*)(XN + (size_t)(m + r) * D + k0) = o; } }
        float acc0[16], acc1[16];
#pragma unroll
        for (int i = 0; i < 16; ++i) { acc0[i] = 0.f; acc1[i] = 0.f; }
#pragma unroll
        for (int j = 0; j < 2; ++j)
#pragma unroll
            for (int e = 0; e < 8; ++e)
#pragma unroll
                for (int cg = 0; cg < 4; ++cg) { const f32x4 w = WD[((j * 8 + e) * 4 + cg) * 64 + C.lane];
#pragma unroll
                    for (int i = 0; i < 4; ++i) { acc0[4 * cg + i] += h[0][j][e] * w[i]; acc1[4 * cg + i] += h[1][j][e] * w[i]; }
                    if (cg == 3 && (e & 1)) asm volatile("" ::: "memory"); }
        reduce_scatter<16>(acc0, C.lane); reduce_scatter<16>(acc1, C.lane);
        if ((C.lane & 3) == 0) { DTRAW[(size_t)m * 16 + (C.lane >> 2)] = acc0[0]; DTRAW[(size_t)(m + 1) * 16 + (C.lane >> 2)] = acc1[0]; }
    }
}
__device__ __forceinline__ void prep_ssd_unit(CArgs& a, const Ctx& C, int unit) {
    const bf16* U = (const bf16*)(a.ws + WS_U); const float* DTRAW = (const float*)(a.ws + WS_DTRAW);
    bf16* BC = (bf16*)(a.ws + WS_BC); bf16* XST = (bf16*)(a.ws + WS_XST);
    float* GA = (float*)(a.ws + WS_GA); float* DTA = (float*)(a.ws + WS_DTA); float* GEND = (float*)(a.ws + WS_GEND); u32x2* DSS = (u32x2*)(a.ws + WS_DSS);
    const int b = unit / NCH, tc = unit % NCH, s0 = 64 * tc; const bool isctx = tc < 4;
    const int rowbase = isctx ? NLAT + b * CTXL + s0 : b * SEQ + (s0 - CTXL);
    const int ilo = isctx ? -s0 : CTXL - s0, ihi = isctx ? CTXL - s0 : SP - s0;
    LAS float* dtl = (LAS float*)C.lds; LAS float* al = dtl + 1024; LAS float* wl = al + 1024;
    LAS bf16* XTl = (LAS bf16*)(C.lds + 12288);
    int ltid = C.tid; asm volatile("" : "+v"(ltid));
    const int ch0 = 2 * ltid;
    unsigned uw[68];
    if (C.tid < 384) { const bf16* up = U + (size_t)rowbase * NU + 512 + ch0;
#pragma unroll
        for (int t = 0; t < 68; ++t) { const int i = t - 2; uw[t] = (i >= ilo && i < ihi) ? *(const unsigned*)(up + (ptrdiff_t)i * NU) : 0u; } }
#pragma unroll
    for (int pi = 0; pi < 2; ++pi) { const int dh = 2 * C.wave + pi, dir = dh >> 3, h = dh & 7, i = C.lane;
        const float xv = DTRAW[(size_t)(rowbase + i) * 16 + dh] + a.dt_bias[dh];
        const float dt = fmaxf(xv, 0.f) + log1pf(__expf(-fabsf(xv)));
        const float av = -dt * __expf(a.a_log[dh]);
        float pre = av;
#pragma unroll
        for (int o = 1; o < 64; o <<= 1) { const float t = __shfl_up(pre, o); pre += (i >= o) ? t : 0.f; }
        const float tot = __shfl(pre, 63);
        const float g = dir == 0 ? pre : tot - pre + av;
        const float gend = tot;
        al[dh * 64 + i] = g; dtl[dh * 64 + i] = dt; wl[dh * 64 + i] = dt * __expf(gend - g);
        const size_t o = (size_t)((b * 2 + dir) * 8 + h) * SP + s0 + i; GA[o] = g; DTA[o] = dt;
        if (i == 0) GEND[((b * 2 + dir) * 8 + h) * NCH + tc] = gend; }
    LDS_BARRIER();
    if (C.tid < 384) {
        f32x2 wk[5];
#pragma unroll
        for (int k = 0; k < 5; ++k) wk[k] = *(const f32x2*)(a.conv_w + k * 768 + ch0);
        const f32x2 cb = *(const f32x2*)(a.conv_b + ch0);
        const int cls = ch0 < 512 ? 0 : (ch0 < 640 ? 1 : 2);
#pragma unroll
        for (int i8 = 0; i8 < 8; ++i8) {
            unsigned t0[4], t1[4]; float pv0 = 0.f, pv1 = 0.f;
#pragma unroll
            for (int ii = 0; ii < 8; ++ii) {
                const int i = 8 * i8 + ii;
                float y0 = cb.x, y1 = cb.y;
#pragma unroll
                for (int k = 0; k < 5; ++k) { y0 += wk[k].x * bflo(uw[i + k]); y1 += wk[k].y * bfhi(uw[i + k]); }
                y0 = siluf(y0); y1 = siluf(y1);
                if (cls != 0) *(unsigned*)(BC + (size_t)(rowbase + i) * 256 + (ch0 - 512)) = cvt_pk_bf16(y0, y1);
                if (ii & 1) { t0[ii >> 1] = cvt_pk_bf16(pv0, y0); t1[ii >> 1] = cvt_pk_bf16(pv1, y1); } else { pv0 = y0; pv1 = y1; }
            }
            if (cls != 2) {
                const u32x4 v0 = (u32x4){t0[0], t0[1], t0[2], t0[3]}, v1 = (u32x4){t1[0], t1[1], t1[2], t1[3]};
                *(LAS u32x4*)(XTl + ch0 * 72 + 8 * i8) = v0; *(LAS u32x4*)(XTl + (ch0 + 1) * 72 + 8 * i8) = v1;
                if (cls == 0) { const size_t r0 = (size_t)(b * 512 + ch0) * SP + s0 + 8 * i8; *(u32x4*)(XST + r0) = v0; *(u32x4*)(XST + r0 + SP) = v1; }
            }
        }
    }
    LDS_BARRIER();
    {
        const int fr = C.lane & 15, q = C.lane >> 4;
#pragma unroll 1
        for (int pi = 0; pi < 2; ++pi) { const int pid = 2 * C.wave + pi, dir = pid >> 3, h = pid & 7, g = h >> 2;
            bf16x8 Bf[4][2]; f32x4 wv[2][2];
#pragma unroll
            for (int ks = 0; ks < 2; ++ks) { wv[ks][0] = *(const LAS f32x4*)(wl + pid * 64 + 32 * ks + 8 * q); wv[ks][1] = *(const LAS f32x4*)(wl + pid * 64 + 32 * ks + 8 * q + 4); }
#pragma unroll
            for (int t = 0; t < 4; ++t)
#pragma unroll
                for (int ks = 0; ks < 2; ++ks) Bf[t][ks] = *(const LAS bf16x8*)(XTl + (h * 64 + 16 * t + fr) * 72 + 32 * ks + 8 * q);
            const size_t ob = ((size_t)((b * 2 + dir) * 8 + h) * NCH + tc) * 1024;
#pragma unroll
            for (int at = 0; at < 4; ++at) { bf16x8 Af[2];
#pragma unroll
                for (int ks = 0; ks < 2; ++ks) { const u32x4 raw = *(const LAS u32x4*)(XTl + (512 + g * 64 + 16 * at + fr) * 72 + 32 * ks + 8 * q); const unsigned rw[4] = {raw.x, raw.y, raw.z, raw.w}; u32x4 o;
                    o.x = cvt_pk_bf16(bflo(rw[0]) * wv[ks][0][0], bfhi(rw[0]) * wv[ks][0][1]); o.y = cvt_pk_bf16(bflo(rw[1]) * wv[ks][0][2], bfhi(rw[1]) * wv[ks][0][3]);
                    o.z = cvt_pk_bf16(bflo(rw[2]) * wv[ks][1][0], bfhi(rw[2]) * wv[ks][1][1]); o.w = cvt_pk_bf16(bflo(rw[3]) * wv[ks][1][2], bfhi(rw[3]) * wv[ks][1][3]);
                    Af[ks] = __builtin_bit_cast(bf16x8, o); }
#pragma unroll
                for (int pt = 0; pt < 4; ++pt) { f32x4 acc = (f32x4){0.f, 0.f, 0.f, 0.f};
                    acc = MFMA16(Af[0], Bf[pt][0], acc); acc = MFMA16(Af[1], Bf[pt][1], acc);
                    DSS[ob + (at * 4 + pt) * 64 + C.lane] = (u32x2){cvt_pk_bf16(acc[0], acc[1]), cvt_pk_bf16(acc[2], acc[3])}; } } }
    }
    LDS_BARRIER();
}
__device__ __forceinline__ void prep_hg_pair(CArgs& a, const Ctx& C, int unit) {
    const bf16* U = (const bf16*)(a.ws + WS_U);
    bf16* QS = (bf16*)(a.ws + WS_QS); bf16* KS = (bf16*)(a.ws + WS_KS); bf16* VT = (bf16*)(a.ws + WS_VT); float* EG = (float*)(a.ws + WS_EG); u32x2* DSP = (u32x2*)(a.ws + WS_DSP); float* EGP = (float*)(a.ws + WS_EGP);
    const int b = unit / (NPR * 4), pr = (unit >> 2) % NPR, h = unit & 3;
    LAS float* ETl = (LAS float*)(C.lds + 63488);
    LAS u32x2* DL = (LAS u32x2*)(C.lds + 65536);
#pragma unroll 1
    for (int sub = 0; sub < 2; ++sub) {
    const int c = 2 * pr + sub, s0 = 64 * c; const bool isctx = c < 4;
    int ltid = C.tid; asm volatile("" : "+v"(ltid));
    const int cp = ltid & 63, tg = ltid >> 6, ch0 = 2 * cp, hc = h * 128 + ch0;
    const int rbase = isctx ? NLAT + b * CTXL + s0 : b * SEQ + (c - 4), rstride = isctx ? 1 : 64;
    const bf16* up = U + (size_t)rbase * NU + 1280 + hc;
    unsigned rq[8], rf[8], rb[8], ri[8];
#pragma unroll
    for (int t = 0; t < 8; ++t) { const bf16* r = up + (size_t)(8 * tg + t) * rstride * NU;
        rq[t] = *(const unsigned*)r; rf[t] = *(const unsigned*)(r + 512); rb[t] = *(const unsigned*)(r + 1024); ri[t] = *(const unsigned*)(r + 1536); }
    LAS float* part = (LAS float*)C.lds;
    LAS bf16* KHl = (LAS bf16*)(C.lds + 8192);
    LAS bf16* VTl = KHl + 2 * 128 * 72;
    f32x2 lbv[2];
#pragma unroll
    for (int d = 0; d < 2; ++d) { lbv[d].x = __builtin_amdgcn_rcpf(1.0f + __expf(a.hg_lb[1024 + d * 512 + hc] - a.hg_lb[d * 512 + hc])); lbv[d].y = __builtin_amdgcn_rcpf(1.0f + __expf(a.hg_lb[1024 + d * 512 + hc + 1] - a.hg_lb[d * 512 + hc + 1])); }
    float la[2][2][8], om[2][2][8];
    float sum[2][2] = {{0.f, 0.f}, {0.f, 0.f}};
#pragma unroll
    for (int t = 0; t < 8; ++t)
#pragma unroll
        for (int d = 0; d < 2; ++d)
#pragma unroll
            for (int e = 0; e < 2; ++e) { const unsigned w = d == 0 ? rf[t] : rb[t]; const float fr_ = e == 0 ? bflo(w) : bfhi(w); const float lb = e == 0 ? lbv[d].x : lbv[d].y;
                const float ex = __builtin_amdgcn_exp2f(fr_ * -1.4426950408889634f); const float t1 = (1.0f - lb) * __builtin_amdgcn_rcpf(1.0f + ex);
                om[d][e][t] = t1 * ex;
                la[d][e][t] = __builtin_amdgcn_logf(lb + t1); sum[d][e] += la[d][e][t]; }
#pragma unroll
    for (int d = 0; d < 2; ++d)
#pragma unroll
        for (int e = 0; e < 2; ++e) part[(tg * 4 + d * 2 + e) * 64 + cp] = sum[d][e];
    LDS_BARRIER();
    float T[2][2], pre[2][2];
#pragma unroll
    for (int d = 0; d < 2; ++d)
#pragma unroll
        for (int e = 0; e < 2; ++e) { float tt = 0.f, pp = 0.f;
#pragma unroll
            for (int g2 = 0; g2 < 8; ++g2) { const float v = part[(g2 * 4 + d * 2 + e) * 64 + cp]; pp += (g2 < tg) ? v : 0.f; tt += v; }
            T[d][e] = tt; pre[d][e] = pp; }
    const size_t DST = (size_t)NB * 4 * SP * 128;
    unsigned khp[2][2][4], vp[2][4];
    float eT[2][2];
#pragma unroll
    for (int d = 0; d < 2; ++d)
#pragma unroll
        for (int e = 0; e < 2; ++e) eT[d][e] = __builtin_amdgcn_exp2f(T[d][e]);
    {
        float runf[2] = {pre[0][0], pre[0][1]}, runb[2] = {pre[1][0], pre[1][1]}, pkf[2] = {0.f, 0.f}, pkb[2] = {0.f, 0.f}, pkv[2] = {0.f, 0.f};
#pragma unroll
        for (int t = 0; t < 8; ++t) { const size_t rm = ((size_t)(b * 4 + h) * SP + s0 + 8 * tg + t) * 128 + ch0;
            const float qv[2] = {siluf(bflo(rq[t])) * 0.08838834764831845f, siluf(bfhi(rq[t])) * 0.08838834764831845f};
            float ktf[2], ktb[2], qtf[2], qtb[2];
#pragma unroll
            for (int e = 0; e < 2; ++e) {
                runf[e] += la[0][e][t]; const float Ef = __builtin_amdgcn_exp2f(-runf[e]);
                const float gb = T[1][e] - runb[e]; runb[e] += la[1][e][t]; const float Eb = __builtin_amdgcn_exp2f(-gb);
                ktf[e] = om[0][e][t] * Ef; ktb[e] = om[1][e][t] * Eb; qtf[e] = qv[e] * __builtin_amdgcn_rcpf(Ef); qtb[e] = qv[e] * __builtin_amdgcn_rcpf(Eb);
                const float khf = ktf[e] * eT[0][e], khb = ktb[e] * eT[1][e], iv = e == 0 ? bflo(ri[t]) : bfhi(ri[t]);
                if (t & 1) { khp[0][e][t >> 1] = cvt_pk_bf16(pkf[e], khf); khp[1][e][t >> 1] = cvt_pk_bf16(pkb[e], khb); vp[e][t >> 1] = cvt_pk_bf16(pkv[e], iv); } else { pkf[e] = khf; pkb[e] = khb; pkv[e] = iv; } }
            *(unsigned*)(QS + rm) = cvt_pk_bf16(qtf[0], qtf[1]); *(unsigned*)(QS + DST + rm) = cvt_pk_bf16(qtb[0], qtb[1]);
            *(unsigned*)(KS + rm) = cvt_pk_bf16(ktf[0], ktf[1]); *(unsigned*)(KS + DST + rm) = cvt_pk_bf16(ktb[0], ktb[1]); }
    }
#pragma unroll
    for (int e = 0; e < 2; ++e) {
        *(LAS u32x4*)(KHl + (0 * 128 + ch0 + e) * 72 + 8 * tg) = (u32x4){khp[0][e][0], khp[0][e][1], khp[0][e][2], khp[0][e][3]};
        *(LAS u32x4*)(KHl + (1 * 128 + ch0 + e) * 72 + 8 * tg) = (u32x4){khp[1][e][0], khp[1][e][1], khp[1][e][2], khp[1][e][3]};
        *(LAS u32x4*)(VTl + (ch0 + e) * 72 + 8 * tg) = (u32x4){vp[e][0], vp[e][1], vp[e][2], vp[e][3]};
        *(u32x4*)(VT + (size_t)((b * 4 + h) * 128 + ch0 + e) * SP + s0 + 8 * tg) = (u32x4){vp[e][0], vp[e][1], vp[e][2], vp[e][3]}; }
    if (tg == 0) {
#pragma unroll
        for (int d = 0; d < 2; ++d) { const f32x2 et = (f32x2){eT[d][0], eT[d][1]};
            *(f32x2*)(EG + ((size_t)((d * 4 + b) * 4 + h) * NCH + c) * 128 + ch0) = et; *(LAS f32x2*)(ETl + (sub * 2 + d) * 128 + ch0) = et;
            if (sub) { const f32x2 e0 = *(const LAS f32x2*)(ETl + d * 128 + ch0); *(f32x2*)(EGP + ((size_t)((d * 4 + b) * 4 + h) * NPR + pr) * 128 + ch0) = (f32x2){e0.x * et.x, e0.y * et.y}; } } }
    LDS_BARRIER();
    {
        const int fr = C.lane & 15, q = C.lane >> 4;
        LAS u32x2* dlb = DL + C.tid; asm volatile("" : "+v"(dlb));
        bf16x8 Bf[2];
#pragma unroll
        for (int ks = 0; ks < 2; ++ks) Bf[ks] = *(const LAS bf16x8*)(VTl + (16 * C.wave + fr) * 72 + 32 * ks + 8 * q);
#pragma unroll
        for (int d = 0; d < 2; ++d) { const int seq = (d * NB + b) * 4 + h;
#pragma unroll
            for (int at = 0; at < 8; ++at) { f32x4 t4 = (f32x4){0.f, 0.f, 0.f, 0.f};
#pragma unroll
                for (int ks = 0; ks < 2; ++ks) { const bf16x8 Af = *(const LAS bf16x8*)(KHl + (d * 128 + 16 * at + fr) * 72 + 32 * ks + 8 * q); t4 = MFMA16(Af, Bf[ks], t4); }
                LAS u32x2* dl = dlb + (d * 8 + at) * 512;
                if (sub == 0) *dl = (u32x2){cvt_pk_bf16(t4[0], t4[1]), cvt_pk_bf16(t4[2], t4[3])};
                else { const u32x2 pw = *dl; const f32x4 pv = (f32x4){bflo(pw.x), bfhi(pw.x), bflo(pw.y), bfhi(pw.y)};
                    const f32x4 r4 = d == 0 ? pv * *(const LAS f32x4*)(ETl + (1 * 2 + 0) * 128 + 16 * at + 4 * q) + t4
                                            : pv + t4 * *(const LAS f32x4*)(ETl + (0 * 2 + 1) * 128 + 16 * at + 4 * q);
                    DSP[((size_t)seq * NPR + pr) * 4096 + (at * 8 + C.wave) * 64 + C.lane] = (u32x2){cvt_pk_bf16(r4[0], r4[1]), cvt_pk_bf16(r4[2], r4[3])}; }
                if (at & 1) asm volatile("" ::: "memory"); } }
    }
    LDS_BARRIER();
    }
}
__device__ __forceinline__ void phase4(CArgs& a, const Ctx& C) {
    constexpr int NHU = NB * NPR * 4;
#pragma unroll 1
    for (int k = 0; k < 4; ++k) { int u; const int v = C.vcu;
        if (k == 0) u = v;
        else if (k == 1) u = v < 208 ? 256 + v : NHU + (v - 208);
        else if (k == 2) u = v < 80 ? 464 + v : (v < 208 ? NHU + 48 + (v - 80) : NHU + 176 + (v - 208));
        else { if (v < 208) break; u = NHU + 224 + (v - 208); }
        if (u < NHU) prep_hg_pair(a, C, u); else prep_ssd_unit(a, C, u - NHU); }
}
__device__ __forceinline__ void phase5(CArgs& a, const Ctx& C) { (void)a; (void)C; }
__device__ __forceinline__ int scan_chunk(int dir, int k) { return dir == 0 ? k : (k < 4 ? 3 - k : 71 - k); }
__device__ __forceinline__ void phase6(CArgs& a, const Ctx& C) {
    const u32x2* DSS = (const u32x2*)(a.ws + WS_DSS); const u32x2* DSP = (const u32x2*)(a.ws + WS_DSP);
    u32x2* SPS = (u32x2*)(a.ws + WS_SPS); u32x2* SPH = (u32x2*)(a.ws + WS_SPH);
    const float* GEND = (const float*)(a.ws + WS_GEND); const float* EGP = (const float*)(a.ws + WS_EGP);
    if (C.vcu < 128) {
        const int task = C.vcu * 512 + C.tid, seq = task >> 10, grp = task & 1023, dir = (seq >> 3) & 1;
        f32x4 S = (f32x4){0.f, 0.f, 0.f, 0.f};
#pragma unroll 1
        for (int kb = 0; kb < NCH; kb += 17) { u32x2 dw[17]; float gd[17];
#pragma unroll
            for (int j = 0; j < 17; ++j) { const int tc = scan_chunk(dir, kb + j); dw[j] = NTLOAD(&DSS[((size_t)seq * NCH + tc) * 1024 + grp]); gd[j] = GEND[seq * NCH + tc]; }
            asm volatile("" ::: "memory");
#pragma unroll
            for (int j = 0; j < 17; ++j) { const int tc = scan_chunk(dir, kb + j);
                if (tc >= 4) SPS[((size_t)seq * NCH + tc) * 1024 + grp] = (u32x2){cvt_pk_bf16(S[0], S[1]), cvt_pk_bf16(S[2], S[3])};
                S = S * __expf(gd[j]) + (f32x4){bflo(dw[j].x), bfhi(dw[j].x), bflo(dw[j].y), bfhi(dw[j].y)}; }
            asm volatile("" ::: "memory"); }
    } else {
#pragma unroll 1
        for (int rep = 0; rep < 2; ++rep) {
            const int t = (C.vcu - 128) * 1024 + rep * 512 + C.tid, seq = t >> 12, grp = t & 4095, d = seq >> 4, tile = grp >> 6, ln = grp & 63, cb = 16 * (tile >> 3) + 4 * (ln >> 4);
            f32x4 S = (f32x4){0.f, 0.f, 0.f, 0.f};
#pragma unroll 1
            for (int kb = 0; kb < NPR; kb += 17) { u32x2 dw[17]; f32x4 dec[17];
#pragma unroll
                for (int j = 0; j < 17; ++j) { const int k = kb + j, tp = d == 0 ? k : (k < 2 ? 1 - k : 35 - k); dw[j] = NTLOAD(&DSP[((size_t)seq * NPR + tp) * 4096 + grp]); dec[j] = *(const f32x4*)(EGP + ((size_t)seq * NPR + tp) * 128 + cb); }
                asm volatile("" ::: "memory");
#pragma unroll
                for (int j = 0; j < 17; ++j) { const int k = kb + j, tp = d == 0 ? k : (k < 2 ? 1 - k : 35 - k);
                    if (tp >= 2) SPH[((size_t)seq * NPR + tp) * 4096 + grp] = (u32x2){cvt_pk_bf16(S[0], S[1]), cvt_pk_bf16(S[2], S[3])};
                    S = S * dec[j] + (f32x4){bflo(dw[j].x), bfhi(dw[j].x), bflo(dw[j].y), bfhi(dw[j].y)}; }
                asm volatile("" ::: "memory"); } }
    }
}
typedef short s16x4 __attribute__((ext_vector_type(4)));
typedef short s16x8 __attribute__((ext_vector_type(8)));
__device__ __forceinline__ s16x4 lds_tr(const LAS bf16* p) { return __builtin_amdgcn_ds_read_tr16_b64_v4i16((LAS s16x4*)p); }
__device__ __forceinline__ bf16x8 ld_split8(const bf16* p0, const bf16* p1) {
    const u32x2 lo = *(const u32x2*)p0, hi = *(const u32x2*)p1; u32x4 w = (u32x4){lo.x, lo.y, hi.x, hi.y}; return __builtin_bit_cast(bf16x8, w);
}
__device__ __forceinline__ void passc_ssd_unit(CArgs& a, const Ctx& C, int unit) {
    const bf16* BC = (const bf16*)(a.ws + WS_BC); const bf16* XST = (const bf16*)(a.ws + WS_XST); const bf16* U = (const bf16*)(a.ws + WS_U);
    const float* GA = (const float*)(a.ws + WS_GA); const float* DTA = (const float*)(a.ws + WS_DTA); const bf16* SPS = (const bf16*)(a.ws + WS_SPS);
    bf16* Y = (bf16*)(a.ws + WS_Y);
    const int b = unit >> 6, tcl = unit & 63, tc = tcl + 4, s0 = 64 * tc, row0 = b * SEQ + 64 * tcl;
    const int h = C.wave, g = h >> 2, fr = C.lane & 15, q = C.lane >> 4;
    LAS unsigned char* wl = C.lds + C.wave * 17408;
    LAS bf16* Ml = (LAS bf16*)wl; LAS float* Yl = (LAS float*)wl; LAS float* red = (LAS float*)(C.lds + 8 * 17408);
    {
        bf16x8 Ca[4][2], Bb[4][2];
#pragma unroll
        for (int t = 0; t < 4; ++t)
#pragma unroll
            for (int ks = 0; ks < 2; ++ks) { const bf16* rp = BC + (size_t)(row0 + 16 * t + fr) * 256 + g * 64 + 32 * ks + 8 * q;
                Bb[t][ks] = *(const bf16x8*)rp; Ca[t][ks] = *(const bf16x8*)(rp + 128); }
        const size_t sf = (size_t)((b * 2 + 0) * 8 + h) * SP + s0, sb = (size_t)((b * 2 + 1) * 8 + h) * SP + s0;
        float gjf[4], gjb[4], dtf[4], dtb[4];
#pragma unroll
        for (int jt = 0; jt < 4; ++jt) { gjf[jt] = GA[sf + 16 * jt + fr]; gjb[jt] = GA[sb + 16 * jt + fr]; dtf[jt] = DTA[sf + 16 * jt + fr]; dtb[jt] = DTA[sb + 16 * jt + fr]; }
        const float Dh = a.ssd_d[h];
#pragma unroll
        for (int it = 0; it < 4; ++it) {
            const f32x4 gif = *(const f32x4*)(GA + sf + 16 * it + 4 * q), gib = *(const f32x4*)(GA + sb + 16 * it + 4 * q);
#pragma unroll
            for (int jt = 0; jt < 4; ++jt) { f32x4 G = (f32x4){0.f, 0.f, 0.f, 0.f};
                G = MFMA16(Ca[it][0], Bb[jt][0], G); G = MFMA16(Ca[it][1], Bb[jt][1], G);
                const int j = 16 * jt + fr;
#pragma unroll
                for (int r = 0; r < 4; ++r) { const int i = 16 * it + 4 * q + r;
                    const float lf = (j <= i) ? dtf[jt] * __expf(fminf(gif[r] - gjf[jt], 0.f)) : 0.f;
                    const float lb = (j >= i) ? dtb[jt] * __expf(fminf(gib[r] - gjb[jt], 0.f)) : 0.f;
                    const float m = G[r] * (lf + lb) + ((i == j) ? Dh : 0.f);
                    Ml[i * 72 + j] = (bf16)(cvt_pk_bf16(m, 0.f) & 0xffff); } } }
    }
    LDS_WAIT(); asm volatile("" ::: "memory");
    bf16x8 Ma[4][2], Cp[4][2];
#pragma unroll
    for (int it = 0; it < 4; ++it)
#pragma unroll
        for (int ks = 0; ks < 2; ++ks) { Ma[it][ks] = *(const LAS bf16x8*)(Ml + (16 * it + fr) * 72 + 32 * ks + 8 * q);
            const bf16* cp = BC + (size_t)(row0 + 16 * it + fr) * 256 + 128 + g * 64 + 32 * ks + 4 * q; Cp[it][ks] = ld_split8(cp, cp + 16); }
    LDS_WAIT(); asm volatile("" ::: "memory");
    f32x4 eg[2][4];
#pragma unroll
    for (int d = 0; d < 2; ++d)
#pragma unroll
        for (int it = 0; it < 4; ++it) { const f32x4 gi = *(const f32x4*)(GA + (size_t)((b * 2 + d) * 8 + h) * SP + s0 + 16 * it + 4 * q);
            eg[d][it] = (f32x4){__expf(gi[0]), __expf(gi[1]), __expf(gi[2]), __expf(gi[3])}; }
#pragma unroll 1
    for (int pt = 0; pt < 4; ++pt) {
        bf16x8 Bx[2];
#pragma unroll
        for (int ks = 0; ks < 2; ++ks) Bx[ks] = *(const bf16x8*)(XST + (size_t)((b * 8 + h) * 64 + 16 * pt + fr) * SP + s0 + 32 * ks + 8 * q);
        f32x4 Yv[4];
#pragma unroll
        for (int it = 0; it < 4; ++it) { Yv[it] = (f32x4){0.f, 0.f, 0.f, 0.f}; Yv[it] = MFMA16(Ma[it][0], Bx[0], Yv[it]); Yv[it] = MFMA16(Ma[it][1], Bx[1], Yv[it]); }
#pragma unroll
        for (int d = 0; d < 2; ++d) { const size_t sbase = ((size_t)((b * 2 + d) * 8 + h) * NCH + tc) * 1024;
            bf16x8 Sb[2];
#pragma unroll
            for (int ks = 0; ks < 2; ++ks) Sb[ks] = ld_split8(SPS + (sbase + ((2 * ks) * 4 + pt) * 64 + C.lane) * 4, SPS + (sbase + ((2 * ks + 1) * 4 + pt) * 64 + C.lane) * 4);
#pragma unroll
            for (int it = 0; it < 4; ++it) { f32x4 T = (f32x4){0.f, 0.f, 0.f, 0.f}; T = MFMA16(Cp[it][0], Sb[0], T); T = MFMA16(Cp[it][1], Sb[1], T); Yv[it] += eg[d][it] * T; } }
#pragma unroll
        for (int it = 0; it < 4; ++it)
#pragma unroll
            for (int r = 0; r < 4; ++r) Yl[(16 * it + 4 * q + r) * 68 + 16 * pt + fr] = Yv[it][r];
    }
    LDS_WAIT(); asm volatile("" ::: "memory");
    const int i = C.lane; float v[64]; float ss = 0.f;
    const bf16* zp = U + (size_t)(row0 + i) * NU + h * 64;
#pragma unroll
    for (int c8 = 0; c8 < 8; ++c8) { const u32x4 zw = *(const u32x4*)(zp + 8 * c8); const f32x4 y0 = *(const LAS f32x4*)(Yl + i * 68 + 8 * c8), y1 = *(const LAS f32x4*)(Yl + i * 68 + 8 * c8 + 4);
        const unsigned zz[4] = {zw.x, zw.y, zw.z, zw.w};
#pragma unroll
        for (int e = 0; e < 4; ++e) { const float ya = e < 2 ? y0[2 * e] : y1[2 * e - 4], yb = e < 2 ? y0[2 * e + 1] : y1[2 * e - 3];
            const float va = ya * siluf(bflo(zz[e])), vb = yb * siluf(bfhi(zz[e])); v[8 * c8 + 2 * e] = va; v[8 * c8 + 2 * e + 1] = vb; ss += va * va + vb * vb; } }
    red[C.wave * 64 + i] = ss;
    LDS_BARRIER();
    float tot = 0.f;
#pragma unroll
    for (int w = 0; w < 8; ++w) tot += red[w * 64 + i];
    const float rstd = rsqrtf(tot * (1.0f / 512.0f) + EPS);
    bf16* yo = Y + (size_t)(row0 + i) * D + h * 64;
#pragma unroll
    for (int c8 = 0; c8 < 8; ++c8) { const f32x4 n0 = *(const f32x4*)(a.ssd_norm + h * 64 + 8 * c8), n1 = *(const f32x4*)(a.ssd_norm + h * 64 + 8 * c8 + 4);
        u32x4 o; o.x = cvt_pk_bf16(v[8 * c8] * rstd * n0[0], v[8 * c8 + 1] * rstd * n0[1]); o.y = cvt_pk_bf16(v[8 * c8 + 2] * rstd * n0[2], v[8 * c8 + 3] * rstd * n0[3]);
        o.z = cvt_pk_bf16(v[8 * c8 + 4] * rstd * n1[0], v[8 * c8 + 5] * rstd * n1[1]); o.w = cvt_pk_bf16(v[8 * c8 + 6] * rstd * n1[2], v[8 * c8 + 7] * rstd * n1[3]);
        *(u32x4*)(yo + 8 * c8) = o; }
    LDS_BARRIER();
}
__device__ __forceinline__ void passc_hg_pair(CArgs& a, const Ctx& C, int unit) {
    const bf16* QS = (const bf16*)(a.ws + WS_QS); const bf16* KS = (const bf16*)(a.ws + WS_KS); const bf16* VT = (const bf16*)(a.ws + WS_VT); const bf16* SPH = (const bf16*)(a.ws + WS_SPH);
    const bf16* U = (const bf16*)(a.ws + WS_U); bf16* Y = (bf16*)(a.ws + WS_Y); const float* EG = (const float*)(a.ws + WS_EG);
    const int b = unit >> 7, pr = 2 + ((unit >> 2) & 31), h = unit & 3;
    const int wv = C.wave, fr = C.lane & 15, q = C.lane >> 4;
    LAS bf16* Pl = (LAS bf16*)C.lds; LAS float* Ol = (LAS float*)(C.lds + 9216); LAS float* red = (LAS float*)(C.lds + 9216 + 64 * 132 * 4);
    LAS bf16* KL = (LAS bf16*)(C.lds + 79872);
    LAS bf16* QL = (LAS bf16*)(C.lds + 45056);
    const size_t DST = (size_t)NB * 4 * SP * 128;
#pragma unroll 1
    for (int sub = 0; sub < 2; ++sub) {
    const int tc = 2 * pr + sub, w = tc - 4, s0 = 64 * tc, oc = 2 * pr + 1 - sub;
    const int it0 = wv >> 1;
    bf16x8 Aq[2][4], Bk[2][2][4];
#pragma unroll
    for (int d = 0; d < 2; ++d) { const size_t base = d * DST + ((size_t)(b * 4 + h) * SP + s0) * 128;
#pragma unroll
        for (int ks = 0; ks < 4; ++ks) { Aq[d][ks] = *(const bf16x8*)(QS + base + (size_t)(16 * it0 + fr) * 128 + 32 * ks + 8 * q);
#pragma unroll
            for (int j2 = 0; j2 < 2; ++j2) Bk[d][j2][ks] = *(const bf16x8*)(KS + base + (size_t)(16 * (2 * (wv & 1) + j2) + fr) * 128 + 32 * ks + 8 * q); } }
    bf16x8 Bv[2], Vo[2], SbD[4];
#pragma unroll
    for (int ks = 0; ks < 2; ++ks) Bv[ks] = *(const bf16x8*)(VT + (size_t)((b * 4 + h) * 128 + 16 * wv + fr) * SP + s0 + 32 * ks + 8 * q);
    const int dm = 1 - sub;
#pragma unroll
    for (int ks = 0; ks < 2; ++ks) Vo[ks] = *(const bf16x8*)(VT + (size_t)((b * 4 + h) * 128 + 16 * wv + fr) * SP + 64 * oc + 32 * ks + 8 * q);
    u32x2 sp[8];
    { const size_t sbD = ((size_t)((sub * NB + b) * 4 + h) * NPR + pr) * 4096, sbM = ((size_t)((dm * NB + b) * 4 + h) * NPR + pr) * 4096;
#pragma unroll
        for (int ks = 0; ks < 4; ++ks) SbD[ks] = ld_split8(SPH + (sbD + ((2 * ks) * 8 + wv) * 64 + C.lane) * 4, SPH + (sbD + ((2 * ks + 1) * 8 + wv) * 64 + C.lane) * 4);
#pragma unroll
        for (int at = 0; at < 8; ++at) sp[at] = *(const u32x2*)(SPH + (sbM + (at * 8 + wv) * 64 + C.lane) * 4); }
    const int kr = C.tid >> 3, kc = (C.tid & 7) * 16;
    const bf16* kso = KS + dm * DST + ((size_t)(b * 4 + h) * SP + 64 * oc) * 128 + kr * 128 + kc;
    const u32x4 kt0 = *(const u32x4*)kso, kt1 = *(const u32x4*)(kso + 8);
    const int i = C.lane;
    const size_t row = (size_t)b * SEQ + i * 64 + w;
    const bf16* gp = U + row * NU + 1280 + 2048 + h * 128 + 16 * wv; bf16* yo = Y + row * D + 512 + h * 128 + 16 * wv; const float* nwp = a.hg_norm + h * 128 + 16 * wv;
    const u32x4 gw0 = *(const u32x4*)gp, gw1 = *(const u32x4*)(gp + 8);
    f32x4 nw[4];
#pragma unroll
    for (int c4 = 0; c4 < 4; ++c4) nw[c4] = *(const f32x4*)(nwp + 4 * c4);
    {
        f32x4 P[2] = {(f32x4){0.f, 0.f, 0.f, 0.f}, (f32x4){0.f, 0.f, 0.f, 0.f}};
#pragma unroll
        for (int d = 0; d < 2; ++d) {
#pragma unroll
            for (int ks = 0; ks < 4; ++ks) if ((wv & 1) == 0) *(LAS bf16x8*)(QL + (d * 64 + 16 * it0 + fr) * 136 + 32 * ks + 8 * q) = Aq[d][ks];
#pragma unroll
            for (int j2 = 0; j2 < 2; ++j2) { const int jt = 2 * (wv & 1) + j2; f32x4 S = (f32x4){0.f, 0.f, 0.f, 0.f};
#pragma unroll
                for (int ks = 0; ks < 4; ++ks) S = MFMA16(Aq[d][ks], Bk[d][j2][ks], S);
                const int j = 16 * jt + fr;
#pragma unroll
                for (int r = 0; r < 4; ++r) { const int ii = 16 * it0 + 4 * q + r; const bool keep = d == 0 ? (j <= ii) : (j >= ii); P[j2][r] += keep ? S[r] : 0.f; } } }
#pragma unroll
        for (int j2 = 0; j2 < 2; ++j2) { const int j = 16 * (2 * (wv & 1) + j2) + fr;
#pragma unroll
            for (int r = 0; r < 4; ++r) Pl[(16 * it0 + 4 * q + r) * 72 + j] = (bf16)(cvt_pk_bf16(P[j2][r], 0.f) & 0xffff); }
        *(LAS u32x4*)(KL + kr * 136 + kc) = kt0; *(LAS u32x4*)(KL + kr * 136 + kc + 8) = kt1;
    }
    LDS_BARRIER();
    f32x4 O[4];
#pragma unroll
    for (int it = 0; it < 4; ++it) { O[it] = (f32x4){0.f, 0.f, 0.f, 0.f};
#pragma unroll
        for (int ks = 0; ks < 2; ++ks) { const bf16x8 Pa = *(const LAS bf16x8*)(Pl + (16 * it + fr) * 72 + 32 * ks + 8 * q); O[it] = MFMA16(Pa, Bv[ks], O[it]); } }
    bf16x8 SbM[4];
    { const float* eg = EG + ((size_t)((dm * NB + b) * 4 + h) * NCH + oc) * 128 + 4 * q;
        const LAS bf16* kt = KL + (8 * q + (fr >> 2)) * 136 + 4 * (fr & 3);
#pragma unroll
        for (int ks = 0; ks < 4; ++ks) { unsigned wd[4];
#pragma unroll
            for (int hh = 0; hh < 2; ++hh) { const int at = 2 * ks + hh; f32x4 t4 = (f32x4){bflo(sp[at].x), bfhi(sp[at].x), bflo(sp[at].y), bfhi(sp[at].y)};
#pragma unroll
                for (int k2 = 0; k2 < 2; ++k2) { const s16x4 a0 = lds_tr(kt + (32 * k2) * 136 + 16 * at), a1 = lds_tr(kt + (32 * k2 + 4) * 136 + 16 * at);
                    const s16x8 av = (s16x8){a0[0], a0[1], a0[2], a0[3], a1[0], a1[1], a1[2], a1[3]}; t4 = MFMA16(__builtin_bit_cast(bf16x8, av), Vo[k2], t4); }
                const f32x4 e4 = *(const f32x4*)(eg + 16 * at);
                wd[2 * hh] = cvt_pk_bf16(t4[0] * e4[0], t4[1] * e4[1]); wd[2 * hh + 1] = cvt_pk_bf16(t4[2] * e4[2], t4[3] * e4[3]); }
            const u32x4 ww = (u32x4){wd[0], wd[1], wd[2], wd[3]}; SbM[ks] = __builtin_bit_cast(bf16x8, ww); } }
#pragma unroll
    for (int d = 0; d < 2; ++d)
#pragma unroll
        for (int ks = 0; ks < 4; ++ks) { const bf16x8 sb = d == sub ? SbD[ks] : SbM[ks];
#pragma unroll
            for (int it = 0; it < 4; ++it) { const LAS bf16* qp = QL + (d * 64 + 16 * it + fr) * 136 + 32 * ks + 4 * q;
                const u32x2 lo = *(const LAS u32x2*)qp, hi = *(const LAS u32x2*)(qp + 16); const u32x4 ww = (u32x4){lo.x, lo.y, hi.x, hi.y};
                O[it] = MFMA16(__builtin_bit_cast(bf16x8, ww), sb, O[it]); } }
#pragma unroll
    for (int it = 0; it < 4; ++it)
#pragma unroll
        for (int r = 0; r < 4; ++r) Ol[(16 * it + 4 * q + r) * 132 + 16 * wv + fr] = O[it][r];
    LDS_BARRIER();
    float o[16]; float ss = 0.f;
#pragma unroll
    for (int c4 = 0; c4 < 4; ++c4) { const f32x4 t = *(const LAS f32x4*)(Ol + i * 132 + 16 * wv + 4 * c4);
#pragma unroll
        for (int e = 0; e < 4; ++e) { o[4 * c4 + e] = t[e]; ss += t[e] * t[e]; } }
    red[wv * 64 + i] = ss;
    LDS_BARRIER();
    float tot = 0.f;
#pragma unroll
    for (int s2 = 0; s2 < 8; ++s2) tot += red[s2 * 64 + i];
    const float rstd = rsqrtf(tot * (1.0f / 128.0f) + EPS);
#pragma unroll
    for (int c8 = 0; c8 < 2; ++c8) { const u32x4 gw4 = c8 == 0 ? gw0 : gw1; const unsigned gz[4] = {gw4.x, gw4.y, gw4.z, gw4.w}; unsigned ow[4];
#pragma unroll
        for (int e = 0; e < 4; ++e) { const int k = 8 * c8 + 2 * e; ow[e] = cvt_pk_bf16(o[k] * rstd * nw[k >> 2][k & 3] * siluf(bflo(gz[e])), o[k + 1] * rstd * nw[(k + 1) >> 2][(k + 1) & 3] * siluf(bfhi(gz[e]))); }
        *(u32x4*)(yo + 8 * c8) = (u32x4){ow[0], ow[1], ow[2], ow[3]}; }
    LDS_BARRIER();
    }
}
__device__ __forceinline__ void phase7(CArgs& a, const Ctx& C) {
    for (int u = C.vcu; u < 256; u += C.G) passc_ssd_unit(a, C, u);
    for (int u = C.vcu; u < 512; u += C.G) passc_hg_pair(a, C, u);
}
__device__ __forceinline__ void phase9_fill(CArgs& a, const Ctx& C, int t0, int nt) {
    LAS float* RW = (LAS float*)C.lds;
    for (int k = t0; k < D; k += nt) {
#pragma unroll
        for (int e4 = 0; e4 < 8; ++e4) { const f32x4 w = *(const f32x4*)(a.router_w + (size_t)k * NE + 4 * e4);
#pragma unroll
            for (int e = 0; e < 4; ++e) RW[(4 * e4 + e) * D + k] = w[e]; } }
}
__device__ __forceinline__ void phase9(CArgs& a, const Ctx& C, bool prefilled) {
    constexpr int NR = 4;
    const float* MOD = (const float*)(a.ws + WS_MOD); const bf16* MIX = (const bf16*)(a.ws + WS_MIX); unsigned char* HX = a.ws + WS_XN; bf16* X1 = (bf16*)(a.ws + WS_U);
    int* TOPE = (int*)(a.ws + WS_ROUTE); float* GATE = (float*)(a.ws + WS_ROUTE + 256 * 1024); int* PPOS = (int*)(a.ws + WS_ROUTE + 512 * 1024); int* ROWTOK = (int*)(a.ws + WS_ROWTOK);
    unsigned* gcnt = (unsigned*)(a.ws + WS_CTL) + CW_CNT;
    LAS float* RW = (LAS float*)C.lds;
    LAS float* LG = (LAS float*)(C.lds + 131072) + C.wave * 128;
    LAS unsigned* lcnt = (LAS unsigned*)(C.lds + LCNT_OFF); LAS unsigned* lbase = lcnt + 32;
    if (!prefilled) phase9_fill(a, C, C.tid, 512);
    if (C.tid < 32) lcnt[C.tid] = 0u;
    __syncthreads();
    LAS float* VA = (LAS float*)(C.lds + 131072 + 4096); LAS float* VB = VA + 1024;
    for (int m0 = NR * C.gw; m0 < NLAT; m0 += NR * C.NGW) {
        const int b = m0 >> 12; const float* mb = MOD + b * 6144;
        __syncthreads();
        for (int k = C.tid; k < D; k += 512) { VA[k] = mb[2048 + k] * a.mix_post[k]; VB[k] = a.ffn_pre[k] * (1.0f + mb[4096 + k]); }
        __syncthreads();
        float hv[NR][16];
#pragma unroll
        for (int r = 0; r < NR; ++r) { const size_t ro = (size_t)(m0 + r) * D; float ss = 0.f;
            f32x4 xv[4];
#pragma unroll
            for (int jj = 0; jj < 4; ++jj) { const u32x2 w = NTLOAD((const u32x2*)(MIX + ro + 256 * jj + 4 * C.lane)); xv[jj] = NTLOAD((const f32x4*)(a.x + ro + 256 * jj + 4 * C.lane));
                hv[r][4 * jj] = bflo(w.x); hv[r][4 * jj + 1] = bfhi(w.x); hv[r][4 * jj + 2] = bflo(w.y); hv[r][4 * jj + 3] = bfhi(w.y); }
#pragma unroll
            for (int i = 0; i < 16; ++i) ss += hv[r][i] * hv[r][i];
            const float rstd = rsqrtf(wave_sum(ss) * (1.0f / D) + EPS); float ss2 = 0.f;
#pragma unroll
            for (int jj = 0; jj < 4; ++jj) { const int k0 = 256 * jj + 4 * C.lane; const f32x4 va = *(const LAS f32x4*)(VA + k0);
                f32x4 x1;
#pragma unroll
                for (int e = 0; e < 4; ++e) { x1[e] = xv[jj][e] + va[e] * (hv[r][4 * jj + e] * rstd); hv[r][4 * jj + e] = x1[e]; ss2 += x1[e] * x1[e]; }
                *(u32x2*)(X1 + ro + k0) = (u32x2){cvt_pk_bf16(x1[0], x1[1]), cvt_pk_bf16(x1[2], x1[3])}; }
            const float rstd2 = rsqrtf(wave_sum(ss2) * (1.0f / D) + EPS);
#pragma unroll
            for (int jj = 0; jj < 4; ++jj) { const int k0 = 256 * jj + 4 * C.lane; const f32x4 vb = *(const LAS f32x4*)(VB + k0), s0 = *(const f32x4*)(mb + 3072 + k0);
#pragma unroll
                for (int e = 0; e < 4; ++e) hv[r][4 * jj + e] = hv[r][4 * jj + e] * rstd2 * vb[e] + s0[e];
                *(unsigned*)(HX + ro + k0) = pk4_fp8(hv[r][4 * jj], hv[r][4 * jj + 1], hv[r][4 * jj + 2], hv[r][4 * jj + 3]); }
            if (r & 1) asm volatile("" ::: "memory"); }
#pragma unroll 1
        for (int eg = 0; eg < 4; ++eg) {
            float lg[NR][8];
#pragma unroll
            for (int r = 0; r < NR; ++r)
#pragma unroll
                for (int e = 0; e < 8; ++e) lg[r][e] = 0.f;
#pragma unroll
            for (int e = 0; e < 8; ++e)
#pragma unroll
                for (int jj = 0; jj < 4; ++jj) { const f32x4 w = *(const LAS f32x4*)(RW + (8 * eg + e) * D + 256 * jj + 4 * C.lane);
#pragma unroll
                    for (int r = 0; r < NR; ++r) lg[r][e] += hv[r][4 * jj] * w[0] + hv[r][4 * jj + 1] * w[1] + hv[r][4 * jj + 2] * w[2] + hv[r][4 * jj + 3] * w[3];
                    if (jj == 3 && (e & 1)) asm volatile("" ::: "memory"); }
#pragma unroll
            for (int r = 0; r < NR; ++r) { reduce_scatter<8>(lg[r], C.lane);
                if ((C.lane & 7) == 0) LG[r * 32 + 8 * eg + (C.lane >> 3)] = lg[r][0]; }
        }
        LDS_WAIT(); asm volatile("" ::: "memory");
        if (C.lane < NR) { const int m = m0 + C.lane; float logit[32];
#pragma unroll
            for (int e4 = 0; e4 < 8; ++e4) { const f32x4 v = *(const LAS f32x4*)(LG + C.lane * 32 + 4 * e4), rb = *(const f32x4*)(a.router_b + 4 * e4);
#pragma unroll
                for (int e = 0; e < 4; ++e) logit[4 * e4 + e] = v[e] + rb[e]; }
            int te[4]; float tv[4]; unsigned taken = 0u;
#pragma unroll
            for (int k = 0; k < 4; ++k) { float best = -3.0e38f; int bi = 0;
#pragma unroll
                for (int e = 0; e < 32; ++e) { const bool better = (((taken >> e) & 1u) == 0u) && (logit[e] > best); best = better ? logit[e] : best; bi = better ? e : bi; }
                te[k] = bi; tv[k] = best; taken |= 1u << bi; }
            float ex[4], sum = 0.f;
#pragma unroll
            for (int k = 0; k < 4; ++k) { ex[k] = __expf(tv[k] - tv[0]); sum += ex[k]; }
            const float inv = 1.0f / sum;
#pragma unroll
            for (int k = 0; k < 4; ++k) { const unsigned pos = __hip_atomic_fetch_add(lcnt + te[k], 1u, __ATOMIC_RELAXED, __HIP_MEMORY_SCOPE_WORKGROUP);
                TOPE[m * 4 + k] = te[k]; GATE[m * 4 + k] = ex[k] * inv; PPOS[m * 4 + k] = (int)pos; } }
        LDS_WAIT(); asm volatile("" ::: "memory");
    }
    __syncthreads();
    if (C.tid < 32) lbase[C.tid] = atomicAdd(gcnt + C.tid, lcnt[C.tid]);
    __syncthreads();
    for (int m0 = 4 * C.gw; m0 < NLAT; m0 += 4 * C.NGW) if (C.lane < 4 * NR) { const int idx = m0 * 4 + C.lane; const int e = TOPE[idx]; const int pos = PPOS[idx] + (int)lbase[e]; PPOS[idx] = pos; ROWTOK[e * 16384 + pos] = m0 + (C.lane >> 2); }
}
__device__ __forceinline__ void moe_tables(CArgs& a, const Ctx& C) {
    const unsigned* gcnt = (const unsigned*)(a.ws + WS_CTL) + CW_CNT; LAS int* TS = (LAS int*)(C.lds + TS_OFF); LAS int* CN = TS + 36;
    if (C.tid < 64) { const int e = C.tid & 31; const int c = (int)__hip_atomic_load(gcnt + e, RLX_AGENT); const int nt = (c + 255) >> 8;
        int pre = nt;
#pragma unroll
        for (int o = 1; o < 32; o <<= 1) { const int t = __shfl_up(pre, o, 32); pre += ((C.tid & 31) >= o) ? t : 0; }
        if (C.tid < 32) { TS[e] = pre - nt; CN[e] = c; if (e == 31) TS[NE] = pre; } }
    __syncthreads();
    if (C.tid < 320) { int e = 0;
#pragma unroll
        for (int k = 1; k < NE; ++k) e += (TS[k] <= C.tid) ? 1 : 0;
        TS[80 + C.tid] = e; }
    __syncthreads();
}
__device__ __forceinline__ void phase13(CArgs& a, const Ctx& C) {
    const float* MOD = (const float*)(a.ws + WS_MOD); const unsigned char* Y2 = a.ws + WS_Y2; const bf16* X1 = (const bf16*)(a.ws + WS_U);
    const int* TOPE = (const int*)(a.ws + WS_ROUTE); const float* GATE = (const float*)(a.ws + WS_ROUTE + 256 * 1024); const int* PPOS = (const int*)(a.ws + WS_ROUTE + 512 * 1024);
    moe_tables(a, C); const LAS int* TS = (const LAS int*)(C.lds + TS_OFF);
    for (int m0 = 4 * C.gw; m0 < NLAT; m0 += 4 * C.NGW) {
        const int b = m0 >> 12; const float* gf = MOD + b * 6144 + 5120;
        int slot = 0; float gk = 0.f;
        if (C.lane < 16) { const int idx = m0 * 4 + C.lane; slot = TS[TOPE[idx]] * 256 + PPOS[idx]; gk = GATE[idx] * (1.0f / Y_SCALE); }
        u32x4 yw[4][4];
#pragma unroll
        for (int r = 0; r < 4; ++r)
#pragma unroll
            for (int k = 0; k < 4; ++k) { const int sl = __shfl(slot, 4 * r + k); yw[r][k] = NTLOAD((const u32x4*)(Y2 + (size_t)sl * D + 16 * C.lane)); }
#pragma unroll
        for (int r = 0; r < 4; ++r) { float f[16];
#pragma unroll
            for (int e = 0; e < 16; ++e) f[e] = 0.f;
#pragma unroll
            for (int k = 0; k < 4; ++k) { const float g = __shfl(gk, 4 * r + k); const unsigned ww[4] = {yw[r][k].x, yw[r][k].y, yw[r][k].z, yw[r][k].w};
#pragma unroll
                for (int e = 0; e < 4; ++e) { const f32x2 lo = __builtin_amdgcn_cvt_pk_f32_fp8((int)ww[e], false), hi = __builtin_amdgcn_cvt_pk_f32_fp8((int)ww[e], true);
                    f[4 * e] += g * lo.x; f[4 * e + 1] += g * lo.y; f[4 * e + 2] += g * hi.x; f[4 * e + 3] += g * hi.y; } }
            float ss = 0.f;
#pragma unroll
            for (int e = 0; e < 16; ++e) ss += f[e] * f[e];
            const float rstd = rsqrtf(wave_sum(ss) * (1.0f / D) + EPS);
            const size_t ro = (size_t)(m0 + r) * D; const int k0 = 16 * C.lane;
            const u32x4 xa = NTLOAD((const u32x4*)(X1 + ro + k0)), xb = NTLOAD((const u32x4*)(X1 + ro + k0 + 8)); const unsigned xw[8] = {xa.x, xa.y, xa.z, xa.w, xb.x, xb.y, xb.z, xb.w};
#pragma unroll
            for (int e4 = 0; e4 < 4; ++e4) { const f32x4 w = *(const f32x4*)(a.ffn_post + k0 + 4 * e4), g = *(const f32x4*)(gf + k0 + 4 * e4);
                f32x4 o; o[0] = bflo(xw[2 * e4]) + g[0] * (f[4 * e4] * rstd * w[0]); o[1] = bfhi(xw[2 * e4]) + g[1] * (f[4 * e4 + 1] * rstd * w[1]);
                o[2] = bflo(xw[2 * e4 + 1]) + g[2] * (f[4 * e4 + 2] * rstd * w[2]); o[3] = bfhi(xw[2 * e4 + 1]) + g[3] * (f[4 * e4 + 3] * rstd * w[3]);
                *(f32x4*)(a.out + ro + k0 + 4 * e4) = o; } }
    }
}

struct ShadowWork { CArgs* ka; const Ctx* C; int fill, first, scr_off, scr_stride;
    __device__ __forceinline__ void operator()() const {
        if (fill == 2) phase2_fill(*ka, *C, C->tid - 64, 448);
        if (fill == 9) phase9_fill(*ka, *C, C->tid - 64, 448);
        if (first >= 0) conv_shadow(*ka, *C, first, C->lds + scr_off, scr_stride); } };
__global__ void __launch_bounds__(512, 2) mega_fwd(Args a) {
    extern __shared__ __attribute__((aligned(16))) unsigned char lds_raw[];
#define MKCTX(C) Ctx C; { int t_ = threadIdx.x; asm volatile("" : "+v"(t_)); C.lds = (LAS unsigned char*)lds_raw; C.tid = t_; C.lane = t_ & 63; C.wave = __builtin_amdgcn_readfirstlane(t_ >> 6); \
        C.G = gridDim.x; const int bx_ = blockIdx.x; C.vcu = (C.G % 8 == 0) ? (bx_ % 8) * (C.G / 8) + bx_ / 8 : bx_; C.gw = C.vcu * 8 + C.wave; C.NGW = C.G * 8; }
    MKCTX(C);
    volatile LAS unsigned* MISC = (volatile LAS unsigned*)(C.lds + MISC_OFF);
    for (int u = C.tid; u < (LDS_BYTES - LDSCTL_OFF) / 4; u += 512) ((LAS unsigned*)(C.lds + LDSCTL_OFF))[u] = 0u;
    __syncthreads();
    const int lo = a.ph_lo, hi = a.ph_hi;
    CArgs* const kargs = (CArgs*)__builtin_amdgcn_kernarg_segment_ptr();
#define KA() (*[&]() { CArgs* p_ = kargs; asm volatile("" : "+s"(p_)); return p_; }())
    if (hi - lo > 1) (void)xcd_barrier_post((unsigned*)(a.ws + WS_CTL) + CW_BAR, MISC + 8);
#define BAR() XcdBarrier{(unsigned*)(KA().ws + WS_CTL) + CW_BAR, xb_xcc_id(), (volatile LAS unsigned*)(C.lds + MISC_OFF) + 8}
#define IN(k) (lo <= (k) && (k) < hi)
#define NEXTPH(k) ((k) == 4 ? 6 : ((k) == 9 ? 11 : (k) + 1))
#define SEAM(k) do { if (IN(k) && IN(NEXTPH(k))) xcd_barrier(BAR()); } while (0)
#define SEAM_WORK(k, ...) do { if (IN(k) && IN(NEXTPH(k))) xcd_barrier(BAR(), __VA_ARGS__); } while (0)
#define SHADOW(sh) ShadowWork{&KA(), &C, 0, (sh) * CONV_B, 16384, 16384}
    if (IN(0)) { MKCTX(C); for (int rp = 0; rp < NREP(0); ++rp) phase0(KA(), C); SEAM_WORK(0, SHADOW(0)); }
    if (IN(1)) { MKCTX(C); for (int rp = 0; rp < NREP(1); ++rp) phase1(KA(), C); SEAM_WORK(1, ShadowWork{&KA(), &C, 2, 1 * CONV_B, 65536, 8448}); }
    if (IN(2)) { MKCTX(C); for (int rp = 0; rp < NREP(2); ++rp) { phase2(KA(), C, IN(1) && rp == 0); __syncthreads(); } SEAM_WORK(2, SHADOW(2)); }
    if (IN(3)) { MKCTX(C); pg8::Gemm g{(const bf16*)(KA().ws + WS_XN), (const bf16*)(KA().ws + WS_WINT), D}; pg8::StaticOrder S; S.init(MROWS, NU, C.G, (int)blockIdx.x);
        pg8::EpiBf16 E{(bf16*)(KA().ws + WS_U), NU, nullptr, 0, 1.0f};
        const bool odd = (C.vcu & 1) != 0;
        if (odd) { conv_range(KA(), C, CONV_W1_HOST, NIT1); __syncthreads(); }
        pg8::gemm_phase<false>(C.lds, g, S, E, pg8::DenseRows{}); __syncthreads();
        if (!odd) conv_range(KA(), C, CONV_W1_HOST, NIT1);
        SEAM_WORK(3, SHADOW(3)); }
    if (IN(4)) { MKCTX(C); for (int rp = 0; rp < NREP(4); ++rp) phase4(KA(), C); SEAM_WORK(4, SHADOW(4)); }

    if (IN(6)) { MKCTX(C); for (int rp = 0; rp < NREP(6); ++rp) phase6(KA(), C); SEAM_WORK(6, SHADOW(5)); }
    if (IN(7)) { MKCTX(C); for (int rp = 0; rp < NREP(7); ++rp) phase7(KA(), C); SEAM_WORK(7, SHADOW(6)); }
    if (IN(8)) { MKCTX(C); pg8::Gemm g{(const bf16*)(KA().ws + WS_Y), (const bf16*)(KA().ws + WS_WOUTT), D}; pg8::StaticOrder S; S.init(NLAT, D, C.G, (int)blockIdx.x);
        pg8::EpiBf16 E{(bf16*)(KA().ws + WS_MIX), D, nullptr, 0, 1.0f}; for (int rp = 0; rp < NREP(8); ++rp) pg8::gemm_phase<false>(C.lds, g, S, E, pg8::DenseRows{}); SEAM_WORK(8, ShadowWork{&KA(), &C, 9, -1, 0, 0}); }
    if (IN(9)) { MKCTX(C); phase9(KA(), C, IN(8)); SEAM_WORK(9, ShadowWork{&KA(), &C, 0, CONV_S9, 16384, 16384}); }
    if (IN(11)) { MKCTX(C); moe_tables(KA(), C); pg8::Gemm g{(const bf16*)(KA().ws + WS_XN), (const bf16*)(KA().ws + WS_W1T), D / 2};   pg8::MoeOrder S; S.init((const LAS int*)(C.lds + TS_OFF), 8, 4, (int)blockIdx.x);
        pg8::EpiSwiglu E{KA().ws + WS_ACT, D, KA().b1, 2048}; LAS unsigned* ROWL = (LAS unsigned*)(C.lds + 131072 + 2048);
        { const int* rowtok = (const int*)(KA().ws + WS_ROWTOK); const LAS int* TSl = (const LAS int*)(C.lds + TS_OFF); const LAS int* CNl = TSl + 36;
          for (int idx = C.tid; idx < 9 * 256; idx += 512) { const int i = idx >> 8, r = idx & 255; pg8::Unit uu;
              if (S.next(i, uu)) { const int p = (uu.pm - TSl[uu.e]) * 256 + r; const int tok = p < CNl[uu.e] ? rowtok[uu.e * 16384 + p] : 0; ROWL[idx] = (unsigned)tok * 1024u; } }
          __syncthreads(); }
        pg8::GatherRows AM{ROWL};
        const bool odd = (C.vcu & 1) != 0;
        constexpr int H0 = CONV_S9 + CONV_B, NH = NIT1 + NIT2 - H0 > 0 ? NIT1 + NIT2 - H0 : 0, CONV_EXI = 5;
        const int nidw = S.nidle * 8, exi = nidw > 0 ? (CONV_EXI * nidw <= NH ? CONV_EXI : NH / nidw) : 0, hbase = NH - exi * nidw;
#pragma unroll 1
        for (int part = 0; part < 2; ++part) {
            if ((odd && part == 0) || (!odd && part == 1)) { conv_range(KA(), C, H0, H0 + hbase); __syncthreads(); }
            S.i0 = odd ? 0 : 4 * part; S.n = odd ? (part == 0 ? (1 << 30) : 0) : (part == 0 ? 4 : (1 << 30));
            pg8::gemm_phase<true>(C.lds, g, S, E, AM); __syncthreads(); }
        if (S.irank >= 0) {
            LAS float* scr = (LAS float*)(C.lds + C.wave * 16384);
#pragma unroll 1
            for (int k = 0; k < exi; ++k) conv_item(KA(), scr, C.lane, H0 + hbase + S.irank * 8 + C.wave + nidw * k); }
        SEAM_WORK(11, ShadowWork{&KA(), &C, 0, -1, 0, 0}); }
    if (IN(12)) { MKCTX(C); moe_tables(KA(), C); pg8::Gemm g{(const bf16*)(KA().ws + WS_ACT), (const bf16*)(KA().ws + WS_W2T), D / 2}; pg8::MoeOrder S; S.init((const LAS int*)(C.lds + TS_OFF), 4, 8, (int)blockIdx.x);
        pg8::EpiFp8 E{KA().ws + WS_Y2, D, KA().b2, D, 1.0f / (W_SCALE * ACT_SCALE)}; for (int rp = 0; rp < NREP(12); ++rp) pg8::gemm_phase<true>(C.lds, g, S, E, pg8::DenseRows{}); SEAM(12); }
    if (IN(13)) { MKCTX(C); for (int rp = 0; rp < NREP(13); ++rp) phase13(KA(), C); }
#undef IN
#undef KA
#undef SEAM
}

extern "C" void kernel_launch(void* const* d_in, const int* in_sizes, int n_in, void* d_out, int out_size, void* d_ws, size_t ws_size, hipStream_t stream) {
    static int grid = 0;
    if (grid == 0) {
        if (n_in != 26 || in_sizes[0] != NLAT * D || out_size != NLAT * D || ws_size < WS_END) {
            fprintf(stderr, "kernel_launch: unexpected shapes: n_in %d in0 %d out %d ws %zu (need %zu); nothing launched\n", n_in, n_in > 0 ? in_sizes[0] : -1, out_size, ws_size, (size_t)WS_END); grid = -1; return; }
        int dev = 0, cus = 0, per_cu = 0;
        if (hipGetDevice(&dev) != hipSuccess || hipDeviceGetAttribute(&cus, hipDeviceAttributeMultiprocessorCount, dev) != hipSuccess) { fprintf(stderr, "kernel_launch: device query failed\n"); grid = -1; return; }
        if (hipFuncSetAttribute((const void*)mega_fwd, hipFuncAttributeMaxDynamicSharedMemorySize, LDS_BYTES) != hipSuccess) { fprintf(stderr, "kernel_launch: hipFuncSetAttribute failed\n"); grid = -1; return; }
        if (hipOccupancyMaxActiveBlocksPerMultiprocessor(&per_cu, (const void*)mega_fwd, 512, LDS_BYTES) != hipSuccess || per_cu < 1)
            fprintf(stderr, "kernel_launch: note: occupancy query reports %d workgroups per CU\n", per_cu);
        (void)hipGetLastError();
        grid = cus;
        if (grid != 256) { fprintf(stderr, "kernel_launch: this kernel needs a 256-CU device (got %d)\n", grid); grid = -1; return; }
    }
    if (grid < 0) return;
    (void)hipMemsetAsync((char*)d_ws + WS_CTL, 0, CTL_ZERO_BYTES, stream);
    Args a{};
    const float** ap = (const float**)&a;
    for (int i = 0; i < 26; ++i) ap[i] = (const float*)d_in[i];
    a.out = (float*)d_out; a.ws = (unsigned char*)d_ws;
#if MK_PER_PHASE
    for (int p = 0; p < NPHASE; ++p) { a.ph_lo = p; a.ph_hi = p + 1; hipLaunchKernelGGL(mega_fwd, dim3(grid), dim3(512), LDS_BYTES, stream, a); }
#else
    a.ph_lo = 0; a.ph_hi = NPHASE; hipLaunchKernelGGL(mega_fwd, dim3(grid), dim3(512), LDS_BYTES, stream, a);
#endif
}
```

```cpp
#include <hip/hip_runtime.h>
#include <cstdio>
#include <cstdint>

#ifndef MK_PER_PHASE
#define MK_PER_PHASE 0
#endif

#ifndef PROBE_REP_MASK
#define PROBE_REP_MASK 0u
#endif
#define NREP(k) ((((PROBE_REP_MASK) >> (k)) & 1u) ? 2 : 1)
#define LAS __attribute__((address_space(3)))
typedef unsigned short bf16;
typedef short bf16x8 __attribute__((ext_vector_type(8)));
typedef float f32x4 __attribute__((ext_vector_type(4)));
typedef float f32x2 __attribute__((ext_vector_type(2)));
typedef unsigned u32x4 __attribute__((ext_vector_type(4)));
typedef unsigned u32x2 __attribute__((ext_vector_type(2)));
typedef int i32x4 __attribute__((ext_vector_type(4)));
typedef int i32x8 __attribute__((ext_vector_type(8)));

constexpr int D = 1024, NB = 4, SEQ = 4096, CTXL = 256;
constexpr int NLAT = NB * SEQ, NCTX = NB * CTXL, MROWS = NLAT + NCTX;
constexpr int NU = 3840;
constexpr int W_IN_COLS = 3856;
constexpr int SP = CTXL + SEQ;
constexpr int NCH = SP / 64;
constexpr int NPR = NCH / 2;
constexpr int NE = 32;
constexpr float EPS = 1e-6f;
constexpr int NPHASE = 14;

constexpr size_t MiB = 1u << 20;
constexpr size_t WS_CTL = 0, CTL_ZERO_BYTES = 1 * MiB;
constexpr size_t WS_MODP = 1 * MiB, WS_MOD = 5 * MiB, WS_DTRAW = 6 * MiB, WS_WINT = 8 * MiB, WS_WOUTT = 16 * MiB;
constexpr size_t WS_W1T = 18 * MiB, WS_W2T = 146 * MiB, WS_XN = 210 * MiB, WS_U = 244 * MiB;
constexpr size_t WS_BC = 372 * MiB, WS_XST = 381 * MiB, WS_XSW = 398 * MiB, WS_BT = 432 * MiB, WS_GA = 437 * MiB, WS_DTA = 439 * MiB, WS_GEND = 441 * MiB;
constexpr size_t WS_QS = 442 * MiB, WS_KS = 476 * MiB, WS_KHT = 510 * MiB, WS_VT = 544 * MiB, WS_EG = 561 * MiB;
constexpr size_t WS_DSP = WS_KHT, WS_EGP = WS_EG + 1179648;
constexpr size_t WS_DSS = 563 * MiB, WS_DSH = 631 * MiB, WS_SPS = 767 * MiB, WS_SPH = 801 * MiB, WS_Y = 869 * MiB, WS_MIX = 901 * MiB, WS_ROUTE = 965 * MiB;
constexpr size_t WS_XS = 372 * MiB, WS_ACT = 516 * MiB, WS_Y2 = 660 * MiB;
constexpr size_t WS_ROWTOK = 966 * MiB;
constexpr size_t WS_END = 968 * MiB;
constexpr int CW_BAR = 4096, CW_CNT = 16384;

constexpr int LDS_BYTES = 147456;
constexpr int LDSCTL_OFF = 144896;
constexpr int MISC_OFF = LDSCTL_OFF;
constexpr int TS_OFF = LDSCTL_OFF + 128;
constexpr int LCNT_OFF = LDSCTL_OFF + 2048;

typedef __bf16 bf16x2_t __attribute__((ext_vector_type(2)));
__device__ __forceinline__ unsigned cvt_pk_bf16(float lo, float hi) { const f32x2 v = {lo, hi}; const bf16x2_t b = __builtin_convertvector(v, bf16x2_t); return __builtin_bit_cast(unsigned, b); }
__device__ __forceinline__ unsigned pk4_fp8(float a, float b, float c, float d) { int w = __builtin_amdgcn_cvt_pk_fp8_f32(a, b, 0, false); w = __builtin_amdgcn_cvt_pk_fp8_f32(c, d, w, true); return (unsigned)w; }
constexpr float W_SCALE = 64.0f, ACT_SCALE = 4.0f, Y_SCALE = 16.0f;
__device__ __forceinline__ float bf2f(unsigned short b) { return __uint_as_float(((unsigned)b) << 16); }
__device__ __forceinline__ float bflo(unsigned w) { return __uint_as_float(w << 16); }
__device__ __forceinline__ float bfhi(unsigned w) { return __uint_as_float(w & 0xffff0000u); }
__device__ __forceinline__ float siluf(float x) { return x * __builtin_amdgcn_rcpf(1.0f + __expf(-x)); }
__device__ __forceinline__ float wave_sum(float v) {
#pragma unroll
    for (int o = 1; o < 64; o <<= 1) v += __shfl_xor(v, o);
    return v;
}
#define LDS_WAIT() asm volatile("s_waitcnt lgkmcnt(0)" ::: "memory")
#define VM_WAIT() asm volatile("s_waitcnt vmcnt(0)" ::: "memory")
#define LDS_BARRIER() do { asm volatile("s_waitcnt lgkmcnt(0)" ::: "memory"); __builtin_amdgcn_s_barrier(); asm volatile("" ::: "memory"); } while (0)
#define RLX_AGENT __ATOMIC_RELAXED, __HIP_MEMORY_SCOPE_AGENT
#define NTLOAD(p) __builtin_nontemporal_load(p)
#define MFMA16(a, b, c) __builtin_amdgcn_mfma_f32_16x16x32_bf16((a), (b), (c), 0, 0, 0)

namespace pg8 {
constexpr int BM = 256, BK = 64, HALF = 128, HTB = HALF * BK * 2, STAGE_BYTES = 8 * HTB, NXCD = 8, WGM = 8;
__host__ __device__ __forceinline__ int lds_byte(int r, int c) { const int st = (r >> 4) * 2 + (c >> 5), rr = r & 15, cc = c & 31, ob = rr * 64 + cc * 2; return st * 1024 + (ob ^ (((ob >> 9) & 1) << 5)); }
__host__ __device__ __forceinline__ void stage_rc(int b, int& R, int& C) { const int st = b / 1024, sb = b % 1024, swz = sb ^ (((sb >> 9) & 1) << 5); R = (st >> 1) * 16 + swz / 64; C = (st & 1) * 32 + (swz % 64) / 2; }
__host__ __device__ __forceinline__ int perm32(int rho) { const int n = rho >> 4, i = rho & 15; return 8 * (i >> 2) + 4 * n + (i & 3); }

struct Unit { int pm, pn, pb, e, ord; };
struct Gemm { const bf16* A; const bf16* Bt; int K; };
struct DenseRows {
    __device__ __forceinline__ size_t ubase(const Unit& u, int h, int K) const { return (size_t)(u.pm * BM + h * HALF) * K * 2; }
    __device__ __forceinline__ unsigned lane_off(const Unit&, int, int R, int K) const { return (unsigned)(R * K) * 2u; } };
struct GatherRows { const LAS unsigned* rowl;
    __device__ __forceinline__ size_t ubase(const Unit&, int, int) const { return 0; }
    __device__ __forceinline__ unsigned lane_off(const Unit& u, int h, int R, int) const { return rowl[u.ord * BM + h * HALF + R]; } };

struct StaticOrder {
    int nM, nN, nwg, G, c, i0, n;
    __device__ __forceinline__ void init(int M, int N, int G_, int c_) { nM = M / BM; nN = N / BM; nwg = nM * nN; G = G_; c = c_; i0 = 0; n = 1 << 30; }
    __device__ __forceinline__ bool next(int i_, Unit& u) const {
        if (i_ >= n) return false; const int i = i_ + i0;
        const long L = (long)i * G + c; if (L >= nwg) return false;
        int wgid = (int)L; { const int q = nwg / NXCD, r = nwg % NXCD, xcd = wgid % NXCD, off = wgid / NXCD; wgid = (xcd < r ? xcd * (q + 1) : r * (q + 1) + (xcd - r) * q) + off; }
        const int nig = WGM * nN, gid = wgid / nig, fm = gid * WGM, gsz = (nM - fm) < WGM ? (nM - fm) : WGM;
        u.pm = fm + ((wgid % nig) % gsz); u.pn = (wgid % nig) / gsz; u.pb = u.pn; u.e = 0; u.ord = i; return true;
    }
};
struct MoeOrder {
    const LAS int* ts; int ntn, mg, x, j, i0, n, nfull, tmt, tnt, nidle, irank;
    __device__ __forceinline__ void init(const LAS int* ts_, int ntn_, int mg_, int c) { ts = ts_; ntn = ntn_; mg = mg_; x = c & 7; j = c >> 3; i0 = 0; n = 1 << 30;
        const int full = __builtin_amdgcn_readfirstlane(ts[NE]), per = mg * 8; nfull = full / per;
        const int rem = full - nfull * per, q = (rem + 7) >> 3; tmt = -1; tnt = 0;
        if (rem > 0) { const int nt = j / q, mt = nfull * per + x * q + (j - nt * q); if (nt < ntn && mt < full) { tmt = mt; tnt = nt; } }
        nidle = 0; irank = -1;
#pragma unroll
        for (int xx = 0; xx < 8; ++xx) { int mx = rem - xx * q; mx = mx < 0 ? 0 : (mx > q ? q : mx);
            if (xx == x && tmt < 0) { const int jj = j < q * ntn ? j : q * ntn; const int tb = q > 0 ? (jj / q) * mx + ((jj % q) < mx ? (jj % q) : mx) : 0; irank = nidle + (j - tb); }
            nidle += 32 - ntn * mx; } }
    __device__ __forceinline__ bool next(int i_, Unit& u) const {
        if (i_ >= n) return false; const int i = i_ + i0;
        int mt, nt;
        if (i < nfull) { mt = mg * (i * 8 + x) + (j % mg); nt = j / mg; }
        else if (i == nfull && tmt >= 0) { mt = tmt; nt = tnt; }
        else return false;
        const int e = __builtin_amdgcn_readfirstlane(ts[80 + mt]);
        u.pm = mt; u.pn = nt; u.e = e; u.pb = e * ntn + nt; u.ord = i; return true;
    }
};

struct EpiF32 {
    static constexpr bool PERM = false, SWZ = false;
    float* C; int ldc;
    __device__ __forceinline__ const float* bias_src(const Unit&) const { return nullptr; }
    __device__ __forceinline__ void operator()(const f32x4 (&acc)[2][2][4][2], const Unit& u, int wr, int wc, int fr, int fq, const LAS float*) const {
        const int row0 = u.pm * BM + wr * 64 + fr, col0 = u.pn * BM + wc * 32 + 4 * fq;
#pragma unroll
        for (int ai = 0; ai < 2; ++ai)
#pragma unroll
            for (int m = 0; m < 4; ++m) { float* rowp = C + (size_t)(row0 + ai * HALF + m * 16) * ldc + col0;
#pragma unroll
                for (int bj = 0; bj < 2; ++bj)
#pragma unroll
                    for (int n = 0; n < 2; ++n) *(f32x4*)(rowp + bj * HALF + n * 16) = acc[ai][bj][m][n]; }
    }
};
struct EpiBf16 {
    static constexpr bool PERM = true, SWZ = false;
    bf16* O; int ldc; const float* bias; int bias_stride; float scale;
    __device__ __forceinline__ const float* bias_src(const Unit& u) const { return bias ? bias + (size_t)u.e * bias_stride + u.pn * BM : nullptr; }
    __device__ __forceinline__ void operator()(const f32x4 (&acc)[2][2][4][2], const Unit& u, int wr, int wc, int fr, int fq, const LAS float* bl) const {
        const int row0 = u.pm * BM + wr * 64 + fr, col0 = u.pn * BM + wc * 32 + 8 * fq;
        f32x4 bv[2][2];
#pragma unroll
        for (int bj = 0; bj < 2; ++bj)
#pragma unroll
            for (int n = 0; n < 2; ++n) bv[bj][n] = bias ? *(const LAS f32x4*)(bl + wc * 32 + 8 * fq + bj * HALF + 4 * n) : (f32x4){0.f, 0.f, 0.f, 0.f};
#pragma unroll
        for (int ai = 0; ai < 2; ++ai)
#pragma unroll
            for (int m = 0; m < 4; ++m) { bf16* rowp = O + (size_t)(row0 + ai * HALF + m * 16) * ldc + col0;
#pragma unroll
                for (int bj = 0; bj < 2; ++bj) { const f32x4 v0 = acc[ai][bj][m][0] * scale + bv[bj][0], v1 = acc[ai][bj][m][1] * scale + bv[bj][1];
                    u32x4 w; w.x = cvt_pk_bf16(v0[0], v0[1]); w.y = cvt_pk_bf16(v0[2], v0[3]); w.z = cvt_pk_bf16(v1[0], v1[1]); w.w = cvt_pk_bf16(v1[2], v1[3]);
                    *(u32x4*)(rowp + bj * HALF) = w; } }
    }
};
struct EpiFp8 {
    static constexpr bool PERM = true, SWZ = false;
    unsigned char* O; int ldc; const float* bias; int bias_stride; float scale;
    __device__ __forceinline__ const float* bias_src(const Unit& u) const { return bias + (size_t)u.e * bias_stride + u.pn * BM; }
    __device__ __forceinline__ void operator()(const f32x4 (&acc)[2][2][4][2], const Unit& u, int wr, int wc, int fr, int fq, const LAS float* bl) const {
        const int row0 = u.pm * BM + wr * 64 + fr, col0 = u.pn * BM + wc * 32 + 8 * fq;
        f32x4 bv[2][2];
#pragma unroll
        for (int bj = 0; bj < 2; ++bj)
#pragma unroll
            for (int n = 0; n < 2; ++n) bv[bj][n] = *(const LAS f32x4*)(bl + wc * 32 + 8 * fq + bj * HALF + 4 * n) * Y_SCALE;
        const float sc = scale * Y_SCALE;
#pragma unroll
        for (int ai = 0; ai < 2; ++ai)
#pragma unroll
            for (int m = 0; m < 4; ++m) { unsigned char* rowp = O + (size_t)(row0 + ai * HALF + m * 16) * ldc + col0;
#pragma unroll
                for (int bj = 0; bj < 2; ++bj) { const f32x4 v0 = acc[ai][bj][m][0] * sc + bv[bj][0], v1 = acc[ai][bj][m][1] * sc + bv[bj][1];
                    *(u32x2*)(rowp + bj * HALF) = (u32x2){pk4_fp8(v0[0], v0[1], v0[2], v0[3]), pk4_fp8(v1[0], v1[1], v1[2], v1[3])}; } }
    }
};
__device__ __forceinline__ f32x2 swiglu2(f32x2 glu, f32x2 lin) {
    const f32x2 g = (f32x2){fminf(glu.x, 7.0f), fminf(glu.y, 7.0f)}, l = (f32x2){__builtin_amdgcn_fmed3f(lin.x, -7.0f, 7.0f), __builtin_amdgcn_fmed3f(lin.y, -7.0f, 7.0f)};
    const f32x2 ea = g * (-1.702f * 1.4426950408889634f);
    const f32x2 den = (f32x2){__builtin_amdgcn_exp2f(ea.x), __builtin_amdgcn_exp2f(ea.y)} + 1.0f;
    const f32x2 r = (f32x2){__builtin_amdgcn_rcpf(den.x), __builtin_amdgcn_rcpf(den.y)};
    return (g * r) * (l * ACT_SCALE + ACT_SCALE);
}
struct EpiSwiglu {
    static constexpr bool PERM = true, SWZ = true;
    unsigned char* O; int ldc; const float* bias; int bias_stride;
    __device__ __forceinline__ const float* bias_src(const Unit& u) const { return bias + (size_t)u.e * bias_stride + u.pn * BM; }
    __device__ __forceinline__ void operator()(const f32x4 (&acc)[2][2][4][2], const Unit& u, int wr, int wc, int fr, int fq, const LAS float* bl) const {
        const int row0 = u.pm * BM + wr * 64 + fr, col0 = u.pn * BM + wc * 32 + 8 * fq, ocol0 = col0 >> 1;
        f32x4 bv[2][2];
#pragma unroll
        for (int bj = 0; bj < 2; ++bj)
#pragma unroll
            for (int n = 0; n < 2; ++n) { const f32x4 t = *(const LAS f32x4*)(bl + wc * 32 + 8 * fq + bj * HALF + 4 * n); bv[bj][n] = (f32x4){t[0], t[2], t[1], t[3]}; }
#pragma unroll
        for (int ai = 0; ai < 2; ++ai)
#pragma unroll
            for (int m = 0; m < 4; ++m) { unsigned char* rowp = O + (size_t)(row0 + ai * HALF + m * 16) * ldc + ocol0;
#pragma unroll
                for (int bj = 0; bj < 2; ++bj) { const f32x4 v0 = acc[ai][bj][m][0] * (1.0f / W_SCALE) + bv[bj][0], v1 = acc[ai][bj][m][1] * (1.0f / W_SCALE) + bv[bj][1];
                    const f32x2 o0 = swiglu2((f32x2){v0[0], v0[1]}, (f32x2){v0[2], v0[3]}), o1 = swiglu2((f32x2){v1[0], v1[1]}, (f32x2){v1[2], v1[3]});
                    *(unsigned*)(rowp + bj * (HALF / 2)) = pk4_fp8(o0.x, o0.y, o1.x, o1.y); } }
    }
};

template <bool F8, class Epi, class Sched, class AMap>
__device__ __forceinline__ void gemm_phase(LAS unsigned char* lds, const Gemm g, const Sched& S, const Epi& E, const AMap& AM) {
    const int tid = threadIdx.x, wid = __builtin_amdgcn_readfirstlane(tid >> 6), lane = tid & 63, wr = wid >> 2, wc = wid & 3, fr = lane & 15, fq = lane >> 4;
    const int K = g.K, nt = K / BK;
    unsigned voffB[2];
#pragma unroll
    for (int i = 0; i < 2; ++i) { int R, C; stage_rc(tid * 16 + i * 8192, R, C); int Rb = Epi::PERM ? ((R & ~31) + perm32(R & 31)) : R; if constexpr (Epi::SWZ) Rb = (Rb & ~3) | ((Rb & 1) << 1) | ((Rb >> 1) & 1);
        voffB[i] = (unsigned)(Rb * K + C) * 2u; }
    unsigned vA0[2], vA1[2], nA0[2], nA1[2];
#define PG8_AOFF(u, o0, o1) do { int _t = tid; asm volatile("" : "+v"(_t));   _Pragma("unroll") for (int _i = 0; _i < 2; ++_i) { int _R, _C; stage_rc(_t * 16 + _i * 8192, _R, _C); \
        o0[_i] = AM.lane_off(u, 0, _R, K) + (unsigned)_C * 2u; o1[_i] = AM.lane_off(u, 1, _R, K) + (unsigned)_C * 2u; } } while (0)
    const size_t kstep = (size_t)(BK * 2);
    const size_t hstep = (size_t)HALF * K * 2;
    const size_t tstep = 2 * hstep;
    const unsigned ldsw = (unsigned)wid * 1024u;
    const int aoff = lds_byte(wr * 64 + fr, fq * 8), boff = lds_byte(wc * 32 + fr, fq * 8);
#define PG8_SA(b, h) (((b) * 2 + (h)) * HTB)
#define PG8_SB(b, h) ((4 + (b) * 2 + (h)) * HTB)
#define PG8_STAGE(bufoff, gbase, voff) do { _Pragma("unroll") for (int _i = 0; _i < 2; ++_i) \
        __builtin_amdgcn_global_load_lds((const unsigned*)((const char*)(gbase) + (voff)[_i]), (LAS unsigned*)(lds + (bufoff) + ldsw + _i * 8192), 16, 0, 0); } while (0)
#define PG8_LDA(dst, b, h) do { _Pragma("unroll") for (int m = 0; m < 4; ++m) { const i32x4 _lo = *(const LAS i32x4*)(lds + PG8_SA(b, h) + aoff + m * 2048), _hi = *(const LAS i32x4*)(lds + PG8_SA(b, h) + aoff + m * 2048 + 1024); \
        dst[m] = __builtin_shufflevector(_lo, _hi, 0, 1, 2, 3, 4, 5, 6, 7); } } while (0)
#define PG8_LDB(dst, b, h) do { _Pragma("unroll") for (int n = 0; n < 2; ++n) { const i32x4 _lo = *(const LAS i32x4*)(lds + PG8_SB(b, h) + boff + n * 2048), _hi = *(const LAS i32x4*)(lds + PG8_SB(b, h) + boff + n * 2048 + 1024); \
        dst[n] = __builtin_shufflevector(_lo, _hi, 0, 1, 2, 3, 4, 5, 6, 7); } } while (0)
#define PG8_LO(x) __builtin_bit_cast(bf16x8, __builtin_shufflevector(x, x, 0, 1, 2, 3))
#define PG8_HI(x) __builtin_bit_cast(bf16x8, __builtin_shufflevector(x, x, 4, 5, 6, 7))
#define PG8_MMA(ai, bj, At, Bt) do { __builtin_amdgcn_s_setprio(1); _Pragma("unroll") for (int m = 0; m < 4; ++m) _Pragma("unroll") for (int n = 0; n < 2; ++n) { \
        if constexpr (F8) asm volatile("v_mfma_scale_f32_16x16x128_f8f6f4 %0, %1, %2, %0, %3, %3 op_sel_hi:[0,0,0]" : "+v"(acc[ai][bj][m][n]) : "v"(Bt[n]), "v"(At[m]), "v"(f8scale)); \
        else { acc[ai][bj][m][n] = __builtin_amdgcn_mfma_f32_16x16x32_bf16(PG8_LO(Bt[n]), PG8_LO(At[m]), acc[ai][bj][m][n], 0, 0, 0); \
               acc[ai][bj][m][n] = __builtin_amdgcn_mfma_f32_16x16x32_bf16(PG8_HI(Bt[n]), PG8_HI(At[m]), acc[ai][bj][m][n], 0, 0, 0); } } \
        __builtin_amdgcn_s_setprio(0); } while (0)
#define PG8_WAIT_V(n) asm volatile("s_waitcnt vmcnt(" #n ")" ::: "memory")
#define PG8_WAIT_L(n) asm volatile("s_waitcnt lgkmcnt(" #n ")" ::: "memory")
#define PG8_BAR __builtin_amdgcn_s_barrier()
#define PG8_SCHED __builtin_amdgcn_sched_barrier(0)
    Unit cur, nxt; int ui = 0;
    if (!S.next(0, cur)) return;
    f32x4 acc[2][2][4][2];
#pragma unroll
    for (int a = 0; a < 2; ++a)
#pragma unroll
        for (int b = 0; b < 2; ++b)
#pragma unroll
            for (int m = 0; m < 4; ++m)
#pragma unroll
                for (int n = 0; n < 2; ++n) acc[a][b][m][n] = (f32x4){0.f, 0.f, 0.f, 0.f};
    i32x8 At[4], B0[2], B1[2];
    int f8scale = 0x7F7F7F7F; asm volatile("" : "+v"(f8scale));
    LAS float* const biasl = (LAS float*)(lds + STAGE_BYTES);
#define PG8_BIAS(u, slot) do { const float* _bs = E.bias_src(u); if (_bs != nullptr && wid == 0) { int _ln = lane; asm volatile("" : "+v"(_ln));     \
        __builtin_amdgcn_global_load_lds((const unsigned*)(_bs + _ln * 4), (LAS unsigned*)(biasl + (slot) * 256), 16, 0, 0); } } while (0)
    PG8_BIAS(cur, 0);
    const char* cA0 = (const char*)g.A + AM.ubase(cur, 0, K); const char* cA1 = (const char*)g.A + AM.ubase(cur, 1, K); const char* cB = (const char*)g.Bt + (size_t)cur.pb * tstep;
    PG8_AOFF(cur, vA0, vA1);
    PG8_STAGE(PG8_SB(0, 0), cB, voffB); PG8_STAGE(PG8_SB(0, 1), cB + hstep, voffB); PG8_STAGE(PG8_SA(0, 0), cA0, vA0); PG8_STAGE(PG8_SA(0, 1), cA1, vA1);
    if (wr == 1) PG8_BAR;
    PG8_WAIT_V(2); PG8_BAR;
    PG8_STAGE(PG8_SB(1, 0), cB + kstep, voffB); PG8_STAGE(PG8_SA(1, 0), cA0 + kstep, vA0); PG8_STAGE(PG8_SB(1, 1), cB + hstep + kstep, voffB);
    PG8_WAIT_V(6); PG8_BAR;
    for (;;) {
        const bool has_next = S.next(ui + 1, nxt);
        const char* nB = has_next ? (const char*)g.Bt + (size_t)nxt.pb * tstep : cB;
        const char* nxA0 = has_next ? (const char*)g.A + AM.ubase(nxt, 0, K) : cA0; const char* nxA1 = has_next ? (const char*)g.A + AM.ubase(nxt, 1, K) : cA1;
        if (has_next) { PG8_AOFF(nxt, nA0, nA1); PG8_BIAS(nxt, (ui + 1) & 1); } else { nA0[0] = vA0[0]; nA0[1] = vA0[1]; nA1[0] = vA1[0]; nA1[1] = vA1[1]; }
#pragma unroll 1
        for (int t = 0; t < nt; t += 2) {
            const bool last = (t == nt - 2);
            const char* a1 = cA1 + (size_t)(t + 1) * kstep;
            const char* a2 = last ? nxA0 : cA0 + (size_t)(t + 2) * kstep; const char* a2h = last ? nxA1 : cA1 + (size_t)(t + 2) * kstep; const char* b2 = last ? nB : cB + (size_t)(t + 2) * kstep;
            const char* a3 = a2 + kstep; const char* b3 = b2 + kstep;
            unsigned w0[2], w1[2];
            w0[0] = last ? nA0[0] : vA0[0]; w0[1] = last ? nA0[1] : vA0[1]; w1[0] = last ? nA1[0] : vA1[0]; w1[1] = last ? nA1[1] : vA1[1];
            PG8_LDB(B0, 0, 0); PG8_LDB(B1, 0, 1); PG8_SCHED; PG8_LDA(At, 0, 0); PG8_STAGE(PG8_SA(1, 1), a1, vA1);
            PG8_WAIT_V(8); PG8_WAIT_L(0); PG8_BAR; PG8_MMA(0, 0, At, B0); PG8_MMA(0, 1, At, B1); PG8_BAR; PG8_SCHED;
            PG8_LDA(At, 0, 1); PG8_STAGE(PG8_SB(0, 0), b2, voffB); PG8_STAGE(PG8_SB(0, 1), b2 + hstep, voffB); PG8_STAGE(PG8_SA(0, 0), a2, w0);
            PG8_WAIT_V(8); PG8_WAIT_L(0); PG8_BAR; PG8_MMA(1, 0, At, B0); PG8_MMA(1, 1, At, B1); PG8_BAR; PG8_SCHED;
            PG8_LDB(B0, 1, 0); PG8_LDB(B1, 1, 1); PG8_SCHED; PG8_LDA(At, 1, 0); PG8_STAGE(PG8_SA(0, 1), a2h, w1);
            PG8_WAIT_V(8); PG8_WAIT_L(0); PG8_BAR; PG8_MMA(0, 0, At, B0); PG8_MMA(0, 1, At, B1); PG8_BAR; PG8_SCHED;
            PG8_LDA(At, 1, 1); PG8_STAGE(PG8_SB(1, 0), b3, voffB); PG8_STAGE(PG8_SB(1, 1), b3 + hstep, voffB); PG8_STAGE(PG8_SA(1, 0), a3, w0);
            PG8_WAIT_V(8); PG8_WAIT_L(0); PG8_BAR; PG8_MMA(1, 0, At, B0); PG8_MMA(1, 1, At, B1); PG8_BAR; PG8_SCHED;
        }
        if (wr == 0) PG8_BAR;
        if constexpr (F8) asm volatile("s_nop 15\n\ts_nop 15" ::: "memory");
        { int ln_e = lane; asm volatile("" : "+v"(ln_e));
          E(acc, cur, wr, wc, ln_e & 15, ln_e >> 4, biasl + (ui & 1) * 256); }
        if (!has_next) break;
#pragma unroll
        for (int a = 0; a < 2; ++a)
#pragma unroll
            for (int b = 0; b < 2; ++b)
#pragma unroll
                for (int m = 0; m < 4; ++m)
#pragma unroll
                    for (int n = 0; n < 2; ++n) acc[a][b][m][n] = (f32x4){0.f, 0.f, 0.f, 0.f};
        cur = nxt; cB = nB; cA0 = nxA0; cA1 = nxA1; ++ui; vA0[0] = nA0[0]; vA0[1] = nA0[1]; vA1[0] = nA1[0]; vA1[1] = nA1[1];
        if (wr == 1) PG8_BAR;
    }
    PG8_WAIT_V(0);
    PG8_BAR;
#undef PG8_AOFF
#undef PG8_BIAS
#undef PG8_SA
#undef PG8_SB
#undef PG8_STAGE
#undef PG8_LDA
#undef PG8_LDB
#undef PG8_MMA
#undef PG8_LO
#undef PG8_HI
#undef PG8_WAIT_V
#undef PG8_WAIT_L
#undef PG8_BAR
#undef PG8_SCHED
}
}

#define XB_TMO      128
#define XB_XCNT(j)  (256  + 64 * (j))
#define XB_XSUB(j)  (1280 + 64 * (j))
#define XB_XGEN(j)  (2304 + 64 * (j))
#define XB_TOP      3328
#define XB_TOPGEN   3392
#define XCD_BAR_WORDS 3456
#define XB_SPIN_CAP (1u << 22)
__device__ __forceinline__ unsigned xb_ld(unsigned* p)              { return __hip_atomic_load(p, __ATOMIC_RELAXED, __HIP_MEMORY_SCOPE_AGENT); }
__device__ __forceinline__ unsigned xb_add(unsigned* p, unsigned v) { return __hip_atomic_fetch_add(p, v, __ATOMIC_RELAXED, __HIP_MEMORY_SCOPE_AGENT); }
__device__ __forceinline__ unsigned xb_xcc_id() { return (unsigned)__builtin_amdgcn_s_getreg((3 << 11) | 20) & 0xFu; }
#define XB_SPIN(cond, bar) do { unsigned _sp = 0; while (cond) { __builtin_amdgcn_s_sleep(1); \
    if ((++_sp & 255u) == 0u) { if (xb_ld(&(bar)[XB_TMO])) break; if (_sp > XB_SPIN_CAP) { atomicAdd(&(bar)[XB_TMO], 1u); break; } } } } while (0)
struct XcdBarrier { unsigned* bar; unsigned x; volatile LAS unsigned* st; };
__device__ __forceinline__ XcdBarrier xcd_barrier_post(unsigned* bar, volatile LAS unsigned* st) {
    XcdBarrier b; b.bar = bar; b.x = xb_xcc_id(); b.st = st;
    if (threadIdx.x == 0) (void)xb_add(&bar[XB_XCNT(b.x)], 1u);
    return b;
}
__device__ __forceinline__ void xcd_barrier_complete(unsigned* bar, unsigned x, unsigned& nloc, unsigned& nx) {
    const unsigned G = gridDim.x * gridDim.y * gridDim.z;
    unsigned sum, cnt, mine, sp = 0u;
    for (;;) {
        sum = 0u; cnt = 0u; mine = 0u;
#pragma unroll
        for (unsigned j = 0; j < 16; ++j) { const unsigned c = xb_ld(&bar[XB_XCNT(j)]); sum += c; cnt += (c > 0u) ? 1u : 0u; mine = (j == x) ? c : mine; }
        if (sum == G) break;
        __builtin_amdgcn_s_sleep(1);
        if ((++sp & 255u) == 0u) { if (xb_ld(&bar[XB_TMO])) break; if (sp > XB_SPIN_CAP) { atomicAdd(&bar[XB_TMO], 1u); break; } }
    }
    nloc = mine > 0u ? mine : 1u; nx = cnt > 0u ? cnt : 1u;
}
struct NoWork { __device__ __forceinline__ void operator()() const {} };
template <class F = NoWork> __device__ __forceinline__ void xcd_barrier(const XcdBarrier& b, F work = F{}) {
    asm volatile("s_waitcnt vmcnt(0)" ::: "memory");
    __syncthreads();
    if (threadIdx.x >= 64) work();
    if (threadIdx.x == 0) {
        unsigned* bar = b.bar;
        __builtin_amdgcn_s_waitcnt(0);
        unsigned nloc = b.st[0], nx = b.st[1];
        if (nloc == 0u) { xcd_barrier_complete(bar, b.x, nloc, nx); b.st[0] = nloc; b.st[1] = nx; }
        const unsigned old = xb_add(&bar[XB_XSUB(b.x)], 1u);
        const unsigned gen = old / nloc;
        if (old + 1u == (gen + 1u) * nloc) {
            __builtin_amdgcn_fence(__ATOMIC_RELEASE, "agent");
            asm volatile("s_waitcnt vmcnt(0)" ::: "memory");
            const unsigned og = xb_add(&bar[XB_TOP], 1u);
            const unsigned tg = og / nx;
            if (og + 1u == (tg + 1u) * nx) xb_add(&bar[XB_TOPGEN], 1u);
            else XB_SPIN(xb_ld(&bar[XB_TOPGEN]) == tg, bar);
            __builtin_amdgcn_fence(__ATOMIC_ACQUIRE, "agent");
            xb_add(&bar[XB_XGEN(b.x)], 1u);
            asm volatile("s_waitcnt vmcnt(0)" ::: "memory");
        } else {
            XB_SPIN(xb_ld(&bar[XB_XGEN(b.x)]) == gen, bar);
            __builtin_amdgcn_fence(__ATOMIC_ACQUIRE, "agent");
            asm volatile("s_waitcnt vmcnt(0)" ::: "memory");
        }
    }
    __syncthreads();
}

struct Args {
    const float *x, *c, *ctx, *c_ctx, *ada_w, *ada_b, *mix_pre, *mix_post, *w_in, *w_out, *conv_w, *conv_b, *dt_bias, *a_log, *ssd_d, *ssd_norm,
                *hg_lb, *hg_norm, *ffn_pre, *ffn_post, *router_w, *router_b, *w1, *b1, *w2, *b2;
    float* out; unsigned char* ws; int ph_lo, ph_hi;
};

typedef const Args __attribute__((address_space(4))) CArgs;
struct Ctx { LAS unsigned char* lds; int tid, lane, wave, vcu, G, gw, NGW; };

__device__ __forceinline__ void transpose_item(const float* W, int ldw, int K, bf16* WT, int dst_row0, int nblk, LAS float* scr, int item, int lane) {
    const int kb = item / nblk, nb = item % nblk, k0 = 64 * kb, n0 = 32 * nb;
    float ld[32];
#pragma unroll
    for (int i = 0; i < 32; ++i) ld[i] = W[(size_t)(k0 + 2 * i + (lane >> 5)) * ldw + n0 + (lane & 31)];
#pragma unroll
    for (int i = 0; i < 32; ++i) scr[(2 * i + (lane >> 5)) * 33 + (lane & 31)] = ld[i];
    LDS_WAIT(); asm volatile("" ::: "memory");
    const int c = lane & 7;
#pragma unroll
    for (int j = 0; j < 4; ++j) { const int n = (lane >> 3) + 8 * j; const LAS float* s = scr + (8 * c) * 33 + n;
        u32x4 o; o.x = cvt_pk_bf16(s[0 * 33], s[1 * 33]); o.y = cvt_pk_bf16(s[2 * 33], s[3 * 33]); o.z = cvt_pk_bf16(s[4 * 33], s[5 * 33]); o.w = cvt_pk_bf16(s[6 * 33], s[7 * 33]);
        *(u32x4*)(WT + (size_t)(dst_row0 + n0 + n) * K + k0 + 8 * c) = o; }
    LDS_WAIT(); asm volatile("" ::: "memory");
}
__device__ __forceinline__ void transpose_item_f8(const float* W, int ldw, int K, unsigned char* WT, int nblk, LAS float* scr, int item, int lane, float scale) {
    const int kb = item / nblk, nb = item % nblk, k0 = 64 * kb, n0 = 32 * nb;
    float ld[32];
#pragma unroll
    for (int i = 0; i < 32; ++i) ld[i] = __builtin_nontemporal_load(&W[(size_t)(k0 + 2 * i + (lane >> 5)) * ldw + n0 + (lane & 31)]);
#pragma unroll
    for (int i = 0; i < 32; ++i) scr[(2 * i + (lane >> 5)) * 33 + (lane & 31)] = ld[i] * scale;
    LDS_WAIT(); asm volatile("" ::: "memory");
    const int c = lane & 7;
#pragma unroll
    for (int j = 0; j < 4; ++j) { const int n = (lane >> 3) + 8 * j; const LAS float* sp = scr + (8 * c) * 33 + n;
        u32x2 o; o.x = pk4_fp8(sp[0 * 33], sp[1 * 33], sp[2 * 33], sp[3 * 33]); o.y = pk4_fp8(sp[4 * 33], sp[5 * 33], sp[6 * 33], sp[7 * 33]);
        *(u32x2*)(WT + (size_t)(n0 + n) * K + k0 + 8 * c) = o; }
    LDS_WAIT(); asm volatile("" ::: "memory");
}
__device__ __forceinline__ void phase0(CArgs& a, const Ctx& C) {
    LAS float* scr = (LAS float*)(C.lds + C.wave * 16384);
    bf16* WINT = (bf16*)(a.ws + WS_WINT); bf16* WOUTT = (bf16*)(a.ws + WS_WOUTT);
    float* MODP = (float*)(a.ws + WS_MODP);
    constexpr int I_GEMV = 96 * 32, I_INA = 16 * 40, I_INB = 16 * 80, I_OUT = 16 * 32;
    constexpr int NITEMS = I_GEMV + I_INA + I_INB + I_OUT;
    for (int it = C.gw; it < NITEMS; it += C.NGW) {
        int r = it;
        if (r < I_GEMV) {
            const int cg = r % 96, ks = r / 96, col = 64 * cg + C.lane, k0 = 32 * ks;
            float sv[5];
            { const int kk = C.lane & 31;
#pragma unroll
              for (int b = 0; b < 4; ++b) sv[b] = siluf(a.c[b * D + k0 + kk]);
              sv[4] = siluf(a.c_ctx[k0 + kk]); }
            float acc[5] = {0.f, 0.f, 0.f, 0.f, 0.f};
#pragma unroll 8
            for (int kk = 0; kk < 32; ++kk) { const float w = a.ada_w[(size_t)(k0 + kk) * 6144 + col];
#pragma unroll
                for (int b = 0; b < 5; ++b) acc[b] += __shfl(sv[b], kk) * w; }
#pragma unroll
            for (int b = 0; b < 5; ++b) MODP[(size_t)(ks * 5 + b) * 6144 + col] = acc[b];
            continue;
        }
        r -= I_GEMV;
        if (r < I_INA) { transpose_item(a.w_in, W_IN_COLS, D, WINT, 0, 40, scr, r, C.lane); continue; } r -= I_INA;
        if (r < I_INB) { transpose_item(a.w_in + 1296, W_IN_COLS, D, WINT, 1280, 80, scr, r, C.lane); continue; } r -= I_INB;
        transpose_item(a.w_out, D, D, WOUTT, 0, 32, scr, r, C.lane);
    }
}
#ifndef CONV_SH
#define CONV_SH 2
#endif
constexpr int NIT1 = 32 * 16 * 64, NIT2 = 32 * 16 * 32, CONV_B = 256 * 7 * CONV_SH;
constexpr int CONV_SH_END = 7 * CONV_B;
constexpr int CONV_W1_HOST = CONV_SH_END < NIT1 ? CONV_SH_END : NIT1;
constexpr int CONV_S9 = CONV_SH_END > NIT1 ? CONV_SH_END : NIT1;
__device__ __forceinline__ void conv_item(CArgs& a, LAS float* scr, int lane, int it) {
    const bool w1 = it < NIT1; const int r = w1 ? it : it - NIT1, per = w1 ? 16 * 64 : 16 * 32, e = r / per, ri = r % per;
    const float* W = w1 ? a.w1 + (size_t)e * D * 2048 : a.w2 + (size_t)e * D * D; unsigned char* WT = w1 ? a.ws + WS_W1T + (size_t)e * 2048 * D : a.ws + WS_W2T + (size_t)e * D * D;
    transpose_item_f8(W, w1 ? 2048 : D, D, WT, w1 ? 64 : 32, scr, ri, lane, W_SCALE);
}
__device__ __forceinline__ void conv_range(CArgs& a, const Ctx& C, int lo, int hi) {
    LAS float* scr = (LAS float*)(C.lds + C.wave * 16384);
#pragma unroll 1
    for (int it = lo + C.gw; it < hi; it += C.NGW) conv_item(a, scr, C.lane, it);
}
__device__ __forceinline__ void conv_shadow(CArgs& a, const Ctx& C, int first, LAS unsigned char* scr_base, int scr_stride) {
    LAS float* scr = (LAS float*)(scr_base + (C.wave - 1) * scr_stride);
    const int it0 = first + (C.vcu * 7 + (C.wave - 1)) * CONV_SH;
#pragma unroll 1
    for (int j = 0; j < CONV_SH; ++j) if (it0 + j < NIT1 + NIT2) conv_item(a, scr, C.lane, it0 + j);
}
__device__ __forceinline__ void phase1(CArgs& a, const Ctx& C) {
    const float* MODP = (const float*)(a.ws + WS_MODP); float* MOD = (float*)(a.ws + WS_MOD);
    for (int i = C.vcu * 512 + C.tid; i < 5 * 6144; i += C.G * 512) {
        const int col = i % 6144, b = i / 6144; float s = a.ada_b[col];
#pragma unroll 8
        for (int ks = 0; ks < 32; ++ks) s += MODP[(size_t)(ks * 5 + b) * 6144 + col];
        MOD[i] = s;
    }
}
template <int N, int O> struct RS { template <int M> static __device__ __forceinline__ void run(float (&v)[M], int lane) {
    const bool up = (lane & O) != 0;
#pragma unroll
    for (int i = 0; i < N / 2; ++i) { const float keep = up ? v[i + N / 2] : v[i], send = up ? v[i] : v[i + N / 2]; v[i] = keep + __shfl_xor(send, O); }
    RS<N / 2, O / 2>::run(v, lane); } };
template <int O> struct RS<1, O> { template <int M> static __device__ __forceinline__ void run(float (&v)[M], int) { v[0] += __shfl_xor(v[0], O); RS<1, O / 2>::run(v, 0); } };
template <> struct RS<1, 0> { template <int M> static __device__ __forceinline__ void run(float (&)[M], int) {} };
template <int N> __device__ __forceinline__ void reduce_scatter(float (&v)[N], int lane) { RS<N, 32>::run(v, lane); }
__device__ __forceinline__ void phase2_fill(CArgs& a, const Ctx& C, int t0, int nt) {
    LAS f32x4* WD = (LAS f32x4*)C.lds;
    for (int idx = t0; idx < 16 * 4 * 64; idx += nt) { const int ln = idx & 63, cg = (idx >> 6) & 3, je = idx >> 8, j = je >> 3, e = je & 7, k = 8 * ln + 512 * j + e;
        WD[idx] = *(const f32x4*)(a.w_in + (size_t)k * W_IN_COLS + 1280 + 4 * cg); }
}
__device__ __forceinline__ void phase2(CArgs& a, const Ctx& C, bool prefilled) {
    const float* MOD = (const float*)(a.ws + WS_MOD); bf16* XN = (bf16*)(a.ws + WS_XN); float* DTRAW = (float*)(a.ws + WS_DTRAW);
    LAS f32x4* WD = (LAS f32x4*)C.lds;
    const int rbase = (MROWS / 256) * C.vcu; constexpr int NPAIR = MROWS / 256 / 2;
    f32x4 nx[2][2][2];
    { const int m = rbase + 2 * C.wave;
#pragma unroll
      for (int r = 0; r < 2; ++r) { const int mr = m + r; const float* xrow = mr < NLAT ? a.x + (size_t)mr * D : a.ctx + (size_t)(mr - NLAT) * D;
#pragma unroll
        for (int j = 0; j < 2; ++j) { nx[r][j][0] = NTLOAD((const f32x4*)(xrow + 8 * C.lane + 512 * j)); nx[r][j][1] = NTLOAD((const f32x4*)(xrow + 8 * C.lane + 512 * j + 4)); } } }
    if (!prefilled) phase2_fill(a, C, C.tid, 512);
    __syncthreads();
#pragma unroll 1
    for (int p = C.wave; p < NPAIR; p += 8) {
        const int m = rbase + 2 * p, b = m < NLAT ? (m >> 12) : 4;
        const float* sh = MOD + b * 6144, *sc = sh + 1024;
        float h[2][2][8]; float ss[2] = {0.f, 0.f};
#pragma unroll
        for (int r = 0; r < 2; ++r)
#pragma unroll
            for (int j = 0; j < 2; ++j) { const f32x4 v0 = nx[r][j][0], v1 = nx[r][j][1];
#pragma unroll
                for (int e = 0; e < 4; ++e) { h[r][j][e] = v0[e]; h[r][j][4 + e] = v1[e]; ss[r] += v0[e] * v0[e] + v1[e] * v1[e]; } }
        { const int m2 = p + 8 < NPAIR ? m + 16 : m;
#pragma unroll
          for (int r = 0; r < 2; ++r) { const int mr = m2 + r; const float* xrow = mr < NLAT ? a.x + (size_t)mr * D : a.ctx + (size_t)(mr - NLAT) * D;
#pragma unroll
            for (int j = 0; j < 2; ++j) { nx[r][j][0] = NTLOAD((const f32x4*)(xrow + 8 * C.lane + 512 * j)); nx[r][j][1] = NTLOAD((const f32x4*)(xrow + 8 * C.lane + 512 * j + 4)); } } }
        const float rstd[2] = {rsqrtf(wave_sum(ss[0]) * (1.0f / D) + EPS), rsqrtf(wave_sum(ss[1]) * (1.0f / D) + EPS)};
#pragma unroll
        for (int j = 0; j < 2; ++j) { const int k0 = 8 * C.lane + 512 * j;
#pragma unroll
            for (int e4 = 0; e4 < 2; ++e4) { const f32x4 w = *(const f32x4*)(a.mix_pre + k0 + 4 * e4), s1 = *(const f32x4*)(sc + k0 + 4 * e4), s0 = *(const f32x4*)(sh + k0 + 4 * e4);
#pragma unroll
                for (int r = 0; r < 2; ++r)
#pragma unroll
                    for (int e = 0; e < 4; ++e) h[r][j][4 * e4 + e] = h[r][j][4 * e4 + e] * rstd[r] * w[e] * (1.0f + s1[e]) + s0[e]; }
#pragma unroll
            for (int r = 0; r < 2; ++r) { u32x4 o; o.x = cvt_pk_bf16(h[r][j][0], h[r][j][1]); o.y = cvt_pk_bf16(h[r][j][2], h[r][j][3]); o.z = cvt_pk_bf16(h[r][j][4], h[r][j][5]); o.w = cvt_pk_bf16(h[r][j][6], h[r][j][7]);
                *(u32x4*)(XN + (size_t)(m + r) * D + k0) = o; } }
        float acc0[16], acc1[16];
#pragma unroll
        for (int i = 0; i < 16; ++i) { acc0[i] = 0.f; acc1[i] = 0.f; }
#pragma unroll
        for (int j = 0; j < 2; ++j)
#pragma unroll
            for (int e = 0; e < 8; ++e)
#pragma unroll
                for (int cg = 0; cg < 4; ++cg) { const f32x4 w = WD[((j * 8 + e) * 4 + cg) * 64 + C.lane];
#pragma unroll
                    for (int i = 0; i < 4; ++i) { acc0[4 * cg + i] += h[0][j][e] * w[i]; acc1[4 * cg + i] += h[1][j][e] * w[i]; }
                    if (cg == 3 && (e & 1)) asm volatile("" ::: "memory"); }
        reduce_scatter<16>(acc0, C.lane); reduce_scatter<16>(acc1, C.lane);
        if ((C.lane & 3) == 0) { DTRAW[(size_t)m * 16 + (C.lane >> 2)] = acc0[0]; DTRAW[(size_t)(m + 1) * 16 + (C.lane >> 2)] = acc1[0]; }
    }
}
__device__ __forceinline__ void prep_ssd_unit(CArgs& a, const Ctx& C, int unit) {
    const bf16* U = (const bf16*)(a.ws + WS_U); const float* DTRAW = (const float*)(a.ws + WS_DTRAW);
    bf16* BC = (bf16*)(a.ws + WS_BC); bf16* XST = (bf16*)(a.ws + WS_XST);
    float* GA = (float*)(a.ws + WS_GA); float* DTA = (float*)(a.ws + WS_DTA); float* GEND = (float*)(a.ws + WS_GEND); u32x2* DSS = (u32x2*)(a.ws + WS_DSS);
    const int b = unit / NCH, tc = unit % NCH, s0 = 64 * tc; const bool isctx = tc < 4;
    const int rowbase = isctx ? NLAT + b * CTXL + s0 : b * SEQ + (s0 - CTXL);
    const int ilo = isctx ? -s0 : CTXL - s0, ihi = isctx ? CTXL - s0 : SP - s0;
    LAS float* dtl = (LAS float*)C.lds; LAS float* al = dtl + 1024; LAS float* wl = al + 1024;
    LAS bf16* XTl = (LAS bf16*)(C.lds + 12288);
    int ltid = C.tid; asm volatile("" : "+v"(ltid));
    const int ch0 = 2 * ltid;
    unsigned uw[68];
    if (C.tid < 384) { const bf16* up = U + (size_t)rowbase * NU + 512 + ch0;
#pragma unroll
        for (int t = 0; t < 68; ++t) { const int i = t - 2; uw[t] = (i >= ilo && i < ihi) ? *(const unsigned*)(up + (ptrdiff_t)i * NU) : 0u; } }
#pragma unroll
    for (int pi = 0; pi < 2; ++pi) { const int dh = 2 * C.wave + pi, dir = dh >> 3, h = dh & 7, i = C.lane;
        const float xv = DTRAW[(size_t)(rowbase + i) * 16 + dh] + a.dt_bias[dh];
        const float dt = fmaxf(xv, 0.f) + log1pf(__expf(-fabsf(xv)));
        const float av = -dt * __expf(a.a_log[dh]);
        float pre = av;
#pragma unroll
        for (int o = 1; o < 64; o <<= 1) { const float t = __shfl_up(pre, o); pre += (i >= o) ? t : 0.f; }
        const float tot = __shfl(pre, 63);
        const float g = dir == 0 ? pre : tot - pre + av;
        const float gend = tot;
        al[dh * 64 + i] = g; dtl[dh * 64 + i] = dt; wl[dh * 64 + i] = dt * __expf(gend - g);
        const size_t o = (size_t)((b * 2 + dir) * 8 + h) * SP + s0 + i; GA[o] = g; DTA[o] = dt;
        if (i == 0) GEND[((b * 2 + dir) * 8 + h) * NCH + tc] = gend; }
    LDS_BARRIER();
    if (C.tid < 384) {
        f32x2 wk[5];
#pragma unroll
        for (int k = 0; k < 5; ++k) wk[k] = *(const f32x2*)(a.conv_w + k * 768 + ch0);
        const f32x2 cb = *(const f32x2*)(a.conv_b + ch0);
        const int cls = ch0 < 512 ? 0 : (ch0 < 640 ? 1 : 2);
#pragma unroll
        for (int i8 = 0; i8 < 8; ++i8) {
            unsigned t0[4], t1[4]; float pv0 = 0.f, pv1 = 0.f;
#pragma unroll
            for (int ii = 0; ii < 8; ++ii) {
                const int i = 8 * i8 + ii;
                float y0 = cb.x, y1 = cb.y;
#pragma unroll
                for (int k = 0; k < 5; ++k) { y0 += wk[k].x * bflo(uw[i + k]); y1 += wk[k].y * bfhi(uw[i + k]); }
                y0 = siluf(y0); y1 = siluf(y1);
                if (cls != 0) *(unsigned*)(BC + (size_t)(rowbase + i) * 256 + (ch0 - 512)) = cvt_pk_bf16(y0, y1);
                if (ii & 1) { t0[ii >> 1] = cvt_pk_bf16(pv0, y0); t1[ii >> 1] = cvt_pk_bf16(pv1, y1); } else { pv0 = y0; pv1 = y1; }
            }
            if (cls != 2) {
                const u32x4 v0 = (u32x4){t0[0], t0[1], t0[2], t0[3]}, v1 = (u32x4){t1[0], t1[1], t1[2], t1[3]};
                *(LAS u32x4*)(XTl + ch0 * 72 + 8 * i8) = v0; *(LAS u32x4*)(XTl + (ch0 + 1) * 72 + 8 * i8) = v1;
                if (cls == 0) { const size_t r0 = (size_t)(b * 512 + ch0) * SP + s0 + 8 * i8; *(u32x4*)(XST + r0) = v0; *(u32x4*)(XST + r0 + SP) = v1; }
            }
        }
    }
    LDS_BARRIER();
    {
        const int fr = C.lane & 15, q = C.lane >> 4;
#pragma unroll 1
        for (int pi = 0; pi < 2; ++pi) { const int pid = 2 * C.wave + pi, dir = pid >> 3, h = pid & 7, g = h >> 2;
            bf16x8 Bf[4][2]; f32x4 wv[2][2];
#pragma unroll
            for (int ks = 0; ks < 2; ++ks) { wv[ks][0] = *(const LAS f32x4*)(wl + pid * 64 + 32 * ks + 8 * q); wv[ks][1] = *(const LAS f32x4*)(wl + pid * 64 + 32 * ks + 8 * q + 4); }
#pragma unroll
            for (int t = 0; t < 4; ++t)
#pragma unroll
                for (int ks = 0; ks < 2; ++ks) Bf[t][ks] = *(const LAS bf16x8*)(XTl + (h * 64 + 16 * t + fr) * 72 + 32 * ks + 8 * q);
            const size_t ob = ((size_t)((b * 2 + dir) * 8 + h) * NCH + tc) * 1024;
#pragma unroll
            for (int at = 0; at < 4; ++at) { bf16x8 Af[2];
#pragma unroll
                for (int ks = 0; ks < 2; ++ks) { const u32x4 raw = *(const LAS u32x4*)(XTl + (512 + g * 64 + 16 * at + fr) * 72 + 32 * ks + 8 * q); const unsigned rw[4] = {raw.x, raw.y, raw.z, raw.w}; u32x4 o;
                    o.x = cvt_pk_bf16(bflo(rw[0]) * wv[ks][0][0], bfhi(rw[0]) * wv[ks][0][1]); o.y = cvt_pk_bf16(bflo(rw[1]) * wv[ks][0][2], bfhi(rw[1]) * wv[ks][0][3]);
                    o.z = cvt_pk_bf16(bflo(rw[2]) * wv[ks][1][0], bfhi(rw[2]) * wv[ks][1][1]); o.w = cvt_pk_bf16(bflo(rw[3]) * wv[ks][1][2], bfhi(rw[3]) * wv[ks][1][3]);
                    Af[ks] = __builtin_bit_cast(bf16x8, o); }
#pragma unroll
                for (int pt = 0; pt < 4; ++pt) { f32x4 acc = (f32x4){0.f, 0.f, 0.f, 0.f};
                    acc = MFMA16(Af[0], Bf[pt][0], acc); acc = MFMA16(Af[1], Bf[pt][1], acc);
                    DSS[ob + (at * 4 + pt) * 64 + C.lane] = (u32x2){cvt_pk_bf16(acc[0], acc[1]), cvt_pk_bf16(acc[2], acc[3])}; } } }
    }
    LDS_BARRIER();
}
__device__ __forceinline__ void prep_hg_pair(CArgs& a, const Ctx& C, int unit) {
    const bf16* U = (const bf16*)(a.ws + WS_U);
    bf16* QS = (bf16*)(a.ws + WS_QS); bf16* KS = (bf16*)(a.ws + WS_KS); bf16* VT = (bf16*)(a.ws + WS_VT); float* EG = (float*)(a.ws + WS_EG); u32x2* DSP = (u32x2*)(a.ws + WS_DSP); float* EGP = (float*)(a.ws + WS_EGP);
    const int b = unit / (NPR * 4), pr = (unit >> 2) % NPR, h = unit & 3;
    LAS float* ETl = (LAS float*)(C.lds + 63488);
    LAS u32x2* DL = (LAS u32x2*)(C.lds + 65536);
#pragma unroll 1
    for (int sub = 0; sub < 2; ++sub) {
    const int c = 2 * pr + sub, s0 = 64 * c; const bool isctx = c < 4;
    int ltid = C.tid; asm volatile("" : "+v"(ltid));
    const int cp = ltid & 63, tg = ltid >> 6, ch0 = 2 * cp, hc = h * 128 + ch0;
    const int rbase = isctx ? NLAT + b * CTXL + s0 : b * SEQ + (c - 4), rstride = isctx ? 1 : 64;
    const bf16* up = U + (size_t)rbase * NU + 1280 + hc;
    unsigned rq[8], rf[8], rb[8], ri[8];
#pragma unroll
    for (int t = 0; t < 8; ++t) { const bf16* r = up + (size_t)(8 * tg + t) * rstride * NU;
        rq[t] = *(const unsigned*)r; rf[t] = *(const unsigned*)(r + 512); rb[t] = *(const unsigned*)(r + 1024); ri[t] = *(const unsigned*)(r + 1536); }
    LAS float* part = (LAS float*)C.lds;
    LAS bf16* KHl = (LAS bf16*)(C.lds + 8192);
    LAS bf16* VTl = KHl + 2 * 128 * 72;
    f32x2 lbv[2];
#pragma unroll
    for (int d = 0; d < 2; ++d) { lbv[d].x = __builtin_amdgcn_rcpf(1.0f + __expf(a.hg_lb[1024 + d * 512 + hc] - a.hg_lb[d * 512 + hc])); lbv[d].y = __builtin_amdgcn_rcpf(1.0f + __expf(a.hg_lb[1024 + d * 512 + hc + 1] - a.hg_lb[d * 512 + hc + 1])); }
    float la[2][2][8], om[2][2][8];
    float sum[2][2] = {{0.f, 0.f}, {0.f, 0.f}};
#pragma unroll
    for (int t = 0; t < 8; ++t)
#pragma unroll
        for (int d = 0; d < 2; ++d)
#pragma unroll
            for (int e = 0; e < 2; ++e) { const unsigned w = d == 0 ? rf[t] : rb[t]; const float fr_ = e == 0 ? bflo(w) : bfhi(w); const float lb = e == 0 ? lbv[d].x : lbv[d].y;
                const float ex = __builtin_amdgcn_exp2f(fr_ * -1.4426950408889634f); const float t1 = (1.0f - lb) * __builtin_amdgcn_rcpf(1.0f + ex);
                om[d][e][t] = t1 * ex;
                la[d][e][t] = __builtin_amdgcn_logf(lb + t1); sum[d][e] += la[d][e][t]; }
#pragma unroll
    for (int d = 0; d < 2; ++d)
#pragma unroll
        for (int e = 0; e < 2; ++e) part[(tg * 4 + d * 2 + e) * 64 + cp] = sum[d][e];
    LDS_BARRIER();
    float T[2][2], pre[2][2];
#pragma unroll
    for (int d = 0; d < 2; ++d)
#pragma unroll
        for (int e = 0; e < 2; ++e) { float tt = 0.f, pp = 0.f;
#pragma unroll
            for (int g2 = 0; g2 < 8; ++g2) { const float v = part[(g2 * 4 + d * 2 + e) * 64 + cp]; pp += (g2 < tg) ? v : 0.f; tt += v; }
            T[d][e] = tt; pre[d][e] = pp; }
    const size_t DST = (size_t)NB * 4 * SP * 128;
    unsigned khp[2][2][4], vp[2][4];
    float eT[2][2];
#pragma unroll
    for (int d = 0; d < 2; ++d)
#pragma unroll
        for (int e = 0; e < 2; ++e) eT[d][e] = __builtin_amdgcn_exp2f(T[d][e]);
    {
        float runf[2] = {pre[0][0], pre[0][1]}, runb[2] = {pre[1][0], pre[1][1]}, pkf[2] = {0.f, 0.f}, pkb[2] = {0.f, 0.f}, pkv[2] = {0.f, 0.f};
#pragma unroll
        for (int t = 0; t < 8; ++t) { const size_t rm = ((size_t)(b * 4 + h) * SP + s0 + 8 * tg + t) * 128 + ch0;
            const float qv[2] = {siluf(bflo(rq[t])) * 0.08838834764831845f, siluf(bfhi(rq[t])) * 0.08838834764831845f};
            float ktf[2], ktb[2], qtf[2], qtb[2];
#pragma unroll
            for (int e = 0; e < 2; ++e) {
                runf[e] += la[0][e][t]; const float Ef = __builtin_amdgcn_exp2f(-runf[e]);
                const float gb = T[1][e] - runb[e]; runb[e] += la[1][e][t]; const float Eb = __builtin_amdgcn_exp2f(-gb);
                ktf[e] = om[0][e][t] * Ef; ktb[e] = om[1][e][t] * Eb; qtf[e] = qv[e] * __builtin_amdgcn_rcpf(Ef); qtb[e] = qv[e] * __builtin_amdgcn_rcpf(Eb);
                const float khf = ktf[e] * eT[0][e], khb = ktb[e] * eT[1][e], iv = e == 0 ? bflo(ri[t]) : bfhi(ri[t]);
                if (t & 1) { khp[0][e][t >> 1] = cvt_pk_bf16(pkf[e], khf); khp[1][e][t >> 1] = cvt_pk_bf16(pkb[e], khb); vp[e][t >> 1] = cvt_pk_bf16(pkv[e], iv); } else { pkf[e] = khf; pkb[e] = khb; pkv[e] = iv; } }
            *(unsigned*)(QS + rm) = cvt_pk_bf16(qtf[0], qtf[1]); *(unsigned*)(QS + DST + rm) = cvt_pk_bf16(qtb[0], qtb[1]);
            *(unsigned*)(KS + rm) = cvt_pk_bf16(ktf[0], ktf[1]); *(unsigned*)(KS + DST + rm) = cvt_pk_bf16(ktb[0], ktb[1]); }
    }
#pragma unroll
    for (int e = 0; e < 2; ++e) {
        *(LAS u32x4*)(KHl + (0 * 128 + ch0 + e) * 72 + 8 * tg) = (u32x4){khp[0][e][0], khp[0][e][1], khp[0][e][2], khp[0][e][3]};
        *(LAS u32x4*)(KHl + (1 * 128 + ch0 + e) * 72 + 8 * tg) = (u32x4){khp[1][e][0], khp[1][e][1], khp[1][e][2], khp[1][e][3]};
        *(LAS u32x4*)(VTl + (ch0 + e) * 72 + 8 * tg) = (u32x4){vp[e][0], vp[e][1], vp[e][2], vp[e][3]};
        *(u32x4*)(VT + (size_t)((b * 4 + h) * 128 + ch0 + e) * SP + s0 + 8 * tg) = (u32x4){vp[e][0], vp[e][1], vp[e][2], vp[e][3]}; }
    if (tg == 0) {
#pragma unroll
        for (int d = 0; d < 2; ++d) { const f32x2 et = (f32x2){eT[d][0], eT[d][1]};
            *(f32x2*)(EG + ((size_t)((d * 4 + b) * 4 + h) * NCH + c) * 128 + ch0) = et; *(LAS f32x2*)(ETl + (sub * 2 + d) * 128 + ch0) = et;
            if (sub) { const f32x2 e0 = *(const LAS f32x2*)(ETl + d * 128 + ch0); *(f32x2*)(EGP + ((size_t)((d * 4 + b) * 4 + h) * NPR + pr) * 128 + ch0) = (f32x2){e0.x * et.x, e0.y * et.y}; } } }
    LDS_BARRIER();
    {
        const int fr = C.lane & 15, q = C.lane >> 4;
        LAS u32x2* dlb = DL + C.tid; asm volatile("" : "+v"(dlb));
        bf16x8 Bf[2];
#pragma unroll
        for (int ks = 0; ks < 2; ++ks) Bf[ks] = *(const LAS bf16x8*)(VTl + (16 * C.wave + fr) * 72 + 32 * ks + 8 * q);
#pragma unroll
        for (int d = 0; d < 2; ++d) { const int seq = (d * NB + b) * 4 + h;
#pragma unroll
            for (int at = 0; at < 8; ++at) { f32x4 t4 = (f32x4){0.f, 0.f, 0.f, 0.f};
#pragma unroll
                for (int ks = 0; ks < 2; ++ks) { const bf16x8 Af = *(const LAS bf16x8*)(KHl + (d * 128 + 16 * at + fr) * 72 + 32 * ks + 8 * q); t4 = MFMA16(Af, Bf[ks], t4); }
                LAS u32x2* dl = dlb + (d * 8 + at) * 512;
                if (sub == 0) *dl = (u32x2){cvt_pk_bf16(t4[0], t4[1]), cvt_pk_bf16(t4[2], t4[3])};
                else { const u32x2 pw = *dl; const f32x4 pv = (f32x4){bflo(pw.x), bfhi(pw.x), bflo(pw.y), bfhi(pw.y)};
                    const f32x4 r4 = d == 0 ? pv * *(const LAS f32x4*)(ETl + (1 * 2 + 0) * 128 + 16 * at + 4 * q) + t4
                                            : pv + t4 * *(const LAS f32x4*)(ETl + (0 * 2 + 1) * 128 + 16 * at + 4 * q);
                    DSP[((size_t)seq * NPR + pr) * 4096 + (at * 8 + C.wave) * 64 + C.lane] = (u32x2){cvt_pk_bf16(r4[0], r4[1]), cvt_pk_bf16(r4[2], r4[3])}; }
                if (at & 1) asm volatile("" ::: "memory"); } }
    }
    LDS_BARRIER();
    }
}
__device__ __forceinline__ void phase4(CArgs& a, const Ctx& C) {
    constexpr int NHU = NB * NPR * 4;
#pragma unroll 1
    for (int k_ = 0; k_ < 4; ++k_) { int u; const int v = C.vcu;
        int k = k_; if (v >= 80 && v < 208 && (v & 1) && k_ < 3) k = (k_ + 2) % 3;
        if (k == 0) u = v;
        else if (k == 1) u = v < 208 ? 256 + v : NHU + (v - 208);
        else if (k == 2) u = v < 80 ? 464 + v : (v < 208 ? NHU + 48 + (v - 80) : NHU + 176 + (v - 208));
        else { if (v < 208) break; u = NHU + 224 + (v - 208); }
        if (u < NHU) prep_hg_pair(a, C, u); else prep_ssd_unit(a, C, u - NHU); }
}
__device__ __forceinline__ void phase5(CArgs& a, const Ctx& C) { (void)a; (void)C; }
__device__ __forceinline__ int scan_chunk(int dir, int k) { return dir == 0 ? k : (k < 4 ? 3 - k : 71 - k); }
__device__ __forceinline__ void phase6(CArgs& a, const Ctx& C) {
    const u32x2* DSS = (const u32x2*)(a.ws + WS_DSS); const u32x2* DSP = (const u32x2*)(a.ws + WS_DSP);
    u32x2* SPS = (u32x2*)(a.ws + WS_SPS); u32x2* SPH = (u32x2*)(a.ws + WS_SPH);
    const float* GEND = (const float*)(a.ws + WS_GEND); const float* EGP = (const float*)(a.ws + WS_EGP);
    if (C.vcu < 128) {
        const int task = C.vcu * 512 + C.tid, seq = task >> 10, grp = task & 1023, dir = (seq >> 3) & 1;
        f32x4 S = (f32x4){0.f, 0.f, 0.f, 0.f};
#pragma unroll 1
        for (int kb = 0; kb < NCH; kb += 17) { u32x2 dw[17]; float gd[17];
#pragma unroll
            for (int j = 0; j < 17; ++j) { const int tc = scan_chunk(dir, kb + j); dw[j] = NTLOAD(&DSS[((size_t)seq * NCH + tc) * 1024 + grp]); gd[j] = GEND[seq * NCH + tc]; }
            asm volatile("" ::: "memory");
#pragma unroll
            for (int j = 0; j < 17; ++j) { const int tc = scan_chunk(dir, kb + j);
                if (tc >= 4) SPS[((size_t)seq * NCH + tc) * 1024 + grp] = (u32x2){cvt_pk_bf16(S[0], S[1]), cvt_pk_bf16(S[2], S[3])};
                S = S * __expf(gd[j]) + (f32x4){bflo(dw[j].x), bfhi(dw[j].x), bflo(dw[j].y), bfhi(dw[j].y)}; }
            asm volatile("" ::: "memory"); }
    } else {
#pragma unroll 1
        for (int rep = 0; rep < 2; ++rep) {
            const int t = (C.vcu - 128) * 1024 + rep * 512 + C.tid, seq = t >> 12, grp = t & 4095, d = seq >> 4, tile = grp >> 6, ln = grp & 63, cb = 16 * (tile >> 3) + 4 * (ln >> 4);
            f32x4 S = (f32x4){0.f, 0.f, 0.f, 0.f};
#pragma unroll 1
            for (int kb = 0; kb < NPR; kb += 17) { u32x2 dw[17]; f32x4 dec[17];
#pragma unroll
                for (int j = 0; j < 17; ++j) { const int k = kb + j, tp = d == 0 ? k : (k < 2 ? 1 - k : 35 - k); dw[j] = NTLOAD(&DSP[((size_t)seq * NPR + tp) * 4096 + grp]); dec[j] = *(const f32x4*)(EGP + ((size_t)seq * NPR + tp) * 128 + cb); }
                asm volatile("" ::: "memory");
#pragma unroll
                for (int j = 0; j < 17; ++j) { const int k = kb + j, tp = d == 0 ? k : (k < 2 ? 1 - k : 35 - k);
                    if (tp >= 2) SPH[((size_t)seq * NPR + tp) * 4096 + grp] = (u32x2){cvt_pk_bf16(S[0], S[1]), cvt_pk_bf16(S[2], S[3])};
                    S = S * dec[j] + (f32x4){bflo(dw[j].x), bfhi(dw[j].x), bflo(dw[j].y), bfhi(dw[j].y)}; }
                asm volatile("" ::: "memory"); } }
    }
}
typedef short s16x4 __attribute__((ext_vector_type(4)));
typedef short s16x8 __attribute__((ext_vector_type(8)));
__device__ __forceinline__ s16x4 lds_tr(const LAS bf16* p) { return __builtin_amdgcn_ds_read_tr16_b64_v4i16((LAS s16x4*)p); }
__device__ __forceinline__ bf16x8 ld_split8(const bf16* p0, const bf16* p1) {
    const u32x2 lo = *(const u32x2*)p0, hi = *(const u32x2*)p1; u32x4 w = (u32x4){lo.x, lo.y, hi.x, hi.y}; return __builtin_bit_cast(bf16x8, w);
}
__device__ __forceinline__ void passc_ssd_unit(CArgs& a, const Ctx& C, int unit) {
    const bf16* BC = (const bf16*)(a.ws + WS_BC); const bf16* XST = (const bf16*)(a.ws + WS_XST); const bf16* U = (const bf16*)(a.ws + WS_U);
    const float* GA = (const float*)(a.ws + WS_GA); const float* DTA = (const float*)(a.ws + WS_DTA); const bf16* SPS = (const bf16*)(a.ws + WS_SPS);
    bf16* Y = (bf16*)(a.ws + WS_Y);
    const int b = unit >> 6, tcl = unit & 63, tc = tcl + 4, s0 = 64 * tc, row0 = b * SEQ + 64 * tcl;
    const int h = C.wave, g = h >> 2, fr = C.lane & 15, q = C.lane >> 4;
    LAS unsigned char* wl = C.lds + C.wave * 17408;
    LAS bf16* Ml = (LAS bf16*)wl; LAS float* Yl = (LAS float*)wl; LAS float* red = (LAS float*)(C.lds + 8 * 17408);
    {
        bf16x8 Ca[4][2], Bb[4][2];
#pragma unroll
        for (int t = 0; t < 4; ++t)
#pragma unroll
            for (int ks = 0; ks < 2; ++ks) { const bf16* rp = BC + (size_t)(row0 + 16 * t + fr) * 256 + g * 64 + 32 * ks + 8 * q;
                Bb[t][ks] = *(const bf16x8*)rp; Ca[t][ks] = *(const bf16x8*)(rp + 128); }
        const size_t sf = (size_t)((b * 2 + 0) * 8 + h) * SP + s0, sb = (size_t)((b * 2 + 1) * 8 + h) * SP + s0;
        float gjf[4], gjb[4], dtf[4], dtb[4];
#pragma unroll
        for (int jt = 0; jt < 4; ++jt) { gjf[jt] = GA[sf + 16 * jt + fr]; gjb[jt] = GA[sb + 16 * jt + fr]; dtf[jt] = DTA[sf + 16 * jt + fr]; dtb[jt] = DTA[sb + 16 * jt + fr]; }
        const float Dh = a.ssd_d[h];
#pragma unroll
        for (int it = 0; it < 4; ++it) {
            const f32x4 gif = *(const f32x4*)(GA + sf + 16 * it + 4 * q), gib = *(const f32x4*)(GA + sb + 16 * it + 4 * q);
#pragma unroll
            for (int jt = 0; jt < 4; ++jt) { f32x4 G = (f32x4){0.f, 0.f, 0.f, 0.f};
                G = MFMA16(Ca[it][0], Bb[jt][0], G); G = MFMA16(Ca[it][1], Bb[jt][1], G);
                const int j = 16 * jt + fr;
#pragma unroll
                for (int r = 0; r < 4; ++r) { const int i = 16 * it + 4 * q + r;
                    const float lf = (j <= i) ? dtf[jt] * __expf(fminf(gif[r] - gjf[jt], 0.f)) : 0.f;
                    const float lb = (j >= i) ? dtb[jt] * __expf(fminf(gib[r] - gjb[jt], 0.f)) : 0.f;
                    const float m = G[r] * (lf + lb) + ((i == j) ? Dh : 0.f);
                    Ml[i * 72 + j] = (bf16)(cvt_pk_bf16(m, 0.f) & 0xffff); } } }
    }
    LDS_WAIT(); asm volatile("" ::: "memory");
    bf16x8 Ma[4][2], Cp[4][2];
#pragma unroll
    for (int it = 0; it < 4; ++it)
#pragma unroll
        for (int ks = 0; ks < 2; ++ks) { Ma[it][ks] = *(const LAS bf16x8*)(Ml + (16 * it + fr) * 72 + 32 * ks + 8 * q);
            const bf16* cp = BC + (size_t)(row0 + 16 * it + fr) * 256 + 128 + g * 64 + 32 * ks + 4 * q; Cp[it][ks] = ld_split8(cp, cp + 16); }
    LDS_WAIT(); asm volatile("" ::: "memory");
    f32x4 eg[2][4];
#pragma unroll
    for (int d = 0; d < 2; ++d)
#pragma unroll
        for (int it = 0; it < 4; ++it) { const f32x4 gi = *(const f32x4*)(GA + (size_t)((b * 2 + d) * 8 + h) * SP + s0 + 16 * it + 4 * q);
            eg[d][it] = (f32x4){__expf(gi[0]), __expf(gi[1]), __expf(gi[2]), __expf(gi[3])}; }
#pragma unroll 1
    for (int pt = 0; pt < 4; ++pt) {
        bf16x8 Bx[2];
#pragma unroll
        for (int ks = 0; ks < 2; ++ks) Bx[ks] = *(const bf16x8*)(XST + (size_t)((b * 8 + h) * 64 + 16 * pt + fr) * SP + s0 + 32 * ks + 8 * q);
        f32x4 Yv[4];
#pragma unroll
        for (int it = 0; it < 4; ++it) { Yv[it] = (f32x4){0.f, 0.f, 0.f, 0.f}; Yv[it] = MFMA16(Ma[it][0], Bx[0], Yv[it]); Yv[it] = MFMA16(Ma[it][1], Bx[1], Yv[it]); }
#pragma unroll
        for (int d = 0; d < 2; ++d) { const size_t sbase = ((size_t)((b * 2 + d) * 8 + h) * NCH + tc) * 1024;
            bf16x8 Sb[2];
#pragma unroll
            for (int ks = 0; ks < 2; ++ks) Sb[ks] = ld_split8(SPS + (sbase + ((2 * ks) * 4 + pt) * 64 + C.lane) * 4, SPS + (sbase + ((2 * ks + 1) * 4 + pt) * 64 + C.lane) * 4);
#pragma unroll
            for (int it = 0; it < 4; ++it) { f32x4 T = (f32x4){0.f, 0.f, 0.f, 0.f}; T = MFMA16(Cp[it][0], Sb[0], T); T = MFMA16(Cp[it][1], Sb[1], T); Yv[it] += eg[d][it] * T; } }
#pragma unroll
        for (int it = 0; it < 4; ++it)
#pragma unroll
            for (int r = 0; r < 4; ++r) Yl[(16 * it + 4 * q + r) * 68 + 16 * pt + fr] = Yv[it][r];
    }
    LDS_WAIT(); asm volatile("" ::: "memory");
    const int i = C.lane; float v[64]; float ss = 0.f;
    const bf16* zp = U + (size_t)(row0 + i) * NU + h * 64;
#pragma unroll
    for (int c8 = 0; c8 < 8; ++c8) { const u32x4 zw = *(const u32x4*)(zp + 8 * c8); const f32x4 y0 = *(const LAS f32x4*)(Yl + i * 68 + 8 * c8), y1 = *(const LAS f32x4*)(Yl + i * 68 + 8 * c8 + 4);
        const unsigned zz[4] = {zw.x, zw.y, zw.z, zw.w};
#pragma unroll
        for (int e = 0; e < 4; ++e) { const float ya = e < 2 ? y0[2 * e] : y1[2 * e - 4], yb = e < 2 ? y0[2 * e + 1] : y1[2 * e - 3];
            const float va = ya * siluf(bflo(zz[e])), vb = yb * siluf(bfhi(zz[e])); v[8 * c8 + 2 * e] = va; v[8 * c8 + 2 * e + 1] = vb; ss += va * va + vb * vb; } }
    red[C.wave * 64 + i] = ss;
    LDS_BARRIER();
    float tot = 0.f;
#pragma unroll
    for (int w = 0; w < 8; ++w) tot += red[w * 64 + i];
    const float rstd = rsqrtf(tot * (1.0f / 512.0f) + EPS);
    bf16* yo = Y + (size_t)(row0 + i) * D + h * 64;
#pragma unroll
    for (int c8 = 0; c8 < 8; ++c8) { const f32x4 n0 = *(const f32x4*)(a.ssd_norm + h * 64 + 8 * c8), n1 = *(const f32x4*)(a.ssd_norm + h * 64 + 8 * c8 + 4);
        u32x4 o; o.x = cvt_pk_bf16(v[8 * c8] * rstd * n0[0], v[8 * c8 + 1] * rstd * n0[1]); o.y = cvt_pk_bf16(v[8 * c8 + 2] * rstd * n0[2], v[8 * c8 + 3] * rstd * n0[3]);
        o.z = cvt_pk_bf16(v[8 * c8 + 4] * rstd * n1[0], v[8 * c8 + 5] * rstd * n1[1]); o.w = cvt_pk_bf16(v[8 * c8 + 6] * rstd * n1[2], v[8 * c8 + 7] * rstd * n1[3]);
        *(u32x4*)(yo + 8 * c8) = o; }
    LDS_BARRIER();
}
__device__ __forceinline__ void passc_hg_pair(CArgs& a, const Ctx& C, int unit) {
    const bf16* QS = (const bf16*)(a.ws + WS_QS); const bf16* KS = (const bf16*)(a.ws + WS_KS); const bf16* VT = (const bf16*)(a.ws + WS_VT); const bf16* SPH = (const bf16*)(a.ws + WS_SPH);
    const bf16* U = (const bf16*)(a.ws + WS_U); bf16* Y = (bf16*)(a.ws + WS_Y); const float* EG = (const float*)(a.ws + WS_EG);
    const int b = unit >> 7, pr = 2 + ((unit >> 2) & 31), h = unit & 3;
    const int wv = C.wave, fr = C.lane & 15, q = C.lane >> 4;
    LAS bf16* Pl = (LAS bf16*)C.lds; LAS float* Ol = (LAS float*)(C.lds + 9216); LAS float* red = (LAS float*)(C.lds + 9216 + 64 * 132 * 4);
    LAS bf16* KL = (LAS bf16*)(C.lds + 79872);
    LAS bf16* QL = (LAS bf16*)(C.lds + 45056);
    const size_t DST = (size_t)NB * 4 * SP * 128;
#pragma unroll 1
    for (int sub = 0; sub < 2; ++sub) {
    const int tc = 2 * pr + sub, w = tc - 4, s0 = 64 * tc, oc = 2 * pr + 1 - sub;
    const int it0 = wv >> 1;
    bf16x8 Aq[2][4], Bk[2][2][4];
#pragma unroll
    for (int d = 0; d < 2; ++d) { const size_t base = d * DST + ((size_t)(b * 4 + h) * SP + s0) * 128;
#pragma unroll
        for (int ks = 0; ks < 4; ++ks) { Aq[d][ks] = *(const bf16x8*)(QS + base + (size_t)(16 * it0 + fr) * 128 + 32 * ks + 8 * q);
#pragma unroll
            for (int j2 = 0; j2 < 2; ++j2) Bk[d][j2][ks] = *(const bf16x8*)(KS + base + (size_t)(16 * (2 * (wv & 1) + j2) + fr) * 128 + 32 * ks + 8 * q); } }
    bf16x8 Bv[2], Vo[2], SbD[4];
#pragma unroll
    for (int ks = 0; ks < 2; ++ks) Bv[ks] = *(const bf16x8*)(VT + (size_t)((b * 4 + h) * 128 + 16 * wv + fr) * SP + s0 + 32 * ks + 8 * q);
    const int dm = 1 - sub;
#pragma unroll
    for (int ks = 0; ks < 2; ++ks) Vo[ks] = *(const bf16x8*)(VT + (size_t)((b * 4 + h) * 128 + 16 * wv + fr) * SP + 64 * oc + 32 * ks + 8 * q);
    u32x2 sp[8];
    { const size_t sbD = ((size_t)((sub * NB + b) * 4 + h) * NPR + pr) * 4096, sbM = ((size_t)((dm * NB + b) * 4 + h) * NPR + pr) * 4096;
#pragma unroll
        for (int ks = 0; ks < 4; ++ks) SbD[ks] = ld_split8(SPH + (sbD + ((2 * ks) * 8 + wv) * 64 + C.lane) * 4, SPH + (sbD + ((2 * ks + 1) * 8 + wv) * 64 + C.lane) * 4);
#pragma unroll
        for (int at = 0; at < 8; ++at) sp[at] = *(const u32x2*)(SPH + (sbM + (at * 8 + wv) * 64 + C.lane) * 4); }
    const int kr = C.tid >> 3, kc = (C.tid & 7) * 16;
    const bf16* kso = KS + dm * DST + ((size_t)(b * 4 + h) * SP + 64 * oc) * 128 + kr * 128 + kc;
    const u32x4 kt0 = *(const u32x4*)kso, kt1 = *(const u32x4*)(kso + 8);
    const int i = C.lane;
    const size_t row = (size_t)b * SEQ + i * 64 + w;
    const bf16* gp = U + row * NU + 1280 + 2048 + h * 128 + 16 * wv; bf16* yo = Y + row * D + 512 + h * 128 + 16 * wv; const float* nwp = a.hg_norm + h * 128 + 16 * wv;
    const u32x4 gw0 = *(const u32x4*)gp, gw1 = *(const u32x4*)(gp + 8);
    f32x4 nw[4];
#pragma unroll
    for (int c4 = 0; c4 < 4; ++c4) nw[c4] = *(const f32x4*)(nwp + 4 * c4);
    {
        f32x4 P[2] = {(f32x4){0.f, 0.f, 0.f, 0.f}, (f32x4){0.f, 0.f, 0.f, 0.f}};
#pragma unroll
        for (int d = 0; d < 2; ++d) {
#pragma unroll
            for (int ks = 0; ks < 4; ++ks) if ((wv & 1) == 0) *(LAS bf16x8*)(QL + (d * 64 + 16 * it0 + fr) * 136 + 32 * ks + 8 * q) = Aq[d][ks];
#pragma unroll
            for (int j2 = 0; j2 < 2; ++j2) { const int jt = 2 * (wv & 1) + j2; f32x4 S = (f32x4){0.f, 0.f, 0.f, 0.f};
#pragma unroll
                for (int ks = 0; ks < 4; ++ks) S = MFMA16(Aq[d][ks], Bk[d][j2][ks], S);
                const int j = 16 * jt + fr;
#pragma unroll
                for (int r = 0; r < 4; ++r) { const int ii = 16 * it0 + 4 * q + r; const bool keep = d == 0 ? (j <= ii) : (j >= ii); P[j2][r] += keep ? S[r] : 0.f; } } }
#pragma unroll
        for (int j2 = 0; j2 < 2; ++j2) { const int j = 16 * (2 * (wv & 1) + j2) + fr;
#pragma unroll
            for (int r = 0; r < 4; ++r) Pl[(16 * it0 + 4 * q + r) * 72 + j] = (bf16)(cvt_pk_bf16(P[j2][r], 0.f) & 0xffff); }
        *(LAS u32x4*)(KL + kr * 136 + kc) = kt0; *(LAS u32x4*)(KL + kr * 136 + kc + 8) = kt1;
    }
    LDS_BARRIER();
    f32x4 O[4];
#pragma unroll
    for (int it = 0; it < 4; ++it) { O[it] = (f32x4){0.f, 0.f, 0.f, 0.f};
#pragma unroll
        for (int ks = 0; ks < 2; ++ks) { const bf16x8 Pa = *(const LAS bf16x8*)(Pl + (16 * it + fr) * 72 + 32 * ks + 8 * q); O[it] = MFMA16(Pa, Bv[ks], O[it]); } }
    bf16x8 SbM[4];
    { const float* eg = EG + ((size_t)((dm * NB + b) * 4 + h) * NCH + oc) * 128 + 4 * q;
        const LAS bf16* kt = KL + (8 * q + (fr >> 2)) * 136 + 4 * (fr & 3);
#pragma unroll
        for (int ks = 0; ks < 4; ++ks) { unsigned wd[4];
#pragma unroll
            for (int hh = 0; hh < 2; ++hh) { const int at = 2 * ks + hh; f32x4 t4 = (f32x4){bflo(sp[at].x), bfhi(sp[at].x), bflo(sp[at].y), bfhi(sp[at].y)};
#pragma unroll
                for (int k2 = 0; k2 < 2; ++k2) { const s16x4 a0 = lds_tr(kt + (32 * k2) * 136 + 16 * at), a1 = lds_tr(kt + (32 * k2 + 4) * 136 + 16 * at);
                    const s16x8 av = (s16x8){a0[0], a0[1], a0[2], a0[3], a1[0], a1[1], a1[2], a1[3]}; t4 = MFMA16(__builtin_bit_cast(bf16x8, av), Vo[k2], t4); }
                const f32x4 e4 = *(const f32x4*)(eg + 16 * at);
                wd[2 * hh] = cvt_pk_bf16(t4[0] * e4[0], t4[1] * e4[1]); wd[2 * hh + 1] = cvt_pk_bf16(t4[2] * e4[2], t4[3] * e4[3]); }
            const u32x4 ww = (u32x4){wd[0], wd[1], wd[2], wd[3]}; SbM[ks] = __builtin_bit_cast(bf16x8, ww); } }
#pragma unroll
    for (int d = 0; d < 2; ++d)
#pragma unroll
        for (int ks = 0; ks < 4; ++ks) { const bf16x8 sb = d == sub ? SbD[ks] : SbM[ks];
#pragma unroll
            for (int it = 0; it < 4; ++it) { const LAS bf16* qp = QL + (d * 64 + 16 * it + fr) * 136 + 32 * ks + 4 * q;
                const u32x2 lo = *(const LAS u32x2*)qp, hi = *(const LAS u32x2*)(qp + 16); const u32x4 ww = (u32x4){lo.x, lo.y, hi.x, hi.y};
                O[it] = MFMA16(__builtin_bit_cast(bf16x8, ww), sb, O[it]); } }
#pragma unroll
    for (int it = 0; it < 4; ++it)
#pragma unroll
        for (int r = 0; r < 4; ++r) Ol[(16 * it + 4 * q + r) * 132 + 16 * wv + fr] = O[it][r];
    LDS_BARRIER();
    float o[16]; float ss = 0.f;
#pragma unroll
    for (int c4 = 0; c4 < 4; ++c4) { const f32x4 t = *(const LAS f32x4*)(Ol + i * 132 + 16 * wv + 4 * c4);
#pragma unroll
        for (int e = 0; e < 4; ++e) { o[4 * c4 + e] = t[e]; ss += t[e] * t[e]; } }
    red[wv * 64 + i] = ss;
    LDS_BARRIER();
    float tot = 0.f;
#pragma unroll
    for (int s2 = 0; s2 < 8; ++s2) tot += red[s2 * 64 + i];
    const float rstd = rsqrtf(tot * (1.0f / 128.0f) + EPS);
#pragma unroll
    for (int c8 = 0; c8 < 2; ++c8) { const u32x4 gw4 = c8 == 0 ? gw0 : gw1; const unsigned gz[4] = {gw4.x, gw4.y, gw4.z, gw4.w}; unsigned ow[4];
#pragma unroll
        for (int e = 0; e < 4; ++e) { const int k = 8 * c8 + 2 * e; ow[e] = cvt_pk_bf16(o[k] * rstd * nw[k >> 2][k & 3] * siluf(bflo(gz[e])), o[k + 1] * rstd * nw[(k + 1) >> 2][(k + 1) & 3] * siluf(bfhi(gz[e]))); }
        *(u32x4*)(yo + 8 * c8) = (u32x4){ow[0], ow[1], ow[2], ow[3]}; }
    LDS_BARRIER();
    }
}
__device__ __forceinline__ void phase7(CArgs& a, const Ctx& C) {
    for (int u = C.vcu; u < 256; u += C.G) passc_ssd_unit(a, C, u);
    for (int u = C.vcu; u < 512; u += C.G) passc_hg_pair(a, C, u);
}
__device__ __forceinline__ void phase9_fill(CArgs& a, const Ctx& C, int t0, int nt) {
    LAS float* RW = (LAS float*)C.lds;
    for (int k = t0; k < D; k += nt) {
#pragma unroll
        for (int e4 = 0; e4 < 8; ++e4) { const f32x4 w = *(const f32x4*)(a.router_w + (size_t)k * NE + 4 * e4);
#pragma unroll
            for (int e = 0; e < 4; ++e) RW[(4 * e4 + e) * D + k] = w[e]; } }
}
__device__ __forceinline__ void phase9(CArgs& a, const Ctx& C, bool prefilled) {
    constexpr int NR = 4;
    const float* MOD = (const float*)(a.ws + WS_MOD); const bf16* MIX = (const bf16*)(a.ws + WS_MIX); unsigned char* HX = a.ws + WS_XN; bf16* X1 = (bf16*)(a.ws + WS_U);
    int* TOPE = (int*)(a.ws + WS_ROUTE); float* GATE = (float*)(a.ws + WS_ROUTE + 256 * 1024); int* PPOS = (int*)(a.ws + WS_ROUTE + 512 * 1024); int* ROWTOK = (int*)(a.ws + WS_ROWTOK);
    unsigned* gcnt = (unsigned*)(a.ws + WS_CTL) + CW_CNT;
    LAS float* RW = (LAS float*)C.lds;
    LAS float* LG = (LAS float*)(C.lds + 131072) + C.wave * 128;
    LAS unsigned* lcnt = (LAS unsigned*)(C.lds + LCNT_OFF); LAS unsigned* lbase = lcnt + 32;
    if (!prefilled) phase9_fill(a, C, C.tid, 512);
    if (C.tid < 32) lcnt[C.tid] = 0u;
    __syncthreads();
    LAS float* VA = (LAS float*)(C.lds + 131072 + 4096); LAS float* VB = VA + 1024;
    for (int m0 = NR * C.gw; m0 < NLAT; m0 += NR * C.NGW) {
        const int b = m0 >> 12; const float* mb = MOD + b * 6144;
        __syncthreads();
        for (int k = C.tid; k < D; k += 512) { VA[k] = mb[2048 + k] * a.mix_post[k]; VB[k] = a.ffn_pre[k] * (1.0f + mb[4096 + k]); }
        __syncthreads();
        float hv[NR][16];
#pragma unroll
        for (int r = 0; r < NR; ++r) { const size_t ro = (size_t)(m0 + r) * D; float ss = 0.f;
            f32x4 xv[4];
#pragma unroll
            for (int jj = 0; jj < 4; ++jj) { const u32x2 w = NTLOAD((const u32x2*)(MIX + ro + 256 * jj + 4 * C.lane)); xv[jj] = NTLOAD((const f32x4*)(a.x + ro + 256 * jj + 4 * C.lane));
                hv[r][4 * jj] = bflo(w.x); hv[r][4 * jj + 1] = bfhi(w.x); hv[r][4 * jj + 2] = bflo(w.y); hv[r][4 * jj + 3] = bfhi(w.y); }
#pragma unroll
            for (int i = 0; i < 16; ++i) ss += hv[r][i] * hv[r][i];
            const float rstd = rsqrtf(wave_sum(ss) * (1.0f / D) + EPS); float ss2 = 0.f;
#pragma unroll
            for (int jj = 0; jj < 4; ++jj) { const int k0 = 256 * jj + 4 * C.lane; const f32x4 va = *(const LAS f32x4*)(VA + k0);
                f32x4 x1;
#pragma unroll
                for (int e = 0; e < 4; ++e) { x1[e] = xv[jj][e] + va[e] * (hv[r][4 * jj + e] * rstd); hv[r][4 * jj + e] = x1[e]; ss2 += x1[e] * x1[e]; }
                *(u32x2*)(X1 + ro + k0) = (u32x2){cvt_pk_bf16(x1[0], x1[1]), cvt_pk_bf16(x1[2], x1[3])}; }
            const float rstd2 = rsqrtf(wave_sum(ss2) * (1.0f / D) + EPS);
#pragma unroll
            for (int jj = 0; jj < 4; ++jj) { const int k0 = 256 * jj + 4 * C.lane; const f32x4 vb = *(const LAS f32x4*)(VB + k0), s0 = *(const f32x4*)(mb + 3072 + k0);
#pragma unroll
                for (int e = 0; e < 4; ++e) hv[r][4 * jj + e] = hv[r][4 * jj + e] * rstd2 * vb[e] + s0[e];
                *(unsigned*)(HX + ro + k0) = pk4_fp8(hv[r][4 * jj], hv[r][4 * jj + 1], hv[r][4 * jj + 2], hv[r][4 * jj + 3]); }
            if (r & 1) asm volatile("" ::: "memory"); }
#pragma unroll 1
        for (int eg = 0; eg < 4; ++eg) {
            float lg[NR][8];
#pragma unroll
            for (int r = 0; r < NR; ++r)
#pragma unroll
                for (int e = 0; e < 8; ++e) lg[r][e] = 0.f;
#pragma unroll
            for (int e = 0; e < 8; ++e)
#pragma unroll
                for (int jj = 0; jj < 4; ++jj) { const f32x4 w = *(const LAS f32x4*)(RW + (8 * eg + e) * D + 256 * jj + 4 * C.lane);
#pragma unroll
                    for (int r = 0; r < NR; ++r) lg[r][e] += hv[r][4 * jj] * w[0] + hv[r][4 * jj + 1] * w[1] + hv[r][4 * jj + 2] * w[2] + hv[r][4 * jj + 3] * w[3];
                    if (jj == 3 && (e & 1)) asm volatile("" ::: "memory"); }
#pragma unroll
            for (int r = 0; r < NR; ++r) { reduce_scatter<8>(lg[r], C.lane);
                if ((C.lane & 7) == 0) LG[r * 32 + 8 * eg + (C.lane >> 3)] = lg[r][0]; }
        }
        LDS_WAIT(); asm volatile("" ::: "memory");
        if (C.lane < NR) { const int m = m0 + C.lane; float logit[32];
#pragma unroll
            for (int e4 = 0; e4 < 8; ++e4) { const f32x4 v = *(const LAS f32x4*)(LG + C.lane * 32 + 4 * e4), rb = *(const f32x4*)(a.router_b + 4 * e4);
#pragma unroll
                for (int e = 0; e < 4; ++e) logit[4 * e4 + e] = v[e] + rb[e]; }
            int te[4]; float tv[4]; unsigned taken = 0u;
#pragma unroll
            for (int k = 0; k < 4; ++k) { float best = -3.0e38f; int bi = 0;
#pragma unroll
                for (int e = 0; e < 32; ++e) { const bool better = (((taken >> e) & 1u) == 0u) && (logit[e] > best); best = better ? logit[e] : best; bi = better ? e : bi; }
                te[k] = bi; tv[k] = best; taken |= 1u << bi; }
            float ex[4], sum = 0.f;
#pragma unroll
            for (int k = 0; k < 4; ++k) { ex[k] = __expf(tv[k] - tv[0]); sum += ex[k]; }
            const float inv = 1.0f / sum;
#pragma unroll
            for (int k = 0; k < 4; ++k) { const unsigned pos = __hip_atomic_fetch_add(lcnt + te[k], 1u, __ATOMIC_RELAXED, __HIP_MEMORY_SCOPE_WORKGROUP);
                TOPE[m * 4 + k] = te[k]; GATE[m * 4 + k] = ex[k] * inv; PPOS[m * 4 + k] = (int)pos; } }
        LDS_WAIT(); asm volatile("" ::: "memory");
    }
    __syncthreads();
    if (C.tid < 32) lbase[C.tid] = atomicAdd(gcnt + C.tid, lcnt[C.tid]);
    __syncthreads();
    for (int m0 = 4 * C.gw; m0 < NLAT; m0 += 4 * C.NGW) if (C.lane < 4 * NR) { const int idx = m0 * 4 + C.lane; const int e = TOPE[idx]; const int pos = PPOS[idx] + (int)lbase[e]; PPOS[idx] = pos; ROWTOK[e * 16384 + pos] = m0 + (C.lane >> 2); }
}
__device__ __forceinline__ void moe_tables(CArgs& a, const Ctx& C) {
    const unsigned* gcnt = (const unsigned*)(a.ws + WS_CTL) + CW_CNT; LAS int* TS = (LAS int*)(C.lds + TS_OFF); LAS int* CN = TS + 36;
    if (C.tid < 64) { const int e = C.tid & 31; const int c = (int)__hip_atomic_load(gcnt + e, RLX_AGENT); const int nt = (c + 255) >> 8;
        int pre = nt;
#pragma unroll
        for (int o = 1; o < 32; o <<= 1) { const int t = __shfl_up(pre, o, 32); pre += ((C.tid & 31) >= o) ? t : 0; }
        if (C.tid < 32) { TS[e] = pre - nt; CN[e] = c; if (e == 31) TS[NE] = pre; } }
    __syncthreads();
    if (C.tid < 320) { int e = 0;
#pragma unroll
        for (int k = 1; k < NE; ++k) e += (TS[k] <= C.tid) ? 1 : 0;
        TS[80 + C.tid] = e; }
    __syncthreads();
}
__device__ __forceinline__ void phase13(CArgs& a, const Ctx& C) {
    const float* MOD = (const float*)(a.ws + WS_MOD); const unsigned char* Y2 = a.ws + WS_Y2; const bf16* X1 = (const bf16*)(a.ws + WS_U);
    const int* TOPE = (const int*)(a.ws + WS_ROUTE); const float* GATE = (const float*)(a.ws + WS_ROUTE + 256 * 1024); const int* PPOS = (const int*)(a.ws + WS_ROUTE + 512 * 1024);
    moe_tables(a, C); const LAS int* TS = (const LAS int*)(C.lds + TS_OFF);
    for (int m0 = 4 * C.gw; m0 < NLAT; m0 += 4 * C.NGW) {
        const int b = m0 >> 12; const float* gf = MOD + b * 6144 + 5120;
        int slot = 0; float gk = 0.f;
        if (C.lane < 16) { const int idx = m0 * 4 + C.lane; slot = TS[TOPE[idx]] * 256 + PPOS[idx]; gk = GATE[idx] * (1.0f / Y_SCALE); }
        u32x4 yw[4][4];
#pragma unroll
        for (int r = 0; r < 4; ++r)
#pragma unroll
            for (int k = 0; k < 4; ++k) { const int sl = __shfl(slot, 4 * r + k); yw[r][k] = NTLOAD((const u32x4*)(Y2 + (size_t)sl * D + 16 * C.lane)); }
#pragma unroll
        for (int r = 0; r < 4; ++r) { float f[16];
#pragma unroll
            for (int e = 0; e < 16; ++e) f[e] = 0.f;
#pragma unroll
            for (int k = 0; k < 4; ++k) { const float g = __shfl(gk, 4 * r + k); const unsigned ww[4] = {yw[r][k].x, yw[r][k].y, yw[r][k].z, yw[r][k].w};
#pragma unroll
                for (int e = 0; e < 4; ++e) { const f32x2 lo = __builtin_amdgcn_cvt_pk_f32_fp8((int)ww[e], false), hi = __builtin_amdgcn_cvt_pk_f32_fp8((int)ww[e], true);
                    f[4 * e] += g * lo.x; f[4 * e + 1] += g * lo.y; f[4 * e + 2] += g * hi.x; f[4 * e + 3] += g * hi.y; } }
            float ss = 0.f;
#pragma unroll
            for (int e = 0; e < 16; ++e) ss += f[e] * f[e];
            const float rstd = rsqrtf(wave_sum(ss) * (1.0f / D) + EPS);
            const size_t ro = (size_t)(m0 + r) * D; const int k0 = 16 * C.lane;
            const u32x4 xa = NTLOAD((const u32x4*)(X1 + ro + k0)), xb = NTLOAD((const u32x4*)(X1 + ro + k0 + 8)); const unsigned xw[8] = {xa.x, xa.y, xa.z, xa.w, xb.x, xb.y, xb.z, xb.w};
#pragma unroll
            for (int e4 = 0; e4 < 4; ++e4) { const f32x4 w = *(const f32x4*)(a.ffn_post + k0 + 4 * e4), g = *(const f32x4*)(gf + k0 + 4 * e4);
                f32x4 o; o[0] = bflo(xw[2 * e4]) + g[0] * (f[4 * e4] * rstd * w[0]); o[1] = bfhi(xw[2 * e4]) + g[1] * (f[4 * e4 + 1] * rstd * w[1]);
                o[2] = bflo(xw[2 * e4 + 1]) + g[2] * (f[4 * e4 + 2] * rstd * w[2]); o[3] = bfhi(xw[2 * e4 + 1]) + g[3] * (f[4 * e4 + 3] * rstd * w[3]);
                *(f32x4*)(a.out + ro + k0 + 4 * e4) = o; } }
    }
}

struct ShadowWork { CArgs* ka; const Ctx* C; int fill, first, scr_off, scr_stride;
    __device__ __forceinline__ void operator()() const {
        if (fill == 2) phase2_fill(*ka, *C, C->tid - 64, 448);
        if (fill == 9) phase9_fill(*ka, *C, C->tid - 64, 448);
        if (first >= 0) conv_shadow(*ka, *C, first, C->lds + scr_off, scr_stride); } };
__global__ void __launch_bounds__(512, 2) mega_fwd(Args a) {
    extern __shared__ __attribute__((aligned(16))) unsigned char lds_raw[];
#define MKCTX(C) Ctx C; { int t_ = threadIdx.x; asm volatile("" : "+v"(t_)); C.lds = (LAS unsigned char*)lds_raw; C.tid = t_; C.lane = t_ & 63; C.wave = __builtin_amdgcn_readfirstlane(t_ >> 6); \
        C.G = gridDim.x; const int bx_ = blockIdx.x; C.vcu = (C.G % 8 == 0) ? (bx_ % 8) * (C.G / 8) + bx_ / 8 : bx_; C.gw = C.vcu * 8 + C.wave; C.NGW = C.G * 8; }
    MKCTX(C);
    volatile LAS unsigned* MISC = (volatile LAS unsigned*)(C.lds + MISC_OFF);
    for (int u = C.tid; u < (LDS_BYTES - LDSCTL_OFF) / 4; u += 512) ((LAS unsigned*)(C.lds + LDSCTL_OFF))[u] = 0u;
    __syncthreads();
    const int lo = a.ph_lo, hi = a.ph_hi;
    CArgs* const kargs = (CArgs*)__builtin_amdgcn_kernarg_segment_ptr();
#define KA() (*[&]() { CArgs* p_ = kargs; asm volatile("" : "+s"(p_)); return p_; }())
    if (hi - lo > 1) (void)xcd_barrier_post((unsigned*)(a.ws + WS_CTL) + CW_BAR, MISC + 8);
#define BAR() XcdBarrier{(unsigned*)(KA().ws + WS_CTL) + CW_BAR, xb_xcc_id(), (volatile LAS unsigned*)(C.lds + MISC_OFF) + 8}
#define IN(k) (lo <= (k) && (k) < hi)
#define NEXTPH(k) ((k) == 4 ? 6 : ((k) == 9 ? 11 : (k) + 1))
#define SEAM(k) do { if (IN(k) && IN(NEXTPH(k))) xcd_barrier(BAR()); } while (0)
#define SEAM_WORK(k, ...) do { if (IN(k) && IN(NEXTPH(k))) xcd_barrier(BAR(), __VA_ARGS__); } while (0)
#define SHADOW(sh) ShadowWork{&KA(), &C, 0, (sh) * CONV_B, 16384, 16384}
    if (IN(0)) { MKCTX(C); for (int rp = 0; rp < NREP(0); ++rp) phase0(KA(), C); SEAM_WORK(0, SHADOW(0)); }
    if (IN(1)) { MKCTX(C); for (int rp = 0; rp < NREP(1); ++rp) phase1(KA(), C); SEAM_WORK(1, ShadowWork{&KA(), &C, 2, 1 * CONV_B, 65536, 8448}); }
    if (IN(2)) { MKCTX(C); for (int rp = 0; rp < NREP(2); ++rp) { phase2(KA(), C, IN(1) && rp == 0); __syncthreads(); } SEAM_WORK(2, SHADOW(2)); }
    if (IN(3)) { MKCTX(C); pg8::Gemm g{(const bf16*)(KA().ws + WS_XN), (const bf16*)(KA().ws + WS_WINT), D}; pg8::StaticOrder S; S.init(MROWS, NU, C.G, (int)blockIdx.x);
        pg8::EpiBf16 E{(bf16*)(KA().ws + WS_U), NU, nullptr, 0, 1.0f};
        const bool odd = (C.vcu & 1) != 0;
        if (odd) { conv_range(KA(), C, CONV_W1_HOST, NIT1); __syncthreads(); }
        pg8::gemm_phase<false>(C.lds, g, S, E, pg8::DenseRows{}); __syncthreads();
        if (!odd) conv_range(KA(), C, CONV_W1_HOST, NIT1);
        SEAM_WORK(3, SHADOW(3)); }
    if (IN(4)) { MKCTX(C); for (int rp = 0; rp < NREP(4); ++rp) phase4(KA(), C); SEAM_WORK(4, SHADOW(4)); }

    if (IN(6)) { MKCTX(C); for (int rp = 0; rp < NREP(6); ++rp) phase6(KA(), C); SEAM_WORK(6, SHADOW(5)); }
    if (IN(7)) { MKCTX(C); for (int rp = 0; rp < NREP(7); ++rp) phase7(KA(), C); SEAM_WORK(7, SHADOW(6)); }
    if (IN(8)) { MKCTX(C); pg8::Gemm g{(const bf16*)(KA().ws + WS_Y), (const bf16*)(KA().ws + WS_WOUTT), D}; pg8::StaticOrder S; S.init(NLAT, D, C.G, (int)blockIdx.x);
        pg8::EpiBf16 E{(bf16*)(KA().ws + WS_MIX), D, nullptr, 0, 1.0f}; for (int rp = 0; rp < NREP(8); ++rp) pg8::gemm_phase<false>(C.lds, g, S, E, pg8::DenseRows{}); SEAM_WORK(8, ShadowWork{&KA(), &C, 9, -1, 0, 0}); }
    if (IN(9)) { MKCTX(C); phase9(KA(), C, IN(8)); SEAM_WORK(9, ShadowWork{&KA(), &C, 0, CONV_S9, 16384, 16384}); }
    if (IN(11)) { MKCTX(C); moe_tables(KA(), C); pg8::Gemm g{(const bf16*)(KA().ws + WS_XN), (const bf16*)(KA().ws + WS_W1T), D / 2};   pg8::MoeOrder S; S.init((const LAS int*)(C.lds + TS_OFF), 8, 4, (int)blockIdx.x);
        pg8::EpiSwiglu E{KA().ws + WS_ACT, D, KA().b1, 2048}; LAS unsigned* ROWL = (LAS unsigned*)(C.lds + 131072 + 2048);
        { const int* rowtok = (const int*)(KA().ws + WS_ROWTOK); const LAS int* TSl = (const LAS int*)(C.lds + TS_OFF); const LAS int* CNl = TSl + 36;
          for (int idx = C.tid; idx < 9 * 256; idx += 512) { const int i = idx >> 8, r = idx & 255; pg8::Unit uu;
              if (S.next(i, uu)) { const int p = (uu.pm - TSl[uu.e]) * 256 + r; const int tok = p < CNl[uu.e] ? rowtok[uu.e * 16384 + p] : 0; ROWL[idx] = (unsigned)tok * 1024u; } }
          __syncthreads(); }
        pg8::GatherRows AM{ROWL};
        const bool odd = (C.vcu & 1) != 0;
        constexpr int H0 = CONV_S9 + CONV_B, NH = NIT1 + NIT2 - H0 > 0 ? NIT1 + NIT2 - H0 : 0, CONV_EXI = 5;
        const int nidw = S.nidle * 8, exi = nidw > 0 ? (CONV_EXI * nidw <= NH ? CONV_EXI : NH / nidw) : 0, hbase = NH - exi * nidw;
#pragma unroll 1
        for (int part = 0; part < 2; ++part) {
            if ((odd && part == 0) || (!odd && part == 1)) { conv_range(KA(), C, H0, H0 + hbase); __syncthreads(); }
            S.i0 = odd ? 0 : 4 * part; S.n = odd ? (part == 0 ? (1 << 30) : 0) : (part == 0 ? 4 : (1 << 30));
            pg8::gemm_phase<true>(C.lds, g, S, E, AM); __syncthreads(); }
        if (S.irank >= 0) {
            LAS float* scr = (LAS float*)(C.lds + C.wave * 16384);
#pragma unroll 1
            for (int k = 0; k < exi; ++k) conv_item(KA(), scr, C.lane, H0 + hbase + S.irank * 8 + C.wave + nidw * k); }
        SEAM_WORK(11, ShadowWork{&KA(), &C, 0, -1, 0, 0}); }
    if (IN(12)) { MKCTX(C); moe_tables(KA(), C); pg8::Gemm g{(const bf16*)(KA().ws + WS_ACT), (const bf16*)(KA().ws + WS_W2T), D / 2}; pg8::MoeOrder S; S.init((const LAS int*)(C.lds + TS_OFF), 4, 8, (int)blockIdx.x);
        pg8::EpiFp8 E{KA().ws + WS_Y2, D, KA().b2, D, 1.0f / (W_SCALE * ACT_SCALE)}; for (int rp = 0; rp < NREP(12); ++rp) pg8::gemm_phase<true>(C.lds, g, S, E, pg8::DenseRows{}); SEAM(12); }
    if (IN(13)) { MKCTX(C); for (int rp = 0; rp < NREP(13); ++rp) phase13(KA(), C); }
#undef IN
#undef KA
#undef SEAM
}

extern "C" void kernel_launch(void* const* d_in, const int* in_sizes, int n_in, void* d_out, int out_size, void* d_ws, size_t ws_size, hipStream_t stream) {
    static int grid = 0;
    if (grid == 0) {
        if (n_in != 26 || in_sizes[0] != NLAT * D || out_size != NLAT * D || ws_size < WS_END) {
            fprintf(stderr, "kernel_launch: unexpected shapes: n_in %d in0 %d out %d ws %zu (need %zu); nothing launched\n", n_in, n_in > 0 ? in_sizes[0] : -1, out_size, ws_size, (size_t)WS_END); grid = -1; return; }
        int dev = 0, cus = 0, per_cu = 0;
        if (hipGetDevice(&dev) != hipSuccess || hipDeviceGetAttribute(&cus, hipDeviceAttributeMultiprocessorCount, dev) != hipSuccess) { fprintf(stderr, "kernel_launch: device query failed\n"); grid = -1; return; }
        if (hipFuncSetAttribute((const void*)mega_fwd, hipFuncAttributeMaxDynamicSharedMemorySize, LDS_BYTES) != hipSuccess) { fprintf(stderr, "kernel_launch: hipFuncSetAttribute failed\n"); grid = -1; return; }
        if (hipOccupancyMaxActiveBlocksPerMultiprocessor(&per_cu, (const void*)mega_fwd, 512, LDS_BYTES) != hipSuccess || per_cu < 1)
            fprintf(stderr, "kernel_launch: note: occupancy query reports %d workgroups per CU\n", per_cu);
        (void)hipGetLastError();
        grid = cus;
        if (grid != 256) { fprintf(stderr, "kernel_launch: this kernel needs a 256-CU device (got %d)\n", grid); grid = -1; return; }
    }
    if (grid < 0) return;
    (void)hipMemsetAsync((char*)d_ws + WS_CTL, 0, CTL_ZERO_BYTES, stream);
    Args a{};
    const float** ap = (const float**)&a;
    for (int i = 0; i < 26; ++i) ap[i] = (const float*)d_in[i];
    a.out = (float*)d_out; a.ws = (unsigned char*)d_ws;
#if MK_PER_PHASE
    for (int p = 0; p < NPHASE; ++p) { a.ph_lo = p; a.ph_hi = p + 1; hipLaunchKernelGGL(mega_fwd, dim3(grid), dim3(512), LDS_BYTES, stream, a); }
#else
    a.ph_lo = 0; a.ph_hi = NPHASE; hipLaunchKernelGGL(mega_fwd, dim3(grid), dim3(512), LDS_BYTES, stream, a);
#endif
}
```

```cpp
#include <hip/hip_runtime.h>
#include <cstdio>
#include <cstdint>

#ifndef MK_PER_PHASE
#define MK_PER_PHASE 0
#endif

#ifndef PROBE_REP_MASK
#define PROBE_REP_MASK 0u
#endif
#define NREP(k) ((((PROBE_REP_MASK) >> (k)) & 1u) ? 2 : 1)
#define LAS __attribute__((address_space(3)))
typedef unsigned short bf16;
typedef short bf16x8 __attribute__((ext_vector_type(8)));
typedef float f32x4 __attribute__((ext_vector_type(4)));
typedef float f32x2 __attribute__((ext_vector_type(2)));
typedef unsigned u32x4 __attribute__((ext_vector_type(4)));
typedef unsigned u32x2 __attribute__((ext_vector_type(2)));
typedef int i32x4 __attribute__((ext_vector_type(4)));
typedef int i32x8 __attribute__((ext_vector_type(8)));

constexpr int D = 1024, NB = 4, SEQ = 4096, CTXL = 256;
constexpr int NLAT = NB * SEQ, NCTX = NB * CTXL, MROWS = NLAT + NCTX;
constexpr int NU = 3840;
constexpr int W_IN_COLS = 3856;
constexpr int SP = CTXL + SEQ;
constexpr int NCH = SP / 64;
constexpr int NPR = NCH / 2;
constexpr int NE = 32;
constexpr float EPS = 1e-6f;
constexpr int NPHASE = 14;

constexpr size_t MiB = 1u << 20;
constexpr size_t WS_CTL = 0, CTL_ZERO_BYTES = 1 * MiB;
constexpr size_t WS_MODP = 1 * MiB, WS_MOD = 5 * MiB, WS_DTRAW = 6 * MiB, WS_WINT = 8 * MiB, WS_WOUTT = 16 * MiB;
constexpr size_t WS_W1T = 18 * MiB, WS_W2T = 146 * MiB, WS_XN = 210 * MiB, WS_U = 244 * MiB;
constexpr size_t WS_BC = 372 * MiB, WS_XST = 381 * MiB, WS_XSW = 398 * MiB, WS_BT = 432 * MiB, WS_GA = 437 * MiB, WS_DTA = 439 * MiB, WS_GEND = 441 * MiB;
constexpr size_t WS_QS = 442 * MiB, WS_KS = 476 * MiB, WS_KHT = 510 * MiB, WS_VT = 544 * MiB, WS_EG = 561 * MiB;
constexpr size_t WS_DSP = WS_KHT, WS_EGP = WS_EG + 1179648;
constexpr size_t WS_DSS = 563 * MiB, WS_DSH = 631 * MiB, WS_SPS = 767 * MiB, WS_SPH = 801 * MiB, WS_Y = 869 * MiB, WS_MIX = 901 * MiB, WS_ROUTE = 965 * MiB;
constexpr size_t WS_XS = 372 * MiB, WS_ACT = 516 * MiB, WS_Y2 = 660 * MiB;
constexpr size_t WS_ROWTOK = 966 * MiB;
constexpr size_t WS_END = 968 * MiB;
constexpr int CW_BAR = 4096, CW_CNT = 16384;

constexpr int LDS_BYTES = 147456;
constexpr int LDSCTL_OFF = 144896;
constexpr int MISC_OFF = LDSCTL_OFF;
constexpr int TS_OFF = LDSCTL_OFF + 128;
constexpr int LCNT_OFF = LDSCTL_OFF + 2048;

typedef __bf16 bf16x2_t __attribute__((ext_vector_type(2)));
__device__ __forceinline__ unsigned cvt_pk_bf16(float lo, float hi) { const f32x2 v = {lo, hi}; const bf16x2_t b = __builtin_convertvector(v, bf16x2_t); return __builtin_bit_cast(unsigned, b); }
__device__ __forceinline__ unsigned pk4_fp8(float a, float b, float c, float d) { int w = __builtin_amdgcn_cvt_pk_fp8_f32(a, b, 0, false); w = __builtin_amdgcn_cvt_pk_fp8_f32(c, d, w, true); return (unsigned)w; }
constexpr float W_SCALE = 64.0f, ACT_SCALE = 4.0f, Y_SCALE = 16.0f;
__device__ __forceinline__ float bf2f(unsigned short b) { return __uint_as_float(((unsigned)b) << 16); }
__device__ __forceinline__ float bflo(unsigned w) { return __uint_as_float(w << 16); }
__device__ __forceinline__ float bfhi(unsigned w) { return __uint_as_float(w & 0xffff0000u); }
__device__ __forceinline__ float siluf(float x) { return x * __builtin_amdgcn_rcpf(1.0f + __expf(-x)); }
template <int CTRL> __device__ __forceinline__ float dppf(float v) { return __builtin_bit_cast(float, __builtin_amdgcn_update_dpp(0, __builtin_bit_cast(int, v), CTRL, 0xf, 0xf, true)); }
constexpr int DPP_X1 = 0xB1, DPP_X2 = 0x4E, DPP_HMIR = 0x141, DPP_MIR = 0x140;
__device__ __forceinline__ float swap16_add(float a, float b) { asm volatile("v_nop\n\tv_nop\n\tv_permlane16_swap_b32 %0, %1\n\tv_nop\n\tv_nop" : "+v"(a), "+v"(b)); return a + b; }
__device__ __forceinline__ float swap32_add(float a, float b) { asm volatile("v_nop\n\tv_nop\n\tv_permlane32_swap_b32 %0, %1\n\tv_nop\n\tv_nop" : "+v"(a), "+v"(b)); return a + b; }
__device__ __forceinline__ float wave_sum(float v) {
    v += dppf<DPP_X1>(v); v += dppf<DPP_X2>(v); v += dppf<DPP_HMIR>(v); v += dppf<DPP_MIR>(v);
    v = swap16_add(v, v); v = swap32_add(v, v);
    return v;
}
#define LDS_WAIT() asm volatile("s_waitcnt lgkmcnt(0)" ::: "memory")
#define VM_WAIT() asm volatile("s_waitcnt vmcnt(0)" ::: "memory")
#define LDS_BARRIER() do { asm volatile("s_waitcnt lgkmcnt(0)" ::: "memory"); __builtin_amdgcn_s_barrier(); asm volatile("" ::: "memory"); } while (0)
#define RLX_AGENT __ATOMIC_RELAXED, __HIP_MEMORY_SCOPE_AGENT
#define NTLOAD(p) __builtin_nontemporal_load(p)
#define MFMA16(a, b, c) __builtin_amdgcn_mfma_f32_16x16x32_bf16((a), (b), (c), 0, 0, 0)

namespace pg8 {
constexpr int BM = 256, BK = 64, HALF = 128, HTB = HALF * BK * 2, STAGE_BYTES = 8 * HTB, NXCD = 8, WGM = 8;
__host__ __device__ __forceinline__ int lds_byte(int r, int c) { const int st = (r >> 4) * 2 + (c >> 5), rr = r & 15, cc = c & 31, ob = rr * 64 + cc * 2; return st * 1024 + (ob ^ (((ob >> 9) & 1) << 5)); }
__host__ __device__ __forceinline__ void stage_rc(int b, int& R, int& C) { const int st = b / 1024, sb = b % 1024, swz = sb ^ (((sb >> 9) & 1) << 5); R = (st >> 1) * 16 + swz / 64; C = (st & 1) * 32 + (swz % 64) / 2; }
__host__ __device__ __forceinline__ int perm32(int rho) { const int n = rho >> 4, i = rho & 15; return 8 * (i >> 2) + 4 * n + (i & 3); }

struct Unit { int pm, pn, pb, e, ord; };
struct Gemm { const bf16* A; const bf16* Bt; int K; };
struct DenseRows {
    __device__ __forceinline__ size_t ubase(const Unit& u, int h, int K) const { return (size_t)(u.pm * BM + h * HALF) * K * 2; }
    __device__ __forceinline__ unsigned lane_off(const Unit&, int, int R, int K) const { return (unsigned)(R * K) * 2u; } };
struct GatherRows { const LAS unsigned* rowl;
    __device__ __forceinline__ size_t ubase(const Unit&, int, int) const { return 0; }
    __device__ __forceinline__ unsigned lane_off(const Unit& u, int h, int R, int) const { return rowl[u.ord * BM + h * HALF + R]; } };

struct StaticOrder {
    int nM, nN, nwg, G, c, i0, n;
    __device__ __forceinline__ void init(int M, int N, int G_, int c_) { nM = M / BM; nN = N / BM; nwg = nM * nN; G = G_; c = c_; i0 = 0; n = 1 << 30; }
    __device__ __forceinline__ bool next(int i_, Unit& u) const {
        if (i_ >= n) return false; const int i = i_ + i0;
        const long L = (long)i * G + c; if (L >= nwg) return false;
        int wgid = (int)L; { const int q = nwg / NXCD, r = nwg % NXCD, xcd = wgid % NXCD, off = wgid / NXCD; wgid = (xcd < r ? xcd * (q + 1) : r * (q + 1) + (xcd - r) * q) + off; }
        const int nig = WGM * nN, gid = wgid / nig, fm = gid * WGM, gsz = (nM - fm) < WGM ? (nM - fm) : WGM;
        u.pm = fm + ((wgid % nig) % gsz); u.pn = (wgid % nig) / gsz; u.pb = u.pn; u.e = 0; u.ord = i; return true;
    }
};
struct MoeOrder {
    const LAS int* ts; int ntn, mg, x, j, i0, n, nfull, tmt, tnt, nidle, irank;
    __device__ __forceinline__ void init(const LAS int* ts_, int ntn_, int mg_, int c) { ts = ts_; ntn = ntn_; mg = mg_; x = c & 7; j = c >> 3; i0 = 0; n = 1 << 30;
        const int full = __builtin_amdgcn_readfirstlane(ts[NE]), per = mg * 8; nfull = full / per;
        const int rem = full - nfull * per, q = (rem + 7) >> 3; tmt = -1; tnt = 0;
        if (rem > 0) { const int nt = j / q, mt = nfull * per + x * q + (j - nt * q); if (nt < ntn && mt < full) { tmt = mt; tnt = nt; } }
        nidle = 0; irank = -1;
#pragma unroll
        for (int xx = 0; xx < 8; ++xx) { int mx = rem - xx * q; mx = mx < 0 ? 0 : (mx > q ? q : mx);
            if (xx == x && tmt < 0) { const int jj = j < q * ntn ? j : q * ntn; const int tb = q > 0 ? (jj / q) * mx + ((jj % q) < mx ? (jj % q) : mx) : 0; irank = nidle + (j - tb); }
            nidle += 32 - ntn * mx; } }
    __device__ __forceinline__ bool next(int i_, Unit& u) const {
        if (i_ >= n) return false; const int i = i_ + i0;
        int mt, nt;
        if (i < nfull) { mt = mg * (i * 8 + x) + (j % mg); nt = j / mg; }
        else if (i == nfull && tmt >= 0) { mt = tmt; nt = tnt; }
        else return false;
        const int e = __builtin_amdgcn_readfirstlane(ts[80 + mt]);
        u.pm = mt; u.pn = nt; u.e = e; u.pb = e * ntn + nt; u.ord = i; return true;
    }
};

struct EpiF32 {
    static constexpr bool PERM = false, SWZ = false;
    float* C; int ldc;
    __device__ __forceinline__ const float* bias_src(const Unit&) const { return nullptr; }
    __device__ __forceinline__ void operator()(const f32x4 (&acc)[2][2][4][2], const Unit& u, int wr, int wc, int fr, int fq, const LAS float*) const {
        const int row0 = u.pm * BM + wr * 64 + fr, col0 = u.pn * BM + wc * 32 + 4 * fq;
#pragma unroll
        for (int ai = 0; ai < 2; ++ai)
#pragma unroll
            for (int m = 0; m < 4; ++m) { float* rowp = C + (size_t)(row0 + ai * HALF + m * 16) * ldc + col0;
#pragma unroll
                for (int bj = 0; bj < 2; ++bj)
#pragma unroll
                    for (int n = 0; n < 2; ++n) *(f32x4*)(rowp + bj * HALF + n * 16) = acc[ai][bj][m][n]; }
    }
};
struct EpiBf16 {
    static constexpr bool PERM = true, SWZ = false;
    bf16* O; int ldc; const float* bias; int bias_stride; float scale;
    __device__ __forceinline__ const float* bias_src(const Unit& u) const { return bias ? bias + (size_t)u.e * bias_stride + u.pn * BM : nullptr; }
    __device__ __forceinline__ void operator()(const f32x4 (&acc)[2][2][4][2], const Unit& u, int wr, int wc, int fr, int fq, const LAS float* bl) const {
        const int row0 = u.pm * BM + wr * 64 + fr, col0 = u.pn * BM + wc * 32 + 8 * fq;
        f32x4 bv[2][2];
#pragma unroll
        for (int bj = 0; bj < 2; ++bj)
#pragma unroll
            for (int n = 0; n < 2; ++n) bv[bj][n] = bias ? *(const LAS f32x4*)(bl + wc * 32 + 8 * fq + bj * HALF + 4 * n) : (f32x4){0.f, 0.f, 0.f, 0.f};
#pragma unroll
        for (int ai = 0; ai < 2; ++ai)
#pragma unroll
            for (int m = 0; m < 4; ++m) { bf16* rowp = O + (size_t)(row0 + ai * HALF + m * 16) * ldc + col0;
#pragma unroll
                for (int bj = 0; bj < 2; ++bj) { const f32x4 v0 = acc[ai][bj][m][0] * scale + bv[bj][0], v1 = acc[ai][bj][m][1] * scale + bv[bj][1];
                    u32x4 w; w.x = cvt_pk_bf16(v0[0], v0[1]); w.y = cvt_pk_bf16(v0[2], v0[3]); w.z = cvt_pk_bf16(v1[0], v1[1]); w.w = cvt_pk_bf16(v1[2], v1[3]);
                    *(u32x4*)(rowp + bj * HALF) = w; } }
    }
};
struct EpiFp8 {
    static constexpr bool PERM = true, SWZ = false;
    unsigned char* O; int ldc; const float* bias; int bias_stride; float scale;
    __device__ __forceinline__ const float* bias_src(const Unit& u) const { return bias + (size_t)u.e * bias_stride + u.pn * BM; }
    __device__ __forceinline__ void operator()(const f32x4 (&acc)[2][2][4][2], const Unit& u, int wr, int wc, int fr, int fq, const LAS float* bl) const {
        const int row0 = u.pm * BM + wr * 64 + fr, col0 = u.pn * BM + wc * 32 + 8 * fq;
        f32x4 bv[2][2];
#pragma unroll
        for (int bj = 0; bj < 2; ++bj)
#pragma unroll
            for (int n = 0; n < 2; ++n) bv[bj][n] = *(const LAS f32x4*)(bl + wc * 32 + 8 * fq + bj * HALF + 4 * n) * Y_SCALE;
        const float sc = scale * Y_SCALE;
#pragma unroll
        for (int ai = 0; ai < 2; ++ai)
#pragma unroll
            for (int m = 0; m < 4; ++m) { unsigned char* rowp = O + (size_t)(row0 + ai * HALF + m * 16) * ldc + col0;
#pragma unroll
                for (int bj = 0; bj < 2; ++bj) { const f32x4 v0 = acc[ai][bj][m][0] * sc + bv[bj][0], v1 = acc[ai][bj][m][1] * sc + bv[bj][1];
                    *(u32x2*)(rowp + bj * HALF) = (u32x2){pk4_fp8(v0[0], v0[1], v0[2], v0[3]), pk4_fp8(v1[0], v1[1], v1[2], v1[3])}; } }
    }
};
__device__ __forceinline__ f32x2 swiglu2(f32x2 glu, f32x2 lin) {
    const f32x2 g = (f32x2){fminf(glu.x, 7.0f), fminf(glu.y, 7.0f)}, l = (f32x2){__builtin_amdgcn_fmed3f(lin.x, -7.0f, 7.0f), __builtin_amdgcn_fmed3f(lin.y, -7.0f, 7.0f)};
    const f32x2 ea = g * (-1.702f * 1.4426950408889634f);
    const f32x2 den = (f32x2){__builtin_amdgcn_exp2f(ea.x), __builtin_amdgcn_exp2f(ea.y)} + 1.0f;
    const f32x2 r = (f32x2){__builtin_amdgcn_rcpf(den.x), __builtin_amdgcn_rcpf(den.y)};
    return (g * r) * (l * ACT_SCALE + ACT_SCALE);
}
struct EpiSwiglu {
    static constexpr bool PERM = true, SWZ = true;
    unsigned char* O; int ldc; const float* bias; int bias_stride;
    __device__ __forceinline__ const float* bias_src(const Unit& u) const { return bias + (size_t)u.e * bias_stride + u.pn * BM; }
    __device__ __forceinline__ void operator()(const f32x4 (&acc)[2][2][4][2], const Unit& u, int wr, int wc, int fr, int fq, const LAS float* bl) const {
        const int row0 = u.pm * BM + wr * 64 + fr, col0 = u.pn * BM + wc * 32 + 8 * fq, ocol0 = col0 >> 1;
        f32x4 bv[2][2];
#pragma unroll
        for (int bj = 0; bj < 2; ++bj)
#pragma unroll
            for (int n = 0; n < 2; ++n) { const f32x4 t = *(const LAS f32x4*)(bl + wc * 32 + 8 * fq + bj * HALF + 4 * n); bv[bj][n] = (f32x4){t[0], t[2], t[1], t[3]}; }
#pragma unroll
        for (int ai = 0; ai < 2; ++ai)
#pragma unroll
            for (int m = 0; m < 4; ++m) { unsigned char* rowp = O + (size_t)(row0 + ai * HALF + m * 16) * ldc + ocol0;
#pragma unroll
                for (int bj = 0; bj < 2; ++bj) { const f32x4 v0 = acc[ai][bj][m][0] * (1.0f / W_SCALE) + bv[bj][0], v1 = acc[ai][bj][m][1] * (1.0f / W_SCALE) + bv[bj][1];
                    const f32x2 o0 = swiglu2((f32x2){v0[0], v0[1]}, (f32x2){v0[2], v0[3]}), o1 = swiglu2((f32x2){v1[0], v1[1]}, (f32x2){v1[2], v1[3]});
                    *(unsigned*)(rowp + bj * (HALF / 2)) = pk4_fp8(o0.x, o0.y, o1.x, o1.y); } }
    }
};

template <bool F8, class Epi, class Sched, class AMap>
__device__ __forceinline__ void gemm_phase(LAS unsigned char* lds, const Gemm g, const Sched& S, const Epi& E, const AMap& AM) {
    const int tid = threadIdx.x, wid = __builtin_amdgcn_readfirstlane(tid >> 6), lane = tid & 63, wr = wid >> 2, wc = wid & 3, fr = lane & 15, fq = lane >> 4;
    const int K = g.K, nt = K / BK;
    unsigned voffB[2];
#pragma unroll
    for (int i = 0; i < 2; ++i) { int R, C; stage_rc(tid * 16 + i * 8192, R, C); int Rb = Epi::PERM ? ((R & ~31) + perm32(R & 31)) : R; if constexpr (Epi::SWZ) Rb = (Rb & ~3) | ((Rb & 1) << 1) | ((Rb >> 1) & 1);
        voffB[i] = (unsigned)(Rb * K + C) * 2u; }
    unsigned vA0[2], vA1[2], nA0[2], nA1[2];
#define PG8_AOFF(u, o0, o1) do { int _t = tid; asm volatile("" : "+v"(_t));   _Pragma("unroll") for (int _i = 0; _i < 2; ++_i) { int _R, _C; stage_rc(_t * 16 + _i * 8192, _R, _C); \
        o0[_i] = AM.lane_off(u, 0, _R, K) + (unsigned)_C * 2u; o1[_i] = AM.lane_off(u, 1, _R, K) + (unsigned)_C * 2u; } } while (0)
    const size_t kstep = (size_t)(BK * 2);
    const size_t hstep = (size_t)HALF * K * 2;
    const size_t tstep = 2 * hstep;
    const unsigned ldsw = (unsigned)wid * 1024u;
    const int aoff = lds_byte(wr * 64 + fr, fq * 8), boff = lds_byte(wc * 32 + fr, fq * 8);
#define PG8_SA(b, h) (((b) * 2 + (h)) * HTB)
#define PG8_SB(b, h) ((4 + (b) * 2 + (h)) * HTB)
#define PG8_STAGE(bufoff, gbase, voff) do { _Pragma("unroll") for (int _i = 0; _i < 2; ++_i) \
        __builtin_amdgcn_global_load_lds((const unsigned*)((const char*)(gbase) + (voff)[_i]), (LAS unsigned*)(lds + (bufoff) + ldsw + _i * 8192), 16, 0, 0); } while (0)
#define PG8_LDA(dst, b, h) do { _Pragma("unroll") for (int m = 0; m < 4; ++m) { const i32x4 _lo = *(const LAS i32x4*)(lds + PG8_SA(b, h) + aoff + m * 2048), _hi = *(const LAS i32x4*)(lds + PG8_SA(b, h) + aoff + m * 2048 + 1024); \
        dst[m] = __builtin_shufflevector(_lo, _hi, 0, 1, 2, 3, 4, 5, 6, 7); } } while (0)
#define PG8_LDB(dst, b, h) do { _Pragma("unroll") for (int n = 0; n < 2; ++n) { const i32x4 _lo = *(const LAS i32x4*)(lds + PG8_SB(b, h) + boff + n * 2048), _hi = *(const LAS i32x4*)(lds + PG8_SB(b, h) + boff + n * 2048 + 1024); \
        dst[n] = __builtin_shufflevector(_lo, _hi, 0, 1, 2, 3, 4, 5, 6, 7); } } while (0)
#define PG8_LO(x) __builtin_bit_cast(bf16x8, __builtin_shufflevector(x, x, 0, 1, 2, 3))
#define PG8_HI(x) __builtin_bit_cast(bf16x8, __builtin_shufflevector(x, x, 4, 5, 6, 7))
#define PG8_MMA(ai, bj, At, Bt) do { __builtin_amdgcn_s_setprio(1); _Pragma("unroll") for (int m = 0; m < 4; ++m) _Pragma("unroll") for (int n = 0; n < 2; ++n) { \
        if constexpr (F8) asm volatile("v_mfma_scale_f32_16x16x128_f8f6f4 %0, %1, %2, %0, %3, %3 op_sel_hi:[0,0,0]" : "+v"(acc[ai][bj][m][n]) : "v"(Bt[n]), "v"(At[m]), "v"(f8scale)); \
        else { acc[ai][bj][m][n] = __builtin_amdgcn_mfma_f32_16x16x32_bf16(PG8_LO(Bt[n]), PG8_LO(At[m]), acc[ai][bj][m][n], 0, 0, 0); \
               acc[ai][bj][m][n] = __builtin_amdgcn_mfma_f32_16x16x32_bf16(PG8_HI(Bt[n]), PG8_HI(At[m]), acc[ai][bj][m][n], 0, 0, 0); } } \
        __builtin_amdgcn_s_setprio(0); } while (0)
#define PG8_WAIT_V(n) asm volatile("s_waitcnt vmcnt(" #n ")" ::: "memory")
#define PG8_WAIT_L(n) asm volatile("s_waitcnt lgkmcnt(" #n ")" ::: "memory")
#define PG8_BAR __builtin_amdgcn_s_barrier()
#define PG8_SCHED __builtin_amdgcn_sched_barrier(0)
    Unit cur, nxt; int ui = 0;
    if (!S.next(0, cur)) return;
    f32x4 acc[2][2][4][2];
#pragma unroll
    for (int a = 0; a < 2; ++a)
#pragma unroll
        for (int b = 0; b < 2; ++b)
#pragma unroll
            for (int m = 0; m < 4; ++m)
#pragma unroll
                for (int n = 0; n < 2; ++n) acc[a][b][m][n] = (f32x4){0.f, 0.f, 0.f, 0.f};
    i32x8 At[4], B0[2], B1[2];
    int f8scale = 0x7F7F7F7F; asm volatile("" : "+v"(f8scale));
    LAS float* const biasl = (LAS float*)(lds + STAGE_BYTES);
#define PG8_BIAS(u, slot) do { const float* _bs = E.bias_src(u); if (_bs != nullptr && wid == 0) { int _ln = lane; asm volatile("" : "+v"(_ln));     \
        __builtin_amdgcn_global_load_lds((const unsigned*)(_bs + _ln * 4), (LAS unsigned*)(biasl + (slot) * 256), 16, 0, 0); } } while (0)
    PG8_BIAS(cur, 0);
    const char* cA0 = (const char*)g.A + AM.ubase(cur, 0, K); const char* cA1 = (const char*)g.A + AM.ubase(cur, 1, K); const char* cB = (const char*)g.Bt + (size_t)cur.pb * tstep;
    PG8_AOFF(cur, vA0, vA1);
    PG8_STAGE(PG8_SB(0, 0), cB, voffB); PG8_STAGE(PG8_SB(0, 1), cB + hstep, voffB); PG8_STAGE(PG8_SA(0, 0), cA0, vA0); PG8_STAGE(PG8_SA(0, 1), cA1, vA1);
    if (wr == 1) PG8_BAR;
    PG8_WAIT_V(2); PG8_BAR;
    PG8_STAGE(PG8_SB(1, 0), cB + kstep, voffB); PG8_STAGE(PG8_SA(1, 0), cA0 + kstep, vA0); PG8_STAGE(PG8_SB(1, 1), cB + hstep + kstep, voffB);
    PG8_WAIT_V(6); PG8_BAR;
    for (;;) {
        const bool has_next = S.next(ui + 1, nxt);
        const char* nB = has_next ? (const char*)g.Bt + (size_t)nxt.pb * tstep : cB;
        const char* nxA0 = has_next ? (const char*)g.A + AM.ubase(nxt, 0, K) : cA0; const char* nxA1 = has_next ? (const char*)g.A + AM.ubase(nxt, 1, K) : cA1;
        if (has_next) { PG8_AOFF(nxt, nA0, nA1); PG8_BIAS(nxt, (ui + 1) & 1); } else { nA0[0] = vA0[0]; nA0[1] = vA0[1]; nA1[0] = vA1[0]; nA1[1] = vA1[1]; }
#pragma unroll 1
        for (int t = 0; t < nt; t += 2) {
            const bool last = (t == nt - 2);
            const char* a1 = cA1 + (size_t)(t + 1) * kstep;
            const char* a2 = last ? nxA0 : cA0 + (size_t)(t + 2) * kstep; const char* a2h = last ? nxA1 : cA1 + (size_t)(t + 2) * kstep; const char* b2 = last ? nB : cB + (size_t)(t + 2) * kstep;
            const char* a3 = a2 + kstep; const char* b3 = b2 + kstep;
            unsigned w0[2], w1[2];
            w0[0] = last ? nA0[0] : vA0[0]; w0[1] = last ? nA0[1] : vA0[1]; w1[0] = last ? nA1[0] : vA1[0]; w1[1] = last ? nA1[1] : vA1[1];
            PG8_LDB(B0, 0, 0); PG8_LDB(B1, 0, 1); PG8_SCHED; PG8_LDA(At, 0, 0); PG8_STAGE(PG8_SA(1, 1), a1, vA1);
            PG8_WAIT_V(8); PG8_WAIT_L(0); PG8_BAR; PG8_MMA(0, 0, At, B0); PG8_MMA(0, 1, At, B1); PG8_BAR; PG8_SCHED;
            PG8_LDA(At, 0, 1); PG8_STAGE(PG8_SB(0, 0), b2, voffB); PG8_STAGE(PG8_SB(0, 1), b2 + hstep, voffB); PG8_STAGE(PG8_SA(0, 0), a2, w0);
            PG8_WAIT_V(8); PG8_WAIT_L(0); PG8_BAR; PG8_MMA(1, 0, At, B0); PG8_MMA(1, 1, At, B1); PG8_BAR; PG8_SCHED;
            PG8_LDB(B0, 1, 0); PG8_LDB(B1, 1, 1); PG8_SCHED; PG8_LDA(At, 1, 0); PG8_STAGE(PG8_SA(0, 1), a2h, w1);
            PG8_WAIT_V(8); PG8_WAIT_L(0); PG8_BAR; PG8_MMA(0, 0, At, B0); PG8_MMA(0, 1, At, B1); PG8_BAR; PG8_SCHED;
            PG8_LDA(At, 1, 1); PG8_STAGE(PG8_SB(1, 0), b3, voffB); PG8_STAGE(PG8_SB(1, 1), b3 + hstep, voffB); PG8_STAGE(PG8_SA(1, 0), a3, w0);
            PG8_WAIT_V(8); PG8_WAIT_L(0); PG8_BAR; PG8_MMA(1, 0, At, B0); PG8_MMA(1, 1, At, B1); PG8_BAR; PG8_SCHED;
        }
        if (wr == 0) PG8_BAR;
        if constexpr (F8) asm volatile("s_nop 15\n\ts_nop 15" ::: "memory");
        { int ln_e = lane; asm volatile("" : "+v"(ln_e));
          E(acc, cur, wr, wc, ln_e & 15, ln_e >> 4, biasl + (ui & 1) * 256); }
        if (!has_next) break;
#pragma unroll
        for (int a = 0; a < 2; ++a)
#pragma unroll
            for (int b = 0; b < 2; ++b)
#pragma unroll
                for (int m = 0; m < 4; ++m)
#pragma unroll
                    for (int n = 0; n < 2; ++n) acc[a][b][m][n] = (f32x4){0.f, 0.f, 0.f, 0.f};
        cur = nxt; cB = nB; cA0 = nxA0; cA1 = nxA1; ++ui; vA0[0] = nA0[0]; vA0[1] = nA0[1]; vA1[0] = nA1[0]; vA1[1] = nA1[1];
        if (wr == 1) PG8_BAR;
    }
    PG8_WAIT_V(0);
    PG8_BAR;
#undef PG8_AOFF
#undef PG8_BIAS
#undef PG8_SA
#undef PG8_SB
#undef PG8_STAGE
#undef PG8_LDA
#undef PG8_LDB
#undef PG8_MMA
#undef PG8_LO
#undef PG8_HI
#undef PG8_WAIT_V
#undef PG8_WAIT_L
#undef PG8_BAR
#undef PG8_SCHED
}
}

#define XB_TMO      128
#define XB_XCNT(j)  (256  + 64 * (j))
#define XB_XSUB(j)  (1280 + 64 * (j))
#define XB_XGEN(j)  (2304 + 64 * (j))
#define XB_TOP      3328
#define XB_TOPGEN   3392
#define XCD_BAR_WORDS 3456
#define XB_SPIN_CAP (1u << 22)
__device__ __forceinline__ unsigned xb_ld(unsigned* p)              { return __hip_atomic_load(p, __ATOMIC_RELAXED, __HIP_MEMORY_SCOPE_AGENT); }
__device__ __forceinline__ unsigned xb_add(unsigned* p, unsigned v) { return __hip_atomic_fetch_add(p, v, __ATOMIC_RELAXED, __HIP_MEMORY_SCOPE_AGENT); }
__device__ __forceinline__ unsigned xb_xcc_id() { return (unsigned)__builtin_amdgcn_s_getreg((3 << 11) | 20) & 0xFu; }
#define XB_SPIN(cond, bar) do { unsigned _sp = 0; while (cond) { __builtin_amdgcn_s_sleep(1); \
    if ((++_sp & 255u) == 0u) { if (xb_ld(&(bar)[XB_TMO])) break; if (_sp > XB_SPIN_CAP) { atomicAdd(&(bar)[XB_TMO], 1u); break; } } } } while (0)
struct XcdBarrier { unsigned* bar; unsigned x; volatile LAS unsigned* st; };
__device__ __forceinline__ XcdBarrier xcd_barrier_post(unsigned* bar, volatile LAS unsigned* st) {
    XcdBarrier b; b.bar = bar; b.x = xb_xcc_id(); b.st = st;
    if (threadIdx.x == 0) (void)xb_add(&bar[XB_XCNT(b.x)], 1u);
    return b;
}
__device__ __forceinline__ void xcd_barrier_complete(unsigned* bar, unsigned x, unsigned& nloc, unsigned& nx) {
    const unsigned G = gridDim.x * gridDim.y * gridDim.z;
    unsigned sum, cnt, mine, sp = 0u;
    for (;;) {
        sum = 0u; cnt = 0u; mine = 0u;
#pragma unroll
        for (unsigned j = 0; j < 16; ++j) { const unsigned c = xb_ld(&bar[XB_XCNT(j)]); sum += c; cnt += (c > 0u) ? 1u : 0u; mine = (j == x) ? c : mine; }
        if (sum == G) break;
        __builtin_amdgcn_s_sleep(1);
        if ((++sp & 255u) == 0u) { if (xb_ld(&bar[XB_TMO])) break; if (sp > XB_SPIN_CAP) { atomicAdd(&bar[XB_TMO], 1u); break; } }
    }
    nloc = mine > 0u ? mine : 1u; nx = cnt > 0u ? cnt : 1u;
}
struct NoWork { __device__ __forceinline__ void operator()() const {} };
template <class F = NoWork> __device__ __forceinline__ void xcd_barrier(const XcdBarrier& b, F work = F{}) {
    asm volatile("s_waitcnt vmcnt(0)" ::: "memory");
    __syncthreads();
    if (threadIdx.x >= 64) work();
    if (threadIdx.x == 0) {
        unsigned* bar = b.bar;
        __builtin_amdgcn_s_waitcnt(0);
        unsigned nloc = b.st[0], nx = b.st[1];
        if (nloc == 0u) { xcd_barrier_complete(bar, b.x, nloc, nx); b.st[0] = nloc; b.st[1] = nx; }
        const unsigned old = xb_add(&bar[XB_XSUB(b.x)], 1u);
        const unsigned gen = old / nloc;
        if (old + 1u == (gen + 1u) * nloc) {
            __builtin_amdgcn_fence(__ATOMIC_RELEASE, "agent");
            asm volatile("s_waitcnt vmcnt(0)" ::: "memory");
            const unsigned og = xb_add(&bar[XB_TOP], 1u);
            const unsigned tg = og / nx;
            if (og + 1u == (tg + 1u) * nx) xb_add(&bar[XB_TOPGEN], 1u);
            else XB_SPIN(xb_ld(&bar[XB_TOPGEN]) == tg, bar);
            __builtin_amdgcn_fence(__ATOMIC_ACQUIRE, "agent");
            xb_add(&bar[XB_XGEN(b.x)], 1u);
            asm volatile("s_waitcnt vmcnt(0)" ::: "memory");
        } else {
            XB_SPIN(xb_ld(&bar[XB_XGEN(b.x)]) == gen, bar);
            __builtin_amdgcn_fence(__ATOMIC_ACQUIRE, "agent");
            asm volatile("s_waitcnt vmcnt(0)" ::: "memory");
        }
    }
    __syncthreads();
}

struct Args {
    const float *x, *c, *ctx, *c_ctx, *ada_w, *ada_b, *mix_pre, *mix_post, *w_in, *w_out, *conv_w, *conv_b, *dt_bias, *a_log, *ssd_d, *ssd_norm,
                *hg_lb, *hg_norm, *ffn_pre, *ffn_post, *router_w, *router_b, *w1, *b1, *w2, *b2;
    float* out; unsigned char* ws; int ph_lo, ph_hi;
};

typedef const Args __attribute__((address_space(4))) CArgs;
struct Ctx { LAS unsigned char* lds; int tid, lane, wave, vcu, G, gw, NGW; };

__device__ __forceinline__ void transpose_item(const float* W, int ldw, int K, bf16* WT, int dst_row0, int nblk, LAS float* scr, int item, int lane) {
    const int kb = item / nblk, nb = item % nblk, k0 = 64 * kb, n0 = 32 * nb;
    float ld[32];
#pragma unroll
    for (int i = 0; i < 32; ++i) ld[i] = W[(size_t)(k0 + 2 * i + (lane >> 5)) * ldw + n0 + (lane & 31)];
#pragma unroll
    for (int i = 0; i < 32; ++i) scr[(2 * i + (lane >> 5)) * 33 + (lane & 31)] = ld[i];
    LDS_WAIT(); asm volatile("" ::: "memory");
    const int c = lane & 7;
#pragma unroll
    for (int j = 0; j < 4; ++j) { const int n = (lane >> 3) + 8 * j; const LAS float* s = scr + (8 * c) * 33 + n;
        u32x4 o; o.x = cvt_pk_bf16(s[0 * 33], s[1 * 33]); o.y = cvt_pk_bf16(s[2 * 33], s[3 * 33]); o.z = cvt_pk_bf16(s[4 * 33], s[5 * 33]); o.w = cvt_pk_bf16(s[6 * 33], s[7 * 33]);
        *(u32x4*)(WT + (size_t)(dst_row0 + n0 + n) * K + k0 + 8 * c) = o; }
    LDS_WAIT(); asm volatile("" ::: "memory");
}
__device__ __forceinline__ void transpose_item_f8(const float* W, int ldw, int K, unsigned char* WT, int nblk, LAS float* scr, int item, int lane, float scale) {
    const int kb = item / nblk, nb = item % nblk, k0 = 64 * kb, n0 = 32 * nb;
    float ld[32];
#pragma unroll
    for (int i = 0; i < 32; ++i) ld[i] = __builtin_nontemporal_load(&W[(size_t)(k0 + 2 * i + (lane >> 5)) * ldw + n0 + (lane & 31)]);
#pragma unroll
    for (int i = 0; i < 32; ++i) scr[(2 * i + (lane >> 5)) * 33 + (lane & 31)] = ld[i] * scale;
    LDS_WAIT(); asm volatile("" ::: "memory");
    const int c = lane & 7;
#pragma unroll
    for (int j = 0; j < 4; ++j) { const int n = (lane >> 3) + 8 * j; const LAS float* sp = scr + (8 * c) * 33 + n;
        u32x2 o; o.x = pk4_fp8(sp[0 * 33], sp[1 * 33], sp[2 * 33], sp[3 * 33]); o.y = pk4_fp8(sp[4 * 33], sp[5 * 33], sp[6 * 33], sp[7 * 33]);
        *(u32x2*)(WT + (size_t)(n0 + n) * K + k0 + 8 * c) = o; }
    LDS_WAIT(); asm volatile("" ::: "memory");
}
__device__ __forceinline__ void phase0(CArgs& a, const Ctx& C) {
    LAS float* scr = (LAS float*)(C.lds + C.wave * 16384);
    bf16* WINT = (bf16*)(a.ws + WS_WINT); bf16* WOUTT = (bf16*)(a.ws + WS_WOUTT);
    float* MODP = (float*)(a.ws + WS_MODP);
    constexpr int I_GEMV = 96 * 32, I_INA = 16 * 40, I_INB = 16 * 80, I_OUT = 16 * 32;
    constexpr int NITEMS = I_GEMV + I_INA + I_INB + I_OUT;
    for (int it = C.gw; it < NITEMS; it += C.NGW) {
        int r = it;
        if (r < I_GEMV) {
            const int cg = r % 96, ks = r / 96, col = 64 * cg + C.lane, k0 = 32 * ks;
            float sv[5];
            { const int kk = C.lane & 31;
#pragma unroll
              for (int b = 0; b < 4; ++b) sv[b] = siluf(a.c[b * D + k0 + kk]);
              sv[4] = siluf(a.c_ctx[k0 + kk]); }
            float acc[5] = {0.f, 0.f, 0.f, 0.f, 0.f};
            float wv_[32];
#pragma unroll
            for (int kk = 0; kk < 32; ++kk) wv_[kk] = __builtin_nontemporal_load(&a.ada_w[(size_t)(k0 + kk) * 6144 + col]);
#pragma unroll
            for (int kk = 0; kk < 32; ++kk) {
#pragma unroll
                for (int b = 0; b < 5; ++b) acc[b] += __builtin_bit_cast(float, __builtin_amdgcn_readlane(__builtin_bit_cast(int, sv[b]), kk)) * wv_[kk]; }
#pragma unroll
            for (int b = 0; b < 5; ++b) MODP[(size_t)(ks * 5 + b) * 6144 + col] = acc[b];
            continue;
        }
        r -= I_GEMV;
        if (r < I_INA) { transpose_item(a.w_in, W_IN_COLS, D, WINT, 0, 40, scr, r, C.lane); continue; } r -= I_INA;
        if (r < I_INB) { transpose_item(a.w_in + 1296, W_IN_COLS, D, WINT, 1280, 80, scr, r, C.lane); continue; } r -= I_INB;
        transpose_item(a.w_out, D, D, WOUTT, 0, 32, scr, r, C.lane);
    }
}
#ifndef CONV_SH
#define CONV_SH 2
#endif
constexpr int NIT1 = 32 * 16 * 64, NIT2 = 32 * 16 * 32, CONV_B = 256 * 7 * CONV_SH;
constexpr int CONV_SH_END = 7 * CONV_B;
constexpr int CONV_W1_HOST = CONV_SH_END < NIT1 ? CONV_SH_END : NIT1;
constexpr int CONV_P4N = 2, CONV_P4 = (NIT1 - CONV_W1_HOST >= 208 * 8 * CONV_P4N) ? 208 * 8 * CONV_P4N : 0;
constexpr int CONV_S9 = CONV_SH_END > NIT1 ? CONV_SH_END : NIT1;
__device__ __forceinline__ void conv_item(CArgs& a, LAS float* scr, int lane, int it) {
    const bool w1 = it < NIT1; const int r = w1 ? it : it - NIT1, per = w1 ? 16 * 64 : 16 * 32, e = r / per, ri = r % per;
    const float* W = w1 ? a.w1 + (size_t)e * D * 2048 : a.w2 + (size_t)e * D * D; unsigned char* WT = w1 ? a.ws + WS_W1T + (size_t)e * 2048 * D : a.ws + WS_W2T + (size_t)e * D * D;
    transpose_item_f8(W, w1 ? 2048 : D, D, WT, w1 ? 64 : 32, scr, ri, lane, W_SCALE);
}
__device__ __forceinline__ void conv_range(CArgs& a, const Ctx& C, int lo, int hi) {
    LAS float* scr = (LAS float*)(C.lds + C.wave * 16384);
#pragma unroll 1
    for (int it = lo + C.gw; it < hi; it += C.NGW) conv_item(a, scr, C.lane, it);
}
__device__ __forceinline__ void conv_shadow(CArgs& a, const Ctx& C, int first, LAS unsigned char* scr_base, int scr_stride) {
    LAS float* scr = (LAS float*)(scr_base + (C.wave - 1) * scr_stride);
    const int it0 = first + (C.vcu * 7 + (C.wave - 1)) * CONV_SH;
#pragma unroll 1
    for (int j = 0; j < CONV_SH; ++j) if (it0 + j < NIT1 + NIT2) conv_item(a, scr, C.lane, it0 + j);
}
__device__ __forceinline__ void phase1(CArgs& a, const Ctx& C) {
    const float* MODP = (const float*)(a.ws + WS_MODP); float* MOD = (float*)(a.ws + WS_MOD);
    for (int i = C.vcu * 512 + C.tid; i < 5 * 6144; i += C.G * 512) {
        const int col = i % 6144, b = i / 6144; float s = a.ada_b[col];
#pragma unroll 8
        for (int ks = 0; ks < 32; ++ks) s += MODP[(size_t)(ks * 5 + b) * 6144 + col];
        MOD[i] = s;
    }
}
template <int N, int O> struct RS { template <int M> static __device__ __forceinline__ void run(float (&v)[M], int lane) {
    const bool up = (lane & O) != 0;
#pragma unroll
    for (int i = 0; i < N / 2; ++i) {
        if constexpr (O == 32) v[i] = swap32_add(v[i], v[i + N / 2]);
        else if constexpr (O == 16) v[i] = swap16_add(v[i], v[i + N / 2]);
        else { const float keep = up ? v[i + N / 2] : v[i], send = up ? v[i] : v[i + N / 2]; v[i] = keep + dppf<O == 8 ? DPP_MIR : DPP_HMIR>(send); } }
    static_assert(O >= 4, "exchange distances 2 and 1 would need a quad_perm pairing here");
    RS<N / 2, O / 2>::run(v, lane); } };
template <int O> struct RS<1, O> { template <int M> static __device__ __forceinline__ void run(float (&v)[M], int) {
    if constexpr (O == 32) v[0] = swap32_add(v[0], v[0]); else if constexpr (O == 16) v[0] = swap16_add(v[0], v[0]);
    else v[0] += dppf<O == 8 ? DPP_MIR : (O == 4 ? DPP_HMIR : (O == 2 ? DPP_X2 : DPP_X1))>(v[0]);
    RS<1, O / 2>::run(v, 0); } };
template <> struct RS<1, 0> { template <int M> static __device__ __forceinline__ void run(float (&)[M], int) {} };
template <int N> __device__ __forceinline__ void reduce_scatter(float (&v)[N], int lane) { RS<N, 32>::run(v, lane); }
__device__ __forceinline__ void phase2_fill(CArgs& a, const Ctx& C, int t0, int nt) {
    LAS f32x4* WD = (LAS f32x4*)C.lds;
    for (int idx = t0; idx < 16 * 4 * 64; idx += nt) { const int ln = idx & 63, cg = (idx >> 6) & 3, je = idx >> 8, j = je >> 3, e = je & 7, k = 8 * ln + 512 * j + e;
        WD[idx] = *(const f32x4*)(a.w_in + (size_t)k * W_IN_COLS + 1280 + 4 * cg); }
}
__device__ __forceinline__ void phase2(CArgs& a, const Ctx& C, bool prefilled, f32x4 (&px)[2][4]) {
    const float* MOD = (const float*)(a.ws + WS_MOD); bf16* XN = (bf16*)(a.ws + WS_XN); float* DTRAW = (float*)(a.ws + WS_DTRAW);
    LAS f32x4* WD = (LAS f32x4*)C.lds;
    const int rbase = (MROWS / 256) * C.vcu; constexpr int NPAIR = MROWS / 256 / 2;
    f32x4 nx[2][2][2];
    if (prefilled && C.wave != 0) {
#pragma unroll
      for (int r = 0; r < 2; ++r)
#pragma unroll
        for (int j = 0; j < 2; ++j) { nx[r][j][0] = px[r][2 * j]; nx[r][j][1] = px[r][2 * j + 1]; }
    } else { const int m = rbase + 2 * C.wave;
#pragma unroll
      for (int r = 0; r < 2; ++r) { const int mr = m + r; const float* xrow = mr < NLAT ? a.x + (size_t)mr * D : a.ctx + (size_t)(mr - NLAT) * D;
#pragma unroll
        for (int j = 0; j < 2; ++j) { nx[r][j][0] = NTLOAD((const f32x4*)(xrow + 8 * C.lane + 512 * j)); nx[r][j][1] = NTLOAD((const f32x4*)(xrow + 8 * C.lane + 512 * j + 4)); } } }
    if (!prefilled) phase2_fill(a, C, C.tid, 512);
    __syncthreads();
#pragma unroll 1
    for (int p = C.wave; p < NPAIR; p += 8) {
        const int m = rbase + 2 * p, b = m < NLAT ? (m >> 12) : 4;
        const float* sh = MOD + b * 6144, *sc = sh + 1024;
        float h[2][2][8]; float ss[2] = {0.f, 0.f};
#pragma unroll
        for (int r = 0; r < 2; ++r)
#pragma unroll
            for (int j = 0; j < 2; ++j) { const f32x4 v0 = nx[r][j][0], v1 = nx[r][j][1];
#pragma unroll
                for (int e = 0; e < 4; ++e) { h[r][j][e] = v0[e]; h[r][j][4 + e] = v1[e]; ss[r] += v0[e] * v0[e] + v1[e] * v1[e]; } }
        { const int m2 = p + 8 < NPAIR ? m + 16 : m;
#pragma unroll
          for (int r = 0; r < 2; ++r) { const int mr = m2 + r; const float* xrow = mr < NLAT ? a.x + (size_t)mr * D : a.ctx + (size_t)(mr - NLAT) * D;
#pragma unroll
            for (int j = 0; j < 2; ++j) { nx[r][j][0] = NTLOAD((const f32x4*)(xrow + 8 * C.lane + 512 * j)); nx[r][j][1] = NTLOAD((const f32x4*)(xrow + 8 * C.lane + 512 * j + 4)); } } }
        const float rstd[2] = {rsqrtf(wave_sum(ss[0]) * (1.0f / D) + EPS), rsqrtf(wave_sum(ss[1]) * (1.0f / D) + EPS)};
#pragma unroll
        for (int j = 0; j < 2; ++j) { const int k0 = 8 * C.lane + 512 * j;
#pragma unroll
            for (int e4 = 0; e4 < 2; ++e4) { const f32x4 w = *(const f32x4*)(a.mix_pre + k0 + 4 * e4), s1 = *(const f32x4*)(sc + k0 + 4 * e4), s0 = *(const f32x4*)(sh + k0 + 4 * e4);
#pragma unroll
                for (int r = 0; r < 2; ++r)
#pragma unroll
                    for (int e = 0; e < 4; ++e) h[r][j][4 * e4 + e] = h[r][j][4 * e4 + e] * rstd[r] * w[e] * (1.0f + s1[e]) + s0[e]; }
#pragma unroll
            for (int r = 0; r < 2; ++r) { u32x4 o; o.x = cvt_pk_bf16(h[r][j][0], h[r][j][1]); o.y = cvt_pk_bf16(h[r][j][2], h[r][j][3]); o.z = cvt_pk_bf16(h[r][j][4], h[r][j][5]); o.w = cvt_pk_bf16(h[r][j][6], h[r][j][7]);
                *(u32x4*)(XN + (size_t)(m + r) * D + k0) = o; } }
        float acc0[16], acc1[16];
#pragma unroll
        for (int i = 0; i < 16; ++i) { acc0[i] = 0.f; acc1[i] = 0.f; }
#pragma unroll
        for (int j = 0; j < 2; ++j)
#pragma unroll
            for (int e = 0; e < 8; ++e)
#pragma unroll
                for (int cg = 0; cg < 4; ++cg) { const f32x4 w = WD[((j * 8 + e) * 4 + cg) * 64 + C.lane];
#pragma unroll
                    for (int i = 0; i < 4; ++i) { acc0[4 * cg + i] += h[0][j][e] * w[i]; acc1[4 * cg + i] += h[1][j][e] * w[i]; }
                    if (cg == 3 && (e & 1)) asm volatile("" ::: "memory"); }
        reduce_scatter<16>(acc0, C.lane); reduce_scatter<16>(acc1, C.lane);
        if ((C.lane & 3) == 0) { DTRAW[(size_t)m * 16 + (C.lane >> 2)] = acc0[0]; DTRAW[(size_t)(m + 1) * 16 + (C.lane >> 2)] = acc1[0]; }
    }
}
__device__ __forceinline__ void prep_ssd_unit(CArgs& a, const Ctx& C, int unit) {
    const bf16* U = (const bf16*)(a.ws + WS_U); const float* DTRAW = (const float*)(a.ws + WS_DTRAW);
    bf16* BC = (bf16*)(a.ws + WS_BC); bf16* XST = (bf16*)(a.ws + WS_XST);
    float* GA = (float*)(a.ws + WS_GA); float* DTA = (float*)(a.ws + WS_DTA); float* GEND = (float*)(a.ws + WS_GEND); u32x2* DSS = (u32x2*)(a.ws + WS_DSS);
    const int b = unit / NCH, tc = unit % NCH, s0 = 64 * tc; const bool isctx = tc < 4;
    const int rowbase = isctx ? NLAT + b * CTXL + s0 : b * SEQ + (s0 - CTXL);
    const int ilo = isctx ? -s0 : CTXL - s0, ihi = isctx ? CTXL - s0 : SP - s0;
    LAS float* dtl = (LAS float*)C.lds; LAS float* al = dtl + 1024; LAS float* wl = al + 1024;
    LAS bf16* XTl = (LAS bf16*)(C.lds + 12288);
    int ltid = C.tid; asm volatile("" : "+v"(ltid));
    const int ch0 = 2 * ltid;
    float dtraw_[2], dtb_[2], alog_[2];
#pragma unroll
    for (int pi = 0; pi < 2; ++pi) { const int dh = 2 * C.wave + pi; dtraw_[pi] = DTRAW[(size_t)(rowbase + C.lane) * 16 + dh]; dtb_[pi] = a.dt_bias[dh]; alog_[pi] = a.a_log[dh]; }
    unsigned uw[68];
    if (C.tid < 384) { const bf16* up = U + (size_t)rowbase * NU + 512 + ch0;
#pragma unroll
        for (int t = 0; t < 68; ++t) { const int i = t - 2; uw[t] = (i >= ilo && i < ihi) ? *(const unsigned*)(up + (ptrdiff_t)i * NU) : 0u; } }
#pragma unroll
    for (int pi = 0; pi < 2; ++pi) { const int dh = 2 * C.wave + pi, dir = dh >> 3, h = dh & 7, i = C.lane;
        const float xv = dtraw_[pi] + dtb_[pi];
        const float dt = fmaxf(xv, 0.f) + log1pf(__expf(-fabsf(xv)));
        const float av = -dt * __expf(alog_[pi]);
        float pre = av;
        pre += dppf<0x111>(pre); pre += dppf<0x112>(pre); pre += dppf<0x114>(pre); pre += dppf<0x118>(pre);
        pre += __builtin_bit_cast(float, __builtin_amdgcn_update_dpp(0, __builtin_bit_cast(int, pre), 0x142, 0xa, 0xf, false));
        pre += __builtin_bit_cast(float, __builtin_amdgcn_update_dpp(0, __builtin_bit_cast(int, pre), 0x143, 0xc, 0xf, false));
        const float tot = __builtin_bit_cast(float, __builtin_amdgcn_readlane(__builtin_bit_cast(int, pre), 63));
        const float g = dir == 0 ? pre : tot - pre + av;
        const float gend = tot;
        al[dh * 64 + i] = g; dtl[dh * 64 + i] = dt; wl[dh * 64 + i] = dt * __expf(gend - g);
        const size_t o = (size_t)((b * 2 + dir) * 8 + h) * SP + s0 + i; GA[o] = g; DTA[o] = dt;
        if (i == 0) GEND[((b * 2 + dir) * 8 + h) * NCH + tc] = gend; }
    LDS_BARRIER();
    if (C.tid < 384) {
        f32x2 wk[5];
#pragma unroll
        for (int k = 0; k < 5; ++k) wk[k] = *(const f32x2*)(a.conv_w + k * 768 + ch0);
        const f32x2 cb = *(const f32x2*)(a.conv_b + ch0);
        const int cls = ch0 < 512 ? 0 : (ch0 < 640 ? 1 : 2);
#pragma unroll
        for (int i8 = 0; i8 < 8; ++i8) {
            unsigned t0[4], t1[4]; float pv0 = 0.f, pv1 = 0.f;
#pragma unroll
            for (int ii = 0; ii < 8; ++ii) {
                const int i = 8 * i8 + ii;
                float y0 = cb.x, y1 = cb.y;
#pragma unroll
                for (int k = 0; k < 5; ++k) { y0 += wk[k].x * bflo(uw[i + k]); y1 += wk[k].y * bfhi(uw[i + k]); }
                y0 = siluf(y0); y1 = siluf(y1);
                if (cls != 0) *(unsigned*)(BC + (size_t)(rowbase + i) * 256 + (ch0 - 512)) = cvt_pk_bf16(y0, y1);
                if (ii & 1) { t0[ii >> 1] = cvt_pk_bf16(pv0, y0); t1[ii >> 1] = cvt_pk_bf16(pv1, y1); } else { pv0 = y0; pv1 = y1; }
            }
            if (cls != 2) {
                const u32x4 v0 = (u32x4){t0[0], t0[1], t0[2], t0[3]}, v1 = (u32x4){t1[0], t1[1], t1[2], t1[3]};
                *(LAS u32x4*)(XTl + ch0 * 72 + 8 * i8) = v0; *(LAS u32x4*)(XTl + (ch0 + 1) * 72 + 8 * i8) = v1;
                if (cls == 0) { const size_t r0 = (size_t)(b * 512 + ch0) * SP + s0 + 8 * i8; *(u32x4*)(XST + r0) = v0; *(u32x4*)(XST + r0 + SP) = v1; }
            }
        }
    }
    LDS_BARRIER();
    {
        const int fr = C.lane & 15, q = C.lane >> 4;
#pragma unroll 1
        for (int pi = 0; pi < 2; ++pi) { const int pid = 2 * C.wave + pi, dir = pid >> 3, h = pid & 7, g = h >> 2;
            bf16x8 Bf[4][2]; f32x4 wv[2][2];
#pragma unroll
            for (int ks = 0; ks < 2; ++ks) { wv[ks][0] = *(const LAS f32x4*)(wl + pid * 64 + 32 * ks + 8 * q); wv[ks][1] = *(const LAS f32x4*)(wl + pid * 64 + 32 * ks + 8 * q + 4); }
#pragma unroll
            for (int t = 0; t < 4; ++t)
#pragma unroll
                for (int ks = 0; ks < 2; ++ks) Bf[t][ks] = *(const LAS bf16x8*)(XTl + (h * 64 + 16 * t + fr) * 72 + 32 * ks + 8 * q);
            const size_t ob = ((size_t)((b * 2 + dir) * 8 + h) * NCH + tc) * 1024;
#pragma unroll
            for (int at = 0; at < 4; ++at) { bf16x8 Af[2];
#pragma unroll
                for (int ks = 0; ks < 2; ++ks) { const u32x4 raw = *(const LAS u32x4*)(XTl + (512 + g * 64 + 16 * at + fr) * 72 + 32 * ks + 8 * q); const unsigned rw[4] = {raw.x, raw.y, raw.z, raw.w}; u32x4 o;
                    o.x = cvt_pk_bf16(bflo(rw[0]) * wv[ks][0][0], bfhi(rw[0]) * wv[ks][0][1]); o.y = cvt_pk_bf16(bflo(rw[1]) * wv[ks][0][2], bfhi(rw[1]) * wv[ks][0][3]);
                    o.z = cvt_pk_bf16(bflo(rw[2]) * wv[ks][1][0], bfhi(rw[2]) * wv[ks][1][1]); o.w = cvt_pk_bf16(bflo(rw[3]) * wv[ks][1][2], bfhi(rw[3]) * wv[ks][1][3]);
                    Af[ks] = __builtin_bit_cast(bf16x8, o); }
#pragma unroll
                for (int pt = 0; pt < 4; ++pt) { f32x4 acc = (f32x4){0.f, 0.f, 0.f, 0.f};
                    acc = MFMA16(Af[0], Bf[pt][0], acc); acc = MFMA16(Af[1], Bf[pt][1], acc);
                    DSS[ob + (at * 4 + pt) * 64 + C.lane] = (u32x2){cvt_pk_bf16(acc[0], acc[1]), cvt_pk_bf16(acc[2], acc[3])}; } } }
    }
    LDS_BARRIER();
}
__device__ __forceinline__ void prep_hg_pair(CArgs& a, const Ctx& C, int unit) {
    const bf16* U = (const bf16*)(a.ws + WS_U);
    bf16* QS = (bf16*)(a.ws + WS_QS); bf16* KS = (bf16*)(a.ws + WS_KS); float* EG = (float*)(a.ws + WS_EG); u32x2* DSP = (u32x2*)(a.ws + WS_DSP); float* EGP = (float*)(a.ws + WS_EGP);
    const int b = unit / (NPR * 4), pr = (unit >> 2) % NPR, h = unit & 3;
    LAS float* ETl = (LAS float*)(C.lds + 63488);
    LAS u32x2* DL = (LAS u32x2*)(C.lds + 65536);
#pragma unroll 1
    for (int sub = 0; sub < 2; ++sub) {
    const int c = 2 * pr + sub, s0 = 64 * c; const bool isctx = c < 4;
    int ltid = C.tid; asm volatile("" : "+v"(ltid));
    const int cp = ltid & 63, tg = ltid >> 6, ch0 = 2 * cp, hc = h * 128 + ch0;
    const int rbase = isctx ? NLAT + b * CTXL + s0 : b * SEQ + (c - 4), rstride = isctx ? 1 : 64;
    const bf16* up = U + (size_t)rbase * NU + 1280 + hc;
    unsigned rq[8], rf[8], rb[8], ri[8];
#pragma unroll
    for (int t = 0; t < 8; ++t) { const bf16* r = up + (size_t)(8 * tg + t) * rstride * NU;
        rq[t] = *(const unsigned*)r; rf[t] = *(const unsigned*)(r + 512); rb[t] = *(const unsigned*)(r + 1024); ri[t] = *(const unsigned*)(r + 1536); }
    LAS float* part = (LAS float*)C.lds;
    LAS bf16* KHl = (LAS bf16*)(C.lds + 8192);
    LAS bf16* VTl = KHl + 2 * 128 * 72;
    f32x2 lbv[2];
#pragma unroll
    for (int d = 0; d < 2; ++d) { lbv[d].x = __builtin_amdgcn_rcpf(1.0f + __expf(a.hg_lb[1024 + d * 512 + hc] - a.hg_lb[d * 512 + hc])); lbv[d].y = __builtin_amdgcn_rcpf(1.0f + __expf(a.hg_lb[1024 + d * 512 + hc + 1] - a.hg_lb[d * 512 + hc + 1])); }
    float la[2][2][8], om[2][2][8];
    float sum[2][2] = {{0.f, 0.f}, {0.f, 0.f}};
#pragma unroll
    for (int t = 0; t < 8; ++t)
#pragma unroll
        for (int d = 0; d < 2; ++d)
#pragma unroll
            for (int e = 0; e < 2; ++e) { const unsigned w = d == 0 ? rf[t] : rb[t]; const float fr_ = e == 0 ? bflo(w) : bfhi(w); const float lb = e == 0 ? lbv[d].x : lbv[d].y;
                const float ex = __builtin_amdgcn_exp2f(fr_ * -1.4426950408889634f); const float t1 = (1.0f - lb) * __builtin_amdgcn_rcpf(1.0f + ex);
                om[d][e][t] = t1 * ex;
                la[d][e][t] = __builtin_amdgcn_logf(lb + t1); sum[d][e] += la[d][e][t]; }
#pragma unroll
    for (int d = 0; d < 2; ++d)
#pragma unroll
        for (int e = 0; e < 2; ++e) part[(tg * 4 + d * 2 + e) * 64 + cp] = sum[d][e];
    LDS_BARRIER();
    float T[2][2], pre[2][2];
#pragma unroll
    for (int d = 0; d < 2; ++d)
#pragma unroll
        for (int e = 0; e < 2; ++e) { float tt = 0.f, pp = 0.f;
#pragma unroll
            for (int g2 = 0; g2 < 8; ++g2) { const float v = part[(g2 * 4 + d * 2 + e) * 64 + cp]; pp += (g2 < tg) ? v : 0.f; tt += v; }
            T[d][e] = tt; pre[d][e] = pp; }
    const size_t DST = (size_t)NB * 4 * SP * 128;
    unsigned khp[2][2][4], vp[2][4];
    float eT[2][2];
#pragma unroll
    for (int d = 0; d < 2; ++d)
#pragma unroll
        for (int e = 0; e < 2; ++e) eT[d][e] = __builtin_amdgcn_exp2f(T[d][e]);
    {
        float runf[2] = {pre[0][0], pre[0][1]}, runb[2] = {pre[1][0], pre[1][1]}, pkf[2] = {0.f, 0.f}, pkb[2] = {0.f, 0.f}, pkv[2] = {0.f, 0.f};
#pragma unroll
        for (int t = 0; t < 8; ++t) { const size_t rm = ((size_t)(b * 4 + h) * SP + s0 + 8 * tg + t) * 128 + ch0;
            const float qv[2] = {siluf(bflo(rq[t])) * 0.08838834764831845f, siluf(bfhi(rq[t])) * 0.08838834764831845f};
            float ktf[2], ktb[2], qtf[2], qtb[2];
#pragma unroll
            for (int e = 0; e < 2; ++e) {
                runf[e] += la[0][e][t]; const float Ef = __builtin_amdgcn_exp2f(-runf[e]);
                const float gb = T[1][e] - runb[e]; runb[e] += la[1][e][t]; const float Eb = __builtin_amdgcn_exp2f(-gb);
                ktf[e] = om[0][e][t] * Ef; ktb[e] = om[1][e][t] * Eb; qtf[e] = qv[e] * __builtin_amdgcn_rcpf(Ef); qtb[e] = qv[e] * __builtin_amdgcn_rcpf(Eb);
                const float khf = ktf[e] * eT[0][e], khb = ktb[e] * eT[1][e], iv = e == 0 ? bflo(ri[t]) : bfhi(ri[t]);
                if (t & 1) { khp[0][e][t >> 1] = cvt_pk_bf16(pkf[e], khf); khp[1][e][t >> 1] = cvt_pk_bf16(pkb[e], khb); vp[e][t >> 1] = cvt_pk_bf16(pkv[e], iv); } else { pkf[e] = khf; pkb[e] = khb; pkv[e] = iv; } }
            *(unsigned*)(QS + rm) = cvt_pk_bf16(qtf[0], qtf[1]); *(unsigned*)(QS + DST + rm) = cvt_pk_bf16(qtb[0], qtb[1]);
            *(unsigned*)(KS + rm) = cvt_pk_bf16(ktf[0], ktf[1]); *(unsigned*)(KS + DST + rm) = cvt_pk_bf16(ktb[0], ktb[1]); }
    }
#pragma unroll
    for (int e = 0; e < 2; ++e) {
        *(LAS u32x4*)(KHl + (0 * 128 + ch0 + e) * 72 + 8 * tg) = (u32x4){khp[0][e][0], khp[0][e][1], khp[0][e][2], khp[0][e][3]};
        *(LAS u32x4*)(KHl + (1 * 128 + ch0 + e) * 72 + 8 * tg) = (u32x4){khp[1][e][0], khp[1][e][1], khp[1][e][2], khp[1][e][3]};
        *(LAS u32x4*)(VTl + (ch0 + e) * 72 + 8 * tg) = (u32x4){vp[e][0], vp[e][1], vp[e][2], vp[e][3]};
    }
    if (tg == 0) {
#pragma unroll
        for (int d = 0; d < 2; ++d) { const f32x2 et = (f32x2){eT[d][0], eT[d][1]};
            *(f32x2*)(EG + ((size_t)((d * 4 + b) * 4 + h) * NCH + c) * 128 + ch0) = et; *(LAS f32x2*)(ETl + (sub * 2 + d) * 128 + ch0) = et;
            if (sub) { const f32x2 e0 = *(const LAS f32x2*)(ETl + d * 128 + ch0); *(f32x2*)(EGP + ((size_t)((d * 4 + b) * 4 + h) * NPR + pr) * 128 + ch0) = (f32x2){e0.x * et.x, e0.y * et.y}; } } }
    LDS_BARRIER();
    {
        const int fr = C.lane & 15, q = C.lane >> 4;
        LAS u32x2* dlb = DL + C.tid; asm volatile("" : "+v"(dlb));
        bf16x8 Bf[2];
#pragma unroll
        for (int ks = 0; ks < 2; ++ks) Bf[ks] = *(const LAS bf16x8*)(VTl + (16 * C.wave + fr) * 72 + 32 * ks + 8 * q);
#pragma unroll
        for (int d = 0; d < 2; ++d) { const int seq = (d * NB + b) * 4 + h;
#pragma unroll
            for (int at = 0; at < 8; ++at) { f32x4 t4 = (f32x4){0.f, 0.f, 0.f, 0.f};
#pragma unroll
                for (int ks = 0; ks < 2; ++ks) { const bf16x8 Af = *(const LAS bf16x8*)(KHl + (d * 128 + 16 * at + fr) * 72 + 32 * ks + 8 * q); t4 = MFMA16(Af, Bf[ks], t4); }
                LAS u32x2* dl = dlb + (d * 8 + at) * 512;
                if (sub == 0) *dl = (u32x2){cvt_pk_bf16(t4[0], t4[1]), cvt_pk_bf16(t4[2], t4[3])};
                else { const u32x2 pw = *dl; const f32x4 pv = (f32x4){bflo(pw.x), bfhi(pw.x), bflo(pw.y), bfhi(pw.y)};
                    const f32x4 r4 = d == 0 ? pv * *(const LAS f32x4*)(ETl + (1 * 2 + 0) * 128 + 16 * at + 4 * q) + t4
                                            : pv + t4 * *(const LAS f32x4*)(ETl + (0 * 2 + 1) * 128 + 16 * at + 4 * q);
                    DSP[((size_t)seq * NPR + pr) * 4096 + (at * 8 + C.wave) * 64 + C.lane] = (u32x2){cvt_pk_bf16(r4[0], r4[1]), cvt_pk_bf16(r4[2], r4[3])}; }
                if (at & 1) asm volatile("" ::: "memory"); } }
    }
    LDS_BARRIER();
    }
}
__device__ __forceinline__ void phase4(CArgs& a, const Ctx& C) {
    constexpr int NHU = NB * NPR * 4;
#pragma unroll 1
    for (int k_ = 0; k_ < 4; ++k_) { int u; const int v = (C.vcu & 31) * 8 + (C.vcu >> 5);
        int k = k_; if (v >= 80 && v < 208 && (C.vcu & 1) && k_ < 3) k = (k_ + 2) % 3;
        if (k == 0) u = v;
        else if (k == 1) u = v < 208 ? 256 + v : NHU + (v - 208);
        else if (k == 2) u = v < 80 ? 464 + v : (v < 208 ? NHU + 48 + (v - 80) : NHU + 176 + (v - 208));
        else { if (v < 208) break; u = NHU + 224 + (v - 208); }
        if (u < NHU) prep_hg_pair(a, C, u); else prep_ssd_unit(a, C, u - NHU); }
    if (CONV_P4 > 0) {
        const int v = (C.vcu & 31) * 8 + (C.vcu >> 5); LAS float* scr = (LAS float*)(C.lds + C.wave * 16384);
        if (v < 208) {
#pragma unroll 1
            for (int j = 0; j < CONV_P4N; ++j) conv_item(a, scr, C.lane, CONV_W1_HOST + (v * 8 + C.wave) * CONV_P4N + j); } }
}
__device__ __forceinline__ void phase5(CArgs& a, const Ctx& C) { (void)a; (void)C; }
__device__ __forceinline__ int scan_chunk(int dir, int k) { return dir == 0 ? k : (k < 4 ? 3 - k : 71 - k); }
__device__ __forceinline__ void phase6(CArgs& a, const Ctx& C) {
    const u32x2* DSS = (const u32x2*)(a.ws + WS_DSS); const u32x2* DSP = (const u32x2*)(a.ws + WS_DSP);
    u32x2* SPS = (u32x2*)(a.ws + WS_SPS); u32x2* SPH = (u32x2*)(a.ws + WS_SPH);
    const float* GEND = (const float*)(a.ws + WS_GEND); const float* EGP = (const float*)(a.ws + WS_EGP);
    if (C.vcu < 128) {
        const int task = C.vcu * 512 + C.tid, seq = task >> 10, grp = task & 1023, dir = (seq >> 3) & 1;
        f32x4 S = (f32x4){0.f, 0.f, 0.f, 0.f};
#pragma unroll 1
        for (int kb = 0; kb < NCH; kb += 17) { u32x2 dw[17]; float gd[17];
#pragma unroll
            for (int j = 0; j < 17; ++j) { const int tc = scan_chunk(dir, kb + j); dw[j] = NTLOAD(&DSS[((size_t)seq * NCH + tc) * 1024 + grp]); gd[j] = GEND[seq * NCH + tc]; }
            asm volatile("" ::: "memory");
#pragma unroll
            for (int j = 0; j < 17; ++j) { const int tc = scan_chunk(dir, kb + j);
                if (tc >= 4) SPS[((size_t)seq * NCH + tc) * 1024 + grp] = (u32x2){cvt_pk_bf16(S[0], S[1]), cvt_pk_bf16(S[2], S[3])};
                S = S * __expf(gd[j]) + (f32x4){bflo(dw[j].x), bfhi(dw[j].x), bflo(dw[j].y), bfhi(dw[j].y)}; }
            asm volatile("" ::: "memory"); }
    } else {
#pragma unroll 1
        for (int rep = 0; rep < 2; ++rep) {
            const int t = (C.vcu - 128) * 1024 + rep * 512 + C.tid, seq = t >> 12, grp = t & 4095, d = seq >> 4, tile = grp >> 6, ln = grp & 63, cb = 16 * (tile >> 3) + 4 * (ln >> 4);
            f32x4 S = (f32x4){0.f, 0.f, 0.f, 0.f};
#pragma unroll 1
            for (int kb = 0; kb < NPR; kb += 17) { u32x2 dw[17]; f32x4 dec[17];
#pragma unroll
                for (int j = 0; j < 17; ++j) { const int k = kb + j, tp = d == 0 ? k : (k < 2 ? 1 - k : 35 - k); dw[j] = NTLOAD(&DSP[((size_t)seq * NPR + tp) * 4096 + grp]); dec[j] = *(const f32x4*)(EGP + ((size_t)seq * NPR + tp) * 128 + cb); }
                asm volatile("" ::: "memory");
#pragma unroll
                for (int j = 0; j < 17; ++j) { const int k = kb + j, tp = d == 0 ? k : (k < 2 ? 1 - k : 35 - k);
                    if (tp >= 2) SPH[((size_t)seq * NPR + tp) * 4096 + grp] = (u32x2){cvt_pk_bf16(S[0], S[1]), cvt_pk_bf16(S[2], S[3])};
                    S = S * dec[j] + (f32x4){bflo(dw[j].x), bfhi(dw[j].x), bflo(dw[j].y), bfhi(dw[j].y)}; }
                asm volatile("" ::: "memory"); } }
    }
}
typedef short s16x4 __attribute__((ext_vector_type(4)));
typedef short s16x8 __attribute__((ext_vector_type(8)));
__device__ __forceinline__ s16x4 lds_tr(const LAS bf16* p) { return __builtin_amdgcn_ds_read_tr16_b64_v4i16((LAS s16x4*)p); }
__device__ __forceinline__ bf16x8 ld_split8(const bf16* p0, const bf16* p1) {
    const u32x2 lo = *(const u32x2*)p0, hi = *(const u32x2*)p1; u32x4 w = (u32x4){lo.x, lo.y, hi.x, hi.y}; return __builtin_bit_cast(bf16x8, w);
}
__device__ __forceinline__ void passc_ssd_unit(CArgs& a, const Ctx& C, int unit) {
    const bf16* BC = (const bf16*)(a.ws + WS_BC); const bf16* XST = (const bf16*)(a.ws + WS_XST); const bf16* U = (const bf16*)(a.ws + WS_U);
    const float* GA = (const float*)(a.ws + WS_GA); const float* DTA = (const float*)(a.ws + WS_DTA); const bf16* SPS = (const bf16*)(a.ws + WS_SPS);
    bf16* Y = (bf16*)(a.ws + WS_Y);
    const int b = unit >> 6, tcl = unit & 63, tc = tcl + 4, s0 = 64 * tc, row0 = b * SEQ + 64 * tcl;
    const int h = C.wave, g = h >> 2, fr = C.lane & 15, q = C.lane >> 4;
    LAS unsigned char* wl = C.lds + C.wave * 17408;
    LAS bf16* Ml = (LAS bf16*)wl; LAS float* Yl = (LAS float*)wl; LAS float* red = (LAS float*)(C.lds + 8 * 17408);
    bf16x8 Cp[4][2];
    {
        bf16x8 Ca[4][2], Bb[4][2];
        { LAS bf16* Bl = (LAS bf16*)wl; LAS bf16* Cl = Bl + 64 * 64; const int r8 = C.lane >> 3, c8 = C.lane & 7; u32x4 tb[8], tcx[8];
#pragma unroll
          for (int jr = 0; jr < 8; ++jr) { const bf16* rp = BC + (size_t)(row0 + 8 * jr + r8) * 256 + g * 64 + 8 * c8; tb[jr] = *(const u32x4*)rp; tcx[jr] = *(const u32x4*)(rp + 128); }
#pragma unroll
          for (int jr = 0; jr < 8; ++jr) { const int r = 8 * jr + r8, o = r * 64 + ((c8 ^ (r & 7)) * 8); *(LAS u32x4*)(Bl + o) = tb[jr]; *(LAS u32x4*)(Cl + o) = tcx[jr]; }
          LDS_WAIT(); asm volatile("" ::: "memory");
#pragma unroll
          for (int t = 0; t < 4; ++t)
#pragma unroll
              for (int ks = 0; ks < 2; ++ks) { const int r = 16 * t + fr, o = r * 64 + (((4 * ks + q) ^ (r & 7)) * 8);
                  Bb[t][ks] = *(const LAS bf16x8*)(Bl + o); Ca[t][ks] = *(const LAS bf16x8*)(Cl + o);
                  const int o1 = r * 64 + (((4 * ks + (q >> 1)) ^ (r & 7)) * 8) + 4 * (q & 1), o2 = r * 64 + (((4 * ks + 2 + (q >> 1)) ^ (r & 7)) * 8) + 4 * (q & 1);
                  const u32x2 lo = *(const LAS u32x2*)(Cl + o1), hi = *(const LAS u32x2*)(Cl + o2); const u32x4 ww = (u32x4){lo.x, lo.y, hi.x, hi.y}; Cp[t][ks] = __builtin_bit_cast(bf16x8, ww); }
          LDS_WAIT(); asm volatile("" ::: "memory"); }
        const size_t sf = (size_t)((b * 2 + 0) * 8 + h) * SP + s0, sb = (size_t)((b * 2 + 1) * 8 + h) * SP + s0;
        float gjf[4], gjb[4], dtf[4], dtb[4];
#pragma unroll
        for (int jt = 0; jt < 4; ++jt) { gjf[jt] = GA[sf + 16 * jt + fr]; gjb[jt] = GA[sb + 16 * jt + fr]; dtf[jt] = DTA[sf + 16 * jt + fr]; dtb[jt] = DTA[sb + 16 * jt + fr]; }
        const float Dh = a.ssd_d[h];
#pragma unroll
        for (int it = 0; it < 4; ++it) {
            const f32x4 gif = *(const f32x4*)(GA + sf + 16 * it + 4 * q), gib = *(const f32x4*)(GA + sb + 16 * it + 4 * q);
#pragma unroll
            for (int jt = 0; jt < 4; ++jt) { f32x4 G = (f32x4){0.f, 0.f, 0.f, 0.f};
                G = MFMA16(Ca[it][0], Bb[jt][0], G); G = MFMA16(Ca[it][1], Bb[jt][1], G);
                const int j = 16 * jt + fr;
#pragma unroll
                for (int r = 0; r < 4; ++r) { const int i = 16 * it + 4 * q + r;
                    const float lf = (j <= i) ? dtf[jt] * __expf(fminf(gif[r] - gjf[jt], 0.f)) : 0.f;
                    const float lb = (j >= i) ? dtb[jt] * __expf(fminf(gib[r] - gjb[jt], 0.f)) : 0.f;
                    const float m = G[r] * (lf + lb) + ((i == j) ? Dh : 0.f);
                    Ml[i * 72 + j] = (bf16)(cvt_pk_bf16(m, 0.f) & 0xffff); } } }
    }
    LDS_WAIT(); asm volatile("" ::: "memory");
    bf16x8 Ma[4][2];
#pragma unroll
    for (int it = 0; it < 4; ++it)
#pragma unroll
        for (int ks = 0; ks < 2; ++ks) Ma[it][ks] = *(const LAS bf16x8*)(Ml + (16 * it + fr) * 72 + 32 * ks + 8 * q);
    LDS_WAIT(); asm volatile("" ::: "memory");
    f32x4 eg[2][4];
#pragma unroll
    for (int d = 0; d < 2; ++d)
#pragma unroll
        for (int it = 0; it < 4; ++it) { const f32x4 gi = *(const f32x4*)(GA + (size_t)((b * 2 + d) * 8 + h) * SP + s0 + 16 * it + 4 * q);
            eg[d][it] = (f32x4){__expf(gi[0]), __expf(gi[1]), __expf(gi[2]), __expf(gi[3])}; }
#pragma unroll 1
    for (int pt = 0; pt < 4; ++pt) {
        bf16x8 Bx[2];
#pragma unroll
        for (int ks = 0; ks < 2; ++ks) Bx[ks] = *(const bf16x8*)(XST + (size_t)((b * 8 + h) * 64 + 16 * pt + fr) * SP + s0 + 32 * ks + 8 * q);
        f32x4 Yv[4];
#pragma unroll
        for (int it = 0; it < 4; ++it) { Yv[it] = (f32x4){0.f, 0.f, 0.f, 0.f}; Yv[it] = MFMA16(Ma[it][0], Bx[0], Yv[it]); Yv[it] = MFMA16(Ma[it][1], Bx[1], Yv[it]); }
#pragma unroll
        for (int d = 0; d < 2; ++d) { const size_t sbase = ((size_t)((b * 2 + d) * 8 + h) * NCH + tc) * 1024;
            bf16x8 Sb[2];
#pragma unroll
            for (int ks = 0; ks < 2; ++ks) Sb[ks] = ld_split8(SPS + (sbase + ((2 * ks) * 4 + pt) * 64 + C.lane) * 4, SPS + (sbase + ((2 * ks + 1) * 4 + pt) * 64 + C.lane) * 4);
#pragma unroll
            for (int it = 0; it < 4; ++it) { f32x4 T = (f32x4){0.f, 0.f, 0.f, 0.f}; T = MFMA16(Cp[it][0], Sb[0], T); T = MFMA16(Cp[it][1], Sb[1], T); Yv[it] += eg[d][it] * T; } }
#pragma unroll
        for (int it = 0; it < 4; ++it)
#pragma unroll
            for (int r = 0; r < 4; ++r) Yl[(16 * it + 4 * q + r) * 68 + 16 * pt + fr] = Yv[it][r];
    }
    LDS_WAIT(); asm volatile("" ::: "memory");
    const int r8 = C.lane >> 3, cc = 8 * (C.lane & 7); float v[64];
    const bf16* zp = U + (size_t)(row0 + r8) * NU + h * 64 + cc;
    u32x4 zq[8];
#pragma unroll
    for (int jr = 0; jr < 8; ++jr) zq[jr] = *(const u32x4*)(zp + (size_t)(8 * jr) * NU);
#pragma unroll
    for (int jr = 0; jr < 8; ++jr) { const u32x4 zw = zq[jr]; const int tr = 8 * jr + r8;
        const f32x4 y0 = *(const LAS f32x4*)(Yl + tr * 68 + cc), y1 = *(const LAS f32x4*)(Yl + tr * 68 + cc + 4);
        const unsigned zz[4] = {zw.x, zw.y, zw.z, zw.w}; float ss = 0.f;
#pragma unroll
        for (int e = 0; e < 4; ++e) { const float ya = e < 2 ? y0[2 * e] : y1[2 * e - 4], yb = e < 2 ? y0[2 * e + 1] : y1[2 * e - 3];
            const float va = ya * siluf(bflo(zz[e])), vb = yb * siluf(bfhi(zz[e])); v[8 * jr + 2 * e] = va; v[8 * jr + 2 * e + 1] = vb; ss += va * va + vb * vb; }
        ss += dppf<DPP_X1>(ss); ss += dppf<DPP_X2>(ss); ss += dppf<DPP_HMIR>(ss);
        if ((C.lane & 7) == 0) red[C.wave * 64 + tr] = ss; }
    LDS_BARRIER();
    const f32x4 n0 = *(const f32x4*)(a.ssd_norm + h * 64 + cc), n1 = *(const f32x4*)(a.ssd_norm + h * 64 + cc + 4);
    bf16* yo = Y + (size_t)(row0 + r8) * D + h * 64 + cc;
#pragma unroll
    for (int jr = 0; jr < 8; ++jr) { const int tr = 8 * jr + r8;
        float tot = red[(C.lane & 7) * 64 + tr];
        tot += dppf<DPP_X1>(tot); tot += dppf<DPP_X2>(tot); tot += dppf<DPP_HMIR>(tot);
        const float rstd = rsqrtf(tot * (1.0f / 512.0f) + EPS);
        u32x4 o; o.x = cvt_pk_bf16(v[8 * jr] * rstd * n0[0], v[8 * jr + 1] * rstd * n0[1]); o.y = cvt_pk_bf16(v[8 * jr + 2] * rstd * n0[2], v[8 * jr + 3] * rstd * n0[3]);
        o.z = cvt_pk_bf16(v[8 * jr + 4] * rstd * n1[0], v[8 * jr + 5] * rstd * n1[1]); o.w = cvt_pk_bf16(v[8 * jr + 6] * rstd * n1[2], v[8 * jr + 7] * rstd * n1[3]);
        *(u32x4*)(yo + (size_t)(8 * jr) * D) = o; }
    LDS_BARRIER();
}
__device__ __forceinline__ void passc_hg_pair(CArgs& a, const Ctx& C, int unit) {
    int ll_ = C.lane, lt_ = C.tid; asm volatile("" : "+v"(ll_), "+v"(lt_));
    const bf16* QS = (const bf16*)(a.ws + WS_QS); const bf16* KS = (const bf16*)(a.ws + WS_KS); const bf16* SPH = (const bf16*)(a.ws + WS_SPH);
    const bf16* U = (const bf16*)(a.ws + WS_U); bf16* Y = (bf16*)(a.ws + WS_Y); const float* EG = (const float*)(a.ws + WS_EG);
    const int b = unit >> 7, pr = 2 + ((unit >> 2) & 31), h = unit & 3;
    const int wv = C.wave, fr = ll_ & 15, q = ll_ >> 4;
    LAS bf16* Pl = (LAS bf16*)C.lds; LAS float* Ol = (LAS float*)(C.lds + 9216); LAS float* red = (LAS float*)(C.lds + 9216 + 64 * 132 * 4);
    LAS bf16* VL = (LAS bf16*)(C.lds + 97280);
    LAS bf16* KL = (LAS bf16*)(C.lds + 79872);
    LAS float* EGl = (LAS float*)(C.lds + 132096);
    LAS bf16* KSL = (LAS bf16*)(C.lds + 9216);
    LAS bf16* QL = (LAS bf16*)(C.lds + 45056);
    const size_t DST = (size_t)NB * 4 * SP * 128;
    u32x4 tq[4][2];
#define HGP_LOAD_QK(s0_) do { _Pragma("unroll") for (int T = 0; T < 4; ++T) { const bf16* tb_ = (T < 2 ? QS : KS) + (T & 1) * DST + ((size_t)(b * 4 + h) * SP + (s0_)) * 128; \
        _Pragma("unroll") for (int j = 0; j < 2; ++j) tq[T][j] = *(const u32x4*)(tb_ + (size_t)(lt_ + 512 * j) * 8); } } while (0)
    bf16x8 SbD[4]; u32x2 sp[8];
    u32x4 nkt0, nkt1, ngw0, ngw1; f32x2 negv;
#pragma unroll
    for (int sub = 0; sub < 2; ++sub) {
    const int tc = 2 * pr + sub, w = tc - 4, s0 = 64 * tc, oc = 2 * pr + 1 - sub;
    asm volatile("" ::: "memory");
    const int it0 = wv >> 1;
    if (sub == 0) HGP_LOAD_QK(s0);
    const int dm = 1 - sub;
    u32x4 vt[2][2];
    if (sub == 0) {
#pragma unroll
        for (int ci = 0; ci < 2; ++ci) { const bf16* vs = U + ((size_t)b * SEQ + (size_t)(lt_ >> 3) * 64 + (2 * pr + ci - 4)) * NU + 1280 + 1536 + h * 128 + (lt_ & 7) * 16;
            vt[ci][0] = *(const u32x4*)vs; vt[ci][1] = *(const u32x4*)(vs + 8); } }
    const int kr = lt_ >> 3, kc = (lt_ & 7) * 16;
    u32x4 kt0, kt1, gw0, gw1; f32x2 egv, nwv = (f32x2){0.f, 0.f};
    if (sub == 0) {
        const bf16* kso = KS + dm * DST + ((size_t)(b * 4 + h) * SP + 64 * oc) * 128 + kr * 128 + kc;
        kt0 = *(const u32x4*)kso; kt1 = *(const u32x4*)(kso + 8);
        egv = *(const f32x2*)(EG + ((size_t)((dm * NB + b) * 4 + h) * NCH + oc) * 128 + 2 * ll_);
        nwv = *(const f32x2*)(a.hg_norm + h * 128 + 2 * ll_);
        const size_t sbD = ((size_t)((0 * NB + b) * 4 + h) * NPR + pr) * 4096, sbM = ((size_t)((1 * NB + b) * 4 + h) * NPR + pr) * 4096;
#pragma unroll
        for (int ks = 0; ks < 4; ++ks) SbD[ks] = ld_split8(SPH + (sbD + ((2 * ks) * 8 + wv) * 64 + ll_) * 4, SPH + (sbD + ((2 * ks + 1) * 8 + wv) * 64 + ll_) * 4);
#pragma unroll
        for (int at = 0; at < 8; ++at) sp[at] = *(const u32x2*)(SPH + (sbM + (at * 8 + wv) * 64 + ll_) * 4);
    } else {
#pragma unroll
        for (int ks = 0; ks < 4; ++ks) { const u32x4 fw = __builtin_bit_cast(u32x4, SbD[ks]); const u32x4 bw = (u32x4){sp[2 * ks].x, sp[2 * ks].y, sp[2 * ks + 1].x, sp[2 * ks + 1].y};
            SbD[ks] = __builtin_bit_cast(bf16x8, bw); sp[2 * ks] = (u32x2){fw.x, fw.y}; sp[2 * ks + 1] = (u32x2){fw.z, fw.w}; }
        kt0 = nkt0; kt1 = nkt1; egv = negv; }
    const int ti = 8 * wv + (ll_ >> 4), c0 = 8 * (ll_ & 15);
    const size_t row = (size_t)b * SEQ + ti * 64 + w;
    const bf16* gp = U + row * NU + 1280 + 2048 + h * 128 + c0; bf16* yo = Y + row * D + 512 + h * 128 + c0;
    if (sub == 0) { gw0 = *(const u32x4*)gp; gw1 = *(const u32x4*)(gp + (size_t)256 * NU); } else { gw0 = ngw0; gw1 = ngw1; }
    {
#pragma unroll
        for (int T = 0; T < 4; ++T)
#pragma unroll
            for (int j = 0; j < 2; ++j) { const int e = (lt_ + 512 * j) * 8; *(LAS u32x4*)((T < 2 ? QL : KSL) + ((T & 1) * 64 + (e >> 7)) * 136 + (e & 127)) = tq[T][j]; }
        *(LAS u32x4*)(KL + kr * 136 + kc) = kt0; *(LAS u32x4*)(KL + kr * 136 + kc + 8) = kt1;
        if (wv == 0) { *(LAS f32x2*)(EGl + 2 * ll_) = egv; if (sub == 0) *(LAS f32x2*)(EGl + 128 + 2 * ll_) = nwv; }
        if (sub == 0) {
#pragma unroll
            for (int ci = 0; ci < 2; ++ci) { *(LAS u32x4*)(VL + ci * 64 * 136 + kr * 136 + kc) = vt[ci][0]; *(LAS u32x4*)(VL + ci * 64 * 136 + kr * 136 + kc + 8) = vt[ci][1]; } }
    }
    LDS_BARRIER();
    if (sub == 0) { HGP_LOAD_QK(s0 + 64);
        const bf16* kso1 = KS + 0 * DST + ((size_t)(b * 4 + h) * SP + s0) * 128 + kr * 128 + kc; nkt0 = *(const u32x4*)kso1; nkt1 = *(const u32x4*)(kso1 + 8);
        negv = *(const f32x2*)(EG + ((size_t)((0 * NB + b) * 4 + h) * NCH + tc) * 128 + 2 * ll_);
        ngw0 = *(const u32x4*)(gp + NU); ngw1 = *(const u32x4*)(gp + NU + (size_t)256 * NU); }
    {
        f32x4 P[2] = {(f32x4){0.f, 0.f, 0.f, 0.f}, (f32x4){0.f, 0.f, 0.f, 0.f}};
#pragma unroll
        for (int d = 0; d < 2; ++d) { f32x4 S[2] = {(f32x4){0.f, 0.f, 0.f, 0.f}, (f32x4){0.f, 0.f, 0.f, 0.f}};
#pragma unroll
            for (int ks = 0; ks < 4; ++ks) { const bf16x8 aq = *(const LAS bf16x8*)(QL + (d * 64 + 16 * it0 + fr) * 136 + 32 * ks + 8 * q);
#pragma unroll
                for (int j2 = 0; j2 < 2; ++j2) { const bf16x8 bk = *(const LAS bf16x8*)(KSL + (d * 64 + 16 * (2 * (wv & 1) + j2) + fr) * 136 + 32 * ks + 8 * q); S[j2] = MFMA16(aq, bk, S[j2]); } }
#pragma unroll
            for (int j2 = 0; j2 < 2; ++j2) { const int j = 16 * (2 * (wv & 1) + j2) + fr;
#pragma unroll
                for (int r = 0; r < 4; ++r) { const int ii = 16 * it0 + 4 * q + r; const bool keep = d == 0 ? (j <= ii) : (j >= ii); P[j2][r] += keep ? S[j2][r] : 0.f; } } }
#pragma unroll
        for (int j2 = 0; j2 < 2; ++j2) { const int j = 16 * (2 * (wv & 1) + j2) + fr;
#pragma unroll
            for (int r = 0; r < 4; ++r) Pl[(16 * it0 + 4 * q + r) * 72 + j] = (bf16)(cvt_pk_bf16(P[j2][r], 0.f) & 0xffff); }
    }
    LDS_BARRIER();
    bf16x8 Bv[2], Vo[2];
    { const LAS bf16* vb = VL + (8 * q + (fr >> 2)) * 136 + 16 * wv + 4 * (fr & 3);
#pragma unroll
      for (int ks = 0; ks < 2; ++ks) {
          const s16x4 c0 = lds_tr(vb + (sub * 64 + 32 * ks) * 136), c1 = lds_tr(vb + (sub * 64 + 32 * ks + 4) * 136), o0 = lds_tr(vb + (dm * 64 + 32 * ks) * 136), o1 = lds_tr(vb + (dm * 64 + 32 * ks + 4) * 136);
          const s16x8 cv = (s16x8){c0[0], c0[1], c0[2], c0[3], c1[0], c1[1], c1[2], c1[3]}, ov = (s16x8){o0[0], o0[1], o0[2], o0[3], o1[0], o1[1], o1[2], o1[3]};
          Bv[ks] = __builtin_bit_cast(bf16x8, cv); Vo[ks] = __builtin_bit_cast(bf16x8, ov); } }
    f32x4 O[4];
#pragma unroll
    for (int it = 0; it < 4; ++it) { O[it] = (f32x4){0.f, 0.f, 0.f, 0.f};
#pragma unroll
        for (int ks = 0; ks < 2; ++ks) { const bf16x8 Pa = *(const LAS bf16x8*)(Pl + (16 * it + fr) * 72 + 32 * ks + 8 * q); O[it] = MFMA16(Pa, Bv[ks], O[it]); } }
    bf16x8 SbM[4];
    { const LAS float* eg = EGl + 4 * q;
        const LAS bf16* kt = KL + (8 * q + (fr >> 2)) * 136 + 4 * (fr & 3);
#pragma unroll
        for (int ks = 0; ks < 4; ++ks) { unsigned wd[4];
#pragma unroll
            for (int hh = 0; hh < 2; ++hh) { const int at = 2 * ks + hh; f32x4 t4 = (f32x4){bflo(sp[at].x), bfhi(sp[at].x), bflo(sp[at].y), bfhi(sp[at].y)};
#pragma unroll
                for (int k2 = 0; k2 < 2; ++k2) { const s16x4 a0 = lds_tr(kt + (32 * k2) * 136 + 16 * at), a1 = lds_tr(kt + (32 * k2 + 4) * 136 + 16 * at);
                    const s16x8 av = (s16x8){a0[0], a0[1], a0[2], a0[3], a1[0], a1[1], a1[2], a1[3]}; t4 = MFMA16(__builtin_bit_cast(bf16x8, av), Vo[k2], t4); }
                const f32x4 e4 = *(const LAS f32x4*)(eg + 16 * at);
                wd[2 * hh] = cvt_pk_bf16(t4[0] * e4[0], t4[1] * e4[1]); wd[2 * hh + 1] = cvt_pk_bf16(t4[2] * e4[2], t4[3] * e4[3]); }
            const u32x4 ww = (u32x4){wd[0], wd[1], wd[2], wd[3]}; SbM[ks] = __builtin_bit_cast(bf16x8, ww); } }
#pragma unroll
    for (int d = 0; d < 2; ++d)
#pragma unroll
        for (int ks = 0; ks < 4; ++ks) { const bf16x8 sb = d == sub ? SbD[ks] : SbM[ks];
#pragma unroll
            for (int it = 0; it < 4; ++it) { const LAS bf16* qp = QL + (d * 64 + 16 * it + fr) * 136 + 32 * ks + 4 * q;
                const u32x2 lo = *(const LAS u32x2*)qp, hi = *(const LAS u32x2*)(qp + 16); const u32x4 ww = (u32x4){lo.x, lo.y, hi.x, hi.y};
                O[it] = MFMA16(__builtin_bit_cast(bf16x8, ww), sb, O[it]); } }
#pragma unroll
    for (int it = 0; it < 4; ++it)
#pragma unroll
        for (int r = 0; r < 4; ++r) Ol[(16 * it + 4 * q + r) * 132 + 16 * wv + fr] = O[it][r];
    LDS_BARRIER();
    { const f32x4 nwa = *(const LAS f32x4*)(EGl + 128 + c0), nwb = *(const LAS f32x4*)(EGl + 128 + c0 + 4); const float nwk[8] = {nwa[0], nwa[1], nwa[2], nwa[3], nwb[0], nwb[1], nwb[2], nwb[3]};
#pragma unroll
      for (int jr = 0; jr < 2; ++jr) { const int tr = ti + 4 * jr;
          const f32x4 oa = *(const LAS f32x4*)(Ol + tr * 132 + c0), ob = *(const LAS f32x4*)(Ol + tr * 132 + c0 + 4); const float o[8] = {oa[0], oa[1], oa[2], oa[3], ob[0], ob[1], ob[2], ob[3]};
          float ss = 0.f;
#pragma unroll
          for (int e = 0; e < 8; ++e) ss += o[e] * o[e];
          ss += dppf<DPP_X1>(ss); ss += dppf<DPP_X2>(ss); ss += dppf<DPP_HMIR>(ss); ss += dppf<DPP_MIR>(ss);
          const float rstd = rsqrtf(ss * (1.0f / 128.0f) + EPS);
          const u32x4 gw4 = jr == 0 ? gw0 : gw1; const unsigned gz[4] = {gw4.x, gw4.y, gw4.z, gw4.w}; unsigned ow[4];
#pragma unroll
          for (int e = 0; e < 4; ++e) ow[e] = cvt_pk_bf16(o[2 * e] * rstd * nwk[2 * e] * siluf(bflo(gz[e])), o[2 * e + 1] * rstd * nwk[2 * e + 1] * siluf(bfhi(gz[e])));
          *(u32x4*)(yo + (size_t)jr * 256 * D) = (u32x4){ow[0], ow[1], ow[2], ow[3]}; } }
    LDS_BARRIER();
    }
}
#undef HGP_LOAD_QK
__device__ __forceinline__ void phase7(CArgs& a, const Ctx& C) {
    for (int u = C.vcu; u < 256; u += C.G) passc_ssd_unit(a, C, u);
    for (int u = C.vcu; u < 512; u += C.G) passc_hg_pair(a, C, u);
}
__device__ __forceinline__ void phase9_fill(CArgs& a, const Ctx& C, int t0, int nt) {
    LAS float* RW = (LAS float*)C.lds;
    for (int k = t0; k < D; k += nt) {
#pragma unroll
        for (int e4 = 0; e4 < 8; ++e4) { const f32x4 w = *(const f32x4*)(a.router_w + (size_t)k * NE + 4 * e4);
#pragma unroll
            for (int e = 0; e < 4; ++e) RW[(4 * e4 + e) * D + k] = w[e]; } }
    const float* mb = (const float*)(a.ws + WS_MOD) + (C.vcu >> 6) * 6144; LAS float* VA = (LAS float*)(C.lds + 131072 + 4096); LAS float* VB = VA + 1024;
    for (int k = t0; k < D; k += nt) { VA[k] = mb[2048 + k] * a.mix_post[k]; VB[k] = a.ffn_pre[k] * (1.0f + mb[4096 + k]); }
}
__device__ __forceinline__ void phase9(CArgs& a, const Ctx& C, bool prefilled, f32x4 (&px)[2][4]) {
    constexpr int NR = 4;
    const float* MOD = (const float*)(a.ws + WS_MOD); const bf16* MIX = (const bf16*)(a.ws + WS_MIX); unsigned char* HX = a.ws + WS_XN; bf16* X1 = (bf16*)(a.ws + WS_U);
    int* TOPE = (int*)(a.ws + WS_ROUTE); float* GATE = (float*)(a.ws + WS_ROUTE + 256 * 1024); int* PPOS = (int*)(a.ws + WS_ROUTE + 512 * 1024); int* ROWTOK = (int*)(a.ws + WS_ROWTOK);
    unsigned* gcnt = (unsigned*)(a.ws + WS_CTL) + CW_CNT;
    LAS float* RW = (LAS float*)C.lds;
    LAS float* LG = (LAS float*)(C.lds + 131072) + C.wave * 128;
    LAS unsigned* lcnt = (LAS unsigned*)(C.lds + LCNT_OFF); LAS unsigned* lbase = lcnt + 32;
    if (!prefilled) phase9_fill(a, C, C.tid, 512);
    if (C.tid < 32) lcnt[C.tid] = 0u;
    __syncthreads();
    LAS float* VA = (LAS float*)(C.lds + 131072 + 4096); LAS float* VB = VA + 1024;
    LAS unsigned* RT = (LAS unsigned*)(C.lds + 131072 + 12288);
    const float* mb = MOD + (C.vcu >> 6) * 6144;
    f32x4 xq[NR][4]; u32x2 mq[NR][4];
#define P9_LOAD(mm, r0, r1) do { _Pragma("unroll") for (int r = (r0); r < (r1); ++r) { const size_t ro_ = (size_t)((mm) + r) * D; _Pragma("unroll") for (int jj = 0; jj < 4; ++jj) { \
        mq[r][jj] = NTLOAD((const u32x2*)(MIX + ro_ + 256 * jj + 4 * C.lane)); xq[r][jj] = NTLOAD((const f32x4*)(a.x + ro_ + 256 * jj + 4 * C.lane)); } } } while (0)
    const bool have_x = prefilled && C.wave != 0;
#define P9_LOADM(mm, r0, r1) do { _Pragma("unroll") for (int r = (r0); r < (r1); ++r) { const size_t ro_ = (size_t)((mm) + r) * D; _Pragma("unroll") for (int jj = 0; jj < 4; ++jj) { \
        mq[r][jj] = NTLOAD((const u32x2*)(MIX + ro_ + 256 * jj + 4 * C.lane)); xq[r][jj] = px[r][jj]; } } } while (0)
    if (have_x) P9_LOADM(64 * C.vcu + NR * C.wave, 0, 2); else P9_LOAD(64 * C.vcu + NR * C.wave, 0, 2);
#pragma unroll 1
    for (int trip = 0; trip < 2; ++trip) { const int lr0 = 32 * trip + NR * C.wave, m0 = 64 * C.vcu + lr0;
        f32x4 s0v[4];
#pragma unroll
        for (int jj = 0; jj < 4; ++jj) s0v[jj] = *(const f32x4*)(mb + 3072 + 256 * jj + 4 * C.lane);
        asm volatile("" ::: "memory");
        P9_LOAD(m0, 2, 4);
        float hv[NR][16];
#pragma unroll
        for (int r = 0; r < NR; ++r) { const size_t ro = (size_t)(m0 + r) * D; float ss = 0.f;
            f32x4 xv[4];
#pragma unroll
            for (int jj = 0; jj < 4; ++jj) { const u32x2 w = mq[r][jj]; xv[jj] = xq[r][jj];
                hv[r][4 * jj] = bflo(w.x); hv[r][4 * jj + 1] = bfhi(w.x); hv[r][4 * jj + 2] = bflo(w.y); hv[r][4 * jj + 3] = bfhi(w.y); }
#pragma unroll
            for (int i = 0; i < 16; ++i) ss += hv[r][i] * hv[r][i];
            const float rstd = rsqrtf(wave_sum(ss) * (1.0f / D) + EPS); float ss2 = 0.f;
#pragma unroll
            for (int jj = 0; jj < 4; ++jj) { const int k0 = 256 * jj + 4 * C.lane; const f32x4 va = *(const LAS f32x4*)(VA + k0);
                f32x4 x1;
#pragma unroll
                for (int e = 0; e < 4; ++e) { x1[e] = xv[jj][e] + va[e] * (hv[r][4 * jj + e] * rstd); hv[r][4 * jj + e] = x1[e]; ss2 += x1[e] * x1[e]; }
                *(u32x2*)(X1 + ro + k0) = (u32x2){cvt_pk_bf16(x1[0], x1[1]), cvt_pk_bf16(x1[2], x1[3])}; }
            const float rstd2 = rsqrtf(wave_sum(ss2) * (1.0f / D) + EPS);
#pragma unroll
            for (int jj = 0; jj < 4; ++jj) { const int k0 = 256 * jj + 4 * C.lane; const f32x4 vb = *(const LAS f32x4*)(VB + k0), s0 = s0v[jj];
#pragma unroll
                for (int e = 0; e < 4; ++e) hv[r][4 * jj + e] = hv[r][4 * jj + e] * rstd2 * vb[e] + s0[e];
                *(unsigned*)(HX + ro + k0) = pk4_fp8(hv[r][4 * jj], hv[r][4 * jj + 1], hv[r][4 * jj + 2], hv[r][4 * jj + 3]); }
            if (r & 1) asm volatile("" ::: "memory"); }
        if (trip == 0) P9_LOAD(64 * C.vcu + 32 + NR * C.wave, 0, 2);
#pragma unroll 1
        for (int eg = 0; eg < 8; ++eg) {
            f32x2 lg2[NR][4];
#pragma unroll
            for (int r = 0; r < NR; ++r)
#pragma unroll
                for (int e = 0; e < 4; ++e) lg2[r][e] = (f32x2){0.f, 0.f};
#pragma unroll
            for (int e = 0; e < 4; ++e)
#pragma unroll
                for (int jj = 0; jj < 4; ++jj) { const f32x4 w = *(const LAS f32x4*)(RW + (4 * eg + e) * D + 256 * jj + 4 * C.lane);
                    const f32x2 w01 = (f32x2){w[0], w[1]}, w23 = (f32x2){w[2], w[3]};
#pragma unroll
                    for (int r = 0; r < NR; ++r) { lg2[r][e] = __builtin_elementwise_fma((f32x2){hv[r][4 * jj], hv[r][4 * jj + 1]}, w01, lg2[r][e]);
                        lg2[r][e] = __builtin_elementwise_fma((f32x2){hv[r][4 * jj + 2], hv[r][4 * jj + 3]}, w23, lg2[r][e]); }
                    if (jj == 3 && (e & 1)) asm volatile("" ::: "memory"); }
            float lg[NR][4];
#pragma unroll
            for (int r = 0; r < NR; ++r)
#pragma unroll
                for (int e = 0; e < 4; ++e) lg[r][e] = lg2[r][e].x + lg2[r][e].y;
#pragma unroll
            for (int r = 0; r < NR; ++r) { reduce_scatter<4>(lg[r], C.lane);
                if ((C.lane & 15) == 0) LG[r * 32 + 4 * eg + (C.lane >> 4)] = lg[r][0]; }
        }
        LDS_WAIT(); asm volatile("" ::: "memory");
        if (C.lane < NR) { const int m = m0 + C.lane; float logit[32];
#pragma unroll
            for (int e4 = 0; e4 < 8; ++e4) { const f32x4 v = *(const LAS f32x4*)(LG + C.lane * 32 + 4 * e4), rb = *(const f32x4*)(a.router_b + 4 * e4);
#pragma unroll
                for (int e = 0; e < 4; ++e) logit[4 * e4 + e] = v[e] + rb[e]; }
            int te[4]; float tv[4]; unsigned taken = 0u;
#pragma unroll
            for (int k = 0; k < 4; ++k) { float best = -3.0e38f; int bi = 0;
#pragma unroll
                for (int e = 0; e < 32; ++e) { const bool better = (((taken >> e) & 1u) == 0u) && (logit[e] > best); best = better ? logit[e] : best; bi = better ? e : bi; }
                te[k] = bi; tv[k] = best; taken |= 1u << bi; }
            float ex[4], sum = 0.f;
#pragma unroll
            for (int k = 0; k < 4; ++k) { ex[k] = __expf(tv[k] - tv[0]); sum += ex[k]; }
            const float inv = 1.0f / sum;
#pragma unroll
            for (int k = 0; k < 4; ++k) { const unsigned pos = __hip_atomic_fetch_add(lcnt + te[k], 1u, __ATOMIC_RELAXED, __HIP_MEMORY_SCOPE_WORKGROUP);
                TOPE[m * 4 + k] = te[k]; GATE[m * 4 + k] = ex[k] * inv; RT[(lr0 + C.lane) * 4 + k] = (pos << 5) | (unsigned)te[k]; } }
        LDS_WAIT(); asm volatile("" ::: "memory");
    }
    __syncthreads();
    if (C.tid < 32) lbase[C.tid] = atomicAdd(gcnt + C.tid, lcnt[C.tid]);
    __syncthreads();
    if (C.tid < 256) { const unsigned pk = RT[C.tid]; const int e = (int)(pk & 31u), pos = (int)(pk >> 5) + (int)lbase[e], m = 64 * C.vcu + (C.tid >> 2);
        PPOS[m * 4 + (C.tid & 3)] = pos; ROWTOK[e * 16384 + pos] = m; }
}
__device__ __forceinline__ void moe_tables(CArgs& a, const Ctx& C) {
    const unsigned* gcnt = (const unsigned*)(a.ws + WS_CTL) + CW_CNT; LAS int* TS = (LAS int*)(C.lds + TS_OFF); LAS int* CN = TS + 36;
    if (C.tid < 64) { const int e = C.tid & 31; const int c = (int)__hip_atomic_load(gcnt + e, RLX_AGENT); const int nt = (c + 255) >> 8;
        int pre = nt;
#pragma unroll
        for (int o = 1; o < 32; o <<= 1) { const int t = __shfl_up(pre, o, 32); pre += ((C.tid & 31) >= o) ? t : 0; }
        if (C.tid < 32) { TS[e] = pre - nt; CN[e] = c; if (e == 31) TS[NE] = pre; } }
    __syncthreads();
    if (C.tid < 320) { int e = 0;
#pragma unroll
        for (int k = 1; k < NE; ++k) e += (TS[k] <= C.tid) ? 1 : 0;
        TS[80 + C.tid] = e; }
    __syncthreads();
}
__device__ __forceinline__ void phase13(CArgs& a, const Ctx& C, bool have_tables) {
    const float* MOD = (const float*)(a.ws + WS_MOD); const unsigned char* Y2 = a.ws + WS_Y2; const bf16* X1 = (const bf16*)(a.ws + WS_U);
    const int* TOPE = (const int*)(a.ws + WS_ROUTE); const float* GATE = (const float*)(a.ws + WS_ROUTE + 256 * 1024); const int* PPOS = (const int*)(a.ws + WS_ROUTE + 512 * 1024);
    if (!have_tables) moe_tables(a, C);
    const LAS int* TS = (const LAS int*)(C.lds + TS_OFF);
    constexpr int NR = 2, NT = 4;
    u32x4 yw[2][NR][4]; u32x2 xw[2][NR][4]; int slot[3]; float gk[3];
#define P13_M0(t) (64 * C.vcu + 16 * (t) + NR * C.wave)
#define P13_ROUTE(t, dst) do { slot[dst] = 0; gk[dst] = 0.f; if (C.lane < 4 * NR) { const int idx = P13_M0(t) * 4 + C.lane; slot[dst] = TS[TOPE[idx]] * 256 + PPOS[idx]; gk[dst] = GATE[idx] * (1.0f / Y_SCALE); } } while (0)
#define P13_LOADS(t, buf, src) do { const int m0_ = P13_M0(t); _Pragma("unroll") for (int r = 0; r < NR; ++r) { \
        _Pragma("unroll") for (int k = 0; k < 4; ++k) { const int sl = __shfl(slot[src], 4 * r + k); const unsigned char* yr = Y2 + (size_t)sl * D + 4 * C.lane; \
            yw[buf][r][k] = (u32x4){NTLOAD((const unsigned*)yr), NTLOAD((const unsigned*)(yr + 256)), NTLOAD((const unsigned*)(yr + 512)), NTLOAD((const unsigned*)(yr + 768))}; } \
        const bf16* xr = X1 + (size_t)(m0_ + r) * D + 4 * C.lane; _Pragma("unroll") for (int jj = 0; jj < 4; ++jj) xw[buf][r][jj] = NTLOAD((const u32x2*)(xr + 256 * jj)); } } while (0)
    P13_ROUTE(0, 0); P13_ROUTE(1, 1); P13_LOADS(0, 0, 0);
    LAS float* GW = (LAS float*)C.lds;
    { const float* gf = MOD + (C.vcu >> 6) * 6144 + 5120; const f32x2 gv = *(const f32x2*)(gf + 2 * C.tid), wv = *(const f32x2*)(a.ffn_post + 2 * C.tid); *(LAS f32x2*)(GW + 2 * C.tid) = gv * wv; }
    __syncthreads();
#pragma unroll
    for (int t = 0; t < NT; ++t) {
        const int m0 = P13_M0(t), cb = t & 1;
        if (t + 2 < NT) P13_ROUTE(t + 2, (t + 2) % 3);
        if (t + 1 < NT) P13_LOADS(t + 1, (t + 1) & 1, (t + 1) % 3);
        asm volatile("" ::: "memory");
#pragma unroll
        for (int r = 0; r < NR; ++r) { float f[16];
#pragma unroll
            for (int e = 0; e < 16; ++e) f[e] = 0.f;
#pragma unroll
            for (int k = 0; k < 4; ++k) { const float g = __shfl(gk[t % 3], 4 * r + k); const unsigned ww[4] = {yw[cb][r][k].x, yw[cb][r][k].y, yw[cb][r][k].z, yw[cb][r][k].w};
#pragma unroll
                for (int e = 0; e < 4; ++e) { const f32x2 lo = __builtin_amdgcn_cvt_pk_f32_fp8((int)ww[e], false), hi = __builtin_amdgcn_cvt_pk_f32_fp8((int)ww[e], true);
                    f[4 * e] += g * lo.x; f[4 * e + 1] += g * lo.y; f[4 * e + 2] += g * hi.x; f[4 * e + 3] += g * hi.y; } }
            float ss = 0.f;
#pragma unroll
            for (int e = 0; e < 16; ++e) ss += f[e] * f[e];
            const float rstd = rsqrtf(wave_sum(ss) * (1.0f / D) + EPS);
            const size_t ro = (size_t)(m0 + r) * D;
#pragma unroll
            for (int jj = 0; jj < 4; ++jj) { const int k0 = 4 * C.lane + 256 * jj; const f32x4 gw = *(const LAS f32x4*)(GW + k0); const u32x2 xx = xw[cb][r][jj];
                f32x4 o; o[0] = bflo(xx.x) + gw[0] * (f[4 * jj] * rstd); o[1] = bfhi(xx.x) + gw[1] * (f[4 * jj + 1] * rstd);
                o[2] = bflo(xx.y) + gw[2] * (f[4 * jj + 2] * rstd); o[3] = bfhi(xx.y) + gw[3] * (f[4 * jj + 3] * rstd);
                *(f32x4*)(a.out + ro + k0) = o; } }
    }
#undef P13_ROUTE
#undef P13_LOADS
#undef P13_M0
}

struct ShadowWork { CArgs* ka; const Ctx* C; int fill, first, scr_off, scr_stride; f32x4 (*px)[4] = nullptr;
    __device__ __forceinline__ void operator()() const {
        if (fill == 2 && px != nullptr) {
            const int m = (MROWS / 256) * C->vcu + 2 * C->wave;
#pragma unroll
            for (int r = 0; r < 2; ++r) { const int mr = m + r; const float* xrow = mr < NLAT ? ka->x + (size_t)mr * D : ka->ctx + (size_t)(mr - NLAT) * D;
#pragma unroll
                for (int j = 0; j < 2; ++j) { px[r][2 * j] = NTLOAD((const f32x4*)(xrow + 8 * C->lane + 512 * j)); px[r][2 * j + 1] = NTLOAD((const f32x4*)(xrow + 8 * C->lane + 512 * j + 4)); } } }
        if (fill == 2) phase2_fill(*ka, *C, C->tid - 64, 448);
        if (fill == 9 && px != nullptr) {
#pragma unroll
            for (int r = 0; r < 2; ++r)
#pragma unroll
                for (int jj = 0; jj < 4; ++jj) px[r][jj] = NTLOAD((const f32x4*)(ka->x + (size_t)(64 * C->vcu + 4 * C->wave + r) * D + 256 * jj + 4 * C->lane)); }
        if (fill == 9) phase9_fill(*ka, *C, C->tid - 64, 448);
        if (first >= 0) conv_shadow(*ka, *C, first, C->lds + scr_off, scr_stride); } };
__global__ void __launch_bounds__(512, 2) mega_fwd(Args a) {
    extern __shared__ __attribute__((aligned(16))) unsigned char lds_raw[];
#define MKCTX(C) Ctx C; { int t_ = threadIdx.x; asm volatile("" : "+v"(t_)); C.lds = (LAS unsigned char*)lds_raw; C.tid = t_; C.lane = t_ & 63; C.wave = __builtin_amdgcn_readfirstlane(t_ >> 6); \
        C.G = gridDim.x; const int bx_ = blockIdx.x; C.vcu = (C.G % 8 == 0) ? (bx_ % 8) * (C.G / 8) + bx_ / 8 : bx_; C.gw = C.vcu * 8 + C.wave; C.NGW = C.G * 8; }
    MKCTX(C);
    volatile LAS unsigned* MISC = (volatile LAS unsigned*)(C.lds + MISC_OFF);
    for (int u = C.tid; u < (LDS_BYTES - LDSCTL_OFF) / 4; u += 512) ((LAS unsigned*)(C.lds + LDSCTL_OFF))[u] = 0u;
    __syncthreads();
    const int lo = a.ph_lo, hi = a.ph_hi;
    CArgs* const kargs = (CArgs*)__builtin_amdgcn_kernarg_segment_ptr();
#define KA() (*[&]() { CArgs* p_ = kargs; asm volatile("" : "+s"(p_)); return p_; }())
    if (hi - lo > 1) (void)xcd_barrier_post((unsigned*)(a.ws + WS_CTL) + CW_BAR, MISC + 8);
#define BAR() XcdBarrier{(unsigned*)(KA().ws + WS_CTL) + CW_BAR, xb_xcc_id(), (volatile LAS unsigned*)(C.lds + MISC_OFF) + 8}
#define IN(k) (lo <= (k) && (k) < hi)
#define NEXTPH(k) ((k) == 4 ? 6 : ((k) == 9 ? 11 : (k) + 1))
#define SEAM(k) do { if (IN(k) && IN(NEXTPH(k))) xcd_barrier(BAR()); } while (0)
#define SEAM_WORK(k, ...) do { if (IN(k) && IN(NEXTPH(k))) xcd_barrier(BAR(), __VA_ARGS__); } while (0)
#define SHADOW(sh) ShadowWork{&KA(), &C, 0, (sh) * CONV_B, 16384, 16384}
    f32x4 p2x[2][4];
    f32x4 p9x[2][4];
    if (IN(0)) { MKCTX(C); for (int rp = 0; rp < NREP(0); ++rp) phase0(KA(), C); SEAM_WORK(0, SHADOW(0)); }
    if (IN(1)) { MKCTX(C); for (int rp = 0; rp < NREP(1); ++rp) phase1(KA(), C); SEAM_WORK(1, ShadowWork{&KA(), &C, 2, 1 * CONV_B, 65536, 8448, p2x}); }
    if (IN(2)) { MKCTX(C); for (int rp = 0; rp < NREP(2); ++rp) { phase2(KA(), C, IN(1) && rp == 0, p2x); __syncthreads(); } SEAM_WORK(2, SHADOW(2)); }
    if (IN(3)) { MKCTX(C); pg8::Gemm g{(const bf16*)(KA().ws + WS_XN), (const bf16*)(KA().ws + WS_WINT), D}; pg8::StaticOrder S; S.init(MROWS, NU, C.G, (int)blockIdx.x);
        pg8::EpiBf16 E{(bf16*)(KA().ws + WS_U), NU, nullptr, 0, 1.0f};
        const bool odd = (C.vcu & 1) != 0;
        if (odd) { conv_range(KA(), C, CONV_W1_HOST + CONV_P4, NIT1); __syncthreads(); }
        pg8::gemm_phase<false>(C.lds, g, S, E, pg8::DenseRows{}); __syncthreads();
        if (!odd) conv_range(KA(), C, CONV_W1_HOST + CONV_P4, NIT1);
        SEAM_WORK(3, SHADOW(3)); }
    if (IN(4)) { MKCTX(C); for (int rp = 0; rp < NREP(4); ++rp) phase4(KA(), C); SEAM_WORK(4, SHADOW(4)); }

    if (IN(6)) { MKCTX(C); for (int rp = 0; rp < NREP(6); ++rp) phase6(KA(), C); SEAM_WORK(6, SHADOW(5)); }
    if (IN(7)) { MKCTX(C); for (int rp = 0; rp < NREP(7); ++rp) phase7(KA(), C); SEAM_WORK(7, SHADOW(6)); }
    if (IN(8)) { MKCTX(C); pg8::Gemm g{(const bf16*)(KA().ws + WS_Y), (const bf16*)(KA().ws + WS_WOUTT), D}; pg8::StaticOrder S; S.init(NLAT, D, C.G, (int)blockIdx.x);
        pg8::EpiBf16 E{(bf16*)(KA().ws + WS_MIX), D, nullptr, 0, 1.0f}; for (int rp = 0; rp < NREP(8); ++rp) pg8::gemm_phase<false>(C.lds, g, S, E, pg8::DenseRows{}); SEAM_WORK(8, ShadowWork{&KA(), &C, 9, -1, 0, 0, p9x}); }
    if (IN(9)) { MKCTX(C); phase9(KA(), C, IN(8), p9x); SEAM_WORK(9, ShadowWork{&KA(), &C, 0, CONV_S9, 16384, 16384}); }
    if (IN(11)) { MKCTX(C); moe_tables(KA(), C); pg8::Gemm g{(const bf16*)(KA().ws + WS_XN), (const bf16*)(KA().ws + WS_W1T), D / 2};   pg8::MoeOrder S; S.init((const LAS int*)(C.lds + TS_OFF), 8, 4, (int)blockIdx.x);
        pg8::EpiSwiglu E{KA().ws + WS_ACT, D, KA().b1, 2048}; LAS unsigned* ROWL = (LAS unsigned*)(C.lds + 131072 + 2048);
        { const int* rowtok = (const int*)(KA().ws + WS_ROWTOK); const LAS int* TSl = (const LAS int*)(C.lds + TS_OFF); const LAS int* CNl = TSl + 36;
          for (int idx = C.tid; idx < 9 * 256; idx += 512) { const int i = idx >> 8, r = idx & 255; pg8::Unit uu;
              if (S.next(i, uu)) { const int p = (uu.pm - TSl[uu.e]) * 256 + r; const int tok = p < CNl[uu.e] ? rowtok[uu.e * 16384 + p] : 0; ROWL[idx] = (unsigned)tok * 1024u; } }
          __syncthreads(); }
        pg8::GatherRows AM{ROWL};
        const bool odd = (C.vcu & 1) != 0;
        constexpr int H0 = CONV_S9 + CONV_B, NH = NIT1 + NIT2 - H0 > 0 ? NIT1 + NIT2 - H0 : 0, CONV_EXI = 5;
        const int nidw = S.nidle * 8, exi = nidw > 0 ? (CONV_EXI * nidw <= NH ? CONV_EXI : NH / nidw) : 0, hbase = NH - exi * nidw;
#pragma unroll 1
        for (int part = 0; part < 2; ++part) {
            if ((odd && part == 0) || (!odd && part == 1)) { conv_range(KA(), C, H0, H0 + hbase); __syncthreads(); }
            S.i0 = odd ? 0 : 4 * part; S.n = odd ? (part == 0 ? (1 << 30) : 0) : (part == 0 ? 4 : (1 << 30));
            pg8::gemm_phase<true>(C.lds, g, S, E, AM); __syncthreads(); }
        if (S.irank >= 0) {
            LAS float* scr = (LAS float*)(C.lds + C.wave * 16384);
#pragma unroll 1
            for (int k = 0; k < exi; ++k) conv_item(KA(), scr, C.lane, H0 + hbase + S.irank * 8 + C.wave + nidw * k); }
        SEAM_WORK(11, ShadowWork{&KA(), &C, 0, -1, 0, 0}); }
    if (IN(12)) { MKCTX(C); if (!IN(11)) moe_tables(KA(), C);     pg8::Gemm g{(const bf16*)(KA().ws + WS_ACT), (const bf16*)(KA().ws + WS_W2T), D / 2}; pg8::MoeOrder S; S.init((const LAS int*)(C.lds + TS_OFF), 4, 8, (int)blockIdx.x);
        pg8::EpiFp8 E{KA().ws + WS_Y2, D, KA().b2, D, 1.0f / (W_SCALE * ACT_SCALE)}; for (int rp = 0; rp < NREP(12); ++rp) pg8::gemm_phase<true>(C.lds, g, S, E, pg8::DenseRows{}); SEAM(12); }
    if (IN(13)) { MKCTX(C); for (int rp = 0; rp < NREP(13); ++rp) phase13(KA(), C, IN(11)); }
#undef IN
#undef KA
#undef SEAM
}

extern "C" void kernel_launch(void* const* d_in, const int* in_sizes, int n_in, void* d_out, int out_size, void* d_ws, size_t ws_size, hipStream_t stream) {
    static int grid = 0;
    if (grid == 0) {
        if (n_in != 26 || in_sizes[0] != NLAT * D || out_size != NLAT * D || ws_size < WS_END) {
            fprintf(stderr, "kernel_launch: unexpected shapes: n_in %d in0 %d out %d ws %zu (need %zu); nothing launched\n", n_in, n_in > 0 ? in_sizes[0] : -1, out_size, ws_size, (size_t)WS_END); grid = -1; return; }
        int dev = 0, cus = 0, per_cu = 0;
        if (hipGetDevice(&dev) != hipSuccess || hipDeviceGetAttribute(&cus, hipDeviceAttributeMultiprocessorCount, dev) != hipSuccess) { fprintf(stderr, "kernel_launch: device query failed\n"); grid = -1; return; }
        if (hipFuncSetAttribute((const void*)mega_fwd, hipFuncAttributeMaxDynamicSharedMemorySize, LDS_BYTES) != hipSuccess) { fprintf(stderr, "kernel_launch: hipFuncSetAttribute failed\n"); grid = -1; return; }
        if (hipOccupancyMaxActiveBlocksPerMultiprocessor(&per_cu, (const void*)mega_fwd, 512, LDS_BYTES) != hipSuccess || per_cu < 1)
            fprintf(stderr, "kernel_launch: note: occupancy query reports %d workgroups per CU\n", per_cu);
        (void)hipGetLastError();
        grid = cus;
        if (grid != 256) { fprintf(stderr, "kernel_launch: this kernel needs a 256-CU device (got %d)\n", grid); grid = -1; return; }
    }
    if (grid < 0) return;
    (void)hipMemsetAsync((char*)d_ws + WS_CTL, 0, CTL_ZERO_BYTES, stream);
    Args a{};
    const float** ap = (const float**)&a;
    for (int i = 0; i < 26; ++i) ap[i] = (const float*)d_in[i];
    a.out = (float*)d_out; a.ws = (unsigned char*)d_ws;
#if MK_PER_PHASE
    for (int p = 0; p < NPHASE; ++p) { a.ph_lo = p; a.ph_hi = p + 1; hipLaunchKernelGGL(mega_fwd, dim3(grid), dim3(512), LDS_BYTES, stream, a); }
#else
    a.ph_lo = 0; a.ph_hi = NPHASE; hipLaunchKernelGGL(mega_fwd, dim3(grid), dim3(512), LDS_BYTES, stream, a);
#endif
}
```
